# Optimizing an MI355X kernel written in HIP

```python
import jax
import jax.numpy as jnp
from jax import lax
import numpy as np

D_MODEL = 1024
BATCH = 32
SEQ = 2048
DEPTH = 2

PLE_DIM = 256
HEAD_DIM = 64
CHUNK = 128
A_HEADS = 4
A_WIDTH = A_HEADS * HEAD_DIM
B_HEADS = 6
B_WIDTH = B_HEADS * HEAD_DIM
RET_THETA = 10000.0
C_HEADS = 6
C_KV_HEADS = 2
C_GROUP = C_HEADS // C_KV_HEADS
C_WIDTH = C_HEADS * HEAD_DIM
C_KV_WIDTH = C_KV_HEADS * HEAD_DIM
WINDOW = 128
ROPE_THETA = 500000.0
ROPE_DIM = HEAD_DIM // 4
MIX_WIDTH = A_WIDTH + B_WIDTH + C_WIDTH
IN_SIZES = (A_WIDTH, A_WIDTH, B_WIDTH, B_WIDTH, B_WIDTH, B_WIDTH, C_WIDTH, C_KV_WIDTH, C_KV_WIDTH)
IN_WIDTH = 2 * A_WIDTH + 4 * B_WIDTH + C_WIDTH + 2 * C_KV_WIDTH
D_FF = ((8 * D_MODEL + 3 * 256 - 1) // (3 * 256)) * 256
EPS = 1e-6
NEG_INF = -1e30

kernel_name = 'hymba_style_gmlp_retention_swa_hybrid'


def rms_norm(x, w):
    xf = x.astype(jnp.float32)
    y = xf * lax.rsqrt(jnp.mean(xf * xf, axis=-1, keepdims=True) + EPS)
    return (y * w.astype(jnp.float32)).astype(x.dtype)


def head_norm(x):
    xf = x.astype(jnp.float32)
    mu = jnp.mean(xf, axis=-1, keepdims=True)
    var = jnp.mean(jnp.square(xf - mu), axis=-1, keepdims=True)
    return (xf - mu) * lax.rsqrt(var + EPS)


def rope(x, rot_dim, theta):
    s = x.shape[1]
    half = rot_dim // 2
    inv = 1.0 / (theta ** (jnp.arange(half, dtype=jnp.float32) / half))
    ang = jnp.arange(s, dtype=jnp.float32)[:, None] * inv[None, :]
    cos = jnp.cos(ang)[None, :, None, :]
    sin = jnp.sin(ang)[None, :, None, :]
    xr = x[..., :rot_dim].astype(jnp.float32)
    x1, x2 = xr[..., :half], xr[..., half:]
    rot = jnp.concatenate([x1 * cos - x2 * sin, x2 * cos + x1 * sin], axis=-1).astype(x.dtype)
    return jnp.concatenate([rot, x[..., rot_dim:]], axis=-1)


def split_cols(t, sizes):
    out, start = [], 0
    for s in sizes:
        out.append(t[..., start:start + s])
        start += s
    return out


def gmlp_mixer(u, v, ln_w, ln_b, w_s, b_s):
    b, s, _ = u.shape
    nc = s // CHUNK
    u = jax.nn.gelu(u)
    v = jax.nn.gelu(v)
    vn = head_norm(v.reshape(b, s, A_HEADS, HEAD_DIM)).reshape(b, s, A_WIDTH)
    vn = (vn * ln_w.astype(jnp.float32) + ln_b.astype(jnp.float32)).astype(v.dtype)
    vc = vn.reshape(b, nc, CHUNK, A_HEADS, HEAD_DIM)
    causal = jnp.tril(jnp.ones((CHUNK, CHUNK), dtype=bool))
    ws = jnp.where(causal[None], w_s, 0.0)
    mixed = jnp.einsum('hts,bcshd->bcthd', ws, vc) + b_s.T[None, None, :, :, None]
    return u * mixed.reshape(b, s, A_WIDTH)


def retention_mixer(q, k, v, g, gn_w):
    b, s, _ = q.shape
    nc = s // CHUNK
    f32 = jnp.float32
    q = rope(q.reshape(b, s, B_HEADS, HEAD_DIM), HEAD_DIM, RET_THETA).astype(f32)
    k = rope(k.reshape(b, s, B_HEADS, HEAD_DIM), HEAD_DIM, RET_THETA).astype(f32) * (HEAD_DIM ** -0.5)
    v = v.reshape(b, s, B_HEADS, HEAD_DIM).astype(f32)
    gamma = 1.0 - 2.0 ** (-5.0 - jnp.arange(B_HEADS, dtype=f32))
    log_g = jnp.log(gamma)
    idx = jnp.arange(CHUNK, dtype=f32)
    diff = idx[:, None] - idx[None, :]
    d_intra = jnp.where(diff[None] >= 0,
                        jnp.exp(jnp.maximum(diff, 0.0)[None] * log_g[:, None, None]), 0.0)
    d_to_end = jnp.exp((CHUNK - 1 - idx)[:, None] * log_g[None, :])
    d_from_start = jnp.exp((idx + 1.0)[:, None] * log_g[None, :])
    d_chunk = jnp.exp(CHUNK * log_g)
    qc = q.reshape(b, nc, CHUNK, B_HEADS, HEAD_DIM)
    kc = k.reshape(b, nc, CHUNK, B_HEADS, HEAD_DIM)
    vc = v.reshape(b, nc, CHUNK, B_HEADS, HEAD_DIM)
    sc = jnp.einsum('bcthd,bcshd->bchts', qc, kc) * d_intra[None, None]
    o_intra = jnp.einsum('bchts,bcshe->bcthe', sc, vc)
    kv = jnp.einsum('bcshd,sh,bcshe->bchde', kc, d_to_end, vc)

    def step(state, kv_c):
        return state * d_chunk[None, :, None, None] + kv_c, state

    init = jnp.zeros((b, B_HEADS, HEAD_DIM, HEAD_DIM), f32)
    _, prev = lax.scan(step, init, jnp.moveaxis(kv, 1, 0))
    prev = jnp.moveaxis(prev, 0, 1)
    o_cross = jnp.einsum('bcthd,bchde->bcthe', qc, prev) * d_from_start[None, None, :, :, None]
    o = (o_intra + o_cross).reshape(b, s, B_HEADS, HEAD_DIM)
    o = head_norm(o).reshape(b, s, B_WIDTH) * gn_w.astype(f32)
    return (jax.nn.silu(g.astype(f32)) * o).astype(g.dtype)


def swa_sink_mixer(q, k, v, sinks):
    b, s, _ = q.shape
    nc = s // CHUNK
    q = rope(q.reshape(b, s, C_HEADS, HEAD_DIM), ROPE_DIM, ROPE_THETA)
    k = rope(k.reshape(b, s, C_KV_HEADS, HEAD_DIM), ROPE_DIM, ROPE_THETA)
    v = v.reshape(b, s, C_KV_HEADS, HEAD_DIM)
    qb = q.reshape(b, nc, CHUNK, C_KV_HEADS, C_GROUP, HEAD_DIM)

    def banded(t):
        tb = t.reshape(b, nc, CHUNK, C_KV_HEADS, HEAD_DIM)
        prev = jnp.pad(tb[:, :-1], ((0, 0), (1, 0), (0, 0), (0, 0), (0, 0)))
        return jnp.concatenate([prev, tb], axis=2)

    kb, vb = banded(k), banded(v)
    sc = jnp.einsum('bcqhgd,bckhd->bchgqk', qb, kb).astype(jnp.float32) * (HEAD_DIM ** -0.5)
    qpos = jnp.arange(CHUNK)[:, None] + CHUNK
    kpos = jnp.arange(2 * CHUNK)[None, :]
    rel = qpos - kpos
    in_window = (rel >= 0) & (rel < WINDOW)
    first_pad = (jnp.arange(nc)[:, None, None] == 0) & (kpos < CHUNK)[None]
    mask = in_window[None] & ~first_pad
    sc = jnp.where(mask[None, :, None, None], sc, NEG_INF)
    sink = jnp.broadcast_to(sinks.astype(jnp.float32).reshape(1, 1, C_KV_HEADS, C_GROUP, 1, 1),
                            sc.shape[:-1] + (1,))
    probs = jax.nn.softmax(jnp.concatenate([sc, sink], axis=-1), axis=-1)[..., :-1]
    o = jnp.einsum('bchgqk,bckhd->bcqhgd', probs.astype(vb.dtype), vb)
    return o.reshape(b, s, C_WIDTH)


def setup_inputs(seed: int = 0) -> dict:
    key = jax.random.key(seed)
    ks = jax.random.split(key, 19)
    f32 = jnp.float32

    def nrm(k, shape, scale):
        return jax.random.normal(k, shape, f32) * scale

    def gain(k, shape):
        return 1.0 + 0.1 * jax.random.normal(k, shape, f32)

    return {
        'x': nrm(ks[0], (BATCH, SEQ, D_MODEL), 1.0),
        'p': nrm(ks[1], (DEPTH, BATCH, SEQ, PLE_DIM), 1.0),
        'norm_mix_pre': gain(ks[2], (DEPTH, D_MODEL)),
        'w_in': nrm(ks[3], (DEPTH, D_MODEL, IN_WIDTH), D_MODEL ** -0.5),
        'gmlp_ln_w': gain(ks[4], (DEPTH, A_WIDTH)),
        'gmlp_ln_b': nrm(ks[5], (DEPTH, A_WIDTH), 0.02),
        'gmlp_ws': nrm(ks[6], (DEPTH, A_HEADS, CHUNK, CHUNK), CHUNK ** -0.5),
        'gmlp_bs': 1.0 + nrm(ks[7], (DEPTH, A_HEADS, CHUNK), 0.1),
        'ret_gn_w': gain(ks[8], (DEPTH, B_WIDTH)),
        'attn_sinks': nrm(ks[9], (DEPTH, C_HEADS), 0.5),
        'w_out': nrm(ks[10], (DEPTH, MIX_WIDTH, D_MODEL), MIX_WIDTH ** -0.5),
        'norm_mix_post': gain(ks[11], (DEPTH, D_MODEL)),
        'norm_ffn_pre': gain(ks[12], (DEPTH, D_MODEL)),
        'w_ffn_in': nrm(ks[13], (DEPTH, D_MODEL, 2 * D_FF), D_MODEL ** -0.5),
        'w_ffn_out': nrm(ks[14], (DEPTH, D_FF, D_MODEL), D_FF ** -0.5),
        'norm_ffn_post': gain(ks[15], (DEPTH, D_MODEL)),
        'w_ple_gate': nrm(ks[16], (DEPTH, D_MODEL, D_MODEL), D_MODEL ** -0.5),
        'w_ple_proj': nrm(ks[17], (DEPTH, PLE_DIM, D_MODEL), PLE_DIM ** -0.5),
        'ple_norm': gain(ks[18], (DEPTH, D_MODEL)),
    }


def reference(x, p, norm_mix_pre, w_in, gmlp_ln_w, gmlp_ln_b, gmlp_ws, gmlp_bs, ret_gn_w,
              attn_sinks, w_out, norm_mix_post, norm_ffn_pre, w_ffn_in, w_ffn_out,
              norm_ffn_post, w_ple_gate, w_ple_proj, ple_norm):
    for i in range(DEPTH):
        h = rms_norm(x, norm_mix_pre[i])
        proj = h @ w_in[i]
        a_u, a_v, b_q, b_k, b_v, b_g, c_q, c_k, c_v = split_cols(proj, IN_SIZES)
        y_a = gmlp_mixer(a_u, a_v, gmlp_ln_w[i], gmlp_ln_b[i], gmlp_ws[i], gmlp_bs[i])
        y_b = retention_mixer(b_q, b_k, b_v, b_g, ret_gn_w[i])
        y_c = swa_sink_mixer(c_q, c_k, c_v, attn_sinks[i])
        mix = jnp.concatenate([y_a, y_b, y_c], axis=-1) @ w_out[i]
        x = x + rms_norm(mix, norm_mix_post[i])
        h = rms_norm(x, norm_ffn_pre[i])
        gate, up = split_cols(h @ w_ffn_in[i], (D_FF, D_FF))
        f = (jax.nn.silu(gate) * up) @ w_ffn_out[i]
        x = x + rms_norm(f, norm_ffn_post[i])
        ple = rms_norm(p[i] @ w_ple_proj[i], ple_norm[i])
        x = x + jax.nn.sigmoid(x @ w_ple_gate[i]) * ple
    return x
```

```cpp
#include <hip/hip_runtime.h>
#include <stdint.h>
#include <stdio.h>

constexpr int D_MODEL = 1024, BATCH = 32, SEQ = 2048, DEPTH = 2, PLE_DIM = 256, HD = 64, CHUNK = 128;
constexpr int M = BATCH * SEQ;
constexpr int IN_W = 2688, D_FF = 2816, NHEADS = 42;
constexpr int H_AU = 0, H_AV = 4, H_BQ = 8, H_BK = 14, H_BV = 20, H_BG = 26, H_CQ = 32, H_CK = 38, H_CV = 40;
constexpr float EPS = 1e-6f;
typedef unsigned short bf16_t;

__device__ __forceinline__ float bf2f(bf16_t v) { return __uint_as_float(((unsigned)v) << 16); }
__device__ __forceinline__ bf16_t f2bf(float f) { unsigned u = __float_as_uint(f); return (bf16_t)((u + 0x7fffu + ((u >> 16) & 1u)) >> 16); }
__device__ __forceinline__ float wave_sum(float v) {
#pragma unroll
    for (int o = 1; o < 64; o <<= 1) v += __shfl_xor(v, o);
    return v;
}
__device__ __forceinline__ float gelu_tanh(float x) {
    const float u = 0.7978845608028654f * (x + 0.044715f * x * x * x);
    const float t = 1.0f - 2.0f / (1.0f + __expf(2.0f * u));
    return 0.5f * x * (1.0f + t);
}
__device__ __forceinline__ float sigmoidf_(float x) { return 1.0f / (1.0f + __expf(-x)); }

__constant__ double c_inv_ret[32] = {1.0, 0.7498942093324559, 0.5623413251903491, 0.4216965034285822, 0.31622776601683794, 0.23713737056616552, 0.1778279410038923, 0.1333521432163324, 0.1, 0.07498942093324558, 0.05623413251903491, 0.042169650342858224, 0.03162277660168379, 0.023713737056616554, 0.01778279410038923, 0.01333521432163324, 0.01, 0.007498942093324558, 0.005623413251903491, 0.004216965034285823, 0.0031622776601683794, 0.0023713737056616554, 0.0017782794100389228, 0.001333521432163324, 0.001, 0.0007498942093324559, 0.0005623413251903491, 0.00042169650342858224, 0.00031622776601683794, 0.00023713737056616554, 0.00017782794100389227, 0.0001333521432163324};
__constant__ double c_inv_swa[8] = {1.0, 0.19392274474868576, 0.03760603093086393, 0.007292664737217109, 0.001414213562373095, 0.0002742481756762073, 5.318295896944988e-05, 1.031338537721246e-05};
__constant__ float c_log2g[6] = {-0.04580368961312479f, -0.02272007650008353f, -0.011315313227834146f, -0.005646563141142063f, -0.0028205190623786626f, -0.0014095702546713536f};

constexpr size_t MiB = 1u << 20;
constexpr size_t WS_CTL = 0;
constexpr size_t WS_TAB = 1 * MiB;
constexpr size_t WS_XB = 64 * MiB;
constexpr size_t WS_BIG = 192 * MiB;
constexpr size_t WS_Y = 544 * MiB;
constexpr size_t WS_MIX = 672 * MiB;
constexpr size_t WS_PP = 800 * MiB;
constexpr size_t WS_END = 928 * MiB;
constexpr int TAB_RC = 0, TAB_RS = 2048 * 32, TAB_SC = 2 * 2048 * 32, TAB_SS = 2 * 2048 * 32 + 2048 * 8;

namespace ref {
__global__ void k_tables(float* tab) {
    const int i = blockIdx.x * blockDim.x + threadIdx.x;
    if (i < 2048 * 32) {
        const int pos = i >> 5, j = i & 31;
        const double rev = (double)pos * c_inv_ret[j] * 0.15915494309189535;
        const float fr = (float)(rev - floor(rev));
        tab[TAB_RC + i] = __builtin_amdgcn_cosf(fr); tab[TAB_RS + i] = __builtin_amdgcn_sinf(fr);
    }
    if (i < 2048 * 8) {
        const int pos = i >> 3, j = i & 7;
        const double rev = (double)pos * c_inv_swa[j] * 0.15915494309189535;
        const float fr = (float)(rev - floor(rev));
        tab[TAB_SC + i] = __builtin_amdgcn_cosf(fr); tab[TAB_SS + i] = __builtin_amdgcn_sinf(fr);
    }
}
__global__ void __launch_bounds__(256) k_rmsnorm_bf16(const float* __restrict__ x, const float* __restrict__ w, bf16_t* __restrict__ out, int mode) {
    const int row = blockIdx.x * 4 + (threadIdx.x >> 6), lane = threadIdx.x & 63;
    const float* xr = x + (size_t)row * D_MODEL;
    float v[16]; float ss = 0.f;
#pragma unroll
    for (int j = 0; j < 16; ++j) { v[j] = xr[lane + 64 * j]; ss += v[j] * v[j]; }
    ss = wave_sum(ss);
    const float rstd = mode == 0 ? rsqrtf(ss * (1.0f / D_MODEL) + EPS) : 1.0f;
#pragma unroll
    for (int j = 0; j < 16; ++j) { const float g = mode == 0 ? w[lane + 64 * j] : 1.0f; out[(size_t)row * D_MODEL + lane + 64 * j] = f2bf(v[j] * rstd * g); }
}
template <typename TA, bool DUAL>
__global__ void __launch_bounds__(256) k_gemm(const TA* __restrict__ A, int lda, const float* __restrict__ W, int ldw, bf16_t* __restrict__ C, int ldc, int K, int w2off) {
    __shared__ float As[16][132];
    __shared__ float Bs[16][132];
    __shared__ float Bs2[DUAL ? 16 : 1][132];
    const int tid = threadIdx.x, tx = tid & 15, ty = tid >> 4;
    const int m0 = blockIdx.y * 128, n0 = blockIdx.x * 128;
    float acc[8][8], acc2[DUAL ? 8 : 1][8];
#pragma unroll
    for (int i = 0; i < 8; ++i)
#pragma unroll
        for (int j = 0; j < 8; ++j) { acc[i][j] = 0.f; if (DUAL) acc2[i][j] = 0.f; }
    const int ar = tid >> 1, ak = (tid & 1) * 8;
    const int bk = tid >> 4, bc = (tid & 15) * 8;
    for (int k0 = 0; k0 < K; k0 += 16) {
        float av[8];
        if constexpr (sizeof(TA) == 2) {
            const uint4 raw = *(const uint4*)(A + (size_t)(m0 + ar) * lda + k0 + ak);
            const unsigned r4[4] = {raw.x, raw.y, raw.z, raw.w};
#pragma unroll
            for (int j = 0; j < 4; ++j) { av[2 * j] = __uint_as_float(r4[j] << 16); av[2 * j + 1] = __uint_as_float(r4[j] & 0xffff0000u); }
        } else {
            const float4 a0 = *(const float4*)(A + (size_t)(m0 + ar) * lda + k0 + ak), a1 = *(const float4*)(A + (size_t)(m0 + ar) * lda + k0 + ak + 4);
            av[0] = a0.x; av[1] = a0.y; av[2] = a0.z; av[3] = a0.w; av[4] = a1.x; av[5] = a1.y; av[6] = a1.z; av[7] = a1.w;
        }
        const float4 b0 = *(const float4*)(W + (size_t)(k0 + bk) * ldw + n0 + bc), b1 = *(const float4*)(W + (size_t)(k0 + bk) * ldw + n0 + bc + 4);
        float4 c0, c1;
        if (DUAL) { c0 = *(const float4*)(W + (size_t)(k0 + bk) * ldw + w2off + n0 + bc); c1 = *(const float4*)(W + (size_t)(k0 + bk) * ldw + w2off + n0 + bc + 4); }
        __syncthreads();
#pragma unroll
        for (int j = 0; j < 8; ++j) As[ak + j][ar] = av[j];
        *(float4*)&Bs[bk][bc] = b0; *(float4*)&Bs[bk][bc + 4] = b1;
        if (DUAL) { *(float4*)&Bs2[bk][bc] = c0; *(float4*)&Bs2[bk][bc + 4] = c1; }
        __syncthreads();
#pragma unroll
        for (int k = 0; k < 16; ++k) {
            float a[8], b[8], b2[8];
            *(float4*)&a[0] = *(const float4*)&As[k][ty * 8]; *(float4*)&a[4] = *(const float4*)&As[k][ty * 8 + 4];
            *(float4*)&b[0] = *(const float4*)&Bs[k][tx * 8]; *(float4*)&b[4] = *(const float4*)&Bs[k][tx * 8 + 4];
            if (DUAL) { *(float4*)&b2[0] = *(const float4*)&Bs2[k][tx * 8]; *(float4*)&b2[4] = *(const float4*)&Bs2[k][tx * 8 + 4]; }
#pragma unroll
            for (int i = 0; i < 8; ++i)
#pragma unroll
                for (int j = 0; j < 8; ++j) { acc[i][j] += a[i] * b[j]; if (DUAL) acc2[i][j] += a[i] * b2[j]; }
        }
    }
#pragma unroll
    for (int i = 0; i < 8; ++i) {
        bf16_t o[8];
#pragma unroll
        for (int j = 0; j < 8; ++j) { float v = acc[i][j]; if (DUAL) v = v * sigmoidf_(v) * acc2[i][j]; o[j] = f2bf(v); }
        uint4 pk; pk.x = o[0] | ((unsigned)o[1] << 16); pk.y = o[2] | ((unsigned)o[3] << 16); pk.z = o[4] | ((unsigned)o[5] << 16); pk.w = o[6] | ((unsigned)o[7] << 16);
        *(uint4*)(C + (size_t)(m0 + ty * 8 + i) * ldc + n0 + tx * 8) = pk;
    }
}
__global__ void __launch_bounds__(256) k_post_proj(bf16_t* __restrict__ P, const float* __restrict__ ln_w, const float* __restrict__ ln_b, const float* __restrict__ tab) {
    const int row = blockIdx.x * 4 + (threadIdx.x >> 6), lane = threadIdx.x & 63, pos = row & (SEQ - 1);
    bf16_t* pr = P + (size_t)row * IN_W;
    for (int h = 0; h < NHEADS; ++h) {
        float v = bf2f(pr[h * 64 + lane]);
        if (h < H_AV) v = gelu_tanh(v);
        else if (h < H_BQ) {
            v = gelu_tanh(v);
            const float mu = wave_sum(v) * (1.0f / 64.0f); const float d = v - mu; const float var = wave_sum(d * d) * (1.0f / 64.0f);
            v = d * rsqrtf(var + EPS) * ln_w[(h - H_AV) * 64 + lane] + ln_b[(h - H_AV) * 64 + lane];
        } else if (h < H_BV) {
            const float o = __shfl_xor(v, 32); const int j = lane & 31;
            const float c = tab[TAB_RC + pos * 32 + j], s = tab[TAB_RS + pos * 32 + j];
            v = lane < 32 ? v * c - o * s : v * c + o * s;
            if (h >= H_BK) v *= 0.125f;
        } else if (h < H_BG) {
        } else if (h < H_CQ) v = v * sigmoidf_(v);
        else if (h < H_CV) {
            const float o = __shfl_xor(v, 8); const int j = lane & 7;
            const float c = tab[TAB_SC + pos * 8 + j], s = tab[TAB_SS + pos * 8 + j];
            if (lane < 8) v = v * c - o * s; else if (lane < 16) v = v * c + o * s;
        }
        pr[h * 64 + lane] = f2bf(v);
    }
}
__global__ void __launch_bounds__(256) k_gmlp(const bf16_t* __restrict__ P, const float* __restrict__ ws, const float* __restrict__ bs, bf16_t* __restrict__ Y) {
    const int h = blockIdx.x & 3, bc = blockIdx.x >> 2; const size_t row0 = (size_t)bc * CHUNK;
    const int d = threadIdx.x & 63, w = threadIdx.x >> 6;
    for (int t = w; t < CHUNK; t += 4) {
        float acc = 0.f;
        for (int s = 0; s <= t; ++s) acc += ws[(h * CHUNK + t) * CHUNK + s] * bf2f(P[(row0 + s) * IN_W + (H_AV + h) * 64 + d]);
        const float u = bf2f(P[(row0 + t) * IN_W + (H_AU + h) * 64 + d]);
        Y[(row0 + t) * D_MODEL + h * 64 + d] = f2bf(u * (acc + bs[h * CHUNK + t]));
    }
}
__global__ void __launch_bounds__(256) k_ret(const bf16_t* __restrict__ P, const float* __restrict__ gn_w, bf16_t* __restrict__ Y) {
    const int lane = threadIdx.x & 63, w = threadIdx.x >> 6;
    const int tq = blockIdx.x & (SEQ / 4 - 1), h = (blockIdx.x / (SEQ / 4)) % 6, b = blockIdx.x / (SEQ / 4 * 6);
    const int t = tq * 4 + w; const size_t rowb = (size_t)b * SEQ;
    const float q = bf2f(P[(rowb + t) * IN_W + (H_BQ + h) * 64 + lane]);
    const float lg = c_log2g[h];
    float acc = 0.f;
    for (int s = 0; s <= t; ++s) {
        const float k = bf2f(P[(rowb + s) * IN_W + (H_BK + h) * 64 + lane]), v = bf2f(P[(rowb + s) * IN_W + (H_BV + h) * 64 + lane]);
        const float dot = wave_sum(q * k);
        acc += exp2f((float)(t - s) * lg) * dot * v;
    }
    const float mu = wave_sum(acc) * (1.0f / 64.0f); const float dd = acc - mu; const float var = wave_sum(dd * dd) * (1.0f / 64.0f);
    const float o = dd * rsqrtf(var + EPS) * gn_w[h * 64 + lane];
    const float g = bf2f(P[(rowb + t) * IN_W + (H_BG + h) * 64 + lane]);
    Y[(rowb + t) * D_MODEL + 256 + h * 64 + lane] = f2bf(g * o);
}
__global__ void __launch_bounds__(256) k_swa(const bf16_t* __restrict__ P, const float* __restrict__ sinks, bf16_t* __restrict__ Y) {
    const int lane = threadIdx.x & 63, w = threadIdx.x >> 6;
    const int tq = blockIdx.x & (SEQ / 4 - 1), qh = (blockIdx.x / (SEQ / 4)) % 6, b = blockIdx.x / (SEQ / 4 * 6);
    const int t = tq * 4 + w, hk = qh / 3; const size_t rowb = (size_t)b * SEQ;
    const float q = bf2f(P[(rowb + t) * IN_W + (H_CQ + qh) * 64 + lane]);
    float m = sinks[qh], l = 1.0f, acc = 0.f;
    const int s0 = t - 127 < 0 ? 0 : t - 127;
    for (int s = s0; s <= t; ++s) {
        const float k = bf2f(P[(rowb + s) * IN_W + (H_CK + hk) * 64 + lane]), v = bf2f(P[(rowb + s) * IN_W + (H_CV + hk) * 64 + lane]);
        const float sc = wave_sum(q * k) * 0.125f;
        const float mn = fmaxf(m, sc), a = __expf(m - mn), e = __expf(sc - mn);
        l = l * a + e; acc = acc * a + e * v; m = mn;
    }
    Y[(rowb + t) * D_MODEL + 640 + qh * 64 + lane] = f2bf(acc / l);
}
__global__ void __launch_bounds__(256) k_resid_rmsnorm(float* __restrict__ x, const bf16_t* __restrict__ T, const float* __restrict__ w) {
    const int row = blockIdx.x * 4 + (threadIdx.x >> 6), lane = threadIdx.x & 63;
    float v[16]; float ss = 0.f;
#pragma unroll
    for (int j = 0; j < 16; ++j) { v[j] = bf2f(T[(size_t)row * D_MODEL + lane + 64 * j]); ss += v[j] * v[j]; }
    const float rstd = rsqrtf(wave_sum(ss) * (1.0f / D_MODEL) + EPS);
#pragma unroll
    for (int j = 0; j < 16; ++j) x[(size_t)row * D_MODEL + lane + 64 * j] += v[j] * rstd * w[lane + 64 * j];
}
__global__ void __launch_bounds__(256) k_ple_update(float* __restrict__ x, const bf16_t* __restrict__ G, const bf16_t* __restrict__ PP, const float* __restrict__ w) {
    const int row = blockIdx.x * 4 + (threadIdx.x >> 6), lane = threadIdx.x & 63;
    float v[16]; float ss = 0.f;
#pragma unroll
    for (int j = 0; j < 16; ++j) { v[j] = bf2f(PP[(size_t)row * D_MODEL + lane + 64 * j]); ss += v[j] * v[j]; }
    const float rstd = rsqrtf(wave_sum(ss) * (1.0f / D_MODEL) + EPS);
#pragma unroll
    for (int j = 0; j < 16; ++j) { const size_t i = (size_t)row * D_MODEL + lane + 64 * j; x[i] += sigmoidf_(bf2f(G[i])) * v[j] * rstd * w[lane + 64 * j]; }
}
}

extern "C" void kernel_launch(void* const* d_in, const int* in_sizes, int n_in, void* d_out, int out_size, void* d_ws, size_t ws_size, hipStream_t stream) {
    if (n_in != 19 || out_size != M * D_MODEL || ws_size < WS_END) { fprintf(stderr, "kernel_launch: unexpected shapes (n_in %d out %d ws %zu)\n", n_in, out_size, ws_size); return; }
    const float* x_in = (const float*)d_in[0]; const float* p = (const float*)d_in[1];
    const float* norm_mix_pre = (const float*)d_in[2]; const float* w_in = (const float*)d_in[3];
    const float* gmlp_ln_w = (const float*)d_in[4]; const float* gmlp_ln_b = (const float*)d_in[5];
    const float* gmlp_ws = (const float*)d_in[6]; const float* gmlp_bs = (const float*)d_in[7];
    const float* ret_gn_w = (const float*)d_in[8]; const float* attn_sinks = (const float*)d_in[9];
    const float* w_out = (const float*)d_in[10]; const float* norm_mix_post = (const float*)d_in[11];
    const float* norm_ffn_pre = (const float*)d_in[12]; const float* w_ffn_in = (const float*)d_in[13];
    const float* w_ffn_out = (const float*)d_in[14]; const float* norm_ffn_post = (const float*)d_in[15];
    const float* w_ple_gate = (const float*)d_in[16]; const float* w_ple_proj = (const float*)d_in[17]; const float* ple_norm = (const float*)d_in[18];
    unsigned char* ws = (unsigned char*)d_ws;
    float* x = (float*)d_out; float* tab = (float*)(ws + WS_TAB);
    bf16_t* XB = (bf16_t*)(ws + WS_XB); bf16_t* BIG = (bf16_t*)(ws + WS_BIG); bf16_t* Y = (bf16_t*)(ws + WS_Y); bf16_t* MIX = (bf16_t*)(ws + WS_MIX); bf16_t* PP = (bf16_t*)(ws + WS_PP);
    hipMemcpyAsync(x, x_in, (size_t)M * D_MODEL * 4, hipMemcpyDeviceToDevice, stream);
    ref::k_tables<<<2048 * 32 / 256, 256, 0, stream>>>(tab);
    for (int i = 0; i < DEPTH; ++i) {
        ref::k_rmsnorm_bf16<<<M / 4, 256, 0, stream>>>(x, norm_mix_pre + i * D_MODEL, XB, 0);
        ref::k_gemm<bf16_t, false><<<dim3(IN_W / 128, M / 128), 256, 0, stream>>>(XB, D_MODEL, w_in + (size_t)i * D_MODEL * IN_W, IN_W, BIG, IN_W, D_MODEL, 0);
        ref::k_post_proj<<<M / 4, 256, 0, stream>>>(BIG, gmlp_ln_w + i * 256, gmlp_ln_b + i * 256, tab);
        ref::k_gmlp<<<BATCH * 16 * 4, 256, 0, stream>>>(BIG, gmlp_ws + (size_t)i * 4 * CHUNK * CHUNK, gmlp_bs + i * 4 * CHUNK, Y);
        ref::k_ret<<<BATCH * 6 * (SEQ / 4), 256, 0, stream>>>(BIG, ret_gn_w + i * 384, Y);
        ref::k_swa<<<BATCH * 6 * (SEQ / 4), 256, 0, stream>>>(BIG, attn_sinks + i * 6, Y);
        ref::k_gemm<bf16_t, false><<<dim3(D_MODEL / 128, M / 128), 256, 0, stream>>>(Y, D_MODEL, w_out + (size_t)i * D_MODEL * D_MODEL, D_MODEL, MIX, D_MODEL, D_MODEL, 0);
        ref::k_resid_rmsnorm<<<M / 4, 256, 0, stream>>>(x, MIX, norm_mix_post + i * D_MODEL);
        ref::k_rmsnorm_bf16<<<M / 4, 256, 0, stream>>>(x, norm_ffn_pre + i * D_MODEL, XB, 0);
        ref::k_gemm<bf16_t, true><<<dim3(D_FF / 128, M / 128), 256, 0, stream>>>(XB, D_MODEL, w_ffn_in + (size_t)i * D_MODEL * 2 * D_FF, 2 * D_FF, BIG, D_FF, D_MODEL, D_FF);
        ref::k_gemm<bf16_t, false><<<dim3(D_MODEL / 128, M / 128), 256, 0, stream>>>(BIG, D_FF, w_ffn_out + (size_t)i * D_FF * D_MODEL, D_MODEL, Y, D_MODEL, D_FF, 0);
        ref::k_resid_rmsnorm<<<M / 4, 256, 0, stream>>>(x, Y, norm_ffn_post + i * D_MODEL);
        ref::k_gemm<float, false><<<dim3(D_MODEL / 128, M / 128), 256, 0, stream>>>(p + (size_t)i * M * PLE_DIM, PLE_DIM, w_ple_proj + (size_t)i * PLE_DIM * D_MODEL, D_MODEL, PP, D_MODEL, PLE_DIM, 0);
        ref::k_rmsnorm_bf16<<<M / 4, 256, 0, stream>>>(x, nullptr, XB, 1);
        ref::k_gemm<bf16_t, false><<<dim3(D_MODEL / 128, M / 128), 256, 0, stream>>>(XB, D_MODEL, w_ple_gate + (size_t)i * D_MODEL * D_MODEL, D_MODEL, MIX, D_MODEL, D_MODEL, 0);
        ref::k_ple_update<<<M / 4, 256, 0, stream>>>(x, MIX, PP, ple_norm + i * D_MODEL);
    }
}
```

```cpp
#include <hip/hip_runtime.h>
#include <stdint.h>
#include <stdio.h>

constexpr int D_MODEL = 1024, BATCH = 32, SEQ = 2048, DEPTH = 2, PLE_DIM = 256, HD = 64, CHUNK = 128;
constexpr int M = BATCH * SEQ;
constexpr int IN_W = 2688, D_FF = 2816, NHEADS = 42;
constexpr int H_AU = 0, H_AV = 4, H_BQ = 8, H_BK = 14, H_BV = 20, H_BG = 26, H_CQ = 32, H_CK = 38, H_CV = 40;
constexpr float EPS = 1e-6f;
typedef unsigned short bf16_t;

__device__ __forceinline__ float bf2f(bf16_t v) { return __uint_as_float(((unsigned)v) << 16); }
__device__ __forceinline__ bf16_t f2bf(float f) { unsigned u = __float_as_uint(f); return (bf16_t)((u + 0x7fffu + ((u >> 16) & 1u)) >> 16); }
__device__ __forceinline__ float shx(float v, int mask, int lane) { return __int_as_float(__builtin_amdgcn_ds_bpermute((lane ^ mask) << 2, __float_as_int(v))); }
__device__ __forceinline__ float wave_sum(float v) {
#pragma unroll
    for (int o = 1; o < 64; o <<= 1) v += __shfl_xor(v, o);
    return v;
}
constexpr float LOG2E_ = 1.4426950408889634f;

__constant__ double c_inv_ret[32] = {1.0, 0.7498942093324559, 0.5623413251903491, 0.4216965034285822, 0.31622776601683794, 0.23713737056616552, 0.1778279410038923, 0.1333521432163324, 0.1, 0.07498942093324558, 0.05623413251903491, 0.042169650342858224, 0.03162277660168379, 0.023713737056616554, 0.01778279410038923, 0.01333521432163324, 0.01, 0.007498942093324558, 0.005623413251903491, 0.004216965034285823, 0.0031622776601683794, 0.0023713737056616554, 0.0017782794100389228, 0.001333521432163324, 0.001, 0.0007498942093324559, 0.0005623413251903491, 0.00042169650342858224, 0.00031622776601683794, 0.00023713737056616554, 0.00017782794100389227, 0.0001333521432163324};
__constant__ double c_inv_swa[8] = {1.0, 0.19392274474868576, 0.03760603093086393, 0.007292664737217109, 0.001414213562373095, 0.0002742481756762073, 5.318295896944988e-05, 1.031338537721246e-05};
__constant__ float c_log2g[6] = {-0.04580368961312479f, -0.02272007650008353f, -0.011315313227834146f, -0.005646563141142063f, -0.0028205190623786626f, -0.0014095702546713536f};

constexpr size_t MiB = 1u << 20;
constexpr size_t WS_CTL = 0, CTL_ZERO_BYTES = 7 * MiB;
constexpr size_t WS_STAT = 1 * MiB;
constexpr size_t WS_TAB = 7 * MiB;
constexpr size_t WS_WM = 7 * MiB + 768 * 1024;
constexpr size_t WS_W = 8 * MiB;
constexpr size_t WS_XB0 = 64 * MiB;
constexpr size_t WS_BIG = 192 * MiB;
constexpr size_t WS_Y = 544 * MiB;
constexpr size_t WS_MIX = 672 * MiB;
constexpr size_t WS_XB1 = 800 * MiB;
constexpr size_t WS_PB = 928 * MiB;
constexpr size_t WS_END = 992 * MiB;
constexpr int TAB_RC = 0, TAB_RS = 2048 * 32, TAB_SC = 2 * 2048 * 32, TAB_SS = 2 * 2048 * 32 + 2048 * 8;


namespace pg8 {
#define PG8_LAS __attribute__((address_space(3)))
typedef unsigned short bf16_t;
typedef short bf16x8 __attribute__((ext_vector_type(8)));
typedef float f32x4 __attribute__((ext_vector_type(4)));
typedef unsigned u32x4 __attribute__((ext_vector_type(4)));
constexpr int BM = 256, BK = 64, HALF = 128, HTB = HALF * BK * 2  , STAGE_BYTES = 8 * HTB, NXCD = 8, WGM = 8;

__host__ __device__ __forceinline__ int lds_byte(int r, int c) { const int st = (r >> 4) * 2 + (c >> 5), rr = r & 15, cc = c & 31, ob = rr * 64 + cc * 2; return st * 1024 + (ob ^ (((ob >> 9) & 1) << 5)); }
__host__ __device__ __forceinline__ void stage_rc(int b, int& R, int& C) { const int st = b / 1024, sb = b % 1024, swz = sb ^ (((sb >> 9) & 1) << 5); R = (st >> 1) * 16 + swz / 64; C = (st & 1) * 32 + (swz % 64) / 2; }
__host__ __device__ __forceinline__ int perm32(int rho) { const int n = rho >> 4, i = rho & 15; return 8 * (i >> 2) + 4 * n + (i & 3); }

struct Unit { int pm, pn; };
struct Gemm { const bf16_t* A; const bf16_t* Bt; int M, N, K; };

struct StaticOrder {
    int nM, nN, nwg, G, c;
    __host__ __device__ void init(int M, int N, int G_, int c_) { nM = M / BM; nN = N / BM; nwg = nM * nN; G = G_; c = c_; }
    __host__ __device__ bool next(int i, Unit& u) const {
        const long L = (long)i * G + c; if (L >= nwg) return false;
        int wgid = (int)L; { const int q = nwg / NXCD, r = nwg % NXCD, xcd = wgid % NXCD, off = wgid / NXCD; wgid = (xcd < r ? xcd * (q + 1) : r * (q + 1) + (xcd - r) * q) + off; }
        const int nig = WGM * nN, gid = wgid / nig, fm = gid * WGM, gsz = (nM - fm) < WGM ? (nM - fm) : WGM;
        u.pm = fm + ((wgid % nig) % gsz); u.pn = (wgid % nig) / gsz; return true;
    }
    __device__ __forceinline__ void a_ready(const Unit&) const {}
    __device__ __forceinline__ void done(const Unit&) const {}
};

typedef float f32x2_cv __attribute__((ext_vector_type(2))); typedef __bf16 bf16x2_cv __attribute__((ext_vector_type(2)));
__device__ __forceinline__ unsigned cvt_pk_bf16(float lo, float hi) { const f32x2_cv v = {lo, hi}; const bf16x2_cv b = __builtin_convertvector(v, bf16x2_cv); return __builtin_bit_cast(unsigned, b); }
__device__ __forceinline__ int pg8_tid(int wave0) {
    unsigned ones = ~0u; asm volatile("" : "+s"(ones));
    return wave0 * 64 + (int)__builtin_amdgcn_mbcnt_hi(ones, __builtin_amdgcn_mbcnt_lo(ones, 0u));
}
template <class Epi, class Sched, bool ALIGN_EPI = false, bool SP2 = false, int KREP = 1>
__device__ __forceinline__ void gemm_phase(PG8_LAS unsigned char* lds, const Gemm g, const Sched& S, const Epi& E, int wave0) {
    const int tid = pg8_tid(wave0);
    const int wid = __builtin_amdgcn_readfirstlane(tid >> 6), lane = tid & 63, wr = wid >> 2, wc = wid & 3, fr = lane & 15, fq = lane >> 4;
    const int K = g.K, nt = K / BK;
    unsigned voffA[2], voffB[2];
#pragma unroll
    for (int i = 0; i < 2; ++i) { int R, C; stage_rc(tid * 16 + i * 8192, R, C); const int Rb = Epi::PERM ? ((R & ~31) + perm32(R & 31)) : R;
        voffA[i] = (unsigned)(R * K + C) * 2u; voffB[i] = (unsigned)(Rb * K + C) * 2u; }
    const size_t kstep = (size_t)(BK * 2);
    const size_t hstep = (size_t)HALF * K * 2;
    const size_t tstep = 2 * hstep;
    const unsigned ldsw = (unsigned)wid * 1024u;
    const int aoff = lds_byte(wr * 64 + fr, fq * 8), boff = lds_byte(wc * 32 + fr, fq * 8);
#define PG8_SA(b, h) (((b) * 2 + (h)) * HTB)
#define PG8_SB(b, h) ((4 + (b) * 2 + (h)) * HTB)
#define PG8_STAGE(bufoff, gbase, voff) do { _Pragma("unroll") for (int _i = 0; _i < 2; ++_i) \
        __builtin_amdgcn_global_load_lds((const unsigned*)((const char*)(gbase) + (voff)[_i]), (PG8_LAS unsigned*)(lds + (bufoff) + ldsw + _i * 8192), 16, 0, 0); } while (0)
#define PG8_LDA(dst, b, h) do { _Pragma("unroll") for (int m = 0; m < 4; ++m) _Pragma("unroll") for (int k = 0; k < 2; ++k) dst[m][k] = *(const PG8_LAS bf16x8*)(lds + PG8_SA(b, h) + aoff + m * 2048 + k * 1024); } while (0)
#define PG8_LDB(dst, b, h) do { _Pragma("unroll") for (int n = 0; n < 2; ++n) _Pragma("unroll") for (int k = 0; k < 2; ++k) dst[n][k] = *(const PG8_LAS bf16x8*)(lds + PG8_SB(b, h) + boff + n * 2048 + k * 1024); } while (0)
#define PG8_MMA(ai, bj, At, Bt) do { __builtin_amdgcn_s_setprio(1); _Pragma("unroll") for (int m = 0; m < 4; ++m) _Pragma("unroll") for (int n = 0; n < 2; ++n) _Pragma("unroll") for (int k = 0; k < 2; ++k) \
        acc[ai][bj][m][n] = __builtin_amdgcn_mfma_f32_16x16x32_bf16(Bt[n][k], At[m][k], acc[ai][bj][m][n], 0, 0, 0); __builtin_amdgcn_s_setprio(0); } while (0)
#define PG8_WAIT_V(n) asm volatile("s_waitcnt vmcnt(" #n ")" ::: "memory")
#define PG8_WAIT_L(n) asm volatile("s_waitcnt lgkmcnt(" #n ")" ::: "memory")
#define PG8_BAR __builtin_amdgcn_s_barrier()
#define PG8_SCHED __builtin_amdgcn_sched_barrier(0)
    Unit cur, nxt; int ui = 0;
    if (!S.next(0, cur)) return;
    f32x4 acc[2][2][4][2];
#pragma unroll
    for (int a = 0; a < 2; ++a)
#pragma unroll
        for (int b = 0; b < 2; ++b)
#pragma unroll
            for (int m = 0; m < 4; ++m)
#pragma unroll
                for (int n = 0; n < 2; ++n) acc[a][b][m][n] = (f32x4){0.f, 0.f, 0.f, 0.f};
    bf16x8 At[4][2], B0[2][2], B1[2][2];
    const char* cA = (const char*)g.A + (size_t)cur.pm * tstep; const char* cB = (const char*)g.Bt + (size_t)cur.pn * tstep;
    S.a_ready(cur);
    if constexpr (SP2) {
        PG8_STAGE(PG8_SB(0, 0), cB, voffB); PG8_STAGE(PG8_SB(0, 1), cB + hstep, voffB); PG8_STAGE(PG8_SA(0, 0), cA, voffA); PG8_STAGE(PG8_SA(0, 1), cA + hstep, voffA);
        if (wr == 1) PG8_BAR;
        PG8_WAIT_V(2); PG8_BAR;
        PG8_STAGE(PG8_SB(1, 0), cB + kstep, voffB); PG8_STAGE(PG8_SA(1, 0), cA + kstep, voffA); PG8_STAGE(PG8_SB(1, 1), cB + hstep + kstep, voffB);
        PG8_WAIT_V(6); PG8_BAR;
    } else {
        PG8_STAGE(PG8_SB(0, 0), cB, voffB); PG8_STAGE(PG8_SA(0, 0), cA, voffA); PG8_STAGE(PG8_SB(0, 1), cB + hstep, voffB); PG8_STAGE(PG8_SA(0, 1), cA + hstep, voffA);
        if (wr == 1) PG8_BAR;
        PG8_WAIT_V(4); PG8_BAR;
        PG8_STAGE(PG8_SB(1, 0), cB + kstep, voffB); PG8_STAGE(PG8_SA(1, 0), cA + kstep, voffA); PG8_STAGE(PG8_SB(1, 1), cB + hstep + kstep, voffB);
        PG8_WAIT_V(6); PG8_BAR;
    }
    for (;;) {
        const bool has_next = S.next(ui + 1, nxt);
        const char* nA = has_next ? (const char*)g.A + (size_t)nxt.pm * tstep : cA; const char* nB = has_next ? (const char*)g.Bt + (size_t)nxt.pn * tstep : cB;
        for (int t = 0; t < nt * KREP; t += 2) {
            const bool last = (t == nt * KREP - 2);
            const int t1 = KREP > 1 ? (t + 1) % nt : t + 1, t2 = KREP > 1 ? (t + 2) % nt : t + 2;
            const char* a1 = cA + (size_t)t1 * kstep;
            const char* a2 = last ? nA : cA + (size_t)t2 * kstep; const char* b2 = last ? nB : cB + (size_t)t2 * kstep;
            const char* a3 = a2 + kstep; const char* b3 = b2 + kstep;
            if (last && has_next) S.a_ready(nxt);
            if constexpr (SP2) {
            PG8_LDB(B0, 0, 0); PG8_LDB(B1, 0, 1); PG8_SCHED; PG8_LDA(At, 0, 0); PG8_STAGE(PG8_SA(1, 1), a1 + hstep, voffA);
            PG8_WAIT_V(8); PG8_WAIT_L(0); PG8_BAR; PG8_MMA(0, 0, At, B0); PG8_MMA(0, 1, At, B1); PG8_BAR; PG8_SCHED;
            PG8_LDA(At, 0, 1); PG8_STAGE(PG8_SB(0, 0), b2, voffB); PG8_STAGE(PG8_SB(0, 1), b2 + hstep, voffB); PG8_STAGE(PG8_SA(0, 0), a2, voffA);
            PG8_WAIT_V(8); PG8_WAIT_L(0); PG8_BAR; PG8_MMA(1, 0, At, B0); PG8_MMA(1, 1, At, B1); PG8_BAR; PG8_SCHED;
            PG8_LDB(B0, 1, 0); PG8_LDB(B1, 1, 1); PG8_SCHED; PG8_LDA(At, 1, 0); PG8_STAGE(PG8_SA(0, 1), a2 + hstep, voffA);
            PG8_WAIT_V(8); PG8_WAIT_L(0); PG8_BAR; PG8_MMA(0, 0, At, B0); PG8_MMA(0, 1, At, B1); PG8_BAR; PG8_SCHED;
            PG8_LDA(At, 1, 1); PG8_STAGE(PG8_SB(1, 0), b3, voffB); PG8_STAGE(PG8_SB(1, 1), b3 + hstep, voffB); PG8_STAGE(PG8_SA(1, 0), a3, voffA);
            PG8_WAIT_V(8); PG8_WAIT_L(0); PG8_BAR; PG8_MMA(1, 0, At, B0); PG8_MMA(1, 1, At, B1); PG8_BAR; PG8_SCHED;
            } else {
            PG8_LDB(B0, 0, 0); PG8_SCHED; PG8_LDA(At, 0, 0); PG8_STAGE(PG8_SA(1, 1), a1 + hstep, voffA);
            PG8_WAIT_L(8); PG8_BAR; PG8_WAIT_L(0); PG8_MMA(0, 0, At, B0); PG8_BAR; PG8_SCHED;
            PG8_LDB(B1, 0, 1); PG8_STAGE(PG8_SB(0, 0), b2, voffB);
            PG8_BAR; PG8_WAIT_L(0); PG8_MMA(0, 1, At, B1); PG8_BAR;
            PG8_LDA(At, 0, 1); PG8_STAGE(PG8_SA(0, 0), a2, voffA);
            PG8_BAR; PG8_WAIT_L(0); PG8_MMA(1, 0, At, B0); PG8_BAR; PG8_SCHED;
            PG8_STAGE(PG8_SB(0, 1), b2 + hstep, voffB);
            PG8_WAIT_V(6); PG8_BAR; PG8_MMA(1, 1, At, B1); PG8_BAR;
            PG8_LDB(B0, 1, 0); PG8_SCHED; PG8_LDA(At, 1, 0); PG8_STAGE(PG8_SA(0, 1), a2 + hstep, voffA);
            PG8_WAIT_L(8); PG8_BAR; PG8_WAIT_L(0); PG8_MMA(0, 0, At, B0); PG8_BAR; PG8_SCHED;
            PG8_LDB(B1, 1, 1); PG8_STAGE(PG8_SB(1, 0), b3, voffB);
            PG8_BAR; PG8_WAIT_L(0); PG8_MMA(0, 1, At, B1); PG8_BAR;
            PG8_LDA(At, 1, 1); PG8_STAGE(PG8_SA(1, 0), a3, voffA);
            PG8_BAR; PG8_WAIT_L(0); PG8_MMA(1, 0, At, B0); PG8_BAR; PG8_SCHED;
            PG8_STAGE(PG8_SB(1, 1), b3 + hstep, voffB);
            PG8_WAIT_V(6); PG8_BAR; PG8_MMA(1, 1, At, B1); PG8_BAR;
            }
        }
        if constexpr (ALIGN_EPI) { if (wr == 0) PG8_BAR; }
        if constexpr (!Epi::AFTER_DRAIN) { E(acc, cur, wr, wc, fr, fq); S.done(cur); }
        if (!has_next) break;
#pragma unroll
        for (int a = 0; a < 2; ++a)
#pragma unroll
            for (int b = 0; b < 2; ++b)
#pragma unroll
                for (int m = 0; m < 4; ++m)
#pragma unroll
                    for (int n = 0; n < 2; ++n) acc[a][b][m][n] = (f32x4){0.f, 0.f, 0.f, 0.f};
        cur = nxt; cA = nA; cB = nB; ++ui;
        if constexpr (ALIGN_EPI) { if (wr == 1) PG8_BAR; }
    }
    PG8_WAIT_V(0);
    if constexpr (!ALIGN_EPI) { if (wr == 0) PG8_BAR; }
    PG8_BAR;
    if constexpr (Epi::AFTER_DRAIN) { E.fused(acc, cur, wr, wc, fr, fq, lds, wid, lane); S.done(cur); }
#undef PG8_SA
#undef PG8_SB
#undef PG8_STAGE
#undef PG8_LDA
#undef PG8_LDB
#undef PG8_MMA
#undef PG8_WAIT_V
#undef PG8_WAIT_L
#undef PG8_BAR
#undef PG8_SCHED
}
}

#define LAS __attribute__((address_space(3)))
#define GAS __attribute__((address_space(1)))
using pg8::f32x4; using pg8::u32x4; using pg8::Unit; using pg8::cvt_pk_bf16;
typedef unsigned u32x2 __attribute__((ext_vector_type(2)));
typedef GAS unsigned gu32;
#define RLX_AGENT __ATOMIC_RELAXED, __HIP_MEMORY_SCOPE_AGENT

constexpr int NWAVES = 8, NTHREADS = 512;
constexpr int LDS_BYTES = 163840;
constexpr int RING_BYTES = 147456, MISC_OFF = RING_BYTES + 320;
constexpr size_t W_IN = 0, W_OUT = W_IN + (size_t)2816 * 1024 * 2, W_FFI = W_OUT + (size_t)1024 * 1024 * 2, W_FFO = W_FFI + (size_t)5632 * 1024 * 2,
                 W_G = W_FFO + (size_t)1024 * 2816 * 2, W_P = W_G + (size_t)1024 * 1024 * 2, W_LAYER = W_P + (size_t)1024 * 256 * 2;
static_assert(WS_W + 2 * W_LAYER <= WS_XB0, "weights fit");
enum { ST_X1 = 0, ST_MIX = 1, ST_X2 = 2, ST_F = 3, ST_PP = 4, ST_N = 5 };
typedef unsigned long long stat_t;
__host__ __device__ __forceinline__ stat_t* stat_ptr(unsigned char* ws, int L, int idx) { return (stat_t*)(ws + WS_STAT) + (size_t)(L * ST_N + idx) * M; }
static_assert(WS_STAT + (size_t)2 * ST_N * M * 8 <= CTL_ZERO_BYTES && CTL_ZERO_BYTES <= WS_TAB, "stats inside the zeroed region");
__device__ __forceinline__ stat_t ss_enc(float s) { return (stat_t)(s * 16777216.0f); }
__device__ __forceinline__ float ss_dec(stat_t v) { return (float)v * (1.0f / 16777216.0f); }
constexpr int CW_BAR = 4096;

#define XB_TMO      128
#define XB_XCNT(j)  (256  + 64 * (j))
#define XB_XSUB(j)  (1280 + 64 * (j))
#define XB_XGEN(j)  (2304 + 64 * (j))
#define XB_TOP      3328
#define XB_TOPGEN   3392
#define XCD_BAR_WORDS 3456
#define XB_SPIN_CAP (1u << 22)
__device__ __forceinline__ unsigned xb_ld(unsigned* p)              { return __hip_atomic_load(p, __ATOMIC_RELAXED, __HIP_MEMORY_SCOPE_AGENT); }
__device__ __forceinline__ unsigned xb_add(unsigned* p, unsigned v) { return __hip_atomic_fetch_add(p, v, __ATOMIC_RELAXED, __HIP_MEMORY_SCOPE_AGENT); }
__device__ __forceinline__ unsigned xb_xcc_id() { return (unsigned)__builtin_amdgcn_s_getreg((3 << 11) | 20) & 0xFu; }
#define XB_SPIN(cond, bar) do { unsigned _sp = 0; while (cond) { __builtin_amdgcn_s_sleep(1); \
    if ((++_sp & 255u) == 0u) { if (xb_ld(&(bar)[XB_TMO])) break; if (_sp > XB_SPIN_CAP) { atomicAdd(&(bar)[XB_TMO], 1u); break; } } } } while (0)
struct XcdBarrier { unsigned* bar; unsigned x; volatile LAS unsigned* st; };
__device__ __forceinline__ XcdBarrier xcd_barrier_post(unsigned* bar, volatile LAS unsigned* st) {
    XcdBarrier b; b.bar = bar; b.x = xb_xcc_id(); b.st = st;
    if (threadIdx.x == 0) (void)xb_add(&bar[XB_XCNT(b.x)], 1u);
    return b;
}
__device__ __forceinline__ void xcd_barrier_complete(unsigned* bar, unsigned x, unsigned& nloc, unsigned& nx) {
    const unsigned G = gridDim.x * gridDim.y * gridDim.z;
    unsigned sum, cnt, mine, sp = 0u;
    for (;;) {
        sum = 0u; cnt = 0u; mine = 0u;
#pragma unroll
        for (unsigned j = 0; j < 16; ++j) { const unsigned c = xb_ld(&bar[XB_XCNT(j)]); sum += c; cnt += (c > 0u) ? 1u : 0u; mine = (j == x) ? c : mine; }
        if (sum == G) break;
        __builtin_amdgcn_s_sleep(1);
        if ((++sp & 255u) == 0u) { if (xb_ld(&bar[XB_TMO])) break; if (sp > XB_SPIN_CAP) { atomicAdd(&bar[XB_TMO], 1u); break; } }
    }
    nloc = mine > 0u ? mine : 1u; nx = cnt > 0u ? cnt : 1u;
}
__device__ __forceinline__ void xcd_barrier(const XcdBarrier& b, int tid) {
    asm volatile("s_waitcnt vmcnt(0)" ::: "memory");
    __syncthreads();
    if (tid == 0) {
        unsigned* bar = b.bar;
        __builtin_amdgcn_s_waitcnt(0);
        unsigned nloc = b.st[0], nx = b.st[1];
        if (nloc == 0u) { xcd_barrier_complete(bar, b.x, nloc, nx); b.st[0] = nloc; b.st[1] = nx; }
        const unsigned old = xb_add(&bar[XB_XSUB(b.x)], 1u);
        const unsigned gen = old / nloc;
        if (old + 1u == (gen + 1u) * nloc) {
            __builtin_amdgcn_fence(__ATOMIC_RELEASE, "agent");
            asm volatile("s_waitcnt vmcnt(0)" ::: "memory");
            const unsigned og = xb_add(&bar[XB_TOP], 1u);
            const unsigned tg = og / nx;
            if (og + 1u == (tg + 1u) * nx) xb_add(&bar[XB_TOPGEN], 1u);
            else XB_SPIN(xb_ld(&bar[XB_TOPGEN]) == tg, bar);
            __builtin_amdgcn_fence(__ATOMIC_ACQUIRE, "agent");
            xb_add(&bar[XB_XGEN(b.x)], 1u);
            asm volatile("s_waitcnt vmcnt(0)" ::: "memory");
        } else {
            XB_SPIN(xb_ld(&bar[XB_XGEN(b.x)]) == gen, bar);
            __builtin_amdgcn_fence(__ATOMIC_ACQUIRE, "agent");
            asm volatile("s_waitcnt vmcnt(0)" ::: "memory");
        }
    }
    __syncthreads();
}

__device__ __forceinline__ float fast_rsq(float x) { return __builtin_amdgcn_rsqf(x); }
__device__ __forceinline__ float sigm(float x) { return __builtin_amdgcn_rcpf(1.0f + __builtin_amdgcn_exp2f(-LOG2E_ * x)); }
__device__ __forceinline__ float gelu_t(float x) { return x * sigm(1.5957691216057308f * (x + 0.044715f * x * x * x)); }
__device__ __forceinline__ void unpack8s(const f32x4& v0, const f32x4& v1, float s, float (&o)[8]) {
    o[0] = v0[0] * s; o[1] = v0[1] * s; o[2] = v0[2] * s; o[3] = v0[3] * s; o[4] = v1[0] * s; o[5] = v1[1] * s; o[6] = v1[2] * s; o[7] = v1[3] * s;
}
__device__ __forceinline__ u32x4 pack8(const float (&o)[8]) {
    u32x4 w; w.x = cvt_pk_bf16(o[0], o[1]); w.y = cvt_pk_bf16(o[2], o[3]); w.z = cvt_pk_bf16(o[4], o[5]); w.w = cvt_pk_bf16(o[6], o[7]); return w;
}
__device__ __forceinline__ void ld8f(const float* p, float (&o)[8]) {
    const f32x4 a = *(const f32x4*)p, b = *(const f32x4*)(p + 4);
    o[0] = a[0]; o[1] = a[1]; o[2] = a[2]; o[3] = a[3]; o[4] = b[0]; o[5] = b[1]; o[6] = b[2]; o[7] = b[3];
}
__device__ __forceinline__ void unpack_bf8(const u32x4& r, float (&o)[8]) {
    o[0] = __uint_as_float(r.x << 16); o[1] = __uint_as_float(r.x & 0xffff0000u); o[2] = __uint_as_float(r.y << 16); o[3] = __uint_as_float(r.y & 0xffff0000u);
    o[4] = __uint_as_float(r.z << 16); o[5] = __uint_as_float(r.z & 0xffff0000u); o[6] = __uint_as_float(r.w << 16); o[7] = __uint_as_float(r.w & 0xffff0000u);
}
__device__ __forceinline__ int fresh_lane() { unsigned ones = ~0u; asm volatile("" : "+s"(ones)); return (int)__builtin_amdgcn_mbcnt_hi(ones, __builtin_amdgcn_mbcnt_lo(ones, 0u)); }
#define EPI_ROW(u, ai, wr, m, fr) ((u).pm * 256 + (ai) * 128 + (wr) * 64 + (m) * 16 + (fr))

enum { T_AU, T_AV, T_BQ, T_BK, T_BV, T_BG, T_CQ, T_CK, T_CV };
struct EpiProj {
    static constexpr bool PERM = true, AFTER_DRAIN = false;
    bf16_t* P; const stat_t* ss; const float* ln_w; const float* ln_b; const float* tab;
    template <int TYPE> __device__ __forceinline__ void rows(const f32x4 (&acc)[2][2][4][2], const Unit& u, int wr, int hs, int hrel, int fr, int fq) const {
        const int d0 = 8 * fq, ln_ = fr + 16 * fq;
        float rs[8];
#pragma unroll
        for (int q = 0; q < 8; ++q) rs[q] = ss_dec(ss[EPI_ROW(u, q >> 2, wr, q & 3, fr)]);
        float wa[8], wb[8], ba[8], bb[8];
        if constexpr (TYPE == T_AV) { ld8f(ln_w + hrel * 64 + d0, wa); ld8f(ln_w + hrel * 64 + 32 + d0, wb); ld8f(ln_b + hrel * 64 + d0, ba); ld8f(ln_b + hrel * 64 + 32 + d0, bb); }
#pragma unroll
        for (int hp = 0; hp < 4; ++hp) {
            const int ai = hp >> 1;
            float tc[2][8], tsn[2][8];
            if constexpr (TYPE == T_BQ || TYPE == T_BK) {
#pragma unroll
                for (int mm = 0; mm < 2; ++mm) { const int pos = EPI_ROW(u, ai, wr, 2 * (hp & 1) + mm, fr) & (SEQ - 1); ld8f(tab + TAB_RC + pos * 32 + d0, tc[mm]); ld8f(tab + TAB_RS + pos * 32 + d0, tsn[mm]); }
            }
            if constexpr (TYPE == T_CQ || TYPE == T_CK) {
#pragma unroll
                for (int mm = 0; mm < 2; ++mm) { const int pos = EPI_ROW(u, ai, wr, 2 * (hp & 1) + mm, fr) & (SEQ - 1); ld8f(tab + TAB_SC + pos * 8, tc[mm]); ld8f(tab + TAB_SS + pos * 8, tsn[mm]); }
            }
#pragma unroll
            for (int mm = 0; mm < 2; ++mm) {
                const int m = 2 * (hp & 1) + mm;
                const int row = EPI_ROW(u, ai, wr, m, fr);
                const float rstd = fast_rsq(rs[ai * 4 + m] * (1.0f / D_MODEL) + EPS);
                float a[8], b[8];
                unpack8s(acc[ai][0][m][0], acc[ai][0][m][1], rstd, a); unpack8s(acc[ai][1][m][0], acc[ai][1][m][1], rstd, b);
                if constexpr (TYPE == T_AU) {
#pragma unroll
                    for (int j = 0; j < 8; ++j) { a[j] = gelu_t(a[j]); b[j] = gelu_t(b[j]); }
                } else if constexpr (TYPE == T_AV) {
                    float sm = 0.f;
#pragma unroll
                    for (int j = 0; j < 8; ++j) { a[j] = gelu_t(a[j]); b[j] = gelu_t(b[j]); sm += a[j] + b[j]; }
                    sm += shx(sm, 16, ln_); sm += shx(sm, 32, ln_);
                    const float mu = sm * (1.0f / 64.0f); float q = 0.f;
#pragma unroll
                    for (int j = 0; j < 8; ++j) { a[j] -= mu; b[j] -= mu; q += a[j] * a[j] + b[j] * b[j]; }
                    q += shx(q, 16, ln_); q += shx(q, 32, ln_);
                    const float rsd = fast_rsq(q * (1.0f / 64.0f) + EPS);
#pragma unroll
                    for (int j = 0; j < 8; ++j) { a[j] = a[j] * rsd * wa[j] + ba[j]; b[j] = b[j] * rsd * wb[j] + bb[j]; }
                } else if constexpr (TYPE == T_BQ || TYPE == T_BK) {
                    const float sc = TYPE == T_BK ? 0.125f : 1.0f;
#pragma unroll
                    for (int j = 0; j < 8; ++j) { const float x1 = a[j], x2 = b[j]; a[j] = (x1 * tc[mm][j] - x2 * tsn[mm][j]) * sc; b[j] = (x2 * tc[mm][j] + x1 * tsn[mm][j]) * sc; }
                } else if constexpr (TYPE == T_BG) {
#pragma unroll
                    for (int j = 0; j < 8; ++j) { a[j] = a[j] * sigm(a[j]); b[j] = b[j] * sigm(b[j]); }
                } else if constexpr (TYPE == T_CQ || TYPE == T_CK) {
                    float o[8];
#pragma unroll
                    for (int j = 0; j < 8; ++j) o[j] = shx(a[j], 16, ln_);
                    if (fq < 2) {
                        const float sg = fq == 0 ? -1.0f : 1.0f;
#pragma unroll
                        for (int j = 0; j < 8; ++j) a[j] = a[j] * tc[mm][j] + sg * o[j] * tsn[mm][j];
                    }
                }
                bf16_t* dst = P + (size_t)row * IN_W + hs * 64 + d0;
                *(u32x4*)dst = pack8(a); *(u32x4*)(dst + 32) = pack8(b);
            }
        }
    }
    __device__ __forceinline__ void operator()(const f32x4 (&acc)[2][2][4][2], const Unit& u, int wr, int wc, int fr, int fq) const {
        const int ln_ = fresh_lane(); fr = ln_ & 15; fq = ln_ >> 4;
        const int hs = u.pn * 4 + wc;
        if (hs >= NHEADS) return;
        if (hs < H_AV) rows<T_AU>(acc, u, wr, hs, hs - H_AU, fr, fq);
        else if (hs < H_BQ) rows<T_AV>(acc, u, wr, hs, hs - H_AV, fr, fq);
        else if (hs < H_BK) rows<T_BQ>(acc, u, wr, hs, hs - H_BQ, fr, fq);
        else if (hs < H_BV) rows<T_BK>(acc, u, wr, hs, hs - H_BK, fr, fq);
        else if (hs < H_BG) rows<T_BV>(acc, u, wr, hs, hs - H_BV, fr, fq);
        else if (hs < H_CQ) rows<T_BG>(acc, u, wr, hs, hs - H_BG, fr, fq);
        else if (hs < H_CK) rows<T_CQ>(acc, u, wr, hs, hs - H_CQ, fr, fq);
        else if (hs < H_CV) rows<T_CK>(acc, u, wr, hs, hs - H_CK, fr, fq);
        else rows<T_CV>(acc, u, wr, hs, hs - H_CV, fr, fq);
    }
};
struct EpiSwiglu {
    static constexpr bool PERM = true, AFTER_DRAIN = false;
    bf16_t* H; const stat_t* ss; float kscale;
    __device__ __forceinline__ void operator()(const f32x4 (&acc)[2][2][4][2], const Unit& u, int wr, int wc, int fr, int fq) const {
        const int ln_ = fresh_lane(); fr = ln_ & 15; fq = ln_ >> 4;
        float rs[8];
#pragma unroll
        for (int q = 0; q < 8; ++q) rs[q] = ss_dec(ss[EPI_ROW(u, q >> 2, wr, q & 3, fr)]);
#pragma unroll
        for (int ai = 0; ai < 2; ++ai)
#pragma unroll
            for (int m = 0; m < 4; ++m) {
                const int row = EPI_ROW(u, ai, wr, m, fr);
                const float rstd = fast_rsq(rs[ai * 4 + m] * (1.0f / D_MODEL) + EPS) * kscale;
                typedef float f32x2 __attribute__((ext_vector_type(2)));
                const float cexp = -LOG2E_ * rstd, r2 = rstd * rstd;
                unsigned wv4[4];
#pragma unroll
                for (int n = 0; n < 2; ++n)
#pragma unroll
                    for (int hf = 0; hf < 2; ++hf) {
                        const f32x2 ag = {acc[ai][0][m][n][2 * hf], acc[ai][0][m][n][2 * hf + 1]}, au = {acc[ai][1][m][n][2 * hf], acc[ai][1][m][n][2 * hf + 1]};
                        f32x2 e = ag * cexp; e.x = __builtin_amdgcn_exp2f(e.x); e.y = __builtin_amdgcn_exp2f(e.y);
                        f32x2 d = e + 1.0f; d.x = __builtin_amdgcn_rcpf(d.x); d.y = __builtin_amdgcn_rcpf(d.y);
                        const f32x2 hh = ((ag * au) * r2) * d;
                        wv4[2 * n + hf] = cvt_pk_bf16(hh.x, hh.y);
                    }
                const u32x4 g = {wv4[0], wv4[1], wv4[2], wv4[3]};
                *(u32x4*)(H + (size_t)row * D_FF + u.pn * 128 + wc * 32 + 8 * fq) = g;
            }
    }
};
struct EpiStore {
    static constexpr bool PERM = true, AFTER_DRAIN = false;
    bf16_t* O;
    __device__ __forceinline__ void operator()(const f32x4 (&acc)[2][2][4][2], const Unit& u, int wr, int wc, int fr, int fq) const {
        const int ln_ = fresh_lane(); fr = ln_ & 15; fq = ln_ >> 4;
#pragma unroll
        for (int q = 0; q < 8; ++q) {
            const int ai = q >> 2, m = q & 3, row = EPI_ROW(u, ai, wr, m, fr);
#pragma unroll
            for (int bj = 0; bj < 2; ++bj) {
                float v[8]; unpack8s(acc[ai][bj][m][0], acc[ai][bj][m][1], 1.0f, v);
                *(u32x4*)(O + (size_t)row * D_MODEL + u.pn * 256 + bj * 128 + wc * 32 + 8 * fq) = pack8(v);
            }
        }
    }
};
struct EpiNormRes {
    static constexpr bool PERM = true, AFTER_DRAIN = false;
    bf16_t* XB; const float* w; stat_t* ssT; stat_t* ss_out; unsigned* tmo;
    __device__ __forceinline__ void operator()(const f32x4 (&acc)[2][2][4][2], const Unit& u, int wr, int wc, int fr, int fq) const {
        const int ln_ = fresh_lane(); fr = ln_ & 15; fq = ln_ >> 4;
        const int col0 = u.pn * 256 + wc * 32 + 8 * fq;
        float s[8];
#pragma unroll
        for (int q = 0; q < 8; ++q) {
            const int ai = q >> 2, m = q & 3; float sq = 0.f;
#pragma unroll
            for (int bj = 0; bj < 2; ++bj)
#pragma unroll
                for (int n = 0; n < 2; ++n) { const f32x4 v = acc[ai][bj][m][n]; sq += (v[0] * v[0] + v[1] * v[1]) + (v[2] * v[2] + v[3] * v[3]); }
            s[q] = sq;
        }
#pragma unroll
        for (int q = 0; q < 8; ++q) s[q] += shx(s[q], 16, ln_);
#pragma unroll
        for (int q = 0; q < 8; ++q) s[q] += shx(s[q], 32, ln_);
        if (fq == 0) {
#pragma unroll
            for (int q = 0; q < 8; ++q) atomicAdd(ssT + EPI_ROW(u, q >> 2, wr, q & 3, fr), (ss_enc(s[q]) << 8) | 1ull);
        }
        float wv[2][8]; ld8f(w + col0, wv[0]); ld8f(w + col0 + 128, wv[1]);
        u32x4 xr[4][2];
#pragma unroll
        for (int m = 0; m < 4; ++m)
#pragma unroll
            for (int bj = 0; bj < 2; ++bj) xr[m][bj] = *(const u32x4*)(XB + (size_t)EPI_ROW(u, 0, wr, m, fr) * D_MODEL + col0 + bj * 128);
        float rs[8];
        {
            stat_t v[8]; unsigned sp = 0;
            for (;;) {
                bool ok = true;
#pragma unroll
                for (int q = 0; q < 8; ++q) { v[q] = __hip_atomic_load(ssT + EPI_ROW(u, q >> 2, wr, q & 3, fr), __ATOMIC_RELAXED, __HIP_MEMORY_SCOPE_AGENT); ok = ok && ((unsigned)v[q] & 255u) == 16u; }
                if (__all(ok)) break;
                __builtin_amdgcn_s_sleep(1);
                if (++sp > (1u << 22)) { if (ln_ == 0) __hip_atomic_store(tmo, 1u, __ATOMIC_RELAXED, __HIP_MEMORY_SCOPE_AGENT); break; }
            }
#pragma unroll
            for (int q = 0; q < 8; ++q) rs[q] = ss_dec(v[q] >> 8);
        }
        float so[8];
#pragma unroll
        for (int ai = 0; ai < 2; ++ai) {
            if (ai == 1) {
#pragma unroll
                for (int m = 0; m < 4; ++m)
#pragma unroll
                    for (int bj = 0; bj < 2; ++bj) xr[m][bj] = *(const u32x4*)(XB + (size_t)EPI_ROW(u, 1, wr, m, fr) * D_MODEL + col0 + bj * 128);
            }
#pragma unroll
            for (int m = 0; m < 4; ++m) {
                const float rstd = fast_rsq(rs[ai * 4 + m] * (1.0f / D_MODEL) + EPS);
                float sq = 0.f;
#pragma unroll
                for (int bj = 0; bj < 2; ++bj) {
                    float t[8], xv[8]; unpack8s(acc[ai][bj][m][0], acc[ai][bj][m][1], rstd, t); unpack_bf8(xr[m][bj], xv);
#pragma unroll
                    for (int j = 0; j < 8; ++j) { xv[j] += t[j] * wv[bj][j]; sq += xv[j] * xv[j]; }
                    *(u32x4*)(XB + (size_t)EPI_ROW(u, ai, wr, m, fr) * D_MODEL + col0 + bj * 128) = pack8(xv);
                }
                so[ai * 4 + m] = sq;
            }
        }
        if (ss_out) {
#pragma unroll
            for (int q = 0; q < 8; ++q) so[q] += shx(so[q], 16, ln_);
#pragma unroll
            for (int q = 0; q < 8; ++q) so[q] += shx(so[q], 32, ln_);
            if (fq == 0) {
#pragma unroll
                for (int q = 0; q < 8; ++q) atomicAdd(ss_out + EPI_ROW(u, q >> 2, wr, q & 3, fr), ss_enc(so[q]));
            }
        }
    }
};
struct EpiStat {
    static constexpr bool PERM = true, AFTER_DRAIN = false;
    bf16_t* O; stat_t* ss;
    __device__ __forceinline__ void operator()(const f32x4 (&acc)[2][2][4][2], const Unit& u, int wr, int wc, int fr, int fq) const {
        const int ln_ = fresh_lane(); fr = ln_ & 15; fq = ln_ >> 4;
        float s[8];
#pragma unroll
        for (int q = 0; q < 8; ++q) {
            const int ai = q >> 2, m = q & 3, row = EPI_ROW(u, ai, wr, m, fr);
            float sq = 0.f;
#pragma unroll
            for (int bj = 0; bj < 2; ++bj) {
                float v[8]; unpack8s(acc[ai][bj][m][0], acc[ai][bj][m][1], 1.0f, v);
#pragma unroll
                for (int j = 0; j < 8; ++j) sq += v[j] * v[j];
                *(u32x4*)(O + (size_t)row * D_MODEL + u.pn * 256 + bj * 128 + wc * 32 + 8 * fq) = pack8(v);
            }
            s[q] = sq;
        }
#pragma unroll
        for (int q = 0; q < 8; ++q) s[q] += shx(s[q], 16, ln_);
#pragma unroll
        for (int q = 0; q < 8; ++q) s[q] += shx(s[q], 32, ln_);
        if (fq == 0) {
#pragma unroll
            for (int q = 0; q < 8; ++q) atomicAdd(ss + EPI_ROW(u, q >> 2, wr, q & 3, fr), ss_enc(s[q]));
        }
    }
};
struct EpiPle {
    static constexpr bool PERM = true, AFTER_DRAIN = false;
    const bf16_t* XBc; const bf16_t* PP; const stat_t* ss_pp; const float* wple; bf16_t* XBn; stat_t* ss_next; float* xout;
    __device__ __forceinline__ void operator()(const f32x4 (&acc)[2][2][4][2], const Unit& u, int wr, int wc, int fr, int fq) const {
        const int ln_ = fresh_lane(); fr = ln_ & 15; fq = ln_ >> 4;
        const int col0 = u.pn * 256 + wc * 32 + 8 * fq;
        float w[2][8], rp[8], s[8];
        ld8f(wple + col0, w[0]); ld8f(wple + col0 + 128, w[1]);
#pragma unroll
        for (int q = 0; q < 8; ++q) rp[q] = ss_dec(ss_pp[EPI_ROW(u, q >> 2, wr, q & 3, fr)]);
#pragma unroll
        for (int q = 0; q < 8; ++q) s[q] = 0.f;
#pragma unroll
        for (int ai = 0; ai < 2; ++ai)
#pragma unroll
            for (int bj = 0; bj < 2; ++bj) {
                u32x4 xr[4], pr[4];
#pragma unroll
                for (int m = 0; m < 4; ++m) { const size_t off = (size_t)EPI_ROW(u, ai, wr, m, fr) * D_MODEL + col0 + bj * 128; xr[m] = *(const u32x4*)(XBc + off); pr[m] = *(const u32x4*)(PP + off); }
#pragma unroll
                for (int m = 0; m < 4; ++m) {
                    const float rpp = fast_rsq(rp[ai * 4 + m] * (1.0f / D_MODEL) + EPS);
                    const size_t off = (size_t)EPI_ROW(u, ai, wr, m, fr) * D_MODEL + col0 + bj * 128;
                    float g[8], xv[8], pv[8]; float sq = 0.f;
                    unpack8s(acc[ai][bj][m][0], acc[ai][bj][m][1], 1.0f, g); unpack_bf8(xr[m], xv); unpack_bf8(pr[m], pv);
#pragma unroll
                    for (int j = 0; j < 8; ++j) { xv[j] += sigm(g[j]) * pv[j] * rpp * w[bj][j]; sq += xv[j] * xv[j]; }
                    if (XBn) *(u32x4*)(XBn + off) = pack8(xv);
                    if (xout) { *(f32x4*)(xout + off) = (f32x4){xv[0], xv[1], xv[2], xv[3]}; *(f32x4*)(xout + off + 4) = (f32x4){xv[4], xv[5], xv[6], xv[7]}; }
                    s[ai * 4 + m] += sq;
                }
            }
        if (ss_next) {
#pragma unroll
            for (int q = 0; q < 8; ++q) s[q] += shx(s[q], 16, ln_);
#pragma unroll
            for (int q = 0; q < 8; ++q) s[q] += shx(s[q], 32, ln_);
            if (fq == 0) {
#pragma unroll
                for (int q = 0; q < 8; ++q) atomicAdd(ss_next + EPI_ROW(u, q >> 2, wr, q & 3, fr), ss_enc(s[q]));
            }
        }
    }
};

__device__ __forceinline__ void ew_rows(bf16_t* XB, const bf16_t* T, const float* w, stat_t* ss_out, int gw, int NGW, int lane) {
    const int hl = lane & 31, hr = lane >> 5;
    float wv[4][8];
#pragma unroll
    for (int j = 0; j < 4; ++j) ld8f(w + 8 * hl + 256 * j, wv[j]);
#pragma unroll 2
    for (int r2 = gw; r2 < M / 2; r2 += NGW) {
        const int row = 2 * r2 + hr; const size_t base = (size_t)row * D_MODEL + 8 * hl;
        u32x4 xr[4], tr[4];
#pragma unroll
        for (int j = 0; j < 4; ++j) { xr[j] = *(const u32x4*)(XB + base + 256 * j); tr[j] = *(const u32x4*)(T + base + 256 * j); }
        float tv[4][8]; float st = 0.f;
#pragma unroll
        for (int j = 0; j < 4; ++j) { unpack_bf8(tr[j], tv[j]);
#pragma unroll
            for (int k = 0; k < 8; ++k) st += tv[j][k] * tv[j][k]; }
#pragma unroll
        for (int o = 1; o < 32; o <<= 1) st += shx(st, o, lane);
        const float rT = fast_rsq(st * (1.0f / D_MODEL) + EPS);
        float s = 0.f;
#pragma unroll
        for (int j = 0; j < 4; ++j) {
            float xv[8]; unpack_bf8(xr[j], xv);
#pragma unroll
            for (int k = 0; k < 8; ++k) { xv[k] += tv[j][k] * rT * wv[j][k]; s += xv[k] * xv[k]; }
            *(u32x4*)(XB + base + 256 * j) = pack8(xv);
        }
        if (ss_out) {
#pragma unroll
            for (int o = 1; o < 32; o <<= 1) s += shx(s, o, lane);
            if (hl == 0) ss_out[row] = ss_enc(s);
        }
    }
}
__device__ __forceinline__ void xprep_rows(const float* x, bf16_t* XB, stat_t* ss_out, int gw, int NGW, int lane) {
    const int hl = lane & 31, hr = lane >> 5;
#pragma unroll 2
    for (int r2 = gw; r2 < M / 2; r2 += NGW) {
        const int row = 2 * r2 + hr; const size_t base = (size_t)row * D_MODEL + 8 * hl;
        float xv[4][8];
#pragma unroll
        for (int j = 0; j < 4; ++j) ld8f(x + base + 256 * j, xv[j]);
        float s = 0.f;
#pragma unroll
        for (int j = 0; j < 4; ++j) {
#pragma unroll
            for (int k = 0; k < 8; ++k) s += xv[j][k] * xv[j][k];
            *(u32x4*)(XB + base + 256 * j) = pack8(xv[j]);
        }
#pragma unroll
        for (int o = 1; o < 32; o <<= 1) s += shx(s, o, lane);
        if (hl == 0) ss_out[row] = ss_enc(s);
    }
}

__device__ __forceinline__ void tr_item(const float* W, int ldw, int K, int sc, const float* gain, bf16_t* WT, int rho0, int k0, LAS float* scr, int lane) {
#pragma unroll 8
    for (int i = 0; i < 32; ++i) {
        const int kk = 2 * i + (lane >> 5);
        float v = sc >= 0 ? W[(size_t)(k0 + kk) * ldw + sc + (lane & 31)] : 0.f;
        if (gain) v *= gain[k0 + kk];
        scr[kk * 33 + (lane & 31)] = v;
    }
    asm volatile("s_waitcnt lgkmcnt(0)" ::: "memory");
    const int c = lane & 7;
#pragma unroll
    for (int j = 0; j < 4; ++j) {
        const int n = (lane >> 3) + 8 * j; const LAS float* s = scr + (8 * c) * 33 + n;
        u32x4 o; o.x = cvt_pk_bf16(s[0 * 33], s[1 * 33]); o.y = cvt_pk_bf16(s[2 * 33], s[3 * 33]); o.z = cvt_pk_bf16(s[4 * 33], s[5 * 33]); o.w = cvt_pk_bf16(s[6 * 33], s[7 * 33]);
        *(u32x4*)(WT + (size_t)(rho0 + n) * K + k0 + 8 * c) = o;
    }
    asm volatile("s_waitcnt lgkmcnt(0)" ::: "memory");
}

struct Args { const float* in[19]; float* out; unsigned char* ws; int ph_lo, ph_hi, li, pad; };

typedef const __attribute__((address_space(4))) Args* KArgs;
__device__ __forceinline__ KArgs kargs() { KArgs p = (KArgs)__builtin_amdgcn_kernarg_segment_ptr(); asm volatile("" : "+s"(p)); return p; }


__device__ __forceinline__ void prologue(KArgs ap, LAS unsigned char* lds, int gw, int NGW, int wave, int lane) {
    unsigned char* ws = ap->ws;
    LAS float* scr = (LAS float*)(lds + wave * 16384);
    for (int L = 0; L < DEPTH; ++L) {
        unsigned char* wl = ws + WS_W + (size_t)L * W_LAYER;
        constexpr int I0 = 16 * 88, I1 = 16 * 32, I2 = 16 * 176, I3 = 44 * 32, I4 = 16 * 32, I5 = 4 * 32, IT = I0 + I1 + I2 + I3 + I4 + I5;
        for (int it = gw; it < IT; it += NGW) {
            int r = it;
            if (r < I0) { const int nb = r % 88, kb = r / 88, pn = nb >> 3, bj = (nb >> 2) & 1, wc = nb & 3, hs = 4 * pn + wc;
                tr_item(ap->in[3] + (size_t)L * D_MODEL * IN_W, IN_W, 1024, hs < NHEADS ? hs * 64 + 32 * bj : -1, ap->in[2] + L * D_MODEL, (bf16_t*)(wl + W_IN), nb * 32, kb * 64, scr, lane); continue; } r -= I0;
            if (r < I1) { const int nb = r % 32, kb = r / 32;
                tr_item(ap->in[10] + (size_t)L * D_MODEL * D_MODEL, D_MODEL, 1024, nb * 32, nullptr, (bf16_t*)(wl + W_OUT), nb * 32, kb * 64, scr, lane); continue; } r -= I1;
            if (r < I2) { const int nb = r % 176, kb = r / 176, pn = nb >> 3, bj = (nb >> 2) & 1, q = nb & 3;
                tr_item(ap->in[13] + (size_t)L * D_MODEL * 2 * D_FF, 2 * D_FF, 1024, bj * D_FF + 128 * pn + 32 * q, ap->in[12] + L * D_MODEL, (bf16_t*)(wl + W_FFI), nb * 32, kb * 64, scr, lane); continue; } r -= I2;
            if (r < I3) { const int nb = r % 32, kb = r / 32;
                tr_item(ap->in[14] + (size_t)L * D_FF * D_MODEL, D_MODEL, D_FF, nb * 32, nullptr, (bf16_t*)(wl + W_FFO), nb * 32, kb * 64, scr, lane); continue; } r -= I3;
            if (r < I4) { const int nb = r % 32, kb = r / 32;
                tr_item(ap->in[16] + (size_t)L * D_MODEL * D_MODEL, D_MODEL, 1024, nb * 32, nullptr, (bf16_t*)(wl + W_G), nb * 32, kb * 64, scr, lane); continue; } r -= I4;
            { const int nb = r % 32, kb = r / 32;
                tr_item(ap->in[17] + (size_t)L * PLE_DIM * D_MODEL, D_MODEL, PLE_DIM, nb * 32, nullptr, (bf16_t*)(wl + W_P), nb * 32, kb * 64, scr, lane); }
        }
    }
    {
        float* tab = (float*)(ws + WS_TAB);
        for (int i = gw * 64 + lane; i < 2048 * 32; i += NGW * 64) {
            { const int pos = i >> 5, j = i & 31; const double rev = (double)pos * c_inv_ret[j] * 0.15915494309189535; const float fr = (float)(rev - floor(rev));
              tab[TAB_RC + i] = __builtin_amdgcn_cosf(fr); tab[TAB_RS + i] = __builtin_amdgcn_sinf(fr); }
            if (i < 2048 * 8) { const int pos = i >> 3, j = i & 7; const double rev = (double)pos * c_inv_swa[j] * 0.15915494309189535; const float fr = (float)(rev - floor(rev));
              tab[TAB_SC + i] = __builtin_amdgcn_cosf(fr); tab[TAB_SS + i] = __builtin_amdgcn_sinf(fr); }
        }
    }
    {
        const float* p = ap->in[1]; bf16_t* PB = (bf16_t*)(ws + WS_PB);
        const size_t n8 = (size_t)DEPTH * M * PLE_DIM / 8;
        for (size_t i = (size_t)gw * 64 + lane; i < n8; i += (size_t)NGW * 64) {
            float v[8]; ld8f(p + i * 8, v); *(u32x4*)(PB + i * 8) = pack8(v);
        }
    }
    {
        const float* wsrc = ap->in[6]; bf16_t* Wm = (bf16_t*)(ws + WS_WM);
        for (int i = gw * 64 + lane; i < DEPTH * 4 * CHUNK * CHUNK; i += NGW * 64) { const int s_ = i & 127, t_ = (i >> 7) & 127; Wm[i] = f2bf(s_ <= t_ ? wsrc[i] : 0.f); }
    }
    xprep_rows(ap->in[0], (bf16_t*)(ws + WS_XB0), stat_ptr(ws, 0, ST_X1), gw, NGW, lane);
}

typedef float f32x16 __attribute__((ext_vector_type(16)));
typedef short s16x4 __attribute__((ext_vector_type(4)));
using pg8::bf16x8;
constexpr int TS = 144;
constexpr float LOG2E = 1.4426950408889634f;
__device__ __forceinline__ int crow(int r, int hi) { return (r & 3) + 8 * (r >> 2) + 4 * hi; }
__device__ __forceinline__ s16x4 tr16(LAS const unsigned char* p) { return __builtin_bit_cast(s16x4, __builtin_amdgcn_ds_read_tr16_b64_v4i16((LAS s16x4*)p)); }
__device__ __forceinline__ bf16x8 rd_row(LAS const unsigned char* tile, int row0, int k0, int lane) {
    return *(LAS const bf16x8*)(tile + (row0 + (lane & 31)) * TS + (k0 + 8 * (lane >> 5)) * 2);
}
template <bool PERMK> __device__ __forceinline__ bf16x8 rd_tr(LAS const unsigned char* tile, int k0, int n0, int lane) {
    const int h = lane >> 5, g1 = (lane >> 4) & 1, q = (lane & 15) >> 2, p = lane & 3;
    const int rA = k0 + (PERMK ? 4 * h : 8 * h) + q, rB = rA + (PERMK ? 8 : 4);
    const int cb = (n0 + 16 * g1 + 4 * p) * 2;
    const s16x4 lo = tr16(tile + rA * TS + cb), hi = tr16(tile + rB * TS + cb);
    return (bf16x8){lo[0], lo[1], lo[2], lo[3], hi[0], hi[1], hi[2], hi[3]};
}
__device__ __forceinline__ bf16x8 pack_frag(const f32x16& v, int s) {
    u32x4 w; w.x = cvt_pk_bf16(v[8 * s + 0], v[8 * s + 1]); w.y = cvt_pk_bf16(v[8 * s + 2], v[8 * s + 3]); w.z = cvt_pk_bf16(v[8 * s + 4], v[8 * s + 5]); w.w = cvt_pk_bf16(v[8 * s + 6], v[8 * s + 7]);
    return __builtin_bit_cast(bf16x8, w);
}
#define MFMA32(a, b, c) __builtin_amdgcn_mfma_f32_32x32x16_bf16((a), (b), (c), 0, 0, 0)
template <bool SCALE> __device__ __forceinline__ void load_tile(LAS unsigned char* tile, const bf16_t* g, int rows, int zero_below, float sl, int tid) {
    for (int i = tid; i < rows * 8; i += NTHREADS) {
        const int r = i >> 3, c = i & 7;
        u32x4 v = (u32x4){0u, 0u, 0u, 0u};
        if (r >= zero_below) v = *(const u32x4*)(g + (ptrdiff_t)r * IN_W + c * 8);
        if (SCALE) { float f[8]; unpack_bf8(v, f); const float s = exp2f((float)r * sl);
#pragma unroll
            for (int j = 0; j < 8; ++j) f[j] *= s;
            v = pack8(f); }
        *(LAS u32x4*)(tile + r * TS + c * 16) = v;
    }
}

constexpr int GM_BUF = 2 * CHUNK * TS;
struct GmRegs { u32x4 r[4]; };
__device__ __forceinline__ void gm_load(GmRegs& R, const bf16_t* P, int item, int tid) {
    const int h = item & 3, bc = item >> 2; const size_t row0 = (size_t)bc * CHUNK;
    const int r = tid >> 3, c = tid & 7;
#pragma unroll
    for (int i = 0; i < 2; ++i) {
        R.r[i] = *(const u32x4*)(P + (row0 + r + 64 * i) * IN_W + (H_AU + h) * 64 + c * 8);
        R.r[2 + i] = *(const u32x4*)(P + (row0 + r + 64 * i) * IN_W + (H_AV + h) * 64 + c * 8);
    }
}
__device__ __forceinline__ void gm_write(const GmRegs& R, LAS unsigned char* buf, int tid) {
    const int r = tid >> 3, c = tid & 7;
#pragma unroll
    for (int i = 0; i < 2; ++i) { *(LAS u32x4*)(buf + (r + 64 * i) * TS + c * 16) = R.r[i]; *(LAS u32x4*)(buf + CHUNK * TS + (r + 64 * i) * TS + c * 16) = R.r[2 + i]; }
}
__device__ __forceinline__ void gm_compute(LAS unsigned char* buf, const bf16_t* Wm, const float* bs, bf16_t* Y, int item, int tid, int wave, int lane, volatile LAS unsigned* slotp, unsigned fut) {
    const int h = item & 3, bc = item >> 2; const size_t row0 = (size_t)bc * CHUNK;
    LAS unsigned char* AUs = buf; LAS unsigned char* AVs = buf + CHUNK * TS;
    const int tb = wave >> 1, db = wave & 1, hh = lane >> 5;
    f32x16 acc = {};
    const bf16_t* wrow = Wm + (size_t)(h * CHUNK + 32 * tb + (lane & 31)) * CHUNK + 8 * hh;
    for (int ks = 0; ks < 2 * (tb + 1); ++ks) {
        const bf16x8 a = *(const bf16x8*)(wrow + 16 * ks);
        const bf16x8 b = rd_tr<false>(AVs, 16 * ks, 32 * db, lane);
        acc = MFMA32(a, b, acc);
    }
    const int d = 32 * db + (lane & 31);
#pragma unroll
    for (int r = 0; r < 16; ++r) {
        const int t = 32 * tb + crow(r, hh);
        LAS bf16_t* pu = (LAS bf16_t*)(AUs + t * TS) + d;
        *pu = f2bf(bf2f(*pu) * (acc[r] + bs[h * CHUNK + t]));
    }
    if (tid == 0) *slotp = fut;
    __syncthreads();
    for (int i = tid; i < CHUNK * 8; i += NTHREADS) { const int r = i >> 3, c = i & 7; *(u32x4*)(Y + (row0 + r) * D_MODEL + h * 64 + c * 8) = *(LAS const u32x4*)(AUs + r * TS + c * 16); }
}

constexpr int SWA_K = 0, SWA_V = 384 * TS, SWA_WSF = 2 * 384 * TS, SWA_OST = SWA_WSF + NWAVES * 128, SWA_END = SWA_OST + NWAVES * 4096;
struct SwaRegs { u32x4 k[6], v[6]; };
__device__ __forceinline__ void swa_load(SwaRegs& R, const bf16_t* P, int item, int tid) {
    const int hk = item & 1, cp = (item >> 1) & 7, b = item >> 4;
    const ptrdiff_t rowk0 = (ptrdiff_t)b * SEQ + 256 * cp - 128;
    const int r0 = tid >> 3, c = tid & 7;
#pragma unroll
    for (int i = 0; i < 6; ++i) {
        const int r = r0 + 64 * i;
        if (cp == 0 && r < 128) { R.k[i] = (u32x4){0u, 0u, 0u, 0u}; R.v[i] = (u32x4){0u, 0u, 0u, 0u}; }
        else { R.k[i] = *(const u32x4*)(P + (rowk0 + r) * IN_W + (H_CK + hk) * 64 + c * 8); R.v[i] = *(const u32x4*)(P + (rowk0 + r) * IN_W + (H_CV + hk) * 64 + c * 8); }
    }
}
__device__ __forceinline__ void swa_write(const SwaRegs& R, LAS unsigned char* lds, int tid) {
    const int r0 = tid >> 3, c = tid & 7;
#pragma unroll
    for (int i = 0; i < 6; ++i) { *(LAS u32x4*)(lds + SWA_K + (r0 + 64 * i) * TS + c * 16) = R.k[i]; *(LAS u32x4*)(lds + SWA_V + (r0 + 64 * i) * TS + c * 16) = R.v[i]; }
}
__device__ __forceinline__ void swa_compute(LAS unsigned char* lds, const bf16_t* P, const float* sinks, bf16_t* Y, int item, int wave, int lane) {
    const int hk = item & 1, cp = (item >> 1) & 7, b = item >> 4;
    const size_t rowq0 = (size_t)b * SEQ + 256 * cp;
    LAS unsigned char* Ks = lds + SWA_K; LAS unsigned char* Vs = lds + SWA_V;
    const int qi = lane & 31, hh = lane >> 5;
    LAS float* wsf = (LAS float*)(lds + SWA_WSF + wave * 128);
    LAS unsigned char* ost = lds + SWA_OST + wave * 4096;
    constexpr float SC = 0.125f * LOG2E;
    for (int g = 0; g < 3; ++g) {
        const int qh = 3 * hk + g;
        const bf16_t* qrow = P + (rowq0 + 32 * wave + qi) * IN_W + (H_CQ + qh) * 64 + 8 * hh;
        bf16x8 bq[4];
#pragma unroll
        for (int kd = 0; kd < 4; ++kd) bq[kd] = *(const bf16x8*)(qrow + 16 * kd);
        f32x16 S[5];
#pragma unroll
        for (int kb = 0; kb < 5; ++kb) {
            S[kb] = (f32x16){};
#pragma unroll
            for (int kd = 0; kd < 4; ++kd) S[kb] = MFMA32(rd_row(Ks, 32 * (wave + kb), 16 * kd, lane), bq[kd], S[kb]);
        }
        const float sk = sinks[qh] * LOG2E;
        float m = sk;
#pragma unroll
        for (int kb = 0; kb < 5; ++kb) {
            const bool blk_ok = cp > 0 || wave + kb >= 4;
#pragma unroll
            for (int r = 0; r < 16; ++r) {
                const int cr = crow(r, hh);
                bool ok = blk_ok;
                if (kb == 0) ok = ok && cr > qi;
                if (kb == 4) ok = ok && cr <= qi;
                const float s = ok ? S[kb][r] * SC : -1e30f;
                S[kb][r] = s; m = fmaxf(m, s);
            }
        }
        m = fmaxf(m, shx(m, 32, lane));
        float l = 0.f;
#pragma unroll
        for (int kb = 0; kb < 5; ++kb)
#pragma unroll
            for (int r = 0; r < 16; ++r) { const float p = __builtin_amdgcn_exp2f(S[kb][r] - m); S[kb][r] = p; l += p; }
        l += shx(l, 32, lane);
        l += __builtin_amdgcn_exp2f(sk - m);
        f32x16 O[2]; O[0] = (f32x16){}; O[1] = (f32x16){};
#pragma unroll
        for (int kb = 0; kb < 5; ++kb)
#pragma unroll
            for (int s2 = 0; s2 < 2; ++s2) {
                const bf16x8 a = pack_frag(S[kb], s2);
#pragma unroll
                for (int db = 0; db < 2; ++db) O[db] = MFMA32(a, rd_tr<true>(Vs, 32 * (wave + kb) + 16 * s2, 32 * db, lane), O[db]);
            }
        if (hh == 0) wsf[qi] = __builtin_amdgcn_rcpf(l);
        asm volatile("s_waitcnt lgkmcnt(0)" ::: "memory");
#pragma unroll
        for (int r = 0; r < 16; ++r) {
            const int q = crow(r, hh); const float rl = wsf[q];
#pragma unroll
            for (int db = 0; db < 2; ++db) *((LAS bf16_t*)(ost + q * 128) + 32 * db + qi) = f2bf(O[db][r] * rl);
        }
        asm volatile("s_waitcnt lgkmcnt(0)" ::: "memory");
#pragma unroll
        for (int i = 0; i < 4; ++i) { const int row = i * 8 + (lane >> 3), ch = lane & 7;
            *(u32x4*)(Y + (rowq0 + 32 * wave + row) * D_MODEL + 640 + qh * 64 + ch * 8) = *(LAS const u32x4*)(ost + row * 128 + ch * 16); }
        asm volatile("s_waitcnt lgkmcnt(0)" ::: "memory");
    }
}

constexpr int RT_Q = 0, RT_K = CHUNK * TS, RT_V = 2 * CHUNK * TS, RT_S = 3 * CHUNK * TS, RT_O = RT_S + 64 * TS, RT_X = RT_O + CHUNK * 68 * 4, RT_END = RT_X + 16384;
struct RetRegs { u32x4 q[2], k[2], v[2], g[2]; };
__device__ __forceinline__ void ret_load(RetRegs& R, const bf16_t* P, size_t row0, int h, int tid) {
    const int r0 = tid >> 3, c = tid & 7;
#pragma unroll
    for (int i = 0; i < 2; ++i) {
        const bf16_t* pr = P + (row0 + r0 + 64 * i) * IN_W + c * 8;
        R.q[i] = *(const u32x4*)(pr + (H_BQ + h) * 64); R.k[i] = *(const u32x4*)(pr + (H_BK + h) * 64); R.v[i] = *(const u32x4*)(pr + (H_BV + h) * 64);
    }
    const int row = tid >> 2, part = tid & 3;
    const bf16_t* gp = P + (row0 + row) * IN_W + (H_BG + h) * 64 + 16 * part;
    R.g[0] = *(const u32x4*)gp; R.g[1] = *(const u32x4*)(gp + 8);
}
typedef float f32x2m __attribute__((ext_vector_type(2)));
__device__ __forceinline__ u32x4 scale_bf8(const u32x4& r, float sc) {
    const unsigned w[4] = {r.x, r.y, r.z, r.w}; unsigned o[4];
#pragma unroll
    for (int k = 0; k < 4; ++k) { f32x2m v = {__uint_as_float(w[k] << 16), __uint_as_float(w[k] & 0xffff0000u)}; v = v * sc; o[k] = cvt_pk_bf16(v.x, v.y); }
    return (u32x4){o[0], o[1], o[2], o[3]};
}
__device__ __forceinline__ void ret_write(const RetRegs& R, LAS unsigned char* lds, const float (&sq)[2], const float (&sk)[2], int tid) {
    const int r0 = tid >> 3, c = tid & 7;
#pragma unroll
    for (int i = 0; i < 2; ++i) {
        const int r = r0 + 64 * i;
        *(LAS u32x4*)(lds + RT_Q + r * TS + c * 16) = scale_bf8(R.q[i], sq[i]);
        *(LAS u32x4*)(lds + RT_K + r * TS + c * 16) = scale_bf8(R.k[i], sk[i]);
        *(LAS u32x4*)(lds + RT_V + r * TS + c * 16) = R.v[i];
    }
}
__device__ __forceinline__ void ret_item(LAS unsigned char* lds, const bf16_t* P, const float* gn_w, bf16_t* Y, int item, int tid, int wave, int lane, volatile LAS unsigned* slotp, unsigned fut) {
    const int h = item % 6, b = item / 6;
    const float lg = c_log2g[h];
    const float g1 = exp2f(lg), g127 = exp2f(127.f * lg), g128 = exp2f(128.f * lg);
    LAS unsigned char* Qs = lds + RT_Q; LAS unsigned char* Ks = lds + RT_K; LAS unsigned char* Vs = lds + RT_V; LAS unsigned char* Sb = lds + RT_S;
    LAS float* Os = (LAS float*)(lds + RT_O); LAS float* Xs = (LAS float*)(lds + RT_X);
    const int tb = wave >> 1, eb = wave & 1, qi = lane & 31, hh = lane >> 5;
    const int db = (wave >> 1) & 1, kh = wave >> 2;
    const int erow = tid >> 2, part = tid & 3;
    float gw0[8], gw1[8]; ld8f(gn_w + h * 64 + 16 * part, gw0); ld8f(gn_w + h * 64 + 16 * part + 8, gw1);
    f32x16 st = {};
    float sq[2], sk[2];
#pragma unroll
    for (int i = 0; i < 2; ++i) { const float r = (float)((tid >> 3) + 64 * i); sq[i] = exp2f(r * lg); sk[i] = exp2f(-r * lg); }
    RetRegs R; ret_load(R, P, (size_t)b * SEQ, h, tid);
    for (int c = 0; c < 16; ++c) {
        const size_t row0 = (size_t)b * SEQ + (size_t)c * CHUNK;
        ret_write(R, lds, sq, sk, tid);
        const u32x4 gq0 = R.g[0], gq1 = R.g[1];
        __syncthreads();
        if (c + 1 < 16) ret_load(R, P, row0 + CHUNK, h, tid);
        f32x16 O = {};
        for (int sb = 0; sb <= tb; ++sb) {
            f32x16 S = {};
#pragma unroll
            for (int kd = 0; kd < 4; ++kd) S = MFMA32(rd_row(Ks, 32 * sb, 16 * kd, lane), rd_row(Qs, 32 * tb, 16 * kd, lane), S);
            if (sb == tb) {
#pragma unroll
                for (int r = 0; r < 16; ++r) S[r] = crow(r, hh) <= qi ? S[r] : 0.f;
            }
#pragma unroll
            for (int s2 = 0; s2 < 2; ++s2) O = MFMA32(pack_frag(S, s2), rd_tr<true>(Vs, 32 * sb + 16 * s2, 32 * eb, lane), O);
        }
        if (c > 0) {
#pragma unroll
            for (int kd = 0; kd < 4; ++kd) O = MFMA32(rd_row(Qs, 32 * tb, 16 * kd, lane), rd_row(Sb, 32 * eb, 16 * kd, lane), O);
        }
#pragma unroll
        for (int r = 0; r < 16; ++r) Os[(32 * tb + crow(r, hh)) * 68 + 32 * eb + qi] = O[r];
        if (c + 1 < 16) {
            f32x16 acc = {};
#pragma unroll
            for (int ks = 0; ks < 4; ++ks) acc = MFMA32(rd_tr<false>(Vs, 64 * kh + 16 * ks, 32 * eb, lane), rd_tr<false>(Ks, 64 * kh + 16 * ks, 32 * db, lane), acc);
#pragma unroll
            for (int r = 0; r < 16; ++r) st[r] = st[r] * g128 + g127 * acc[r];
            if (kh == 1) {
#pragma unroll
                for (int r = 0; r < 16; ++r) Xs[((eb * 2 + db) * 16 + r) * 64 + lane] = st[r];
            }
        }
        __syncthreads();
        if (c + 1 < 16 && kh == 0) {
#pragma unroll
            for (int r = 0; r < 16; ++r) { const int e = 32 * eb + crow(r, hh), d = 32 * db + qi; const float sv = (st[r] + Xs[((eb * 2 + db) * 16 + r) * 64 + lane]) * g1; *((LAS bf16_t*)(Sb + e * TS) + d) = (bf16_t)cvt_pk_bf16(sv, sv); }
        }
        {
            float v[16]; float s = 0.f;
#pragma unroll
            for (int j = 0; j < 16; ++j) { v[j] = Os[erow * 68 + 16 * part + j]; s += v[j]; }
            s += shx(s, 1, lane); s += shx(s, 2, lane);
            const float mu = s * (1.0f / 64.0f); float q = 0.f;
#pragma unroll
            for (int j = 0; j < 16; ++j) { v[j] -= mu; q += v[j] * v[j]; }
            q += shx(q, 1, lane); q += shx(q, 2, lane);
            const float rs = fast_rsq(q * (1.0f / 64.0f) + EPS);
            float ga[8], gb[8], o0[8], o1[8];
            unpack_bf8(gq0, ga); unpack_bf8(gq1, gb);
#pragma unroll
            for (int j = 0; j < 8; ++j) { o0[j] = (ga[j] * gw0[j]) * (v[j] * rs); o1[j] = (gb[j] * gw1[j]) * (v[8 + j] * rs); }
            bf16_t* yp = Y + (row0 + erow) * D_MODEL + 256 + h * 64 + 16 * part;
            *(u32x4*)yp = pack8(o0); *(u32x4*)(yp + 8) = pack8(o1);
        }
    }
    if (tid == 0) *slotp = fut;
    __syncthreads();
}

constexpr int CW_TMO = 1024;
constexpr int CW_QUEUE = 2048;
constexpr int MQ_RET = 192, MQ_SWA = MQ_RET + 512, MQ_ALL = MQ_SWA + 2048;
__device__ __forceinline__ void mixers(KArgs ap, int L, LAS unsigned char* lds, int tid, int wave, int lane) {
    unsigned char* ws = ap->ws;
    const bf16_t* P = (const bf16_t*)(ws + WS_BIG); bf16_t* Y = (bf16_t*)(ws + WS_Y);
    const bf16_t* Wm = (const bf16_t*)(ws + WS_WM) + (size_t)L * 4 * CHUNK * CHUNK;
    const float* gbs = ap->in[7] + L * 4 * CHUNK; const float* gn_w = ap->in[8] + L * 384; const float* sinks = ap->in[9] + L * 6;
    unsigned* head = (unsigned*)ws + CW_QUEUE + 64 * L;
    volatile LAS unsigned* slot = (volatile LAS unsigned*)(lds + MISC_OFF + 64);
    if (tid == 0) slot[0] = atomicAdd(head, 1u);
    __syncthreads();
    unsigned cur = (unsigned)__builtin_amdgcn_readfirstlane((int)slot[0]);
    __syncthreads();
    if (tid == 0) slot[1] = atomicAdd(head, 1u);
    __syncthreads();
    unsigned nxt = (unsigned)__builtin_amdgcn_readfirstlane((int)slot[1]);
    int k = 0;
#define MQ_FETCH() unsigned fut = 0u; if (tid == 0) fut = atomicAdd(head, 1u)
#define MQ_ADVANCE() do { cur = nxt; nxt = (unsigned)__builtin_amdgcn_readfirstlane((int)slot[k]); k ^= 1; } while (0)
    while (cur < (unsigned)MQ_ALL) {
        if (cur < (unsigned)MQ_RET) {
            MQ_FETCH();
            ret_item(lds, P, gn_w, Y, (int)cur, tid, wave, lane, slot + k, fut);
            MQ_ADVANCE();
        } else if (cur < (unsigned)MQ_SWA) {
            MQ_FETCH();
            { SwaRegs R; swa_load(R, P, (int)cur - MQ_RET, tid); swa_write(R, lds, tid); }
            __syncthreads();
            swa_compute(lds, P, sinks, Y, (int)cur - MQ_RET, wave, lane);
            if (tid == 0) slot[k] = fut;
            __syncthreads();
            MQ_ADVANCE();
        } else {
            GmRegs R; gm_load(R, P, (int)cur - MQ_SWA, tid);
            int bsel = 0;
            for (;;) {
                MQ_FETCH();
                LAS unsigned char* buf = lds + bsel * GM_BUF;
                gm_write(R, buf, tid);
                __syncthreads();
                const bool more = nxt < (unsigned)MQ_ALL;
                if (more) gm_load(R, P, (int)nxt - MQ_SWA, tid);
                gm_compute(buf, Wm, gbs, Y, (int)cur - MQ_SWA, tid, wave, lane, slot + k, fut);
                MQ_ADVANCE(); bsel ^= 1;
                if (!more) break;
            }
            __syncthreads();
        }
    }
#undef MQ_FETCH
#undef MQ_ADVANCE
    __syncthreads();
}

#ifndef PG8_SP2
#define PG8_SP2 true
#endif
#ifndef PG8_ALIGN
#define PG8_ALIGN true
#endif
constexpr int N_PHASES = 1 + 8 * DEPTH;
#ifndef PHMASK
#define PHMASK 0x1ff
#endif
#ifndef DUP_MASK
#define DUP_MASK 0
#endif
#define NREP(bit) ((DUP_MASK & (bit)) ? 2 : 1)
#ifndef KREP3
#define KREP3 1
#endif
__global__ void __launch_bounds__(NTHREADS, 2) mega(Args a_) {
    extern __shared__ __attribute__((aligned(16))) unsigned char lds_raw[];
    LAS unsigned char* lds = (LAS unsigned char*)lds_raw;
    const int G = gridDim.x, bid = blockIdx.x;
    const int vcu = (G % 8 == 0) ? (bid % 8) * (G / 8) + bid / 8 : bid;
    const int NGW = G * NWAVES;
    const int wave0 = __builtin_amdgcn_readfirstlane((int)threadIdx.x >> 6);
#define opq_tid() pg8::pg8_tid(wave0)
    { const int tid = opq_tid(); for (int u = tid; u < (LDS_BYTES - RING_BYTES) / 4; u += NTHREADS) ((LAS unsigned*)(lds + RING_BYTES))[u] = 0u; }
    __syncthreads();
    XcdBarrier bar = xcd_barrier_post((unsigned*)kargs()->ws + CW_BAR + kargs()->li * XCD_BAR_WORDS, (volatile LAS unsigned*)(lds + MISC_OFF));
    const int lo = kargs()->ph_lo, hi = kargs()->ph_hi;
#define IN(k) (lo <= (k) && (k) < hi)
#define SEAM(k) do { if (IN(k) && IN((k) + 1)) xcd_barrier(bar, opq_tid()); } while (0)
#define LANE_VARS const int tid_ = opq_tid(), lane = tid_ & 63, wave = __builtin_amdgcn_readfirstlane(tid_ >> 6), gw = vcu * NWAVES + wave
    if (IN(0) && (PHMASK & 1)) for (int rep = 0; rep < NREP(1); ++rep) { LANE_VARS; prologue(kargs(), lds, gw, NGW, wave, lane); }
    SEAM(0);
#define OPQ(p) ({ auto _p = (p); asm volatile("" : "+s"(_p)); _p; })
    for (int L = 0; L < DEPTH; ++L) {
        const int p0 = 1 + 8 * L;
        if (IN(p0 + 0) && (PHMASK & 2)) for (int rep = 0; rep < NREP(2); ++rep) {
            KArgs ap = kargs(); unsigned char* wsp = ap->ws; const int Lp = OPQ(L);
            pg8::Gemm g{(const bf16_t*)(wsp + ((Lp & 1) ? WS_XB1 : WS_XB0)), (const bf16_t*)(wsp + WS_W + (size_t)Lp * W_LAYER + W_IN), M, 2816, 1024}; pg8::StaticOrder S; S.init(M, 2816, G, bid);
            EpiProj E{(bf16_t*)(wsp + WS_BIG), stat_ptr(wsp, Lp, ST_X1), ap->in[4] + Lp * 256, ap->in[5] + Lp * 256, (const float*)(wsp + WS_TAB)};
            pg8::gemm_phase<EpiProj, pg8::StaticOrder, PG8_ALIGN, PG8_SP2>(lds, g, S, E, wave0);
        }
        SEAM(p0 + 0);
        if (IN(p0 + 1) && (PHMASK & 4)) {
            LANE_VARS; (void)gw; mixers(kargs(), OPQ(L), lds, tid_, wave, lane);
        }
        SEAM(p0 + 1);
        if (IN(p0 + 2) && (PHMASK & 8)) {
            KArgs ap = kargs(); unsigned char* wsp = ap->ws; const int Lp = OPQ(L);
            pg8::Gemm g{(const bf16_t*)(wsp + WS_Y), (const bf16_t*)(wsp + WS_W + (size_t)Lp * W_LAYER + W_OUT), M, 1024, 1024}; pg8::StaticOrder S; S.init(M, 1024, G, bid);
            EpiNormRes E{(bf16_t*)(wsp + ((Lp & 1) ? WS_XB1 : WS_XB0)), ap->in[11] + Lp * D_MODEL, stat_ptr(wsp, Lp, ST_MIX), stat_ptr(wsp, Lp, ST_X2), (unsigned*)wsp + CW_TMO};
            pg8::gemm_phase<EpiNormRes, pg8::StaticOrder, PG8_ALIGN, PG8_SP2>(lds, g, S, E, wave0);
        }
        SEAM(p0 + 2);
        if (IN(p0 + 4) && (PHMASK & 32)) for (int rep = 0; rep < NREP(32); ++rep) {
            KArgs ap = kargs(); unsigned char* wsp = ap->ws; const int Lp = OPQ(L);
            pg8::Gemm g{(const bf16_t*)(wsp + ((Lp & 1) ? WS_XB1 : WS_XB0)), (const bf16_t*)(wsp + WS_W + (size_t)Lp * W_LAYER + W_FFI), M, 5632, 1024}; pg8::StaticOrder S; S.init(M, 5632, G, bid);
            EpiSwiglu E{(bf16_t*)(wsp + WS_BIG), stat_ptr(wsp, Lp, ST_X2), 1.0f / KREP3};
            pg8::gemm_phase<EpiSwiglu, pg8::StaticOrder, PG8_ALIGN, PG8_SP2, KREP3>(lds, g, S, E, wave0);
        }
        SEAM(p0 + 4);
        if (IN(p0 + 5) && (PHMASK & 64)) {
            { KArgs ap = kargs(); unsigned char* wsp = ap->ws; const int Lp = OPQ(L);
              pg8::Gemm g{(const bf16_t*)(wsp + WS_BIG), (const bf16_t*)(wsp + WS_W + (size_t)Lp * W_LAYER + W_FFO), M, 1024, D_FF}; pg8::StaticOrder S; S.init(M, 1024, G, bid);
              EpiNormRes E{(bf16_t*)(wsp + ((Lp & 1) ? WS_XB1 : WS_XB0)), ap->in[15] + Lp * D_MODEL, stat_ptr(wsp, Lp, ST_F), nullptr, (unsigned*)wsp + CW_TMO};
              pg8::gemm_phase<EpiNormRes, pg8::StaticOrder, PG8_ALIGN, PG8_SP2>(lds, g, S, E, wave0); }
            { KArgs ap = kargs(); unsigned char* wsp = ap->ws; const int Lp = OPQ(L);
              pg8::Gemm g{(const bf16_t*)(wsp + WS_PB) + (size_t)Lp * M * PLE_DIM, (const bf16_t*)(wsp + WS_W + (size_t)Lp * W_LAYER + W_P), M, 1024, PLE_DIM}; pg8::StaticOrder S; S.init(M, 1024, G, bid);
              EpiStat E{(bf16_t*)(wsp + WS_MIX), stat_ptr(wsp, Lp, ST_PP)};
              pg8::gemm_phase<EpiStat, pg8::StaticOrder, PG8_ALIGN, PG8_SP2>(lds, g, S, E, wave0); }
        }
        SEAM(p0 + 5);
        if (IN(p0 + 7) && (PHMASK & 256)) {
            KArgs ap = kargs(); unsigned char* wsp = ap->ws; const int Lp = OPQ(L);
            const bf16_t* XBc = (const bf16_t*)(wsp + ((Lp & 1) ? WS_XB1 : WS_XB0));
            pg8::Gemm g{XBc, (const bf16_t*)(wsp + WS_W + (size_t)Lp * W_LAYER + W_G), M, 1024, 1024}; pg8::StaticOrder S; S.init(M, 1024, G, bid);
            const bool last = (Lp == DEPTH - 1);
            EpiPle E{XBc, (const bf16_t*)(wsp + WS_MIX), stat_ptr(wsp, Lp, ST_PP), ap->in[18] + Lp * D_MODEL, last ? nullptr : (bf16_t*)(wsp + ((Lp & 1) ? WS_XB0 : WS_XB1)), last ? nullptr : stat_ptr(wsp, Lp + 1, ST_X1), last ? ap->out : nullptr};
            pg8::gemm_phase<EpiPle, pg8::StaticOrder, PG8_ALIGN, PG8_SP2>(lds, g, S, E, wave0);
        }
        SEAM(p0 + 7);
    }
#undef IN
#undef SEAM
#undef LANE_VARS
#undef opq_tid
}

extern "C" void kernel_launch(void* const* d_in, const int* in_sizes, int n_in, void* d_out, int out_size, void* d_ws, size_t ws_size, hipStream_t stream) {
    static int grid = 0;
    if (grid == 0) {
        if (n_in != 19 || out_size != M * D_MODEL || ws_size < WS_END) { fprintf(stderr, "kernel_launch: unexpected shapes (n_in %d out %d ws %zu)\n", n_in, out_size, ws_size); grid = -1; return; }
        int dev = 0, cus = 0, per_cu = 0;
        if (hipGetDevice(&dev) != hipSuccess || hipDeviceGetAttribute(&cus, hipDeviceAttributeMultiprocessorCount, dev) != hipSuccess) { grid = -1; return; }
        if (hipFuncSetAttribute((const void*)mega, hipFuncAttributeMaxDynamicSharedMemorySize, LDS_BYTES) != hipSuccess) { fprintf(stderr, "kernel_launch: hipFuncSetAttribute failed\n"); grid = -1; return; }
        if (hipOccupancyMaxActiveBlocksPerMultiprocessor(&per_cu, (const void*)mega, NTHREADS, LDS_BYTES) != hipSuccess || per_cu < 1) { fprintf(stderr, "kernel_launch: occupancy query says %d\n", per_cu); }
        (void)hipGetLastError();
        grid = cus >= 256 ? 256 : cus;
    }
    if (grid < 0) return;
    unsigned char* ws = (unsigned char*)d_ws;
    (void)hipMemsetAsync(ws + WS_CTL, 0, CTL_ZERO_BYTES, stream);
    Args a{};
    for (int i = 0; i < 19; ++i) a.in[i] = (const float*)d_in[i];
    a.out = (float*)d_out; a.ws = ws; a.li = 0; a.pad = 0;
    a.ph_lo = 0; a.ph_hi = N_PHASES;
    hipLaunchKernelGGL(mega, dim3(grid), dim3(NTHREADS), LDS_BYTES, stream, a);
}
```

```cpp
#include <hip/hip_runtime.h>
#include <stdint.h>
#include <stdio.h>

constexpr int D_MODEL = 1024, BATCH = 32, SEQ = 2048, DEPTH = 2, PLE_DIM = 256, HD = 64, CHUNK = 128;
constexpr int M = BATCH * SEQ;
constexpr int IN_W = 2688, D_FF = 2816, NHEADS = 42;
constexpr int H_AU = 0, H_AV = 4, H_BQ = 8, H_BK = 14, H_BV = 20, H_BG = 26, H_CQ = 32, H_CK = 38, H_CV = 40;
constexpr float EPS = 1e-6f;
typedef unsigned short bf16_t;

__device__ __forceinline__ float bf2f(bf16_t v) { return __uint_as_float(((unsigned)v) << 16); }
__device__ __forceinline__ bf16_t f2bf(float f) { unsigned u = __float_as_uint(f); return (bf16_t)((u + 0x7fffu + ((u >> 16) & 1u)) >> 16); }
__device__ __forceinline__ float shx(float v, int mask, int lane) { return __int_as_float(__builtin_amdgcn_ds_bpermute((lane ^ mask) << 2, __float_as_int(v))); }
__device__ __forceinline__ float wave_sum(float v) {
#pragma unroll
    for (int o = 1; o < 64; o <<= 1) v += __shfl_xor(v, o);
    return v;
}
constexpr float LOG2E_ = 1.4426950408889634f;

__constant__ double c_inv_ret[32] = {1.0, 0.7498942093324559, 0.5623413251903491, 0.4216965034285822, 0.31622776601683794, 0.23713737056616552, 0.1778279410038923, 0.1333521432163324, 0.1, 0.07498942093324558, 0.05623413251903491, 0.042169650342858224, 0.03162277660168379, 0.023713737056616554, 0.01778279410038923, 0.01333521432163324, 0.01, 0.007498942093324558, 0.005623413251903491, 0.004216965034285823, 0.0031622776601683794, 0.0023713737056616554, 0.0017782794100389228, 0.001333521432163324, 0.001, 0.0007498942093324559, 0.0005623413251903491, 0.00042169650342858224, 0.00031622776601683794, 0.00023713737056616554, 0.00017782794100389227, 0.0001333521432163324};
__constant__ double c_inv_swa[8] = {1.0, 0.19392274474868576, 0.03760603093086393, 0.007292664737217109, 0.001414213562373095, 0.0002742481756762073, 5.318295896944988e-05, 1.031338537721246e-05};
__constant__ float c_log2g[6] = {-0.04580368961312479f, -0.02272007650008353f, -0.011315313227834146f, -0.005646563141142063f, -0.0028205190623786626f, -0.0014095702546713536f};

constexpr size_t MiB = 1u << 20;
constexpr size_t WS_CTL = 0, CTL_ZERO_BYTES = 7 * MiB;
constexpr size_t WS_STAT = 1 * MiB;
constexpr size_t WS_TAB = 7 * MiB;
constexpr size_t WS_WM = 7 * MiB + 768 * 1024;
constexpr size_t WS_W = 8 * MiB;
constexpr size_t WS_XB0 = 64 * MiB;
constexpr size_t WS_BIG = 192 * MiB;
constexpr size_t WS_Y = 544 * MiB;
constexpr size_t WS_MIX = 672 * MiB;
constexpr size_t WS_XB1 = 800 * MiB;
constexpr size_t WS_PB = 928 * MiB;
constexpr size_t WS_END = 992 * MiB;
constexpr int TAB_RC = 0, TAB_RS = 2048 * 32, TAB_SC = 2 * 2048 * 32, TAB_SS = 2 * 2048 * 32 + 2048 * 8;


namespace pg8 {
#define PG8_LAS __attribute__((address_space(3)))
typedef unsigned short bf16_t;
typedef short bf16x8 __attribute__((ext_vector_type(8)));
typedef float f32x4 __attribute__((ext_vector_type(4)));
typedef unsigned u32x4 __attribute__((ext_vector_type(4)));
constexpr int BM = 256, BK = 64, HALF = 128, HTB = HALF * BK * 2  , STAGE_BYTES = 8 * HTB, NXCD = 8, WGM = 8;

__host__ __device__ __forceinline__ int lds_byte(int r, int c) { const int st = (r >> 4) * 2 + (c >> 5), rr = r & 15, cc = c & 31, ob = rr * 64 + cc * 2; return st * 1024 + (ob ^ (((ob >> 9) & 1) << 5)); }
__host__ __device__ __forceinline__ void stage_rc(int b, int& R, int& C) { const int st = b / 1024, sb = b % 1024, swz = sb ^ (((sb >> 9) & 1) << 5); R = (st >> 1) * 16 + swz / 64; C = (st & 1) * 32 + (swz % 64) / 2; }
__host__ __device__ __forceinline__ int perm32(int rho) { const int n = rho >> 4, i = rho & 15; return 8 * (i >> 2) + 4 * n + (i & 3); }

struct Unit { int pm, pn; };
struct Gemm { const bf16_t* A; const bf16_t* Bt; int M, N, K; };

struct StaticOrder {
    int nM, nN, nwg, G, c, wgm;
    __host__ __device__ void init(int M, int N, int G_, int c_) { nM = M / BM; nN = N / BM; nwg = nM * nN; G = G_; c = c_; wgm = nN >= 8 ? 4 : WGM; }
    __host__ __device__ bool next(int i, Unit& u) const {
        const long L = (long)i * G + c; if (L >= nwg) return false;
        int wgid = (int)L; { const int q = nwg / NXCD, r = nwg % NXCD, xcd = wgid % NXCD, off = wgid / NXCD; wgid = (xcd < r ? xcd * (q + 1) : r * (q + 1) + (xcd - r) * q) + off; }
        const int nig = wgm * nN, gid = wgid / nig, fm = gid * wgm, gsz = (nM - fm) < wgm ? (nM - fm) : wgm;
        u.pm = fm + ((wgid % nig) % gsz); u.pn = (wgid % nig) / gsz; return true;
    }
    __device__ __forceinline__ void a_ready(const Unit&) const {}
    __device__ __forceinline__ void done(const Unit&) const {}
};

typedef float f32x2_cv __attribute__((ext_vector_type(2))); typedef __bf16 bf16x2_cv __attribute__((ext_vector_type(2)));
__device__ __forceinline__ unsigned cvt_pk_bf16(float lo, float hi) { const f32x2_cv v = {lo, hi}; const bf16x2_cv b = __builtin_convertvector(v, bf16x2_cv); return __builtin_bit_cast(unsigned, b); }
__device__ __forceinline__ int pg8_tid(int wave0) {
    unsigned ones = ~0u; asm volatile("" : "+s"(ones));
    return wave0 * 64 + (int)__builtin_amdgcn_mbcnt_hi(ones, __builtin_amdgcn_mbcnt_lo(ones, 0u));
}
template <class Epi, class Sched, bool ALIGN_EPI = false, bool SP2 = false, int KREP = 1>
__device__ __forceinline__ void gemm_phase(PG8_LAS unsigned char* lds, const Gemm g, const Sched& S, const Epi& E, int wave0) {
    const int tid = pg8_tid(wave0);
    const int wid = __builtin_amdgcn_readfirstlane(tid >> 6), lane = tid & 63, wr = wid >> 2, wc = wid & 3, fr = lane & 15, fq = lane >> 4;
    const int K = g.K, nt = K / BK;
    unsigned voffA[2], voffB[2];
#pragma unroll
    for (int i = 0; i < 2; ++i) { int R, C; stage_rc(tid * 16 + i * 8192, R, C); const int Rb = Epi::PERM ? ((R & ~31) + perm32(R & 31)) : R;
        voffA[i] = (unsigned)(R * K + C) * 2u; voffB[i] = (unsigned)(Rb * K + C) * 2u; }
    const size_t kstep = (size_t)(BK * 2);
    const size_t hstep = (size_t)HALF * K * 2;
    const size_t tstep = 2 * hstep;
    const unsigned ldsw = (unsigned)wid * 1024u;
    const int aoff = lds_byte(wr * 64 + fr, fq * 8), boff = lds_byte(wc * 32 + fr, fq * 8);
#define PG8_SA(b, h) (((b) * 2 + (h)) * HTB)
#define PG8_SB(b, h) ((4 + (b) * 2 + (h)) * HTB)
#define PG8_STAGE(bufoff, gbase, voff) do { _Pragma("unroll") for (int _i = 0; _i < 2; ++_i) \
        __builtin_amdgcn_global_load_lds((const unsigned*)((const char*)(gbase) + (voff)[_i]), (PG8_LAS unsigned*)(lds + (bufoff) + ldsw + _i * 8192), 16, 0, 0); } while (0)
#define PG8_LDA(dst, b, h) do { _Pragma("unroll") for (int m = 0; m < 4; ++m) _Pragma("unroll") for (int k = 0; k < 2; ++k) dst[m][k] = *(const PG8_LAS bf16x8*)(lds + PG8_SA(b, h) + aoff + m * 2048 + k * 1024); } while (0)
#define PG8_LDB(dst, b, h) do { _Pragma("unroll") for (int n = 0; n < 2; ++n) _Pragma("unroll") for (int k = 0; k < 2; ++k) dst[n][k] = *(const PG8_LAS bf16x8*)(lds + PG8_SB(b, h) + boff + n * 2048 + k * 1024); } while (0)
#define PG8_MMA(ai, bj, At, Bt) do { __builtin_amdgcn_s_setprio(1); _Pragma("unroll") for (int m = 0; m < 4; ++m) _Pragma("unroll") for (int n = 0; n < 2; ++n) _Pragma("unroll") for (int k = 0; k < 2; ++k) \
        acc[ai][bj][m][n] = __builtin_amdgcn_mfma_f32_16x16x32_bf16(Bt[n][k], At[m][k], acc[ai][bj][m][n], 0, 0, 0); __builtin_amdgcn_s_setprio(0); } while (0)
#define PG8_WAIT_V(n) asm volatile("s_waitcnt vmcnt(" #n ")" ::: "memory")
#define PG8_WAIT_L(n) asm volatile("s_waitcnt lgkmcnt(" #n ")" ::: "memory")
#define PG8_BAR __builtin_amdgcn_s_barrier()
#define PG8_SCHED __builtin_amdgcn_sched_barrier(0)
    Unit cur, nxt; int ui = 0;
    if (!S.next(0, cur)) return;
    f32x4 acc[2][2][4][2];
#pragma unroll
    for (int a = 0; a < 2; ++a)
#pragma unroll
        for (int b = 0; b < 2; ++b)
#pragma unroll
            for (int m = 0; m < 4; ++m)
#pragma unroll
                for (int n = 0; n < 2; ++n) acc[a][b][m][n] = (f32x4){0.f, 0.f, 0.f, 0.f};
    bf16x8 At[4][2], B0[2][2], B1[2][2];
    const char* cA = (const char*)g.A + (size_t)cur.pm * tstep; const char* cB = (const char*)g.Bt + (size_t)cur.pn * tstep;
    S.a_ready(cur);
    if constexpr (SP2) {
        PG8_STAGE(PG8_SB(0, 0), cB, voffB); PG8_STAGE(PG8_SB(0, 1), cB + hstep, voffB); PG8_STAGE(PG8_SA(0, 0), cA, voffA); PG8_STAGE(PG8_SA(0, 1), cA + hstep, voffA);
        if (wr == 1) PG8_BAR;
        PG8_WAIT_V(2); PG8_BAR;
        PG8_STAGE(PG8_SB(1, 0), cB + kstep, voffB); PG8_STAGE(PG8_SA(1, 0), cA + kstep, voffA); PG8_STAGE(PG8_SB(1, 1), cB + hstep + kstep, voffB);
        PG8_WAIT_V(6); PG8_BAR;
    } else {
        PG8_STAGE(PG8_SB(0, 0), cB, voffB); PG8_STAGE(PG8_SA(0, 0), cA, voffA); PG8_STAGE(PG8_SB(0, 1), cB + hstep, voffB); PG8_STAGE(PG8_SA(0, 1), cA + hstep, voffA);
        if (wr == 1) PG8_BAR;
        PG8_WAIT_V(4); PG8_BAR;
        PG8_STAGE(PG8_SB(1, 0), cB + kstep, voffB); PG8_STAGE(PG8_SA(1, 0), cA + kstep, voffA); PG8_STAGE(PG8_SB(1, 1), cB + hstep + kstep, voffB);
        PG8_WAIT_V(6); PG8_BAR;
    }
    for (;;) {
        const bool has_next = S.next(ui + 1, nxt);
        const char* nA = has_next ? (const char*)g.A + (size_t)nxt.pm * tstep : cA; const char* nB = has_next ? (const char*)g.Bt + (size_t)nxt.pn * tstep : cB;
        for (int t = 0; t < nt * KREP; t += 2) {
            const bool last = (t == nt * KREP - 2);
            const int t1 = KREP > 1 ? (t + 1) % nt : t + 1, t2 = KREP > 1 ? (t + 2) % nt : t + 2;
            const char* a1 = cA + (size_t)t1 * kstep;
            const char* a2 = last ? nA : cA + (size_t)t2 * kstep; const char* b2 = last ? nB : cB + (size_t)t2 * kstep;
            const char* a3 = a2 + kstep; const char* b3 = b2 + kstep;
            if (last && has_next) S.a_ready(nxt);
            if constexpr (SP2) {
            PG8_LDB(B0, 0, 0); PG8_LDB(B1, 0, 1); PG8_SCHED; PG8_LDA(At, 0, 0); PG8_STAGE(PG8_SA(1, 1), a1 + hstep, voffA);
            PG8_WAIT_V(8); PG8_WAIT_L(0); PG8_BAR; PG8_MMA(0, 0, At, B0); PG8_MMA(0, 1, At, B1); PG8_BAR; PG8_SCHED;
            PG8_LDA(At, 0, 1); PG8_STAGE(PG8_SB(0, 0), b2, voffB); PG8_STAGE(PG8_SB(0, 1), b2 + hstep, voffB); PG8_STAGE(PG8_SA(0, 0), a2, voffA);
            PG8_WAIT_V(8); PG8_WAIT_L(0); PG8_BAR; PG8_MMA(1, 0, At, B0); PG8_MMA(1, 1, At, B1); PG8_BAR; PG8_SCHED;
            PG8_LDB(B0, 1, 0); PG8_LDB(B1, 1, 1); PG8_SCHED; PG8_LDA(At, 1, 0); PG8_STAGE(PG8_SA(0, 1), a2 + hstep, voffA);
            PG8_WAIT_V(8); PG8_WAIT_L(0); PG8_BAR; PG8_MMA(0, 0, At, B0); PG8_MMA(0, 1, At, B1); PG8_BAR; PG8_SCHED;
            PG8_LDA(At, 1, 1); PG8_STAGE(PG8_SB(1, 0), b3, voffB); PG8_STAGE(PG8_SB(1, 1), b3 + hstep, voffB); PG8_STAGE(PG8_SA(1, 0), a3, voffA);
            PG8_WAIT_V(8); PG8_WAIT_L(0); PG8_BAR; PG8_MMA(1, 0, At, B0); PG8_MMA(1, 1, At, B1); PG8_BAR; PG8_SCHED;
            } else {
            PG8_LDB(B0, 0, 0); PG8_SCHED; PG8_LDA(At, 0, 0); PG8_STAGE(PG8_SA(1, 1), a1 + hstep, voffA);
            PG8_WAIT_L(8); PG8_BAR; PG8_WAIT_L(0); PG8_MMA(0, 0, At, B0); PG8_BAR; PG8_SCHED;
            PG8_LDB(B1, 0, 1); PG8_STAGE(PG8_SB(0, 0), b2, voffB);
            PG8_BAR; PG8_WAIT_L(0); PG8_MMA(0, 1, At, B1); PG8_BAR;
            PG8_LDA(At, 0, 1); PG8_STAGE(PG8_SA(0, 0), a2, voffA);
            PG8_BAR; PG8_WAIT_L(0); PG8_MMA(1, 0, At, B0); PG8_BAR; PG8_SCHED;
            PG8_STAGE(PG8_SB(0, 1), b2 + hstep, voffB);
            PG8_WAIT_V(6); PG8_BAR; PG8_MMA(1, 1, At, B1); PG8_BAR;
            PG8_LDB(B0, 1, 0); PG8_SCHED; PG8_LDA(At, 1, 0); PG8_STAGE(PG8_SA(0, 1), a2 + hstep, voffA);
            PG8_WAIT_L(8); PG8_BAR; PG8_WAIT_L(0); PG8_MMA(0, 0, At, B0); PG8_BAR; PG8_SCHED;
            PG8_LDB(B1, 1, 1); PG8_STAGE(PG8_SB(1, 0), b3, voffB);
            PG8_BAR; PG8_WAIT_L(0); PG8_MMA(0, 1, At, B1); PG8_BAR;
            PG8_LDA(At, 1, 1); PG8_STAGE(PG8_SA(1, 0), a3, voffA);
            PG8_BAR; PG8_WAIT_L(0); PG8_MMA(1, 0, At, B0); PG8_BAR; PG8_SCHED;
            PG8_STAGE(PG8_SB(1, 1), b3 + hstep, voffB);
            PG8_WAIT_V(6); PG8_BAR; PG8_MMA(1, 1, At, B1); PG8_BAR;
            }
        }
        if constexpr (ALIGN_EPI) { if (wr == 0) PG8_BAR; }
        if constexpr (!Epi::AFTER_DRAIN) { E(acc, cur, wr, wc, fr, fq); S.done(cur); }
        if (!has_next) break;
#pragma unroll
        for (int a = 0; a < 2; ++a)
#pragma unroll
            for (int b = 0; b < 2; ++b)
#pragma unroll
                for (int m = 0; m < 4; ++m)
#pragma unroll
                    for (int n = 0; n < 2; ++n) acc[a][b][m][n] = (f32x4){0.f, 0.f, 0.f, 0.f};
        cur = nxt; cA = nA; cB = nB; ++ui;
        if constexpr (ALIGN_EPI) { if (wr == 1) PG8_BAR; }
    }
    PG8_WAIT_V(0);
    if constexpr (!ALIGN_EPI) { if (wr == 0) PG8_BAR; }
    PG8_BAR;
    if constexpr (Epi::AFTER_DRAIN) { E.fused(acc, cur, wr, wc, fr, fq, lds, wid, lane); S.done(cur); }
#undef PG8_SA
#undef PG8_SB
#undef PG8_STAGE
#undef PG8_LDA
#undef PG8_LDB
#undef PG8_MMA
#undef PG8_WAIT_V
#undef PG8_WAIT_L
#undef PG8_BAR
#undef PG8_SCHED
}
}

#define LAS __attribute__((address_space(3)))
#define GAS __attribute__((address_space(1)))
using pg8::f32x4; using pg8::u32x4; using pg8::Unit; using pg8::cvt_pk_bf16;
typedef unsigned u32x2 __attribute__((ext_vector_type(2)));
typedef GAS unsigned gu32;
#define RLX_AGENT __ATOMIC_RELAXED, __HIP_MEMORY_SCOPE_AGENT

constexpr int NWAVES = 8, NTHREADS = 512;
constexpr int LDS_BYTES = 163840;
constexpr int RING_BYTES = 147456, MISC_OFF = RING_BYTES + 320;
constexpr size_t W_IN = 0, W_OUT = W_IN + (size_t)2816 * 1024 * 2, W_FFI = W_OUT + (size_t)1024 * 1024 * 2, W_FFO = W_FFI + (size_t)5632 * 1024 * 2,
                 W_G = W_FFO + (size_t)1024 * 2816 * 2, W_P = W_G + (size_t)1024 * 1024 * 2, W_LAYER = W_P + (size_t)1024 * 256 * 2;
static_assert(WS_W + 2 * W_LAYER <= WS_XB0, "weights fit");
enum { ST_X1 = 0, ST_MIX = 1, ST_X2 = 2, ST_F = 3, ST_PP = 4, ST_N = 5 };
typedef unsigned long long stat_t;
__host__ __device__ __forceinline__ stat_t* stat_ptr(unsigned char* ws, int L, int idx) { return (stat_t*)(ws + WS_STAT) + (size_t)(L * ST_N + idx) * M; }
static_assert(WS_STAT + (size_t)2 * ST_N * M * 8 <= CTL_ZERO_BYTES && CTL_ZERO_BYTES <= WS_TAB, "stats inside the zeroed region");
__device__ __forceinline__ stat_t ss_enc(float s) { return (stat_t)(s * 16777216.0f); }
__device__ __forceinline__ float ss_dec(stat_t v) { return (float)v * (1.0f / 16777216.0f); }
constexpr int CW_BAR = 4096;

#define XB_TMO      128
#define XB_XCNT(j)  (256  + 64 * (j))
#define XB_XSUB(j)  (1280 + 64 * (j))
#define XB_XGEN(j)  (2304 + 64 * (j))
#define XB_TOP      3328
#define XB_TOPGEN   3392
#define XCD_BAR_WORDS 3456
#define XB_SPIN_CAP (1u << 22)
__device__ __forceinline__ unsigned xb_ld(unsigned* p)              { return __hip_atomic_load(p, __ATOMIC_RELAXED, __HIP_MEMORY_SCOPE_AGENT); }
__device__ __forceinline__ unsigned xb_add(unsigned* p, unsigned v) { return __hip_atomic_fetch_add(p, v, __ATOMIC_RELAXED, __HIP_MEMORY_SCOPE_AGENT); }
__device__ __forceinline__ unsigned xb_xcc_id() { return (unsigned)__builtin_amdgcn_s_getreg((3 << 11) | 20) & 0xFu; }
#define XB_SPIN(cond, bar) do { unsigned _sp = 0; while (cond) { __builtin_amdgcn_s_sleep(1); \
    if ((++_sp & 255u) == 0u) { if (xb_ld(&(bar)[XB_TMO])) break; if (_sp > XB_SPIN_CAP) { atomicAdd(&(bar)[XB_TMO], 1u); break; } } } } while (0)
struct XcdBarrier { unsigned* bar; unsigned x; volatile LAS unsigned* st; };
__device__ __forceinline__ XcdBarrier xcd_barrier_post(unsigned* bar, volatile LAS unsigned* st) {
    XcdBarrier b; b.bar = bar; b.x = xb_xcc_id(); b.st = st;
    if (threadIdx.x == 0) (void)xb_add(&bar[XB_XCNT(b.x)], 1u);
    return b;
}
__device__ __forceinline__ void xcd_barrier_complete(unsigned* bar, unsigned x, unsigned& nloc, unsigned& nx) {
    const unsigned G = gridDim.x * gridDim.y * gridDim.z;
    unsigned sum, cnt, mine, sp = 0u;
    for (;;) {
        sum = 0u; cnt = 0u; mine = 0u;
#pragma unroll
        for (unsigned j = 0; j < 16; ++j) { const unsigned c = xb_ld(&bar[XB_XCNT(j)]); sum += c; cnt += (c > 0u) ? 1u : 0u; mine = (j == x) ? c : mine; }
        if (sum == G) break;
        __builtin_amdgcn_s_sleep(1);
        if ((++sp & 255u) == 0u) { if (xb_ld(&bar[XB_TMO])) break; if (sp > XB_SPIN_CAP) { atomicAdd(&bar[XB_TMO], 1u); break; } }
    }
    nloc = mine > 0u ? mine : 1u; nx = cnt > 0u ? cnt : 1u;
}
__device__ __forceinline__ void xcd_barrier(const XcdBarrier& b, int tid) {
    asm volatile("s_waitcnt vmcnt(0)" ::: "memory");
    __syncthreads();
    if (tid == 0) {
        unsigned* bar = b.bar;
        __builtin_amdgcn_s_waitcnt(0);
        unsigned nloc = b.st[0], nx = b.st[1];
        if (nloc == 0u) { xcd_barrier_complete(bar, b.x, nloc, nx); b.st[0] = nloc; b.st[1] = nx; }
        const unsigned old = xb_add(&bar[XB_XSUB(b.x)], 1u);
        const unsigned gen = old / nloc;
        if (old + 1u == (gen + 1u) * nloc) {
            __builtin_amdgcn_fence(__ATOMIC_RELEASE, "agent");
            asm volatile("s_waitcnt vmcnt(0)" ::: "memory");
            const unsigned og = xb_add(&bar[XB_TOP], 1u);
            const unsigned tg = og / nx;
            if (og + 1u == (tg + 1u) * nx) xb_add(&bar[XB_TOPGEN], 1u);
            else XB_SPIN(xb_ld(&bar[XB_TOPGEN]) == tg, bar);
            __builtin_amdgcn_fence(__ATOMIC_ACQUIRE, "agent");
            xb_add(&bar[XB_XGEN(b.x)], 1u);
            asm volatile("s_waitcnt vmcnt(0)" ::: "memory");
        } else {
            XB_SPIN(xb_ld(&bar[XB_XGEN(b.x)]) == gen, bar);
            __builtin_amdgcn_fence(__ATOMIC_ACQUIRE, "agent");
            asm volatile("s_waitcnt vmcnt(0)" ::: "memory");
        }
    }
    __syncthreads();
}

__device__ __forceinline__ float fast_rsq(float x) { return __builtin_amdgcn_rsqf(x); }
__device__ __forceinline__ float sigm(float x) { return __builtin_amdgcn_rcpf(1.0f + __builtin_amdgcn_exp2f(-LOG2E_ * x)); }
__device__ __forceinline__ float gelu_t(float x) { return x * sigm(1.5957691216057308f * (x + 0.044715f * x * x * x)); }
__device__ __forceinline__ void unpack8s(const f32x4& v0, const f32x4& v1, float s, float (&o)[8]) {
    o[0] = v0[0] * s; o[1] = v0[1] * s; o[2] = v0[2] * s; o[3] = v0[3] * s; o[4] = v1[0] * s; o[5] = v1[1] * s; o[6] = v1[2] * s; o[7] = v1[3] * s;
}
__device__ __forceinline__ u32x4 pack8(const float (&o)[8]) {
    u32x4 w; w.x = cvt_pk_bf16(o[0], o[1]); w.y = cvt_pk_bf16(o[2], o[3]); w.z = cvt_pk_bf16(o[4], o[5]); w.w = cvt_pk_bf16(o[6], o[7]); return w;
}
__device__ __forceinline__ void ld8f(const float* p, float (&o)[8]) {
    const f32x4 a = *(const f32x4*)p, b = *(const f32x4*)(p + 4);
    o[0] = a[0]; o[1] = a[1]; o[2] = a[2]; o[3] = a[3]; o[4] = b[0]; o[5] = b[1]; o[6] = b[2]; o[7] = b[3];
}
__device__ __forceinline__ void unpack_bf8(const u32x4& r, float (&o)[8]) {
    o[0] = __uint_as_float(r.x << 16); o[1] = __uint_as_float(r.x & 0xffff0000u); o[2] = __uint_as_float(r.y << 16); o[3] = __uint_as_float(r.y & 0xffff0000u);
    o[4] = __uint_as_float(r.z << 16); o[5] = __uint_as_float(r.z & 0xffff0000u); o[6] = __uint_as_float(r.w << 16); o[7] = __uint_as_float(r.w & 0xffff0000u);
}
__device__ __forceinline__ int fresh_lane() { unsigned ones = ~0u; asm volatile("" : "+s"(ones)); return (int)__builtin_amdgcn_mbcnt_hi(ones, __builtin_amdgcn_mbcnt_lo(ones, 0u)); }
#define EPI_ROW(u, ai, wr, m, fr) ((u).pm * 256 + (ai) * 128 + (wr) * 64 + (m) * 16 + (fr))

enum { T_AU, T_AV, T_BQ, T_BK, T_BV, T_BG, T_CQ, T_CK, T_CV };
struct EpiProj {
    static constexpr bool PERM = true, AFTER_DRAIN = false;
    bf16_t* P; const stat_t* ss; const float* ln_w; const float* ln_b; const float* tab;
    template <int TYPE> __device__ __forceinline__ void rows(const f32x4 (&acc)[2][2][4][2], const Unit& u, int wr, int hs, int hrel, int fr, int fq) const {
        const int d0 = 8 * fq, ln_ = fr + 16 * fq;
        float rs[8];
#pragma unroll
        for (int q = 0; q < 8; ++q) rs[q] = ss_dec(ss[EPI_ROW(u, q >> 2, wr, q & 3, fr)]);
        float wa[8], wb[8], ba[8], bb[8];
        if constexpr (TYPE == T_AV) { ld8f(ln_w + hrel * 64 + d0, wa); ld8f(ln_w + hrel * 64 + 32 + d0, wb); ld8f(ln_b + hrel * 64 + d0, ba); ld8f(ln_b + hrel * 64 + 32 + d0, bb); }
#pragma unroll
        for (int hp = 0; hp < 4; ++hp) {
            const int ai = hp >> 1;
            float tc[2][8], tsn[2][8];
            if constexpr (TYPE == T_BQ || TYPE == T_BK) {
#pragma unroll
                for (int mm = 0; mm < 2; ++mm) { const int pos = EPI_ROW(u, ai, wr, 2 * (hp & 1) + mm, fr) & (SEQ - 1); ld8f(tab + TAB_RC + pos * 32 + d0, tc[mm]); ld8f(tab + TAB_RS + pos * 32 + d0, tsn[mm]); }
            }
            if constexpr (TYPE == T_CQ || TYPE == T_CK) {
#pragma unroll
                for (int mm = 0; mm < 2; ++mm) { const int pos = EPI_ROW(u, ai, wr, 2 * (hp & 1) + mm, fr) & (SEQ - 1); ld8f(tab + TAB_SC + pos * 8, tc[mm]); ld8f(tab + TAB_SS + pos * 8, tsn[mm]); }
            }
#pragma unroll
            for (int mm = 0; mm < 2; ++mm) {
                const int m = 2 * (hp & 1) + mm;
                const int row = EPI_ROW(u, ai, wr, m, fr);
                const float rstd = fast_rsq(rs[ai * 4 + m] * (1.0f / D_MODEL) + EPS);
                float a[8], b[8];
                unpack8s(acc[ai][0][m][0], acc[ai][0][m][1], rstd, a); unpack8s(acc[ai][1][m][0], acc[ai][1][m][1], rstd, b);
                if constexpr (TYPE == T_AU) {
#pragma unroll
                    for (int j = 0; j < 8; ++j) { a[j] = gelu_t(a[j]); b[j] = gelu_t(b[j]); }
                } else if constexpr (TYPE == T_AV) {
                    float sm = 0.f;
#pragma unroll
                    for (int j = 0; j < 8; ++j) { a[j] = gelu_t(a[j]); b[j] = gelu_t(b[j]); sm += a[j] + b[j]; }
                    sm += shx(sm, 16, ln_); sm += shx(sm, 32, ln_);
                    const float mu = sm * (1.0f / 64.0f); float q = 0.f;
#pragma unroll
                    for (int j = 0; j < 8; ++j) { a[j] -= mu; b[j] -= mu; q += a[j] * a[j] + b[j] * b[j]; }
                    q += shx(q, 16, ln_); q += shx(q, 32, ln_);
                    const float rsd = fast_rsq(q * (1.0f / 64.0f) + EPS);
#pragma unroll
                    for (int j = 0; j < 8; ++j) { a[j] = a[j] * rsd * wa[j] + ba[j]; b[j] = b[j] * rsd * wb[j] + bb[j]; }
                } else if constexpr (TYPE == T_BQ || TYPE == T_BK) {
                    const float sc = TYPE == T_BK ? 0.125f : 1.0f;
#pragma unroll
                    for (int j = 0; j < 8; ++j) { const float x1 = a[j], x2 = b[j]; a[j] = (x1 * tc[mm][j] - x2 * tsn[mm][j]) * sc; b[j] = (x2 * tc[mm][j] + x1 * tsn[mm][j]) * sc; }
                } else if constexpr (TYPE == T_BG) {
#pragma unroll
                    for (int j = 0; j < 8; ++j) { a[j] = a[j] * sigm(a[j]); b[j] = b[j] * sigm(b[j]); }
                } else if constexpr (TYPE == T_CQ || TYPE == T_CK) {
                    float o[8];
#pragma unroll
                    for (int j = 0; j < 8; ++j) o[j] = shx(a[j], 16, ln_);
                    if (fq < 2) {
                        const float sg = fq == 0 ? -1.0f : 1.0f;
#pragma unroll
                        for (int j = 0; j < 8; ++j) a[j] = a[j] * tc[mm][j] + sg * o[j] * tsn[mm][j];
                    }
                }
                bf16_t* dst = P + (size_t)row * IN_W + hs * 64 + d0;
                *(u32x4*)dst = pack8(a); *(u32x4*)(dst + 32) = pack8(b);
            }
        }
    }
    __device__ __forceinline__ void operator()(const f32x4 (&acc)[2][2][4][2], const Unit& u, int wr, int wc, int fr, int fq) const {
        const int ln_ = fresh_lane(); fr = ln_ & 15; fq = ln_ >> 4;
        const int hs = u.pn * 4 + wc;
        if (hs >= NHEADS) return;
        if (hs < H_AV) rows<T_AU>(acc, u, wr, hs, hs - H_AU, fr, fq);
        else if (hs < H_BQ) rows<T_AV>(acc, u, wr, hs, hs - H_AV, fr, fq);
        else if (hs < H_BK) rows<T_BQ>(acc, u, wr, hs, hs - H_BQ, fr, fq);
        else if (hs < H_BV) rows<T_BK>(acc, u, wr, hs, hs - H_BK, fr, fq);
        else if (hs < H_BG) rows<T_BV>(acc, u, wr, hs, hs - H_BV, fr, fq);
        else if (hs < H_CQ) rows<T_BG>(acc, u, wr, hs, hs - H_BG, fr, fq);
        else if (hs < H_CK) rows<T_CQ>(acc, u, wr, hs, hs - H_CQ, fr, fq);
        else if (hs < H_CV) rows<T_CK>(acc, u, wr, hs, hs - H_CK, fr, fq);
        else rows<T_CV>(acc, u, wr, hs, hs - H_CV, fr, fq);
    }
};
struct EpiSwiglu {
    static constexpr bool PERM = true, AFTER_DRAIN = false;
    bf16_t* H; const stat_t* ss; float kscale;
    __device__ __forceinline__ void operator()(const f32x4 (&acc)[2][2][4][2], const Unit& u, int wr, int wc, int fr, int fq) const {
        const int ln_ = fresh_lane(); fr = ln_ & 15; fq = ln_ >> 4;
        float rs[8];
#pragma unroll
        for (int q = 0; q < 8; ++q) rs[q] = ss_dec(ss[EPI_ROW(u, q >> 2, wr, q & 3, fr)]);
#pragma unroll
        for (int ai = 0; ai < 2; ++ai)
#pragma unroll
            for (int m = 0; m < 4; ++m) {
                const int row = EPI_ROW(u, ai, wr, m, fr);
                const float rstd = fast_rsq(rs[ai * 4 + m] * (1.0f / D_MODEL) + EPS) * kscale;
                typedef float f32x2 __attribute__((ext_vector_type(2)));
                const float cexp = -LOG2E_ * rstd, r2 = rstd * rstd;
                unsigned wv4[4];
#pragma unroll
                for (int n = 0; n < 2; ++n)
#pragma unroll
                    for (int hf = 0; hf < 2; ++hf) {
                        const f32x2 ag = {acc[ai][0][m][n][2 * hf], acc[ai][0][m][n][2 * hf + 1]}, au = {acc[ai][1][m][n][2 * hf], acc[ai][1][m][n][2 * hf + 1]};
                        f32x2 e = ag * cexp; e.x = __builtin_amdgcn_exp2f(e.x); e.y = __builtin_amdgcn_exp2f(e.y);
                        f32x2 d = e + 1.0f; d.x = __builtin_amdgcn_rcpf(d.x); d.y = __builtin_amdgcn_rcpf(d.y);
                        const f32x2 hh = ((ag * au) * r2) * d;
                        wv4[2 * n + hf] = cvt_pk_bf16(hh.x, hh.y);
                    }
                const u32x4 g = {wv4[0], wv4[1], wv4[2], wv4[3]};
                *(u32x4*)(H + (size_t)row * D_FF + u.pn * 128 + wc * 32 + 8 * fq) = g;
            }
    }
};
struct EpiStore {
    static constexpr bool PERM = true, AFTER_DRAIN = false;
    bf16_t* O;
    __device__ __forceinline__ void operator()(const f32x4 (&acc)[2][2][4][2], const Unit& u, int wr, int wc, int fr, int fq) const {
        const int ln_ = fresh_lane(); fr = ln_ & 15; fq = ln_ >> 4;
#pragma unroll
        for (int q = 0; q < 8; ++q) {
            const int ai = q >> 2, m = q & 3, row = EPI_ROW(u, ai, wr, m, fr);
#pragma unroll
            for (int bj = 0; bj < 2; ++bj) {
                float v[8]; unpack8s(acc[ai][bj][m][0], acc[ai][bj][m][1], 1.0f, v);
                *(u32x4*)(O + (size_t)row * D_MODEL + u.pn * 256 + bj * 128 + wc * 32 + 8 * fq) = pack8(v);
            }
        }
    }
};
struct EpiNormRes {
    static constexpr bool PERM = true, AFTER_DRAIN = false;
    bf16_t* XB; const float* w; stat_t* ssT; stat_t* ss_out; unsigned* tmo;
    __device__ __forceinline__ void operator()(const f32x4 (&acc)[2][2][4][2], const Unit& u, int wr, int wc, int fr, int fq) const {
        const int ln_ = fresh_lane(); fr = ln_ & 15; fq = ln_ >> 4;
        const int col0 = u.pn * 256 + wc * 32 + 8 * fq;
        float s[8];
#pragma unroll
        for (int q = 0; q < 8; ++q) {
            const int ai = q >> 2, m = q & 3; float sq = 0.f;
#pragma unroll
            for (int bj = 0; bj < 2; ++bj)
#pragma unroll
                for (int n = 0; n < 2; ++n) { const f32x4 v = acc[ai][bj][m][n]; sq += (v[0] * v[0] + v[1] * v[1]) + (v[2] * v[2] + v[3] * v[3]); }
            s[q] = sq;
        }
#pragma unroll
        for (int q = 0; q < 8; ++q) s[q] += shx(s[q], 16, ln_);
#pragma unroll
        for (int q = 0; q < 8; ++q) s[q] += shx(s[q], 32, ln_);
        if (fq == 0) {
#pragma unroll
            for (int q = 0; q < 8; ++q) atomicAdd(ssT + EPI_ROW(u, q >> 2, wr, q & 3, fr), (ss_enc(s[q]) << 8) | 1ull);
        }
        float wv[2][8]; ld8f(w + col0, wv[0]); ld8f(w + col0 + 128, wv[1]);
        u32x4 xr[4][2];
#pragma unroll
        for (int m = 0; m < 4; ++m)
#pragma unroll
            for (int bj = 0; bj < 2; ++bj) xr[m][bj] = *(const u32x4*)(XB + (size_t)EPI_ROW(u, 0, wr, m, fr) * D_MODEL + col0 + bj * 128);
        float rs[8];
        {
            stat_t v[8]; unsigned sp = 0;
            for (;;) {
                bool ok = true;
#pragma unroll
                for (int q = 0; q < 8; ++q) { v[q] = __hip_atomic_load(ssT + EPI_ROW(u, q >> 2, wr, q & 3, fr), __ATOMIC_RELAXED, __HIP_MEMORY_SCOPE_AGENT); ok = ok && ((unsigned)v[q] & 255u) == 16u; }
                if (__all(ok)) break;
                __builtin_amdgcn_s_sleep(1);
                if (++sp > (1u << 22)) { if (ln_ == 0) __hip_atomic_store(tmo, 1u, __ATOMIC_RELAXED, __HIP_MEMORY_SCOPE_AGENT); break; }
            }
#pragma unroll
            for (int q = 0; q < 8; ++q) rs[q] = ss_dec(v[q] >> 8);
        }
        float so[8];
#pragma unroll
        for (int ai = 0; ai < 2; ++ai) {
            if (ai == 1) {
#pragma unroll
                for (int m = 0; m < 4; ++m)
#pragma unroll
                    for (int bj = 0; bj < 2; ++bj) xr[m][bj] = *(const u32x4*)(XB + (size_t)EPI_ROW(u, 1, wr, m, fr) * D_MODEL + col0 + bj * 128);
            }
#pragma unroll
            for (int m = 0; m < 4; ++m) {
                const float rstd = fast_rsq(rs[ai * 4 + m] * (1.0f / D_MODEL) + EPS);
                float sq = 0.f;
#pragma unroll
                for (int bj = 0; bj < 2; ++bj) {
                    float t[8], xv[8]; unpack8s(acc[ai][bj][m][0], acc[ai][bj][m][1], rstd, t); unpack_bf8(xr[m][bj], xv);
#pragma unroll
                    for (int j = 0; j < 8; ++j) { xv[j] += t[j] * wv[bj][j]; sq += xv[j] * xv[j]; }
                    *(u32x4*)(XB + (size_t)EPI_ROW(u, ai, wr, m, fr) * D_MODEL + col0 + bj * 128) = pack8(xv);
                }
                so[ai * 4 + m] = sq;
            }
        }
        if (ss_out) {
#pragma unroll
            for (int q = 0; q < 8; ++q) so[q] += shx(so[q], 16, ln_);
#pragma unroll
            for (int q = 0; q < 8; ++q) so[q] += shx(so[q], 32, ln_);
            if (fq == 0) {
#pragma unroll
                for (int q = 0; q < 8; ++q) atomicAdd(ss_out + EPI_ROW(u, q >> 2, wr, q & 3, fr), ss_enc(so[q]));
            }
        }
    }
};
struct EpiStat {
    static constexpr bool PERM = true, AFTER_DRAIN = false;
    bf16_t* O; stat_t* ss;
    __device__ __forceinline__ void operator()(const f32x4 (&acc)[2][2][4][2], const Unit& u, int wr, int wc, int fr, int fq) const {
        const int ln_ = fresh_lane(); fr = ln_ & 15; fq = ln_ >> 4;
        float s[8];
#pragma unroll
        for (int q = 0; q < 8; ++q) {
            const int ai = q >> 2, m = q & 3, row = EPI_ROW(u, ai, wr, m, fr);
            float sq = 0.f;
#pragma unroll
            for (int bj = 0; bj < 2; ++bj) {
                float v[8]; unpack8s(acc[ai][bj][m][0], acc[ai][bj][m][1], 1.0f, v);
#pragma unroll
                for (int j = 0; j < 8; ++j) sq += v[j] * v[j];
                *(u32x4*)(O + (size_t)row * D_MODEL + u.pn * 256 + bj * 128 + wc * 32 + 8 * fq) = pack8(v);
            }
            s[q] = sq;
        }
#pragma unroll
        for (int q = 0; q < 8; ++q) s[q] += shx(s[q], 16, ln_);
#pragma unroll
        for (int q = 0; q < 8; ++q) s[q] += shx(s[q], 32, ln_);
        if (fq == 0) {
#pragma unroll
            for (int q = 0; q < 8; ++q) atomicAdd(ss + EPI_ROW(u, q >> 2, wr, q & 3, fr), ss_enc(s[q]));
        }
    }
};
struct EpiPle {
    static constexpr bool PERM = true, AFTER_DRAIN = false;
    const bf16_t* XBc; const bf16_t* PP; const stat_t* ss_pp; const float* wple; bf16_t* XBn; stat_t* ss_next; float* xout;
    __device__ __forceinline__ void operator()(const f32x4 (&acc)[2][2][4][2], const Unit& u, int wr, int wc, int fr, int fq) const {
        const int ln_ = fresh_lane(); fr = ln_ & 15; fq = ln_ >> 4;
        const int col0 = u.pn * 256 + wc * 32 + 8 * fq;
        float w[2][8], rp[8], s[8];
        ld8f(wple + col0, w[0]); ld8f(wple + col0 + 128, w[1]);
#pragma unroll
        for (int q = 0; q < 8; ++q) rp[q] = ss_dec(ss_pp[EPI_ROW(u, q >> 2, wr, q & 3, fr)]);
#pragma unroll
        for (int q = 0; q < 8; ++q) s[q] = 0.f;
#pragma unroll
        for (int ai = 0; ai < 2; ++ai)
#pragma unroll
            for (int bj = 0; bj < 2; ++bj) {
                u32x4 xr[4], pr[4];
#pragma unroll
                for (int m = 0; m < 4; ++m) { const size_t off = (size_t)EPI_ROW(u, ai, wr, m, fr) * D_MODEL + col0 + bj * 128; xr[m] = *(const u32x4*)(XBc + off); pr[m] = *(const u32x4*)(PP + off); }
#pragma unroll
                for (int m = 0; m < 4; ++m) {
                    const float rpp = fast_rsq(rp[ai * 4 + m] * (1.0f / D_MODEL) + EPS);
                    const size_t off = (size_t)EPI_ROW(u, ai, wr, m, fr) * D_MODEL + col0 + bj * 128;
                    float g[8], xv[8], pv[8]; float sq = 0.f;
                    unpack8s(acc[ai][bj][m][0], acc[ai][bj][m][1], 1.0f, g); unpack_bf8(xr[m], xv); unpack_bf8(pr[m], pv);
#pragma unroll
                    for (int j = 0; j < 8; ++j) { xv[j] += sigm(g[j]) * pv[j] * rpp * w[bj][j]; sq += xv[j] * xv[j]; }
                    if (XBn) *(u32x4*)(XBn + off) = pack8(xv);
                    if (xout) { *(f32x4*)(xout + off) = (f32x4){xv[0], xv[1], xv[2], xv[3]}; *(f32x4*)(xout + off + 4) = (f32x4){xv[4], xv[5], xv[6], xv[7]}; }
                    s[ai * 4 + m] += sq;
                }
            }
        if (ss_next) {
#pragma unroll
            for (int q = 0; q < 8; ++q) s[q] += shx(s[q], 16, ln_);
#pragma unroll
            for (int q = 0; q < 8; ++q) s[q] += shx(s[q], 32, ln_);
            if (fq == 0) {
#pragma unroll
                for (int q = 0; q < 8; ++q) atomicAdd(ss_next + EPI_ROW(u, q >> 2, wr, q & 3, fr), ss_enc(s[q]));
            }
        }
    }
};

__device__ __forceinline__ void ew_rows(bf16_t* XB, const bf16_t* T, const float* w, stat_t* ss_out, int gw, int NGW, int lane) {
    const int hl = lane & 31, hr = lane >> 5;
    float wv[4][8];
#pragma unroll
    for (int j = 0; j < 4; ++j) ld8f(w + 8 * hl + 256 * j, wv[j]);
#pragma unroll 2
    for (int r2 = gw; r2 < M / 2; r2 += NGW) {
        const int row = 2 * r2 + hr; const size_t base = (size_t)row * D_MODEL + 8 * hl;
        u32x4 xr[4], tr[4];
#pragma unroll
        for (int j = 0; j < 4; ++j) { xr[j] = *(const u32x4*)(XB + base + 256 * j); tr[j] = *(const u32x4*)(T + base + 256 * j); }
        float tv[4][8]; float st = 0.f;
#pragma unroll
        for (int j = 0; j < 4; ++j) { unpack_bf8(tr[j], tv[j]);
#pragma unroll
            for (int k = 0; k < 8; ++k) st += tv[j][k] * tv[j][k]; }
#pragma unroll
        for (int o = 1; o < 32; o <<= 1) st += shx(st, o, lane);
        const float rT = fast_rsq(st * (1.0f / D_MODEL) + EPS);
        float s = 0.f;
#pragma unroll
        for (int j = 0; j < 4; ++j) {
            float xv[8]; unpack_bf8(xr[j], xv);
#pragma unroll
            for (int k = 0; k < 8; ++k) { xv[k] += tv[j][k] * rT * wv[j][k]; s += xv[k] * xv[k]; }
            *(u32x4*)(XB + base + 256 * j) = pack8(xv);
        }
        if (ss_out) {
#pragma unroll
            for (int o = 1; o < 32; o <<= 1) s += shx(s, o, lane);
            if (hl == 0) ss_out[row] = ss_enc(s);
        }
    }
}
__device__ __forceinline__ void xprep_rows(const float* x, bf16_t* XB, stat_t* ss_out, int gw, int NGW, int lane) {
    const int hl = lane & 31, hr = lane >> 5;
#pragma unroll 2
    for (int r2 = gw; r2 < M / 2; r2 += NGW) {
        const int row = 2 * r2 + hr; const size_t base = (size_t)row * D_MODEL + 8 * hl;
        float xv[4][8];
#pragma unroll
        for (int j = 0; j < 4; ++j) ld8f(x + base + 256 * j, xv[j]);
        float s = 0.f;
#pragma unroll
        for (int j = 0; j < 4; ++j) {
#pragma unroll
            for (int k = 0; k < 8; ++k) s += xv[j][k] * xv[j][k];
            *(u32x4*)(XB + base + 256 * j) = pack8(xv[j]);
        }
#pragma unroll
        for (int o = 1; o < 32; o <<= 1) s += shx(s, o, lane);
        if (hl == 0) ss_out[row] = ss_enc(s);
    }
}

__device__ __forceinline__ void tr_item(const float* W, int ldw, int K, int sc, const float* gain, bf16_t* WT, int rho0, int k0, LAS float* scr, int lane) {
#pragma unroll 8
    for (int i = 0; i < 32; ++i) {
        const int kk = 2 * i + (lane >> 5);
        float v = sc >= 0 ? W[(size_t)(k0 + kk) * ldw + sc + (lane & 31)] : 0.f;
        if (gain) v *= gain[k0 + kk];
        scr[kk * 33 + (lane & 31)] = v;
    }
    asm volatile("s_waitcnt lgkmcnt(0)" ::: "memory");
    const int c = lane & 7;
#pragma unroll
    for (int j = 0; j < 4; ++j) {
        const int n = (lane >> 3) + 8 * j; const LAS float* s = scr + (8 * c) * 33 + n;
        u32x4 o; o.x = cvt_pk_bf16(s[0 * 33], s[1 * 33]); o.y = cvt_pk_bf16(s[2 * 33], s[3 * 33]); o.z = cvt_pk_bf16(s[4 * 33], s[5 * 33]); o.w = cvt_pk_bf16(s[6 * 33], s[7 * 33]);
        *(u32x4*)(WT + (size_t)(rho0 + n) * K + k0 + 8 * c) = o;
    }
    asm volatile("s_waitcnt lgkmcnt(0)" ::: "memory");
}

struct Args { const float* in[19]; float* out; unsigned char* ws; int ph_lo, ph_hi, li, pad; };

typedef const __attribute__((address_space(4))) Args* KArgs;
__device__ __forceinline__ KArgs kargs() { KArgs p = (KArgs)__builtin_amdgcn_kernarg_segment_ptr(); asm volatile("" : "+s"(p)); return p; }


__device__ __forceinline__ void prologue(KArgs ap, LAS unsigned char* lds, int gw, int NGW, int wave, int lane) {
    unsigned char* ws = ap->ws;
    LAS float* scr = (LAS float*)(lds + wave * 16384);
    for (int L = 0; L < DEPTH; ++L) {
        unsigned char* wl = ws + WS_W + (size_t)L * W_LAYER;
        constexpr int I0 = 16 * 88, I1 = 16 * 32, I2 = 16 * 176, I3 = 44 * 32, I4 = 16 * 32, I5 = 4 * 32, IT = I0 + I1 + I2 + I3 + I4 + I5;
        for (int it = gw; it < IT; it += NGW) {
            int r = it;
            if (r < I0) { const int nb = r % 88, kb = r / 88, pn = nb >> 3, bj = (nb >> 2) & 1, wc = nb & 3, hs = 4 * pn + wc;
                tr_item(ap->in[3] + (size_t)L * D_MODEL * IN_W, IN_W, 1024, hs < NHEADS ? hs * 64 + 32 * bj : -1, ap->in[2] + L * D_MODEL, (bf16_t*)(wl + W_IN), nb * 32, kb * 64, scr, lane); continue; } r -= I0;
            if (r < I1) { const int nb = r % 32, kb = r / 32;
                tr_item(ap->in[10] + (size_t)L * D_MODEL * D_MODEL, D_MODEL, 1024, nb * 32, nullptr, (bf16_t*)(wl + W_OUT), nb * 32, kb * 64, scr, lane); continue; } r -= I1;
            if (r < I2) { const int nb = r % 176, kb = r / 176, pn = nb >> 3, bj = (nb >> 2) & 1, q = nb & 3;
                tr_item(ap->in[13] + (size_t)L * D_MODEL * 2 * D_FF, 2 * D_FF, 1024, bj * D_FF + 128 * pn + 32 * q, ap->in[12] + L * D_MODEL, (bf16_t*)(wl + W_FFI), nb * 32, kb * 64, scr, lane); continue; } r -= I2;
            if (r < I3) { const int nb = r % 32, kb = r / 32;
                tr_item(ap->in[14] + (size_t)L * D_FF * D_MODEL, D_MODEL, D_FF, nb * 32, nullptr, (bf16_t*)(wl + W_FFO), nb * 32, kb * 64, scr, lane); continue; } r -= I3;
            if (r < I4) { const int nb = r % 32, kb = r / 32;
                tr_item(ap->in[16] + (size_t)L * D_MODEL * D_MODEL, D_MODEL, 1024, nb * 32, nullptr, (bf16_t*)(wl + W_G), nb * 32, kb * 64, scr, lane); continue; } r -= I4;
            { const int nb = r % 32, kb = r / 32;
                tr_item(ap->in[17] + (size_t)L * PLE_DIM * D_MODEL, D_MODEL, PLE_DIM, nb * 32, nullptr, (bf16_t*)(wl + W_P), nb * 32, kb * 64, scr, lane); }
        }
    }
    {
        float* tab = (float*)(ws + WS_TAB);
        for (int i = gw * 64 + lane; i < 2048 * 32; i += NGW * 64) {
            { const int pos = i >> 5, j = i & 31; const double rev = (double)pos * c_inv_ret[j] * 0.15915494309189535; const float fr = (float)(rev - floor(rev));
              tab[TAB_RC + i] = __builtin_amdgcn_cosf(fr); tab[TAB_RS + i] = __builtin_amdgcn_sinf(fr); }
            if (i < 2048 * 8) { const int pos = i >> 3, j = i & 7; const double rev = (double)pos * c_inv_swa[j] * 0.15915494309189535; const float fr = (float)(rev - floor(rev));
              tab[TAB_SC + i] = __builtin_amdgcn_cosf(fr); tab[TAB_SS + i] = __builtin_amdgcn_sinf(fr); }
        }
    }
    {
        const float* p = ap->in[1]; bf16_t* PB = (bf16_t*)(ws + WS_PB);
        const size_t n8 = (size_t)DEPTH * M * PLE_DIM / 8;
        for (size_t i = (size_t)gw * 64 + lane; i < n8; i += (size_t)NGW * 64) {
            float v[8]; ld8f(p + i * 8, v); *(u32x4*)(PB + i * 8) = pack8(v);
        }
    }
    {
        const float* wsrc = ap->in[6]; bf16_t* Wm = (bf16_t*)(ws + WS_WM);
        for (int i = gw * 64 + lane; i < DEPTH * 4 * CHUNK * CHUNK; i += NGW * 64) { const int s_ = i & 127, t_ = (i >> 7) & 127; Wm[i] = f2bf(s_ <= t_ ? wsrc[i] : 0.f); }
    }
    xprep_rows(ap->in[0], (bf16_t*)(ws + WS_XB0), stat_ptr(ws, 0, ST_X1), gw, NGW, lane);
}

typedef float f32x16 __attribute__((ext_vector_type(16)));
typedef short s16x4 __attribute__((ext_vector_type(4)));
using pg8::bf16x8;
constexpr int TS = 144;
constexpr float LOG2E = 1.4426950408889634f;
__device__ __forceinline__ int crow(int r, int hi) { return (r & 3) + 8 * (r >> 2) + 4 * hi; }
__device__ __forceinline__ s16x4 tr16(LAS const unsigned char* p) { return __builtin_bit_cast(s16x4, __builtin_amdgcn_ds_read_tr16_b64_v4i16((LAS s16x4*)p)); }
__device__ __forceinline__ bf16x8 rd_row(LAS const unsigned char* tile, int row0, int k0, int lane) {
    return *(LAS const bf16x8*)(tile + (row0 + (lane & 31)) * TS + (k0 + 8 * (lane >> 5)) * 2);
}
template <bool PERMK> __device__ __forceinline__ bf16x8 rd_tr(LAS const unsigned char* tile, int k0, int n0, int lane) {
    const int h = lane >> 5, g1 = (lane >> 4) & 1, q = (lane & 15) >> 2, p = lane & 3;
    const int rA = k0 + (PERMK ? 4 * h : 8 * h) + q, rB = rA + (PERMK ? 8 : 4);
    const int cb = (n0 + 16 * g1 + 4 * p) * 2;
    const s16x4 lo = tr16(tile + rA * TS + cb), hi = tr16(tile + rB * TS + cb);
    return (bf16x8){lo[0], lo[1], lo[2], lo[3], hi[0], hi[1], hi[2], hi[3]};
}
__device__ __forceinline__ bf16x8 pack_frag(const f32x16& v, int s) {
    u32x4 w; w.x = cvt_pk_bf16(v[8 * s + 0], v[8 * s + 1]); w.y = cvt_pk_bf16(v[8 * s + 2], v[8 * s + 3]); w.z = cvt_pk_bf16(v[8 * s + 4], v[8 * s + 5]); w.w = cvt_pk_bf16(v[8 * s + 6], v[8 * s + 7]);
    return __builtin_bit_cast(bf16x8, w);
}
#define MFMA32(a, b, c) __builtin_amdgcn_mfma_f32_32x32x16_bf16((a), (b), (c), 0, 0, 0)
template <bool SCALE> __device__ __forceinline__ void load_tile(LAS unsigned char* tile, const bf16_t* g, int rows, int zero_below, float sl, int tid) {
    for (int i = tid; i < rows * 8; i += NTHREADS) {
        const int r = i >> 3, c = i & 7;
        u32x4 v = (u32x4){0u, 0u, 0u, 0u};
        if (r >= zero_below) v = *(const u32x4*)(g + (ptrdiff_t)r * IN_W + c * 8);
        if (SCALE) { float f[8]; unpack_bf8(v, f); const float s = exp2f((float)r * sl);
#pragma unroll
            for (int j = 0; j < 8; ++j) f[j] *= s;
            v = pack8(f); }
        *(LAS u32x4*)(tile + r * TS + c * 16) = v;
    }
}

constexpr int GM_BUF = 2 * CHUNK * TS;
struct GmRegs { u32x4 r[4]; };
__device__ __forceinline__ void gm_load(GmRegs& R, const bf16_t* P, int item, int tid) {
    const int h = item & 3, bc = item >> 2; const size_t row0 = (size_t)bc * CHUNK;
    const int r = tid >> 3, c = tid & 7;
#pragma unroll
    for (int i = 0; i < 2; ++i) {
        R.r[i] = *(const u32x4*)(P + (row0 + r + 64 * i) * IN_W + (H_AU + h) * 64 + c * 8);
        R.r[2 + i] = *(const u32x4*)(P + (row0 + r + 64 * i) * IN_W + (H_AV + h) * 64 + c * 8);
    }
}
__device__ __forceinline__ void gm_write(const GmRegs& R, LAS unsigned char* buf, int tid) {
    const int r = tid >> 3, c = tid & 7;
#pragma unroll
    for (int i = 0; i < 2; ++i) { *(LAS u32x4*)(buf + (r + 64 * i) * TS + c * 16) = R.r[i]; *(LAS u32x4*)(buf + CHUNK * TS + (r + 64 * i) * TS + c * 16) = R.r[2 + i]; }
}
__device__ __forceinline__ void gm_compute(LAS unsigned char* buf, const bf16_t* Wm, const float* bs, bf16_t* Y, int item, int tid, int wave, int lane, volatile LAS unsigned* slotp, unsigned fut) {
    const int h = item & 3, bc = item >> 2; const size_t row0 = (size_t)bc * CHUNK;
    LAS unsigned char* AUs = buf; LAS unsigned char* AVs = buf + CHUNK * TS;
    const int tb = wave >> 1, db = wave & 1, hh = lane >> 5;
    f32x16 acc = {};
    const bf16_t* wrow = Wm + (size_t)(h * CHUNK + 32 * tb + (lane & 31)) * CHUNK + 8 * hh;
    for (int ks = 0; ks < 2 * (tb + 1); ++ks) {
        const bf16x8 a = *(const bf16x8*)(wrow + 16 * ks);
        const bf16x8 b = rd_tr<false>(AVs, 16 * ks, 32 * db, lane);
        acc = MFMA32(a, b, acc);
    }
    const int d = 32 * db + (lane & 31);
#pragma unroll
    for (int r = 0; r < 16; ++r) {
        const int t = 32 * tb + crow(r, hh);
        LAS bf16_t* pu = (LAS bf16_t*)(AUs + t * TS) + d;
        *pu = f2bf(bf2f(*pu) * (acc[r] + bs[h * CHUNK + t]));
    }
    if (tid == 0) *slotp = fut;
    __syncthreads();
    for (int i = tid; i < CHUNK * 8; i += NTHREADS) { const int r = i >> 3, c = i & 7; *(u32x4*)(Y + (row0 + r) * D_MODEL + h * 64 + c * 8) = *(LAS const u32x4*)(AUs + r * TS + c * 16); }
}

constexpr int SWA_K = 0, SWA_V = 384 * TS, SWA_WSF = 2 * 384 * TS, SWA_OST = SWA_WSF + NWAVES * 128, SWA_END = SWA_OST + NWAVES * 4096;
struct SwaRegs { u32x4 k[6], v[6]; };
__device__ __forceinline__ void swa_load(SwaRegs& R, const bf16_t* P, int item, int tid) {
    const int hk = item & 1, cp = (item >> 1) & 7, b = item >> 4;
    const ptrdiff_t rowk0 = (ptrdiff_t)b * SEQ + 256 * cp - 128;
    const int r0 = tid >> 3, c = tid & 7;
#pragma unroll
    for (int i = 0; i < 6; ++i) {
        const int r = r0 + 64 * i;
        if (cp == 0 && r < 128) { R.k[i] = (u32x4){0u, 0u, 0u, 0u}; R.v[i] = (u32x4){0u, 0u, 0u, 0u}; }
        else { R.k[i] = *(const u32x4*)(P + (rowk0 + r) * IN_W + (H_CK + hk) * 64 + c * 8); R.v[i] = *(const u32x4*)(P + (rowk0 + r) * IN_W + (H_CV + hk) * 64 + c * 8); }
    }
}
__device__ __forceinline__ void swa_write(const SwaRegs& R, LAS unsigned char* lds, int tid) {
    const int r0 = tid >> 3, c = tid & 7;
#pragma unroll
    for (int i = 0; i < 6; ++i) { *(LAS u32x4*)(lds + SWA_K + (r0 + 64 * i) * TS + c * 16) = R.k[i]; *(LAS u32x4*)(lds + SWA_V + (r0 + 64 * i) * TS + c * 16) = R.v[i]; }
}
__device__ __forceinline__ void swa_compute(LAS unsigned char* lds, const bf16_t* P, const float* sinks, bf16_t* Y, int item, int wave, int lane) {
    const int hk = item & 1, cp = (item >> 1) & 7, b = item >> 4;
    const size_t rowq0 = (size_t)b * SEQ + 256 * cp;
    LAS unsigned char* Ks = lds + SWA_K; LAS unsigned char* Vs = lds + SWA_V;
    const int qi = lane & 31, hh = lane >> 5;
    LAS float* wsf = (LAS float*)(lds + SWA_WSF + wave * 128);
    LAS unsigned char* ost = lds + SWA_OST + wave * 4096;
    constexpr float SC = 0.125f * LOG2E;
    for (int g = 0; g < 3; ++g) {
        const int qh = 3 * hk + g;
        const bf16_t* qrow = P + (rowq0 + 32 * wave + qi) * IN_W + (H_CQ + qh) * 64 + 8 * hh;
        bf16x8 bq[4];
#pragma unroll
        for (int kd = 0; kd < 4; ++kd) bq[kd] = *(const bf16x8*)(qrow + 16 * kd);
        f32x16 S[5];
#pragma unroll
        for (int kb = 0; kb < 5; ++kb) {
            S[kb] = (f32x16){};
#pragma unroll
            for (int kd = 0; kd < 4; ++kd) S[kb] = MFMA32(rd_row(Ks, 32 * (wave + kb), 16 * kd, lane), bq[kd], S[kb]);
        }
        const float sk = sinks[qh] * LOG2E;
        float m = sk;
#pragma unroll
        for (int kb = 0; kb < 5; ++kb) {
            const bool blk_ok = cp > 0 || wave + kb >= 4;
#pragma unroll
            for (int r = 0; r < 16; ++r) {
                const int cr = crow(r, hh);
                bool ok = blk_ok;
                if (kb == 0) ok = ok && cr > qi;
                if (kb == 4) ok = ok && cr <= qi;
                const float s = ok ? S[kb][r] * SC : -1e30f;
                S[kb][r] = s; m = fmaxf(m, s);
            }
        }
        m = fmaxf(m, shx(m, 32, lane));
        float l = 0.f;
#pragma unroll
        for (int kb = 0; kb < 5; ++kb)
#pragma unroll
            for (int r = 0; r < 16; ++r) { const float p = __builtin_amdgcn_exp2f(S[kb][r] - m); S[kb][r] = p; l += p; }
        l += shx(l, 32, lane);
        l += __builtin_amdgcn_exp2f(sk - m);
        f32x16 O[2]; O[0] = (f32x16){}; O[1] = (f32x16){};
#pragma unroll
        for (int kb = 0; kb < 5; ++kb)
#pragma unroll
            for (int s2 = 0; s2 < 2; ++s2) {
                const bf16x8 a = pack_frag(S[kb], s2);
#pragma unroll
                for (int db = 0; db < 2; ++db) O[db] = MFMA32(a, rd_tr<true>(Vs, 32 * (wave + kb) + 16 * s2, 32 * db, lane), O[db]);
            }
        if (hh == 0) wsf[qi] = __builtin_amdgcn_rcpf(l);
        asm volatile("s_waitcnt lgkmcnt(0)" ::: "memory");
#pragma unroll
        for (int r = 0; r < 16; ++r) {
            const int q = crow(r, hh); const float rl = wsf[q];
#pragma unroll
            for (int db = 0; db < 2; ++db) *((LAS bf16_t*)(ost + q * 128) + 32 * db + qi) = f2bf(O[db][r] * rl);
        }
        asm volatile("s_waitcnt lgkmcnt(0)" ::: "memory");
#pragma unroll
        for (int i = 0; i < 4; ++i) { const int row = i * 8 + (lane >> 3), ch = lane & 7;
            *(u32x4*)(Y + (rowq0 + 32 * wave + row) * D_MODEL + 640 + qh * 64 + ch * 8) = *(LAS const u32x4*)(ost + row * 128 + ch * 16); }
        asm volatile("s_waitcnt lgkmcnt(0)" ::: "memory");
    }
}

constexpr int RT_Q = 0, RT_K = CHUNK * TS, RT_V = 2 * CHUNK * TS, RT_S = 3 * CHUNK * TS, RT_O = RT_S + 64 * TS, RT_X = RT_O + CHUNK * 68 * 4, RT_END = RT_X + 16384;
struct RetRegs { u32x4 q[2], k[2], v[2], g[2]; };
__device__ __forceinline__ void ret_load(RetRegs& R, const bf16_t* P, size_t row0, int h, int tid) {
    const int r0 = tid >> 3, c = tid & 7;
#pragma unroll
    for (int i = 0; i < 2; ++i) {
        const bf16_t* pr = P + (row0 + r0 + 64 * i) * IN_W + c * 8;
        R.q[i] = *(const u32x4*)(pr + (H_BQ + h) * 64); R.k[i] = *(const u32x4*)(pr + (H_BK + h) * 64); R.v[i] = *(const u32x4*)(pr + (H_BV + h) * 64);
    }
    const int row = tid >> 2, part = tid & 3;
    const bf16_t* gp = P + (row0 + row) * IN_W + (H_BG + h) * 64 + 16 * part;
    R.g[0] = *(const u32x4*)gp; R.g[1] = *(const u32x4*)(gp + 8);
}
typedef float f32x2m __attribute__((ext_vector_type(2)));
__device__ __forceinline__ u32x4 scale_bf8(const u32x4& r, float sc) {
    const unsigned w[4] = {r.x, r.y, r.z, r.w}; unsigned o[4];
#pragma unroll
    for (int k = 0; k < 4; ++k) { f32x2m v = {__uint_as_float(w[k] << 16), __uint_as_float(w[k] & 0xffff0000u)}; v = v * sc; o[k] = cvt_pk_bf16(v.x, v.y); }
    return (u32x4){o[0], o[1], o[2], o[3]};
}
__device__ __forceinline__ void ret_write(const RetRegs& R, LAS unsigned char* lds, const float (&sq)[2], const float (&sk)[2], int tid) {
    const int r0 = tid >> 3, c = tid & 7;
#pragma unroll
    for (int i = 0; i < 2; ++i) {
        const int r = r0 + 64 * i;
        *(LAS u32x4*)(lds + RT_Q + r * TS + c * 16) = scale_bf8(R.q[i], sq[i]);
        *(LAS u32x4*)(lds + RT_K + r * TS + c * 16) = scale_bf8(R.k[i], sk[i]);
        *(LAS u32x4*)(lds + RT_V + r * TS + c * 16) = R.v[i];
    }
}
__device__ __forceinline__ void ret_item(LAS unsigned char* lds, const bf16_t* P, const float* gn_w, bf16_t* Y, int item, int tid, int wave, int lane, volatile LAS unsigned* slotp, unsigned fut) {
    const int h = item % 6, b = item / 6;
    const float lg = c_log2g[h];
    const float g1 = exp2f(lg), g127 = exp2f(127.f * lg), g128 = exp2f(128.f * lg);
    LAS unsigned char* Qs = lds + RT_Q; LAS unsigned char* Ks = lds + RT_K; LAS unsigned char* Vs = lds + RT_V; LAS unsigned char* Sb = lds + RT_S;
    LAS float* Os = (LAS float*)(lds + RT_O); LAS float* Xs = (LAS float*)(lds + RT_X);
    const int tb = wave >> 1, eb = wave & 1, qi = lane & 31, hh = lane >> 5;
    const int db = (wave >> 1) & 1, kh = wave >> 2;
    const int erow = tid >> 2, part = tid & 3;
    float gw0[8], gw1[8]; ld8f(gn_w + h * 64 + 16 * part, gw0); ld8f(gn_w + h * 64 + 16 * part + 8, gw1);
    f32x16 st = {};
    float sq[2], sk[2];
#pragma unroll
    for (int i = 0; i < 2; ++i) { const float r = (float)((tid >> 3) + 64 * i); sq[i] = exp2f(r * lg); sk[i] = exp2f(-r * lg); }
    RetRegs R; ret_load(R, P, (size_t)b * SEQ, h, tid);
    for (int c = 0; c < 16; ++c) {
        const size_t row0 = (size_t)b * SEQ + (size_t)c * CHUNK;
        ret_write(R, lds, sq, sk, tid);
        const u32x4 gq0 = R.g[0], gq1 = R.g[1];
        __syncthreads();
        if (c + 1 < 16) ret_load(R, P, row0 + CHUNK, h, tid);
        f32x16 O = {};
        for (int sb = 0; sb <= tb; ++sb) {
            f32x16 S = {};
#pragma unroll
            for (int kd = 0; kd < 4; ++kd) S = MFMA32(rd_row(Ks, 32 * sb, 16 * kd, lane), rd_row(Qs, 32 * tb, 16 * kd, lane), S);
            if (sb == tb) {
#pragma unroll
                for (int r = 0; r < 16; ++r) S[r] = crow(r, hh) <= qi ? S[r] : 0.f;
            }
#pragma unroll
            for (int s2 = 0; s2 < 2; ++s2) O = MFMA32(pack_frag(S, s2), rd_tr<true>(Vs, 32 * sb + 16 * s2, 32 * eb, lane), O);
        }
        if (c > 0) {
#pragma unroll
            for (int kd = 0; kd < 4; ++kd) O = MFMA32(rd_row(Qs, 32 * tb, 16 * kd, lane), rd_row(Sb, 32 * eb, 16 * kd, lane), O);
        }
#pragma unroll
        for (int r = 0; r < 16; ++r) Os[(32 * tb + crow(r, hh)) * 68 + 32 * eb + qi] = O[r];
        if (c + 1 < 16) {
            f32x16 acc = {};
#pragma unroll
            for (int ks = 0; ks < 4; ++ks) acc = MFMA32(rd_tr<false>(Vs, 64 * kh + 16 * ks, 32 * eb, lane), rd_tr<false>(Ks, 64 * kh + 16 * ks, 32 * db, lane), acc);
#pragma unroll
            for (int r = 0; r < 16; ++r) st[r] = st[r] * g128 + g127 * acc[r];
            if (kh == 1) {
#pragma unroll
                for (int r = 0; r < 16; ++r) Xs[((eb * 2 + db) * 16 + r) * 64 + lane] = st[r];
            }
        }
        __syncthreads();
        if (c + 1 < 16 && kh == 0) {
#pragma unroll
            for (int r = 0; r < 16; ++r) { const int e = 32 * eb + crow(r, hh), d = 32 * db + qi; const float sv = (st[r] + Xs[((eb * 2 + db) * 16 + r) * 64 + lane]) * g1; *((LAS bf16_t*)(Sb + e * TS) + d) = (bf16_t)cvt_pk_bf16(sv, sv); }
        }
        {
            float v[16]; float s = 0.f;
#pragma unroll
            for (int j = 0; j < 16; ++j) { v[j] = Os[erow * 68 + 16 * part + j]; s += v[j]; }
            s += shx(s, 1, lane); s += shx(s, 2, lane);
            const float mu = s * (1.0f / 64.0f); float q = 0.f;
#pragma unroll
            for (int j = 0; j < 16; ++j) { v[j] -= mu; q += v[j] * v[j]; }
            q += shx(q, 1, lane); q += shx(q, 2, lane);
            const float rs = fast_rsq(q * (1.0f / 64.0f) + EPS);
            float ga[8], gb[8], o0[8], o1[8];
            unpack_bf8(gq0, ga); unpack_bf8(gq1, gb);
#pragma unroll
            for (int j = 0; j < 8; ++j) { o0[j] = (ga[j] * gw0[j]) * (v[j] * rs); o1[j] = (gb[j] * gw1[j]) * (v[8 + j] * rs); }
            bf16_t* yp = Y + (row0 + erow) * D_MODEL + 256 + h * 64 + 16 * part;
            *(u32x4*)yp = pack8(o0); *(u32x4*)(yp + 8) = pack8(o1);
        }
    }
    if (tid == 0) *slotp = fut;
    __syncthreads();
}

constexpr int CW_TMO = 1024;
constexpr int CW_QUEUE = 2048;
constexpr int MQ_RET = 192, MQ_SWA = MQ_RET + 512, MQ_ALL = MQ_SWA + 2048;
__device__ __forceinline__ void mixers(KArgs ap, int L, LAS unsigned char* lds, int tid, int wave, int lane) {
    unsigned char* ws = ap->ws;
    const bf16_t* P = (const bf16_t*)(ws + WS_BIG); bf16_t* Y = (bf16_t*)(ws + WS_Y);
    const bf16_t* Wm = (const bf16_t*)(ws + WS_WM) + (size_t)L * 4 * CHUNK * CHUNK;
    const float* gbs = ap->in[7] + L * 4 * CHUNK; const float* gn_w = ap->in[8] + L * 384; const float* sinks = ap->in[9] + L * 6;
    unsigned* head = (unsigned*)ws + CW_QUEUE + 64 * L;
    volatile LAS unsigned* slot = (volatile LAS unsigned*)(lds + MISC_OFF + 64);
    if (tid == 0) slot[0] = atomicAdd(head, 1u);
    __syncthreads();
    unsigned cur = (unsigned)__builtin_amdgcn_readfirstlane((int)slot[0]);
    __syncthreads();
    if (tid == 0) slot[1] = atomicAdd(head, 1u);
    __syncthreads();
    unsigned nxt = (unsigned)__builtin_amdgcn_readfirstlane((int)slot[1]);
    int k = 0;
#define MQ_FETCH() unsigned fut = 0u; if (tid == 0) fut = atomicAdd(head, 1u)
#define MQ_ADVANCE() do { cur = nxt; nxt = (unsigned)__builtin_amdgcn_readfirstlane((int)slot[k]); k ^= 1; } while (0)
    while (cur < (unsigned)MQ_ALL) {
        if (cur < (unsigned)MQ_RET) {
            MQ_FETCH();
            ret_item(lds, P, gn_w, Y, (int)cur, tid, wave, lane, slot + k, fut);
            MQ_ADVANCE();
        } else if (cur < (unsigned)MQ_SWA) {
            MQ_FETCH();
            { SwaRegs R; swa_load(R, P, (int)cur - MQ_RET, tid); swa_write(R, lds, tid); }
            __syncthreads();
            swa_compute(lds, P, sinks, Y, (int)cur - MQ_RET, wave, lane);
            if (tid == 0) slot[k] = fut;
            __syncthreads();
            MQ_ADVANCE();
        } else {
            GmRegs R; gm_load(R, P, (int)cur - MQ_SWA, tid);
            int bsel = 0;
            for (;;) {
                MQ_FETCH();
                LAS unsigned char* buf = lds + bsel * GM_BUF;
                gm_write(R, buf, tid);
                __syncthreads();
                const bool more = nxt < (unsigned)MQ_ALL;
                if (more) gm_load(R, P, (int)nxt - MQ_SWA, tid);
                gm_compute(buf, Wm, gbs, Y, (int)cur - MQ_SWA, tid, wave, lane, slot + k, fut);
                MQ_ADVANCE(); bsel ^= 1;
                if (!more) break;
            }
            __syncthreads();
        }
    }
#undef MQ_FETCH
#undef MQ_ADVANCE
    __syncthreads();
}

#ifndef PG8_SP2
#define PG8_SP2 true
#endif
#ifndef PG8_ALIGN
#define PG8_ALIGN true
#endif
constexpr int N_PHASES = 1 + 8 * DEPTH;
#ifndef PHMASK
#define PHMASK 0x1ff
#endif
#ifndef DUP_MASK
#define DUP_MASK 0
#endif
#define NREP(bit) ((DUP_MASK & (bit)) ? 2 : 1)
#ifndef KREP3
#define KREP3 1
#endif
__global__ void __launch_bounds__(NTHREADS, 2) mega(Args a_) {
    extern __shared__ __attribute__((aligned(16))) unsigned char lds_raw[];
    LAS unsigned char* lds = (LAS unsigned char*)lds_raw;
    const int G = gridDim.x, bid = blockIdx.x;
    const int vcu = (G % 8 == 0) ? (bid % 8) * (G / 8) + bid / 8 : bid;
    const int NGW = G * NWAVES;
    const int wave0 = __builtin_amdgcn_readfirstlane((int)threadIdx.x >> 6);
#define opq_tid() pg8::pg8_tid(wave0)
    { const int tid = opq_tid(); for (int u = tid; u < (LDS_BYTES - RING_BYTES) / 4; u += NTHREADS) ((LAS unsigned*)(lds + RING_BYTES))[u] = 0u; }
    __syncthreads();
    XcdBarrier bar = xcd_barrier_post((unsigned*)kargs()->ws + CW_BAR + kargs()->li * XCD_BAR_WORDS, (volatile LAS unsigned*)(lds + MISC_OFF));
    const int lo = kargs()->ph_lo, hi = kargs()->ph_hi;
#define IN(k) (lo <= (k) && (k) < hi)
#define SEAM(k) do { if (IN(k) && IN((k) + 1)) xcd_barrier(bar, opq_tid()); } while (0)
#define LANE_VARS const int tid_ = opq_tid(), lane = tid_ & 63, wave = __builtin_amdgcn_readfirstlane(tid_ >> 6), gw = vcu * NWAVES + wave
    if (IN(0) && (PHMASK & 1)) for (int rep = 0; rep < NREP(1); ++rep) { LANE_VARS; prologue(kargs(), lds, gw, NGW, wave, lane); }
    SEAM(0);
#define OPQ(p) ({ auto _p = (p); asm volatile("" : "+s"(_p)); _p; })
    for (int L = 0; L < DEPTH; ++L) {
        const int p0 = 1 + 8 * L;
        if (IN(p0 + 0) && (PHMASK & 2)) for (int rep = 0; rep < NREP(2); ++rep) {
            KArgs ap = kargs(); unsigned char* wsp = ap->ws; const int Lp = OPQ(L);
            pg8::Gemm g{(const bf16_t*)(wsp + ((Lp & 1) ? WS_XB1 : WS_XB0)), (const bf16_t*)(wsp + WS_W + (size_t)Lp * W_LAYER + W_IN), M, 2816, 1024}; pg8::StaticOrder S; S.init(M, 2816, G, bid);
            EpiProj E{(bf16_t*)(wsp + WS_BIG), stat_ptr(wsp, Lp, ST_X1), ap->in[4] + Lp * 256, ap->in[5] + Lp * 256, (const float*)(wsp + WS_TAB)};
            pg8::gemm_phase<EpiProj, pg8::StaticOrder, PG8_ALIGN, PG8_SP2>(lds, g, S, E, wave0);
        }
        SEAM(p0 + 0);
        if (IN(p0 + 1) && (PHMASK & 4)) {
            LANE_VARS; (void)gw; mixers(kargs(), OPQ(L), lds, tid_, wave, lane);
        }
        SEAM(p0 + 1);
        if (IN(p0 + 2) && (PHMASK & 8)) {
            KArgs ap = kargs(); unsigned char* wsp = ap->ws; const int Lp = OPQ(L);
            pg8::Gemm g{(const bf16_t*)(wsp + WS_Y), (const bf16_t*)(wsp + WS_W + (size_t)Lp * W_LAYER + W_OUT), M, 1024, 1024}; pg8::StaticOrder S; S.init(M, 1024, G, bid);
            EpiNormRes E{(bf16_t*)(wsp + ((Lp & 1) ? WS_XB1 : WS_XB0)), ap->in[11] + Lp * D_MODEL, stat_ptr(wsp, Lp, ST_MIX), stat_ptr(wsp, Lp, ST_X2), (unsigned*)wsp + CW_TMO};
            pg8::gemm_phase<EpiNormRes, pg8::StaticOrder, PG8_ALIGN, PG8_SP2>(lds, g, S, E, wave0);
        }
        SEAM(p0 + 2);
        if (IN(p0 + 4) && (PHMASK & 32)) for (int rep = 0; rep < NREP(32); ++rep) {
            KArgs ap = kargs(); unsigned char* wsp = ap->ws; const int Lp = OPQ(L);
            pg8::Gemm g{(const bf16_t*)(wsp + ((Lp & 1) ? WS_XB1 : WS_XB0)), (const bf16_t*)(wsp + WS_W + (size_t)Lp * W_LAYER + W_FFI), M, 5632, 1024}; pg8::StaticOrder S; S.init(M, 5632, G, bid);
            EpiSwiglu E{(bf16_t*)(wsp + WS_BIG), stat_ptr(wsp, Lp, ST_X2), 1.0f / KREP3};
            pg8::gemm_phase<EpiSwiglu, pg8::StaticOrder, PG8_ALIGN, PG8_SP2, KREP3>(lds, g, S, E, wave0);
        }
        SEAM(p0 + 4);
        if (IN(p0 + 5) && (PHMASK & 64)) {
            { KArgs ap = kargs(); unsigned char* wsp = ap->ws; const int Lp = OPQ(L);
              pg8::Gemm g{(const bf16_t*)(wsp + WS_BIG), (const bf16_t*)(wsp + WS_W + (size_t)Lp * W_LAYER + W_FFO), M, 1024, D_FF}; pg8::StaticOrder S; S.init(M, 1024, G, bid);
              EpiNormRes E{(bf16_t*)(wsp + ((Lp & 1) ? WS_XB1 : WS_XB0)), ap->in[15] + Lp * D_MODEL, stat_ptr(wsp, Lp, ST_F), nullptr, (unsigned*)wsp + CW_TMO};
              pg8::gemm_phase<EpiNormRes, pg8::StaticOrder, PG8_ALIGN, PG8_SP2>(lds, g, S, E, wave0); }
            { KArgs ap = kargs(); unsigned char* wsp = ap->ws; const int Lp = OPQ(L);
              pg8::Gemm g{(const bf16_t*)(wsp + WS_PB) + (size_t)Lp * M * PLE_DIM, (const bf16_t*)(wsp + WS_W + (size_t)Lp * W_LAYER + W_P), M, 1024, PLE_DIM}; pg8::StaticOrder S; S.init(M, 1024, G, bid);
              EpiStat E{(bf16_t*)(wsp + WS_MIX), stat_ptr(wsp, Lp, ST_PP)};
              pg8::gemm_phase<EpiStat, pg8::StaticOrder, PG8_ALIGN, PG8_SP2>(lds, g, S, E, wave0); }
        }
        SEAM(p0 + 5);
        if (IN(p0 + 7) && (PHMASK & 256)) {
            KArgs ap = kargs(); unsigned char* wsp = ap->ws; const int Lp = OPQ(L);
            const bf16_t* XBc = (const bf16_t*)(wsp + ((Lp & 1) ? WS_XB1 : WS_XB0));
            pg8::Gemm g{XBc, (const bf16_t*)(wsp + WS_W + (size_t)Lp * W_LAYER + W_G), M, 1024, 1024}; pg8::StaticOrder S; S.init(M, 1024, G, bid);
            const bool last = (Lp == DEPTH - 1);
            EpiPle E{XBc, (const bf16_t*)(wsp + WS_MIX), stat_ptr(wsp, Lp, ST_PP), ap->in[18] + Lp * D_MODEL, last ? nullptr : (bf16_t*)(wsp + ((Lp & 1) ? WS_XB0 : WS_XB1)), last ? nullptr : stat_ptr(wsp, Lp + 1, ST_X1), last ? ap->out : nullptr};
            pg8::gemm_phase<EpiPle, pg8::StaticOrder, PG8_ALIGN, PG8_SP2>(lds, g, S, E, wave0);
        }
        SEAM(p0 + 7);
    }
#undef IN
#undef SEAM
#undef LANE_VARS
#undef opq_tid
}

extern "C" void kernel_launch(void* const* d_in, const int* in_sizes, int n_in, void* d_out, int out_size, void* d_ws, size_t ws_size, hipStream_t stream) {
    static int grid = 0;
    if (grid == 0) {
        if (n_in != 19 || out_size != M * D_MODEL || ws_size < WS_END) { fprintf(stderr, "kernel_launch: unexpected shapes (n_in %d out %d ws %zu)\n", n_in, out_size, ws_size); grid = -1; return; }
        int dev = 0, cus = 0, per_cu = 0;
        if (hipGetDevice(&dev) != hipSuccess || hipDeviceGetAttribute(&cus, hipDeviceAttributeMultiprocessorCount, dev) != hipSuccess) { grid = -1; return; }
        if (hipFuncSetAttribute((const void*)mega, hipFuncAttributeMaxDynamicSharedMemorySize, LDS_BYTES) != hipSuccess) { fprintf(stderr, "kernel_launch: hipFuncSetAttribute failed\n"); grid = -1; return; }
        if (hipOccupancyMaxActiveBlocksPerMultiprocessor(&per_cu, (const void*)mega, NTHREADS, LDS_BYTES) != hipSuccess || per_cu < 1) { fprintf(stderr, "kernel_launch: occupancy query says %d\n", per_cu); }
        (void)hipGetLastError();
        grid = cus >= 256 ? 256 : cus;
    }
    if (grid < 0) return;
    unsigned char* ws = (unsigned char*)d_ws;
    (void)hipMemsetAsync(ws + WS_CTL, 0, CTL_ZERO_BYTES, stream);
    Args a{};
    for (int i = 0; i < 19; ++i) a.in[i] = (const float*)d_in[i];
    a.out = (float*)d_out; a.ws = ws; a.li = 0; a.pad = 0;
    a.ph_lo = 0; a.ph_hi = N_PHASES;
    hipLaunchKernelGGL(mega, dim3(grid), dim3(NTHREADS), LDS_BYTES, stream, a);
}
```

```cpp
#include <hip/hip_runtime.h>
#include <stdint.h>
#include <stdio.h>

constexpr int D_MODEL = 1024, BATCH = 32, SEQ = 2048, DEPTH = 2, PLE_DIM = 256, HD = 64, CHUNK = 128;
constexpr int M = BATCH * SEQ;
constexpr int IN_W = 2688, D_FF = 2816, NHEADS = 42;
constexpr int H_AU = 0, H_AV = 4, H_BQ = 8, H_BK = 14, H_BV = 20, H_BG = 26, H_CQ = 32, H_CK = 38, H_CV = 40;
constexpr float EPS = 1e-6f;
typedef unsigned short bf16_t;

__device__ __forceinline__ float bf2f(bf16_t v) { return __uint_as_float(((unsigned)v) << 16); }
__device__ __forceinline__ bf16_t f2bf(float f) { unsigned u = __float_as_uint(f); return (bf16_t)((u + 0x7fffu + ((u >> 16) & 1u)) >> 16); }
__device__ __forceinline__ float shx(float v, int mask, int lane) { return __int_as_float(__builtin_amdgcn_ds_bpermute((lane ^ mask) << 2, __float_as_int(v))); }
__device__ __forceinline__ float wave_sum(float v) {
#pragma unroll
    for (int o = 1; o < 64; o <<= 1) v += __shfl_xor(v, o);
    return v;
}
constexpr float LOG2E_ = 1.4426950408889634f;

__constant__ double c_inv_ret[32] = {1.0, 0.7498942093324559, 0.5623413251903491, 0.4216965034285822, 0.31622776601683794, 0.23713737056616552, 0.1778279410038923, 0.1333521432163324, 0.1, 0.07498942093324558, 0.05623413251903491, 0.042169650342858224, 0.03162277660168379, 0.023713737056616554, 0.01778279410038923, 0.01333521432163324, 0.01, 0.007498942093324558, 0.005623413251903491, 0.004216965034285823, 0.0031622776601683794, 0.0023713737056616554, 0.0017782794100389228, 0.001333521432163324, 0.001, 0.0007498942093324559, 0.0005623413251903491, 0.00042169650342858224, 0.00031622776601683794, 0.00023713737056616554, 0.00017782794100389227, 0.0001333521432163324};
__constant__ double c_inv_swa[8] = {1.0, 0.19392274474868576, 0.03760603093086393, 0.007292664737217109, 0.001414213562373095, 0.0002742481756762073, 5.318295896944988e-05, 1.031338537721246e-05};
__constant__ float c_log2g[6] = {-0.04580368961312479f, -0.02272007650008353f, -0.011315313227834146f, -0.005646563141142063f, -0.0028205190623786626f, -0.0014095702546713536f};

constexpr size_t MiB = 1u << 20;
constexpr size_t WS_CTL = 0, CTL_ZERO_BYTES = 7 * MiB;
constexpr size_t WS_STAT = 1 * MiB;
constexpr size_t WS_TAB = 7 * MiB;
constexpr size_t WS_WM = 7 * MiB + 768 * 1024;
constexpr size_t WS_W = 8 * MiB;
constexpr size_t WS_XB0 = 64 * MiB;
constexpr size_t WS_BIG = 192 * MiB;
constexpr size_t WS_Y = 544 * MiB;
constexpr size_t WS_MIX = 672 * MiB;
constexpr size_t WS_XB1 = 800 * MiB;
constexpr size_t WS_PB = 928 * MiB;
constexpr size_t WS_END = 992 * MiB;
constexpr int TAB_RC = 0, TAB_RS = 2048 * 32, TAB_SC = 2 * 2048 * 32, TAB_SS = 2 * 2048 * 32 + 2048 * 8;


namespace pg8 {
#define PG8_LAS __attribute__((address_space(3)))
typedef unsigned short bf16_t;
typedef short bf16x8 __attribute__((ext_vector_type(8)));
typedef float f32x4 __attribute__((ext_vector_type(4)));
typedef unsigned u32x4 __attribute__((ext_vector_type(4)));
constexpr int BM = 256, BK = 64, HALF = 128, HTB = HALF * BK * 2  , STAGE_BYTES = 8 * HTB, NXCD = 8, WGM = 8;

__host__ __device__ __forceinline__ int lds_byte(int r, int c) { const int st = (r >> 4) * 2 + (c >> 5), rr = r & 15, cc = c & 31, ob = rr * 64 + cc * 2; return st * 1024 + (ob ^ (((ob >> 9) & 1) << 5)); }
__host__ __device__ __forceinline__ void stage_rc(int b, int& R, int& C) { const int st = b / 1024, sb = b % 1024, swz = sb ^ (((sb >> 9) & 1) << 5); R = (st >> 1) * 16 + swz / 64; C = (st & 1) * 32 + (swz % 64) / 2; }
__host__ __device__ __forceinline__ int perm32(int rho) { const int n = rho >> 4, i = rho & 15; return 8 * (i >> 2) + 4 * n + (i & 3); }

struct Unit { int pm, pn; };
struct Gemm { const bf16_t* A; const bf16_t* Bt; int M, N, K; };

struct StaticOrder {
    int nM, nN, nwg, G, c, wgm;
    __host__ __device__ void init(int M, int N, int G_, int c_) { nM = M / BM; nN = N / BM; nwg = nM * nN; G = G_; c = c_; wgm = nN >= 8 ? 4 : WGM; }
    __host__ __device__ bool next(int i, Unit& u) const {
        const long L = (long)i * G + c; if (L >= nwg) return false;
        int wgid = (int)L; { const int q = nwg / NXCD, r = nwg % NXCD, xcd = wgid % NXCD, off = wgid / NXCD; wgid = (xcd < r ? xcd * (q + 1) : r * (q + 1) + (xcd - r) * q) + off; }
        const int nig = wgm * nN, gid = wgid / nig, fm = gid * wgm, gsz = (nM - fm) < wgm ? (nM - fm) : wgm;
        u.pm = fm + ((wgid % nig) % gsz); u.pn = (wgid % nig) / gsz; return true;
    }
    __device__ __forceinline__ void a_ready(const Unit&) const {}
    __device__ __forceinline__ void done(const Unit&) const {}
};

typedef float f32x2_cv __attribute__((ext_vector_type(2))); typedef __bf16 bf16x2_cv __attribute__((ext_vector_type(2)));
__device__ __forceinline__ unsigned cvt_pk_bf16(float lo, float hi) { const f32x2_cv v = {lo, hi}; const bf16x2_cv b = __builtin_convertvector(v, bf16x2_cv); return __builtin_bit_cast(unsigned, b); }
__device__ __forceinline__ int pg8_tid(int wave0) {
    unsigned ones = ~0u; asm volatile("" : "+s"(ones));
    return wave0 * 64 + (int)__builtin_amdgcn_mbcnt_hi(ones, __builtin_amdgcn_mbcnt_lo(ones, 0u));
}
template <class Epi, class Sched, bool ALIGN_EPI = false, bool SP2 = false, int KREP = 1>
__device__ __forceinline__ void gemm_phase(PG8_LAS unsigned char* lds, const Gemm g, const Sched& S, const Epi& E, int wave0) {
    const int tid = pg8_tid(wave0);
    const int wid = __builtin_amdgcn_readfirstlane(tid >> 6), lane = tid & 63, wr = wid >> 2, wc = wid & 3, fr = lane & 15, fq = lane >> 4;
    const int K = g.K, nt = K / BK;
    unsigned voffA[2], voffB[2];
#pragma unroll
    for (int i = 0; i < 2; ++i) { int R, C; stage_rc(tid * 16 + i * 8192, R, C); const int Rb = Epi::PERM ? ((R & ~31) + perm32(R & 31)) : R;
        voffA[i] = (unsigned)(R * K + C) * 2u; voffB[i] = (unsigned)(Rb * K + C) * 2u; }
    const size_t kstep = (size_t)(BK * 2);
    const size_t hstep = (size_t)HALF * K * 2;
    const size_t tstep = 2 * hstep;
    const unsigned ldsw = (unsigned)wid * 1024u;
    const int aoff = lds_byte(wr * 64 + fr, fq * 8), boff = lds_byte(wc * 32 + fr, fq * 8);
#define PG8_SA(b, h) (((b) * 2 + (h)) * HTB)
#define PG8_SB(b, h) ((4 + (b) * 2 + (h)) * HTB)
#define PG8_STAGE(bufoff, gbase, voff) do { _Pragma("unroll") for (int _i = 0; _i < 2; ++_i) \
        __builtin_amdgcn_global_load_lds((const unsigned*)((const char*)(gbase) + (voff)[_i]), (PG8_LAS unsigned*)(lds + (bufoff) + ldsw + _i * 8192), 16, 0, 0); } while (0)
#define PG8_LDA(dst, b, h) do { _Pragma("unroll") for (int m = 0; m < 4; ++m) _Pragma("unroll") for (int k = 0; k < 2; ++k) dst[m][k] = *(const PG8_LAS bf16x8*)(lds + PG8_SA(b, h) + aoff + m * 2048 + k * 1024); } while (0)
#define PG8_LDB(dst, b, h) do { _Pragma("unroll") for (int n = 0; n < 2; ++n) _Pragma("unroll") for (int k = 0; k < 2; ++k) dst[n][k] = *(const PG8_LAS bf16x8*)(lds + PG8_SB(b, h) + boff + n * 2048 + k * 1024); } while (0)
#define PG8_MMA(ai, bj, At, Bt) do { __builtin_amdgcn_s_setprio(1); _Pragma("unroll") for (int m = 0; m < 4; ++m) _Pragma("unroll") for (int n = 0; n < 2; ++n) _Pragma("unroll") for (int k = 0; k < 2; ++k) \
        acc[ai][bj][m][n] = __builtin_amdgcn_mfma_f32_16x16x32_bf16(Bt[n][k], At[m][k], acc[ai][bj][m][n], 0, 0, 0); __builtin_amdgcn_s_setprio(0); } while (0)
#define PG8_WAIT_V(n) asm volatile("s_waitcnt vmcnt(" #n ")" ::: "memory")
#define PG8_WAIT_L(n) asm volatile("s_waitcnt lgkmcnt(" #n ")" ::: "memory")
#define PG8_BAR __builtin_amdgcn_s_barrier()
#define PG8_SCHED __builtin_amdgcn_sched_barrier(0)
    Unit cur, nxt; int ui = 0;
    if (!S.next(0, cur)) return;
    f32x4 acc[2][2][4][2];
#pragma unroll
    for (int a = 0; a < 2; ++a)
#pragma unroll
        for (int b = 0; b < 2; ++b)
#pragma unroll
            for (int m = 0; m < 4; ++m)
#pragma unroll
                for (int n = 0; n < 2; ++n) acc[a][b][m][n] = (f32x4){0.f, 0.f, 0.f, 0.f};
    bf16x8 At[4][2], B0[2][2], B1[2][2];
    const char* cA = (const char*)g.A + (size_t)cur.pm * tstep; const char* cB = (const char*)g.Bt + (size_t)cur.pn * tstep;
    S.a_ready(cur);
    if constexpr (SP2) {
        PG8_STAGE(PG8_SB(0, 0), cB, voffB); PG8_STAGE(PG8_SB(0, 1), cB + hstep, voffB); PG8_STAGE(PG8_SA(0, 0), cA, voffA); PG8_STAGE(PG8_SA(0, 1), cA + hstep, voffA);
        if (wr == 1) PG8_BAR;
        PG8_WAIT_V(2); PG8_BAR;
        PG8_STAGE(PG8_SB(1, 0), cB + kstep, voffB); PG8_STAGE(PG8_SA(1, 0), cA + kstep, voffA); PG8_STAGE(PG8_SB(1, 1), cB + hstep + kstep, voffB);
        PG8_WAIT_V(6); PG8_BAR;
    } else {
        PG8_STAGE(PG8_SB(0, 0), cB, voffB); PG8_STAGE(PG8_SA(0, 0), cA, voffA); PG8_STAGE(PG8_SB(0, 1), cB + hstep, voffB); PG8_STAGE(PG8_SA(0, 1), cA + hstep, voffA);
        if (wr == 1) PG8_BAR;
        PG8_WAIT_V(4); PG8_BAR;
        PG8_STAGE(PG8_SB(1, 0), cB + kstep, voffB); PG8_STAGE(PG8_SA(1, 0), cA + kstep, voffA); PG8_STAGE(PG8_SB(1, 1), cB + hstep + kstep, voffB);
        PG8_WAIT_V(6); PG8_BAR;
    }
    for (;;) {
        const bool has_next = S.next(ui + 1, nxt);
        const char* nA = has_next ? (const char*)g.A + (size_t)nxt.pm * tstep : cA; const char* nB = has_next ? (const char*)g.Bt + (size_t)nxt.pn * tstep : cB;
        for (int t = 0; t < nt * KREP; t += 2) {
            const bool last = (t == nt * KREP - 2);
            const int t1 = KREP > 1 ? (t + 1) % nt : t + 1, t2 = KREP > 1 ? (t + 2) % nt : t + 2;
            const char* a1 = cA + (size_t)t1 * kstep;
            const char* a2 = last ? nA : cA + (size_t)t2 * kstep; const char* b2 = last ? nB : cB + (size_t)t2 * kstep;
            const char* a3 = a2 + kstep; const char* b3 = b2 + kstep;
            if (last && has_next) S.a_ready(nxt);
            if constexpr (SP2) {
            PG8_LDB(B0, 0, 0); PG8_LDB(B1, 0, 1); PG8_SCHED; PG8_LDA(At, 0, 0); PG8_STAGE(PG8_SA(1, 1), a1 + hstep, voffA);
            PG8_WAIT_V(8); PG8_WAIT_L(0); PG8_BAR; PG8_MMA(0, 0, At, B0); PG8_MMA(0, 1, At, B1); PG8_BAR; PG8_SCHED;
            PG8_LDA(At, 0, 1); PG8_STAGE(PG8_SB(0, 0), b2, voffB); PG8_STAGE(PG8_SB(0, 1), b2 + hstep, voffB); PG8_STAGE(PG8_SA(0, 0), a2, voffA);
            PG8_WAIT_V(8); PG8_WAIT_L(0); PG8_BAR; PG8_MMA(1, 0, At, B0); PG8_MMA(1, 1, At, B1); PG8_BAR; PG8_SCHED;
            PG8_LDB(B0, 1, 0); PG8_LDB(B1, 1, 1); PG8_SCHED; PG8_LDA(At, 1, 0); PG8_STAGE(PG8_SA(0, 1), a2 + hstep, voffA);
            PG8_WAIT_V(8); PG8_WAIT_L(0); PG8_BAR; PG8_MMA(0, 0, At, B0); PG8_MMA(0, 1, At, B1); PG8_BAR; PG8_SCHED;
            PG8_LDA(At, 1, 1); PG8_STAGE(PG8_SB(1, 0), b3, voffB); PG8_STAGE(PG8_SB(1, 1), b3 + hstep, voffB); PG8_STAGE(PG8_SA(1, 0), a3, voffA);
            PG8_WAIT_V(8); PG8_WAIT_L(0); PG8_BAR; PG8_MMA(1, 0, At, B0); PG8_MMA(1, 1, At, B1); PG8_BAR; PG8_SCHED;
            } else {
            PG8_LDB(B0, 0, 0); PG8_SCHED; PG8_LDA(At, 0, 0); PG8_STAGE(PG8_SA(1, 1), a1 + hstep, voffA);
            PG8_WAIT_L(8); PG8_BAR; PG8_WAIT_L(0); PG8_MMA(0, 0, At, B0); PG8_BAR; PG8_SCHED;
            PG8_LDB(B1, 0, 1); PG8_STAGE(PG8_SB(0, 0), b2, voffB);
            PG8_BAR; PG8_WAIT_L(0); PG8_MMA(0, 1, At, B1); PG8_BAR;
            PG8_LDA(At, 0, 1); PG8_STAGE(PG8_SA(0, 0), a2, voffA);
            PG8_BAR; PG8_WAIT_L(0); PG8_MMA(1, 0, At, B0); PG8_BAR; PG8_SCHED;
            PG8_STAGE(PG8_SB(0, 1), b2 + hstep, voffB);
            PG8_WAIT_V(6); PG8_BAR; PG8_MMA(1, 1, At, B1); PG8_BAR;
            PG8_LDB(B0, 1, 0); PG8_SCHED; PG8_LDA(At, 1, 0); PG8_STAGE(PG8_SA(0, 1), a2 + hstep, voffA);
            PG8_WAIT_L(8); PG8_BAR; PG8_WAIT_L(0); PG8_MMA(0, 0, At, B0); PG8_BAR; PG8_SCHED;
            PG8_LDB(B1, 1, 1); PG8_STAGE(PG8_SB(1, 0), b3, voffB);
            PG8_BAR; PG8_WAIT_L(0); PG8_MMA(0, 1, At, B1); PG8_BAR;
            PG8_LDA(At, 1, 1); PG8_STAGE(PG8_SA(1, 0), a3, voffA);
            PG8_BAR; PG8_WAIT_L(0); PG8_MMA(1, 0, At, B0); PG8_BAR; PG8_SCHED;
            PG8_STAGE(PG8_SB(1, 1), b3 + hstep, voffB);
            PG8_WAIT_V(6); PG8_BAR; PG8_MMA(1, 1, At, B1); PG8_BAR;
            }
        }
        if constexpr (ALIGN_EPI) { if (wr == 0) PG8_BAR; }
        if constexpr (!Epi::AFTER_DRAIN) { E(acc, cur, wr, wc, fr, fq); S.done(cur); }
        if (!has_next) break;
#pragma unroll
        for (int a = 0; a < 2; ++a)
#pragma unroll
            for (int b = 0; b < 2; ++b)
#pragma unroll
                for (int m = 0; m < 4; ++m)
#pragma unroll
                    for (int n = 0; n < 2; ++n) acc[a][b][m][n] = (f32x4){0.f, 0.f, 0.f, 0.f};
        cur = nxt; cA = nA; cB = nB; ++ui;
        if constexpr (ALIGN_EPI) { if (wr == 1) PG8_BAR; }
    }
    PG8_WAIT_V(0);
    if constexpr (!ALIGN_EPI) { if (wr == 0) PG8_BAR; }
    PG8_BAR;
    if constexpr (Epi::AFTER_DRAIN) { E.fused(acc, cur, wr, wc, fr, fq, lds, wid, lane); S.done(cur); }
#undef PG8_SA
#undef PG8_SB
#undef PG8_STAGE
#undef PG8_LDA
#undef PG8_LDB
#undef PG8_MMA
#undef PG8_WAIT_V
#undef PG8_WAIT_L
#undef PG8_BAR
#undef PG8_SCHED
}
}

#define LAS __attribute__((address_space(3)))
#define GAS __attribute__((address_space(1)))
using pg8::f32x4; using pg8::u32x4; using pg8::Unit; using pg8::cvt_pk_bf16;
typedef unsigned u32x2 __attribute__((ext_vector_type(2)));
typedef GAS unsigned gu32;
#define RLX_AGENT __ATOMIC_RELAXED, __HIP_MEMORY_SCOPE_AGENT

constexpr int NWAVES = 8, NTHREADS = 512;
constexpr int LDS_BYTES = 163840;
constexpr int RING_BYTES = 147456, MISC_OFF = RING_BYTES + 320;
constexpr size_t W_IN = 0, W_OUT = W_IN + (size_t)2816 * 1024 * 2, W_FFI = W_OUT + (size_t)1024 * 1024 * 2, W_FFO = W_FFI + (size_t)5632 * 1024 * 2,
                 W_G = W_FFO + (size_t)1024 * 2816 * 2, W_P = W_G + (size_t)1024 * 1024 * 2, W_LAYER = W_P + (size_t)1024 * 256 * 2;
static_assert(WS_W + 2 * W_LAYER <= WS_XB0, "weights fit");
enum { ST_X1 = 0, ST_MIX = 1, ST_X2 = 2, ST_F = 3, ST_PP = 4, ST_N = 5 };
typedef unsigned long long stat_t;
__host__ __device__ __forceinline__ stat_t* stat_ptr(unsigned char* ws, int L, int idx) { return (stat_t*)(ws + WS_STAT) + (size_t)(L * ST_N + idx) * M; }
static_assert(WS_STAT + (size_t)2 * ST_N * M * 8 <= CTL_ZERO_BYTES && CTL_ZERO_BYTES <= WS_TAB, "stats inside the zeroed region");
__device__ __forceinline__ stat_t ss_enc(float s) { return (stat_t)(s * 16777216.0f); }
__device__ __forceinline__ float ss_dec(stat_t v) { return (float)v * (1.0f / 16777216.0f); }
constexpr int CW_BAR = 4096;

#define XB_TMO      128
#define XB_XCNT(j)  (256  + 64 * (j))
#define XB_XSUB(j)  (1280 + 64 * (j))
#define XB_XGEN(j)  (2304 + 64 * (j))
#define XB_TOP      3328
#define XB_TOPGEN   3392
#define XCD_BAR_WORDS 3456
#define XB_SPIN_CAP (1u << 22)
__device__ __forceinline__ unsigned xb_ld(unsigned* p)              { return __hip_atomic_load(p, __ATOMIC_RELAXED, __HIP_MEMORY_SCOPE_AGENT); }
__device__ __forceinline__ unsigned xb_add(unsigned* p, unsigned v) { return __hip_atomic_fetch_add(p, v, __ATOMIC_RELAXED, __HIP_MEMORY_SCOPE_AGENT); }
__device__ __forceinline__ unsigned xb_xcc_id() { return (unsigned)__builtin_amdgcn_s_getreg((3 << 11) | 20) & 0xFu; }
#define XB_SPIN(cond, bar) do { unsigned _sp = 0; while (cond) { __builtin_amdgcn_s_sleep(1); \
    if ((++_sp & 255u) == 0u) { if (xb_ld(&(bar)[XB_TMO])) break; if (_sp > XB_SPIN_CAP) { atomicAdd(&(bar)[XB_TMO], 1u); break; } } } } while (0)
struct XcdBarrier { unsigned* bar; unsigned x; volatile LAS unsigned* st; };
__device__ __forceinline__ XcdBarrier xcd_barrier_post(unsigned* bar, volatile LAS unsigned* st) {
    XcdBarrier b; b.bar = bar; b.x = xb_xcc_id(); b.st = st;
    if (threadIdx.x == 0) (void)xb_add(&bar[XB_XCNT(b.x)], 1u);
    return b;
}
__device__ __forceinline__ void xcd_barrier_complete(unsigned* bar, unsigned x, unsigned& nloc, unsigned& nx) {
    const unsigned G = gridDim.x * gridDim.y * gridDim.z;
    unsigned sum, cnt, mine, sp = 0u;
    for (;;) {
        sum = 0u; cnt = 0u; mine = 0u;
#pragma unroll
        for (unsigned j = 0; j < 16; ++j) { const unsigned c = xb_ld(&bar[XB_XCNT(j)]); sum += c; cnt += (c > 0u) ? 1u : 0u; mine = (j == x) ? c : mine; }
        if (sum == G) break;
        __builtin_amdgcn_s_sleep(1);
        if ((++sp & 255u) == 0u) { if (xb_ld(&bar[XB_TMO])) break; if (sp > XB_SPIN_CAP) { atomicAdd(&bar[XB_TMO], 1u); break; } }
    }
    nloc = mine > 0u ? mine : 1u; nx = cnt > 0u ? cnt : 1u;
}
__device__ __forceinline__ void xcd_barrier(const XcdBarrier& b, int tid) {
    asm volatile("s_waitcnt vmcnt(0)" ::: "memory");
    __syncthreads();
    if (tid == 0) {
        unsigned* bar = b.bar;
        __builtin_amdgcn_s_waitcnt(0);
        unsigned nloc = b.st[0], nx = b.st[1];
        if (nloc == 0u) { xcd_barrier_complete(bar, b.x, nloc, nx); b.st[0] = nloc; b.st[1] = nx; }
        const unsigned old = xb_add(&bar[XB_XSUB(b.x)], 1u);
        const unsigned gen = old / nloc;
        if (old + 1u == (gen + 1u) * nloc) {
            __builtin_amdgcn_fence(__ATOMIC_RELEASE, "agent");
            asm volatile("s_waitcnt vmcnt(0)" ::: "memory");
            const unsigned og = xb_add(&bar[XB_TOP], 1u);
            const unsigned tg = og / nx;
            if (og + 1u == (tg + 1u) * nx) xb_add(&bar[XB_TOPGEN], 1u);
            else XB_SPIN(xb_ld(&bar[XB_TOPGEN]) == tg, bar);
            __builtin_amdgcn_fence(__ATOMIC_ACQUIRE, "agent");
            xb_add(&bar[XB_XGEN(b.x)], 1u);
            asm volatile("s_waitcnt vmcnt(0)" ::: "memory");
        } else {
            XB_SPIN(xb_ld(&bar[XB_XGEN(b.x)]) == gen, bar);
            __builtin_amdgcn_fence(__ATOMIC_ACQUIRE, "agent");
            asm volatile("s_waitcnt vmcnt(0)" ::: "memory");
        }
    }
    __syncthreads();
}

__device__ __forceinline__ float fast_rsq(float x) { return __builtin_amdgcn_rsqf(x); }
__device__ __forceinline__ float sigm(float x) { return __builtin_amdgcn_rcpf(1.0f + __builtin_amdgcn_exp2f(-LOG2E_ * x)); }
__device__ __forceinline__ float gelu_t(float x) { return x * sigm(1.5957691216057308f * (x + 0.044715f * x * x * x)); }
__device__ __forceinline__ void unpack8s(const f32x4& v0, const f32x4& v1, float s, float (&o)[8]) {
    o[0] = v0[0] * s; o[1] = v0[1] * s; o[2] = v0[2] * s; o[3] = v0[3] * s; o[4] = v1[0] * s; o[5] = v1[1] * s; o[6] = v1[2] * s; o[7] = v1[3] * s;
}
__device__ __forceinline__ u32x4 pack8(const float (&o)[8]) {
    u32x4 w; w.x = cvt_pk_bf16(o[0], o[1]); w.y = cvt_pk_bf16(o[2], o[3]); w.z = cvt_pk_bf16(o[4], o[5]); w.w = cvt_pk_bf16(o[6], o[7]); return w;
}
__device__ __forceinline__ void ld8f(const float* p, float (&o)[8]) {
    const f32x4 a = *(const f32x4*)p, b = *(const f32x4*)(p + 4);
    o[0] = a[0]; o[1] = a[1]; o[2] = a[2]; o[3] = a[3]; o[4] = b[0]; o[5] = b[1]; o[6] = b[2]; o[7] = b[3];
}
__device__ __forceinline__ void unpack_bf8(const u32x4& r, float (&o)[8]) {
    o[0] = __uint_as_float(r.x << 16); o[1] = __uint_as_float(r.x & 0xffff0000u); o[2] = __uint_as_float(r.y << 16); o[3] = __uint_as_float(r.y & 0xffff0000u);
    o[4] = __uint_as_float(r.z << 16); o[5] = __uint_as_float(r.z & 0xffff0000u); o[6] = __uint_as_float(r.w << 16); o[7] = __uint_as_float(r.w & 0xffff0000u);
}
__device__ __forceinline__ int fresh_lane() { unsigned ones = ~0u; asm volatile("" : "+s"(ones)); return (int)__builtin_amdgcn_mbcnt_hi(ones, __builtin_amdgcn_mbcnt_lo(ones, 0u)); }
#define EPI_ROW(u, ai, wr, m, fr) ((u).pm * 256 + (ai) * 128 + (wr) * 64 + (m) * 16 + (fr))

enum { T_AU, T_AV, T_BQ, T_BK, T_BV, T_BG, T_CQ, T_CK, T_CV };
struct EpiProj {
    static constexpr bool PERM = true, AFTER_DRAIN = false;
    bf16_t* P; const stat_t* ss; const float* ln_w; const float* ln_b; const float* tab;
    template <int TYPE> __device__ __forceinline__ void rows(const f32x4 (&acc)[2][2][4][2], const Unit& u, int wr, int hs, int hrel, int fr, int fq) const {
        const int d0 = 8 * fq, ln_ = fr + 16 * fq;
        float rs[8];
#pragma unroll
        for (int q = 0; q < 8; ++q) rs[q] = ss_dec(ss[EPI_ROW(u, q >> 2, wr, q & 3, fr)]);
        float wa[8], wb[8], ba[8], bb[8];
        if constexpr (TYPE == T_AV) { ld8f(ln_w + hrel * 64 + d0, wa); ld8f(ln_w + hrel * 64 + 32 + d0, wb); ld8f(ln_b + hrel * 64 + d0, ba); ld8f(ln_b + hrel * 64 + 32 + d0, bb); }
#pragma unroll
        for (int hp = 0; hp < 4; ++hp) {
            const int ai = hp >> 1;
            float tc[2][8], tsn[2][8];
            if constexpr (TYPE == T_BQ || TYPE == T_BK) {
#pragma unroll
                for (int mm = 0; mm < 2; ++mm) { const int pos = EPI_ROW(u, ai, wr, 2 * (hp & 1) + mm, fr) & (SEQ - 1); ld8f(tab + TAB_RC + pos * 32 + d0, tc[mm]); ld8f(tab + TAB_RS + pos * 32 + d0, tsn[mm]); }
            }
            if constexpr (TYPE == T_CQ || TYPE == T_CK) {
#pragma unroll
                for (int mm = 0; mm < 2; ++mm) { const int pos = EPI_ROW(u, ai, wr, 2 * (hp & 1) + mm, fr) & (SEQ - 1); ld8f(tab + TAB_SC + pos * 8, tc[mm]); ld8f(tab + TAB_SS + pos * 8, tsn[mm]); }
            }
#pragma unroll
            for (int mm = 0; mm < 2; ++mm) {
                const int m = 2 * (hp & 1) + mm;
                const int row = EPI_ROW(u, ai, wr, m, fr);
                const float rstd = fast_rsq(rs[ai * 4 + m] * (1.0f / D_MODEL) + EPS);
                float a[8], b[8];
                unpack8s(acc[ai][0][m][0], acc[ai][0][m][1], rstd, a); unpack8s(acc[ai][1][m][0], acc[ai][1][m][1], rstd, b);
                if constexpr (TYPE == T_AU) {
#pragma unroll
                    for (int j = 0; j < 8; ++j) { a[j] = gelu_t(a[j]); b[j] = gelu_t(b[j]); }
                } else if constexpr (TYPE == T_AV) {
                    float sm = 0.f;
#pragma unroll
                    for (int j = 0; j < 8; ++j) { a[j] = gelu_t(a[j]); b[j] = gelu_t(b[j]); sm += a[j] + b[j]; }
                    sm += shx(sm, 16, ln_); sm += shx(sm, 32, ln_);
                    const float mu = sm * (1.0f / 64.0f); float q = 0.f;
#pragma unroll
                    for (int j = 0; j < 8; ++j) { a[j] -= mu; b[j] -= mu; q += a[j] * a[j] + b[j] * b[j]; }
                    q += shx(q, 16, ln_); q += shx(q, 32, ln_);
                    const float rsd = fast_rsq(q * (1.0f / 64.0f) + EPS);
#pragma unroll
                    for (int j = 0; j < 8; ++j) { a[j] = a[j] * rsd * wa[j] + ba[j]; b[j] = b[j] * rsd * wb[j] + bb[j]; }
                } else if constexpr (TYPE == T_BQ || TYPE == T_BK) {
                    const float sc = TYPE == T_BK ? 0.125f : 1.0f;
#pragma unroll
                    for (int j = 0; j < 8; ++j) { const float x1 = a[j], x2 = b[j]; a[j] = (x1 * tc[mm][j] - x2 * tsn[mm][j]) * sc; b[j] = (x2 * tc[mm][j] + x1 * tsn[mm][j]) * sc; }
                } else if constexpr (TYPE == T_BG) {
#pragma unroll
                    for (int j = 0; j < 8; ++j) { a[j] = a[j] * sigm(a[j]); b[j] = b[j] * sigm(b[j]); }
                } else if constexpr (TYPE == T_CQ || TYPE == T_CK) {
                    float o[8];
#pragma unroll
                    for (int j = 0; j < 8; ++j) o[j] = shx(a[j], 16, ln_);
                    if (fq < 2) {
                        const float sg = fq == 0 ? -1.0f : 1.0f;
#pragma unroll
                        for (int j = 0; j < 8; ++j) a[j] = a[j] * tc[mm][j] + sg * o[j] * tsn[mm][j];
                    }
                }
                bf16_t* dst = P + (size_t)row * IN_W + hs * 64 + d0;
                *(u32x4*)dst = pack8(a); *(u32x4*)(dst + 32) = pack8(b);
            }
        }
    }
    __device__ __forceinline__ void operator()(const f32x4 (&acc)[2][2][4][2], const Unit& u, int wr, int wc, int fr, int fq) const {
        const int ln_ = fresh_lane(); fr = ln_ & 15; fq = ln_ >> 4;
        const int hs = u.pn * 4 + wc;
        if (hs >= NHEADS) return;
        if (hs < H_AV) rows<T_AU>(acc, u, wr, hs, hs - H_AU, fr, fq);
        else if (hs < H_BQ) rows<T_AV>(acc, u, wr, hs, hs - H_AV, fr, fq);
        else if (hs < H_BK) rows<T_BQ>(acc, u, wr, hs, hs - H_BQ, fr, fq);
        else if (hs < H_BV) rows<T_BK>(acc, u, wr, hs, hs - H_BK, fr, fq);
        else if (hs < H_BG) rows<T_BV>(acc, u, wr, hs, hs - H_BV, fr, fq);
        else if (hs < H_CQ) rows<T_BG>(acc, u, wr, hs, hs - H_BG, fr, fq);
        else if (hs < H_CK) rows<T_CQ>(acc, u, wr, hs, hs - H_CQ, fr, fq);
        else if (hs < H_CV) rows<T_CK>(acc, u, wr, hs, hs - H_CK, fr, fq);
        else rows<T_CV>(acc, u, wr, hs, hs - H_CV, fr, fq);
    }
};
struct EpiSwiglu {
    static constexpr bool PERM = true, AFTER_DRAIN = false;
    bf16_t* H; const stat_t* ss; float kscale;
    __device__ __forceinline__ void operator()(const f32x4 (&acc)[2][2][4][2], const Unit& u, int wr, int wc, int fr, int fq) const {
        const int ln_ = fresh_lane(); fr = ln_ & 15; fq = ln_ >> 4;
        float rs[8];
#pragma unroll
        for (int q = 0; q < 8; ++q) rs[q] = ss_dec(ss[EPI_ROW(u, q >> 2, wr, q & 3, fr)]);
#pragma unroll
        for (int ai = 0; ai < 2; ++ai)
#pragma unroll
            for (int m = 0; m < 4; ++m) {
                const int row = EPI_ROW(u, ai, wr, m, fr);
                const float rstd = fast_rsq(rs[ai * 4 + m] * (1.0f / D_MODEL) + EPS) * kscale;
                typedef float f32x2 __attribute__((ext_vector_type(2)));
                const float cexp = -LOG2E_ * rstd, r2 = rstd * rstd;
                unsigned wv4[4];
#pragma unroll
                for (int n = 0; n < 2; ++n)
#pragma unroll
                    for (int hf = 0; hf < 2; ++hf) {
                        const f32x2 ag = {acc[ai][0][m][n][2 * hf], acc[ai][0][m][n][2 * hf + 1]}, au = {acc[ai][1][m][n][2 * hf], acc[ai][1][m][n][2 * hf + 1]};
                        f32x2 e = ag * cexp; e.x = __builtin_amdgcn_exp2f(e.x); e.y = __builtin_amdgcn_exp2f(e.y);
                        f32x2 d = e + 1.0f; d.x = __builtin_amdgcn_rcpf(d.x); d.y = __builtin_amdgcn_rcpf(d.y);
                        const f32x2 hh = ((ag * au) * r2) * d;
                        wv4[2 * n + hf] = cvt_pk_bf16(hh.x, hh.y);
                    }
                const u32x4 g = {wv4[0], wv4[1], wv4[2], wv4[3]};
                *(u32x4*)(H + (size_t)row * D_FF + u.pn * 128 + wc * 32 + 8 * fq) = g;
            }
    }
};
struct EpiStore {
    static constexpr bool PERM = true, AFTER_DRAIN = false;
    bf16_t* O;
    __device__ __forceinline__ void operator()(const f32x4 (&acc)[2][2][4][2], const Unit& u, int wr, int wc, int fr, int fq) const {
        const int ln_ = fresh_lane(); fr = ln_ & 15; fq = ln_ >> 4;
#pragma unroll
        for (int q = 0; q < 8; ++q) {
            const int ai = q >> 2, m = q & 3, row = EPI_ROW(u, ai, wr, m, fr);
#pragma unroll
            for (int bj = 0; bj < 2; ++bj) {
                float v[8]; unpack8s(acc[ai][bj][m][0], acc[ai][bj][m][1], 1.0f, v);
                *(u32x4*)(O + (size_t)row * D_MODEL + u.pn * 256 + bj * 128 + wc * 32 + 8 * fq) = pack8(v);
            }
        }
    }
};
struct EpiNormRes {
    static constexpr bool PERM = true, AFTER_DRAIN = false;
    bf16_t* XB; const float* w; stat_t* ssT; stat_t* ss_out; unsigned* tmo;
    __device__ __forceinline__ void operator()(const f32x4 (&acc)[2][2][4][2], const Unit& u, int wr, int wc, int fr, int fq) const {
        const int ln_ = fresh_lane(); fr = ln_ & 15; fq = ln_ >> 4;
        const int col0 = u.pn * 256 + wc * 32 + 8 * fq;
        float s[8];
#pragma unroll
        for (int q = 0; q < 8; ++q) {
            const int ai = q >> 2, m = q & 3; float sq = 0.f;
#pragma unroll
            for (int bj = 0; bj < 2; ++bj)
#pragma unroll
                for (int n = 0; n < 2; ++n) { const f32x4 v = acc[ai][bj][m][n]; sq += (v[0] * v[0] + v[1] * v[1]) + (v[2] * v[2] + v[3] * v[3]); }
            s[q] = sq;
        }
#pragma unroll
        for (int q = 0; q < 8; ++q) s[q] += shx(s[q], 16, ln_);
#pragma unroll
        for (int q = 0; q < 8; ++q) s[q] += shx(s[q], 32, ln_);
        if (fq == 0) {
#pragma unroll
            for (int q = 0; q < 8; ++q) atomicAdd(ssT + EPI_ROW(u, q >> 2, wr, q & 3, fr), (ss_enc(s[q]) << 8) | 1ull);
        }
        float wv[2][8]; ld8f(w + col0, wv[0]); ld8f(w + col0 + 128, wv[1]);
        u32x4 xr[4][2];
#pragma unroll
        for (int m = 0; m < 4; ++m)
#pragma unroll
            for (int bj = 0; bj < 2; ++bj) xr[m][bj] = *(const u32x4*)(XB + (size_t)EPI_ROW(u, 0, wr, m, fr) * D_MODEL + col0 + bj * 128);
        float rs[8];
        {
            stat_t v[8]; unsigned sp = 0;
            for (;;) {
                bool ok = true;
#pragma unroll
                for (int q = 0; q < 8; ++q) { v[q] = __hip_atomic_load(ssT + EPI_ROW(u, q >> 2, wr, q & 3, fr), __ATOMIC_RELAXED, __HIP_MEMORY_SCOPE_AGENT); ok = ok && ((unsigned)v[q] & 255u) == 16u; }
                if (__all(ok)) break;
                __builtin_amdgcn_s_sleep(1);
                if (++sp > (1u << 22)) { if (ln_ == 0) __hip_atomic_store(tmo, 1u, __ATOMIC_RELAXED, __HIP_MEMORY_SCOPE_AGENT); break; }
            }
#pragma unroll
            for (int q = 0; q < 8; ++q) rs[q] = ss_dec(v[q] >> 8);
        }
        float so[8];
#pragma unroll
        for (int ai = 0; ai < 2; ++ai) {
            if (ai == 1) {
#pragma unroll
                for (int m = 0; m < 4; ++m)
#pragma unroll
                    for (int bj = 0; bj < 2; ++bj) xr[m][bj] = *(const u32x4*)(XB + (size_t)EPI_ROW(u, 1, wr, m, fr) * D_MODEL + col0 + bj * 128);
            }
#pragma unroll
            for (int m = 0; m < 4; ++m) {
                const float rstd = fast_rsq(rs[ai * 4 + m] * (1.0f / D_MODEL) + EPS);
                float sq = 0.f;
#pragma unroll
                for (int bj = 0; bj < 2; ++bj) {
                    float t[8], xv[8]; unpack8s(acc[ai][bj][m][0], acc[ai][bj][m][1], rstd, t); unpack_bf8(xr[m][bj], xv);
#pragma unroll
                    for (int j = 0; j < 8; ++j) { xv[j] += t[j] * wv[bj][j]; sq += xv[j] * xv[j]; }
                    *(u32x4*)(XB + (size_t)EPI_ROW(u, ai, wr, m, fr) * D_MODEL + col0 + bj * 128) = pack8(xv);
                }
                so[ai * 4 + m] = sq;
            }
        }
        if (ss_out) {
#pragma unroll
            for (int q = 0; q < 8; ++q) so[q] += shx(so[q], 16, ln_);
#pragma unroll
            for (int q = 0; q < 8; ++q) so[q] += shx(so[q], 32, ln_);
            if (fq == 0) {
#pragma unroll
                for (int q = 0; q < 8; ++q) atomicAdd(ss_out + EPI_ROW(u, q >> 2, wr, q & 3, fr), ss_enc(so[q]));
            }
        }
    }
};
struct EpiStat {
    static constexpr bool PERM = true, AFTER_DRAIN = false;
    bf16_t* O; stat_t* ss;
    __device__ __forceinline__ void operator()(const f32x4 (&acc)[2][2][4][2], const Unit& u, int wr, int wc, int fr, int fq) const {
        const int ln_ = fresh_lane(); fr = ln_ & 15; fq = ln_ >> 4;
        float s[8];
#pragma unroll
        for (int q = 0; q < 8; ++q) {
            const int ai = q >> 2, m = q & 3, row = EPI_ROW(u, ai, wr, m, fr);
            float sq = 0.f;
#pragma unroll
            for (int bj = 0; bj < 2; ++bj) {
                float v[8]; unpack8s(acc[ai][bj][m][0], acc[ai][bj][m][1], 1.0f, v);
#pragma unroll
                for (int j = 0; j < 8; ++j) sq += v[j] * v[j];
                *(u32x4*)(O + (size_t)row * D_MODEL + u.pn * 256 + bj * 128 + wc * 32 + 8 * fq) = pack8(v);
            }
            s[q] = sq;
        }
#pragma unroll
        for (int q = 0; q < 8; ++q) s[q] += shx(s[q], 16, ln_);
#pragma unroll
        for (int q = 0; q < 8; ++q) s[q] += shx(s[q], 32, ln_);
        if (fq == 0) {
#pragma unroll
            for (int q = 0; q < 8; ++q) atomicAdd(ss + EPI_ROW(u, q >> 2, wr, q & 3, fr), ss_enc(s[q]));
        }
    }
};
struct EpiPle {
    static constexpr bool PERM = true, AFTER_DRAIN = false;
    const bf16_t* XBc; const bf16_t* PP; const stat_t* ss_pp; const float* wple; bf16_t* XBn; stat_t* ss_next; float* xout;
    __device__ __forceinline__ void operator()(const f32x4 (&acc)[2][2][4][2], const Unit& u, int wr, int wc, int fr, int fq) const {
        typedef float f32x2 __attribute__((ext_vector_type(2)));
        const int ln_ = fresh_lane(); fr = ln_ & 15; fq = ln_ >> 4;
        const int col0 = u.pn * 256 + wc * 32 + 8 * fq;
        float rp[8], s[8], w[2][8];
        ld8f(wple + col0, w[0]); ld8f(wple + col0 + 128, w[1]);
#pragma unroll
        for (int q = 0; q < 8; ++q) rp[q] = ss_dec(ss_pp[EPI_ROW(u, q >> 2, wr, q & 3, fr)]);
#pragma unroll
        for (int q = 0; q < 8; ++q) s[q] = 0.f;
        u32x4 xr[2][2], pr[2][2];
#define PLE_LOAD(b_, set_) do { _Pragma("unroll") for (int mm = 0; mm < 2; ++mm) { const size_t off_ = (size_t)EPI_ROW(u, (b_) >> 2, wr, 2 * ((b_) & 1) + mm, fr) * D_MODEL + col0 + (((b_) >> 1) & 1) * 128; \
            xr[set_][mm] = *(const u32x4*)(XBc + off_); pr[set_][mm] = *(const u32x4*)(PP + off_); } } while (0)
        PLE_LOAD(0, 0);
#pragma unroll
        for (int b = 0; b < 8; ++b) {
            const int ai = b >> 2, bj = (b >> 1) & 1, set = b & 1;
            if (b + 1 < 8) PLE_LOAD(b + 1, (b + 1) & 1);
#pragma unroll
            for (int mm = 0; mm < 2; ++mm) {
                const int m = 2 * (b & 1) + mm;
                const float rpp = fast_rsq(rp[ai * 4 + m] * (1.0f / D_MODEL) + EPS);
                const size_t off = (size_t)EPI_ROW(u, ai, wr, m, fr) * D_MODEL + col0 + bj * 128;
                const unsigned xw[4] = {xr[set][mm].x, xr[set][mm].y, xr[set][mm].z, xr[set][mm].w}, pw[4] = {pr[set][mm].x, pr[set][mm].y, pr[set][mm].z, pr[set][mm].w};
                f32x2 sq2 = {0.f, 0.f}; f32x2 xo[4];
#pragma unroll
                for (int k = 0; k < 4; ++k) {
                    const f32x2 g = {acc[ai][bj][m][k >> 1][2 * (k & 1)], acc[ai][bj][m][k >> 1][2 * (k & 1) + 1]};
                    f32x2 xv = {__uint_as_float(xw[k] << 16), __uint_as_float(xw[k] & 0xffff0000u)}; const f32x2 pv = {__uint_as_float(pw[k] << 16), __uint_as_float(pw[k] & 0xffff0000u)};
                    f32x2 e = g * (-LOG2E_); e.x = __builtin_amdgcn_exp2f(e.x); e.y = __builtin_amdgcn_exp2f(e.y);
                    f32x2 d = e + 1.0f; d.x = __builtin_amdgcn_rcpf(d.x); d.y = __builtin_amdgcn_rcpf(d.y);
                    const f32x2 wk = {w[bj][2 * k], w[bj][2 * k + 1]};
                    xv = xv + d * ((pv * wk) * rpp); sq2 = sq2 + xv * xv; xo[k] = xv;
                }
                if (XBn) { u32x4 o; o.x = cvt_pk_bf16(xo[0].x, xo[0].y); o.y = cvt_pk_bf16(xo[1].x, xo[1].y); o.z = cvt_pk_bf16(xo[2].x, xo[2].y); o.w = cvt_pk_bf16(xo[3].x, xo[3].y); *(u32x4*)(XBn + off) = o; }
                if (xout) { *(f32x4*)(xout + off) = (f32x4){xo[0].x, xo[0].y, xo[1].x, xo[1].y}; *(f32x4*)(xout + off + 4) = (f32x4){xo[2].x, xo[2].y, xo[3].x, xo[3].y}; }
                s[ai * 4 + m] += sq2.x + sq2.y;
            }
        }
#undef PLE_LOAD
        if (ss_next) {
#pragma unroll
            for (int q = 0; q < 8; ++q) s[q] += shx(s[q], 16, ln_);
#pragma unroll
            for (int q = 0; q < 8; ++q) s[q] += shx(s[q], 32, ln_);
            if (fq == 0) {
#pragma unroll
                for (int q = 0; q < 8; ++q) atomicAdd(ss_next + EPI_ROW(u, q >> 2, wr, q & 3, fr), ss_enc(s[q]));
            }
        }
    }
};

__device__ __forceinline__ void ew_rows(bf16_t* XB, const bf16_t* T, const float* w, stat_t* ss_out, int gw, int NGW, int lane) {
    const int hl = lane & 31, hr = lane >> 5;
    float wv[4][8];
#pragma unroll
    for (int j = 0; j < 4; ++j) ld8f(w + 8 * hl + 256 * j, wv[j]);
#pragma unroll 2
    for (int r2 = gw; r2 < M / 2; r2 += NGW) {
        const int row = 2 * r2 + hr; const size_t base = (size_t)row * D_MODEL + 8 * hl;
        u32x4 xr[4], tr[4];
#pragma unroll
        for (int j = 0; j < 4; ++j) { xr[j] = *(const u32x4*)(XB + base + 256 * j); tr[j] = *(const u32x4*)(T + base + 256 * j); }
        float tv[4][8]; float st = 0.f;
#pragma unroll
        for (int j = 0; j < 4; ++j) { unpack_bf8(tr[j], tv[j]);
#pragma unroll
            for (int k = 0; k < 8; ++k) st += tv[j][k] * tv[j][k]; }
#pragma unroll
        for (int o = 1; o < 32; o <<= 1) st += shx(st, o, lane);
        const float rT = fast_rsq(st * (1.0f / D_MODEL) + EPS);
        float s = 0.f;
#pragma unroll
        for (int j = 0; j < 4; ++j) {
            float xv[8]; unpack_bf8(xr[j], xv);
#pragma unroll
            for (int k = 0; k < 8; ++k) { xv[k] += tv[j][k] * rT * wv[j][k]; s += xv[k] * xv[k]; }
            *(u32x4*)(XB + base + 256 * j) = pack8(xv);
        }
        if (ss_out) {
#pragma unroll
            for (int o = 1; o < 32; o <<= 1) s += shx(s, o, lane);
            if (hl == 0) ss_out[row] = ss_enc(s);
        }
    }
}
__device__ __forceinline__ void xprep_rows(const float* x, bf16_t* XB, stat_t* ss_out, int gw, int NGW, int lane) {
    const int hl = lane & 31, hr = lane >> 5;
#pragma unroll 2
    for (int r2 = gw; r2 < M / 2; r2 += NGW) {
        const int row = 2 * r2 + hr; const size_t base = (size_t)row * D_MODEL + 8 * hl;
        float xv[4][8];
#pragma unroll
        for (int j = 0; j < 4; ++j) ld8f(x + base + 256 * j, xv[j]);
        float s = 0.f;
#pragma unroll
        for (int j = 0; j < 4; ++j) {
#pragma unroll
            for (int k = 0; k < 8; ++k) s += xv[j][k] * xv[j][k];
            *(u32x4*)(XB + base + 256 * j) = pack8(xv[j]);
        }
#pragma unroll
        for (int o = 1; o < 32; o <<= 1) s += shx(s, o, lane);
        if (hl == 0) ss_out[row] = ss_enc(s);
    }
}

__device__ __forceinline__ void tr_item(const float* W, int ldw, int K, int sc, const float* gain, bf16_t* WT, int rho0, int k0, LAS float* scr, int lane) {
#pragma unroll 8
    for (int i = 0; i < 32; ++i) {
        const int kk = 2 * i + (lane >> 5);
        float v = sc >= 0 ? W[(size_t)(k0 + kk) * ldw + sc + (lane & 31)] : 0.f;
        if (gain) v *= gain[k0 + kk];
        scr[kk * 33 + (lane & 31)] = v;
    }
    asm volatile("s_waitcnt lgkmcnt(0)" ::: "memory");
    const int c = lane & 7;
#pragma unroll
    for (int j = 0; j < 4; ++j) {
        const int n = (lane >> 3) + 8 * j; const LAS float* s = scr + (8 * c) * 33 + n;
        u32x4 o; o.x = cvt_pk_bf16(s[0 * 33], s[1 * 33]); o.y = cvt_pk_bf16(s[2 * 33], s[3 * 33]); o.z = cvt_pk_bf16(s[4 * 33], s[5 * 33]); o.w = cvt_pk_bf16(s[6 * 33], s[7 * 33]);
        *(u32x4*)(WT + (size_t)(rho0 + n) * K + k0 + 8 * c) = o;
    }
    asm volatile("s_waitcnt lgkmcnt(0)" ::: "memory");
}

struct Args { const float* in[19]; float* out; unsigned char* ws; int ph_lo, ph_hi, li, pad; };

typedef const __attribute__((address_space(4))) Args* KArgs;
__device__ __forceinline__ KArgs kargs() { KArgs p = (KArgs)__builtin_amdgcn_kernarg_segment_ptr(); asm volatile("" : "+s"(p)); return p; }


__device__ __forceinline__ void prologue(KArgs ap, LAS unsigned char* lds, int gw, int NGW, int wave, int lane) {
    unsigned char* ws = ap->ws;
    LAS float* scr = (LAS float*)(lds + wave * 16384);
    for (int L = 0; L < DEPTH; ++L) {
        unsigned char* wl = ws + WS_W + (size_t)L * W_LAYER;
        constexpr int I0 = 16 * 88, I1 = 16 * 32, I2 = 16 * 176, I3 = 44 * 32, I4 = 16 * 32, I5 = 4 * 32, IT = I0 + I1 + I2 + I3 + I4 + I5;
        for (int it = gw; it < IT; it += NGW) {
            int r = it;
            if (r < I0) { const int nb = r % 88, kb = r / 88, pn = nb >> 3, bj = (nb >> 2) & 1, wc = nb & 3, hs = 4 * pn + wc;
                tr_item(ap->in[3] + (size_t)L * D_MODEL * IN_W, IN_W, 1024, hs < NHEADS ? hs * 64 + 32 * bj : -1, ap->in[2] + L * D_MODEL, (bf16_t*)(wl + W_IN), nb * 32, kb * 64, scr, lane); continue; } r -= I0;
            if (r < I1) { const int nb = r % 32, kb = r / 32;
                tr_item(ap->in[10] + (size_t)L * D_MODEL * D_MODEL, D_MODEL, 1024, nb * 32, nullptr, (bf16_t*)(wl + W_OUT), nb * 32, kb * 64, scr, lane); continue; } r -= I1;
            if (r < I2) { const int nb = r % 176, kb = r / 176, pn = nb >> 3, bj = (nb >> 2) & 1, q = nb & 3;
                tr_item(ap->in[13] + (size_t)L * D_MODEL * 2 * D_FF, 2 * D_FF, 1024, bj * D_FF + 128 * pn + 32 * q, ap->in[12] + L * D_MODEL, (bf16_t*)(wl + W_FFI), nb * 32, kb * 64, scr, lane); continue; } r -= I2;
            if (r < I3) { const int nb = r % 32, kb = r / 32;
                tr_item(ap->in[14] + (size_t)L * D_FF * D_MODEL, D_MODEL, D_FF, nb * 32, nullptr, (bf16_t*)(wl + W_FFO), nb * 32, kb * 64, scr, lane); continue; } r -= I3;
            if (r < I4) { const int nb = r % 32, kb = r / 32;
                tr_item(ap->in[16] + (size_t)L * D_MODEL * D_MODEL, D_MODEL, 1024, nb * 32, nullptr, (bf16_t*)(wl + W_G), nb * 32, kb * 64, scr, lane); continue; } r -= I4;
            { const int nb = r % 32, kb = r / 32;
                tr_item(ap->in[17] + (size_t)L * PLE_DIM * D_MODEL, D_MODEL, PLE_DIM, nb * 32, nullptr, (bf16_t*)(wl + W_P), nb * 32, kb * 64, scr, lane); }
        }
    }
    {
        float* tab = (float*)(ws + WS_TAB);
        for (int i = gw * 64 + lane; i < 2048 * 32; i += NGW * 64) {
            { const int pos = i >> 5, j = i & 31; const double rev = (double)pos * c_inv_ret[j] * 0.15915494309189535; const float fr = (float)(rev - floor(rev));
              tab[TAB_RC + i] = __builtin_amdgcn_cosf(fr); tab[TAB_RS + i] = __builtin_amdgcn_sinf(fr); }
            if (i < 2048 * 8) { const int pos = i >> 3, j = i & 7; const double rev = (double)pos * c_inv_swa[j] * 0.15915494309189535; const float fr = (float)(rev - floor(rev));
              tab[TAB_SC + i] = __builtin_amdgcn_cosf(fr); tab[TAB_SS + i] = __builtin_amdgcn_sinf(fr); }
        }
    }
    {
        const float* p = ap->in[1]; bf16_t* PB = (bf16_t*)(ws + WS_PB);
        const size_t n8 = (size_t)DEPTH * M * PLE_DIM / 8;
        for (size_t i = (size_t)gw * 64 + lane; i < n8; i += (size_t)NGW * 64) {
            float v[8]; ld8f(p + i * 8, v); *(u32x4*)(PB + i * 8) = pack8(v);
        }
    }
    {
        const float* wsrc = ap->in[6]; bf16_t* Wm = (bf16_t*)(ws + WS_WM);
        for (int i = gw * 64 + lane; i < DEPTH * 4 * CHUNK * CHUNK; i += NGW * 64) { const int s_ = i & 127, t_ = (i >> 7) & 127; Wm[i] = f2bf(s_ <= t_ ? wsrc[i] : 0.f); }
    }
    xprep_rows(ap->in[0], (bf16_t*)(ws + WS_XB0), stat_ptr(ws, 0, ST_X1), gw, NGW, lane);
}

typedef float f32x16 __attribute__((ext_vector_type(16)));
typedef short s16x4 __attribute__((ext_vector_type(4)));
using pg8::bf16x8;
constexpr int TS = 144;
constexpr float LOG2E = 1.4426950408889634f;
__device__ __forceinline__ int crow(int r, int hi) { return (r & 3) + 8 * (r >> 2) + 4 * hi; }
__device__ __forceinline__ s16x4 tr16(LAS const unsigned char* p) { return __builtin_bit_cast(s16x4, __builtin_amdgcn_ds_read_tr16_b64_v4i16((LAS s16x4*)p)); }
__device__ __forceinline__ bf16x8 rd_row(LAS const unsigned char* tile, int row0, int k0, int lane) {
    return *(LAS const bf16x8*)(tile + (row0 + (lane & 31)) * TS + (k0 + 8 * (lane >> 5)) * 2);
}
template <bool PERMK> __device__ __forceinline__ bf16x8 rd_tr(LAS const unsigned char* tile, int k0, int n0, int lane) {
    const int h = lane >> 5, g1 = (lane >> 4) & 1, q = (lane & 15) >> 2, p = lane & 3;
    const int rA = k0 + (PERMK ? 4 * h : 8 * h) + q, rB = rA + (PERMK ? 8 : 4);
    const int cb = (n0 + 16 * g1 + 4 * p) * 2;
    const s16x4 lo = tr16(tile + rA * TS + cb), hi = tr16(tile + rB * TS + cb);
    return (bf16x8){lo[0], lo[1], lo[2], lo[3], hi[0], hi[1], hi[2], hi[3]};
}
__device__ __forceinline__ bf16x8 pack_frag(const f32x16& v, int s) {
    u32x4 w; w.x = cvt_pk_bf16(v[8 * s + 0], v[8 * s + 1]); w.y = cvt_pk_bf16(v[8 * s + 2], v[8 * s + 3]); w.z = cvt_pk_bf16(v[8 * s + 4], v[8 * s + 5]); w.w = cvt_pk_bf16(v[8 * s + 6], v[8 * s + 7]);
    return __builtin_bit_cast(bf16x8, w);
}
#define MFMA32(a, b, c) __builtin_amdgcn_mfma_f32_32x32x16_bf16((a), (b), (c), 0, 0, 0)
template <bool SCALE> __device__ __forceinline__ void load_tile(LAS unsigned char* tile, const bf16_t* g, int rows, int zero_below, float sl, int tid) {
    for (int i = tid; i < rows * 8; i += NTHREADS) {
        const int r = i >> 3, c = i & 7;
        u32x4 v = (u32x4){0u, 0u, 0u, 0u};
        if (r >= zero_below) v = *(const u32x4*)(g + (ptrdiff_t)r * IN_W + c * 8);
        if (SCALE) { float f[8]; unpack_bf8(v, f); const float s = exp2f((float)r * sl);
#pragma unroll
            for (int j = 0; j < 8; ++j) f[j] *= s;
            v = pack8(f); }
        *(LAS u32x4*)(tile + r * TS + c * 16) = v;
    }
}

constexpr int GM_BUF = 2 * CHUNK * TS;
struct GmRegs { u32x4 r[4]; };
__device__ __forceinline__ void gm_load(GmRegs& R, const bf16_t* P, int item, int tid) {
    const int h = item & 3, bc = item >> 2; const size_t row0 = (size_t)bc * CHUNK;
    const int r = tid >> 3, c = tid & 7;
#pragma unroll
    for (int i = 0; i < 2; ++i) {
        R.r[i] = *(const u32x4*)(P + (row0 + r + 64 * i) * IN_W + (H_AU + h) * 64 + c * 8);
        R.r[2 + i] = *(const u32x4*)(P + (row0 + r + 64 * i) * IN_W + (H_AV + h) * 64 + c * 8);
    }
}
__device__ __forceinline__ void gm_write(const GmRegs& R, LAS unsigned char* buf, int tid) {
    const int r = tid >> 3, c = tid & 7;
#pragma unroll
    for (int i = 0; i < 2; ++i) { *(LAS u32x4*)(buf + (r + 64 * i) * TS + c * 16) = R.r[i]; *(LAS u32x4*)(buf + CHUNK * TS + (r + 64 * i) * TS + c * 16) = R.r[2 + i]; }
}
__device__ __forceinline__ void gm_compute(LAS unsigned char* buf, const bf16_t* Wm, const float* bs, bf16_t* Y, int item, int tid, int wave, int lane, volatile LAS unsigned* slotp, unsigned fut) {
    const int h = item & 3, bc = item >> 2; const size_t row0 = (size_t)bc * CHUNK;
    LAS unsigned char* AUs = buf; LAS unsigned char* AVs = buf + CHUNK * TS;
    const int tb = wave >> 1, db = wave & 1, hh = lane >> 5;
    f32x16 acc = {};
    const bf16_t* wrow = Wm + (size_t)(h * CHUNK + 32 * tb + (lane & 31)) * CHUNK + 8 * hh;
    for (int ks = 0; ks < 2 * (tb + 1); ++ks) {
        const bf16x8 a = *(const bf16x8*)(wrow + 16 * ks);
        const bf16x8 b = rd_tr<false>(AVs, 16 * ks, 32 * db, lane);
        acc = MFMA32(a, b, acc);
    }
    const int d = 32 * db + (lane & 31);
#pragma unroll
    for (int r = 0; r < 16; ++r) {
        const int t = 32 * tb + crow(r, hh);
        LAS bf16_t* pu = (LAS bf16_t*)(AUs + t * TS) + d;
        *pu = f2bf(bf2f(*pu) * (acc[r] + bs[h * CHUNK + t]));
    }
    if (tid == 0) *slotp = fut;
    __syncthreads();
    for (int i = tid; i < CHUNK * 8; i += NTHREADS) { const int r = i >> 3, c = i & 7; *(u32x4*)(Y + (row0 + r) * D_MODEL + h * 64 + c * 8) = *(LAS const u32x4*)(AUs + r * TS + c * 16); }
}

constexpr int SWA_K = 0, SWA_V = 384 * TS, SWA_WSF = 2 * 384 * TS, SWA_OST = SWA_WSF + NWAVES * 128, SWA_END = SWA_OST + NWAVES * 4096;
struct SwaRegs { u32x4 k[6], v[6]; };
__device__ __forceinline__ void swa_load(SwaRegs& R, const bf16_t* P, int item, int tid) {
    const int hk = item & 1, cp = (item >> 1) & 7, b = item >> 4;
    const ptrdiff_t rowk0 = (ptrdiff_t)b * SEQ + 256 * cp - 128;
    const int r0 = tid >> 3, c = tid & 7;
#pragma unroll
    for (int i = 0; i < 6; ++i) {
        const int r = r0 + 64 * i;
        if (cp == 0 && r < 128) { R.k[i] = (u32x4){0u, 0u, 0u, 0u}; R.v[i] = (u32x4){0u, 0u, 0u, 0u}; }
        else { R.k[i] = *(const u32x4*)(P + (rowk0 + r) * IN_W + (H_CK + hk) * 64 + c * 8); R.v[i] = *(const u32x4*)(P + (rowk0 + r) * IN_W + (H_CV + hk) * 64 + c * 8); }
    }
}
__device__ __forceinline__ void swa_write(const SwaRegs& R, LAS unsigned char* lds, int tid) {
    const int r0 = tid >> 3, c = tid & 7;
#pragma unroll
    for (int i = 0; i < 6; ++i) { *(LAS u32x4*)(lds + SWA_K + (r0 + 64 * i) * TS + c * 16) = R.k[i]; *(LAS u32x4*)(lds + SWA_V + (r0 + 64 * i) * TS + c * 16) = R.v[i]; }
}
__device__ __forceinline__ void swa_compute(LAS unsigned char* lds, const bf16_t* P, const float* sinks, bf16_t* Y, int item, int wave, int lane) {
    const int hk = item & 1, cp = (item >> 1) & 7, b = item >> 4;
    const size_t rowq0 = (size_t)b * SEQ + 256 * cp;
    LAS unsigned char* Ks = lds + SWA_K; LAS unsigned char* Vs = lds + SWA_V;
    const int qi = lane & 31, hh = lane >> 5;
    LAS float* wsf = (LAS float*)(lds + SWA_WSF + wave * 128);
    LAS unsigned char* ost = lds + SWA_OST + wave * 4096;
    constexpr float SC = 0.125f * LOG2E;
    for (int g = 0; g < 3; ++g) {
        const int qh = 3 * hk + g;
        const bf16_t* qrow = P + (rowq0 + 32 * wave + qi) * IN_W + (H_CQ + qh) * 64 + 8 * hh;
        bf16x8 bq[4];
#pragma unroll
        for (int kd = 0; kd < 4; ++kd) bq[kd] = *(const bf16x8*)(qrow + 16 * kd);
        f32x16 S[5];
#pragma unroll
        for (int kb = 0; kb < 5; ++kb) {
            S[kb] = (f32x16){};
#pragma unroll
            for (int kd = 0; kd < 4; ++kd) S[kb] = MFMA32(rd_row(Ks, 32 * (wave + kb), 16 * kd, lane), bq[kd], S[kb]);
        }
        const float sk = sinks[qh] * LOG2E;
        float m = sk;
#pragma unroll
        for (int kb = 0; kb < 5; ++kb) {
            const bool blk_ok = cp > 0 || wave + kb >= 4;
#pragma unroll
            for (int r = 0; r < 16; ++r) {
                const int cr = crow(r, hh);
                bool ok = blk_ok;
                if (kb == 0) ok = ok && cr > qi;
                if (kb == 4) ok = ok && cr <= qi;
                const float s = ok ? S[kb][r] * SC : -1e30f;
                S[kb][r] = s; m = fmaxf(m, s);
            }
        }
        m = fmaxf(m, shx(m, 32, lane));
        float l = 0.f;
#pragma unroll
        for (int kb = 0; kb < 5; ++kb)
#pragma unroll
            for (int r = 0; r < 16; ++r) { const float p = __builtin_amdgcn_exp2f(S[kb][r] - m); S[kb][r] = p; l += p; }
        l += shx(l, 32, lane);
        l += __builtin_amdgcn_exp2f(sk - m);
        f32x16 O[2]; O[0] = (f32x16){}; O[1] = (f32x16){};
#pragma unroll
        for (int kb = 0; kb < 5; ++kb)
#pragma unroll
            for (int s2 = 0; s2 < 2; ++s2) {
                const bf16x8 a = pack_frag(S[kb], s2);
#pragma unroll
                for (int db = 0; db < 2; ++db) O[db] = MFMA32(a, rd_tr<true>(Vs, 32 * (wave + kb) + 16 * s2, 32 * db, lane), O[db]);
            }
        if (hh == 0) wsf[qi] = __builtin_amdgcn_rcpf(l);
        asm volatile("s_waitcnt lgkmcnt(0)" ::: "memory");
#pragma unroll
        for (int r = 0; r < 16; ++r) {
            const int q = crow(r, hh); const float rl = wsf[q];
#pragma unroll
            for (int db = 0; db < 2; ++db) *((LAS bf16_t*)(ost + q * 128) + 32 * db + qi) = f2bf(O[db][r] * rl);
        }
        asm volatile("s_waitcnt lgkmcnt(0)" ::: "memory");
#pragma unroll
        for (int i = 0; i < 4; ++i) { const int row = i * 8 + (lane >> 3), ch = lane & 7;
            *(u32x4*)(Y + (rowq0 + 32 * wave + row) * D_MODEL + 640 + qh * 64 + ch * 8) = *(LAS const u32x4*)(ost + row * 128 + ch * 16); }
        asm volatile("s_waitcnt lgkmcnt(0)" ::: "memory");
    }
}

constexpr int RT_Q = 0, RT_K = CHUNK * TS, RT_V = 2 * CHUNK * TS, RT_S = 3 * CHUNK * TS, RT_O = RT_S + 64 * TS, RT_X = RT_O + CHUNK * 68 * 4, RT_END = RT_X + 16384;
struct RetRegs { u32x4 q[2], k[2], v[2], g[2]; };
__device__ __forceinline__ void ret_load(RetRegs& R, const bf16_t* P, size_t row0, int h, int tid) {
    const int r0 = tid >> 3, c = tid & 7;
#pragma unroll
    for (int i = 0; i < 2; ++i) {
        const bf16_t* pr = P + (row0 + r0 + 64 * i) * IN_W + c * 8;
        R.q[i] = *(const u32x4*)(pr + (H_BQ + h) * 64); R.k[i] = *(const u32x4*)(pr + (H_BK + h) * 64); R.v[i] = *(const u32x4*)(pr + (H_BV + h) * 64);
    }
    const int row = tid >> 2, part = tid & 3;
    const bf16_t* gp = P + (row0 + row) * IN_W + (H_BG + h) * 64 + 16 * part;
    R.g[0] = *(const u32x4*)gp; R.g[1] = *(const u32x4*)(gp + 8);
}
typedef float f32x2m __attribute__((ext_vector_type(2)));
__device__ __forceinline__ u32x4 scale_bf8(const u32x4& r, float sc) {
    const unsigned w[4] = {r.x, r.y, r.z, r.w}; unsigned o[4];
#pragma unroll
    for (int k = 0; k < 4; ++k) { f32x2m v = {__uint_as_float(w[k] << 16), __uint_as_float(w[k] & 0xffff0000u)}; v = v * sc; o[k] = cvt_pk_bf16(v.x, v.y); }
    return (u32x4){o[0], o[1], o[2], o[3]};
}
__device__ __forceinline__ void ret_write(const RetRegs& R, LAS unsigned char* lds, const float (&sq)[2], const float (&sk)[2], int tid) {
    const int r0 = tid >> 3, c = tid & 7;
#pragma unroll
    for (int i = 0; i < 2; ++i) {
        const int r = r0 + 64 * i;
        *(LAS u32x4*)(lds + RT_Q + r * TS + c * 16) = scale_bf8(R.q[i], sq[i]);
        *(LAS u32x4*)(lds + RT_K + r * TS + c * 16) = scale_bf8(R.k[i], sk[i]);
        *(LAS u32x4*)(lds + RT_V + r * TS + c * 16) = R.v[i];
    }
}
__device__ __forceinline__ void ret_item(LAS unsigned char* lds, const bf16_t* P, const float* gn_w, bf16_t* Y, int item, int tid, int wave, int lane, volatile LAS unsigned* slotp, unsigned fut) {
    const int h = item % 6, b = item / 6;
    const float lg = c_log2g[h];
    const float g1 = exp2f(lg), g127 = exp2f(127.f * lg), g128 = exp2f(128.f * lg);
    LAS unsigned char* Qs = lds + RT_Q; LAS unsigned char* Ks = lds + RT_K; LAS unsigned char* Vs = lds + RT_V; LAS unsigned char* Sb = lds + RT_S;
    LAS float* Os = (LAS float*)(lds + RT_O); LAS float* Xs = (LAS float*)(lds + RT_X);
    const int tb = wave >> 1, eb = wave & 1, qi = lane & 31, hh = lane >> 5;
    const int db = (wave >> 1) & 1, kh = wave >> 2;
    const int erow = tid >> 2, part = tid & 3;
    float gw0[8], gw1[8]; ld8f(gn_w + h * 64 + 16 * part, gw0); ld8f(gn_w + h * 64 + 16 * part + 8, gw1);
    f32x16 st = {};
    float sq[2], sk[2];
#pragma unroll
    for (int i = 0; i < 2; ++i) { const float r = (float)((tid >> 3) + 64 * i); sq[i] = exp2f(r * lg); sk[i] = exp2f(-r * lg); }
    RetRegs R; ret_load(R, P, (size_t)b * SEQ, h, tid);
    for (int c = 0; c < 16; ++c) {
        const size_t row0 = (size_t)b * SEQ + (size_t)c * CHUNK;
        ret_write(R, lds, sq, sk, tid);
        const u32x4 gq0 = R.g[0], gq1 = R.g[1];
        __syncthreads();
        if (c + 1 < 16) ret_load(R, P, row0 + CHUNK, h, tid);
        f32x16 O = {};
        for (int sb = 0; sb <= tb; ++sb) {
            f32x16 S = {};
#pragma unroll
            for (int kd = 0; kd < 4; ++kd) S = MFMA32(rd_row(Ks, 32 * sb, 16 * kd, lane), rd_row(Qs, 32 * tb, 16 * kd, lane), S);
            if (sb == tb) {
#pragma unroll
                for (int r = 0; r < 16; ++r) S[r] = crow(r, hh) <= qi ? S[r] : 0.f;
            }
#pragma unroll
            for (int s2 = 0; s2 < 2; ++s2) O = MFMA32(pack_frag(S, s2), rd_tr<true>(Vs, 32 * sb + 16 * s2, 32 * eb, lane), O);
        }
        if (c > 0) {
#pragma unroll
            for (int kd = 0; kd < 4; ++kd) O = MFMA32(rd_row(Qs, 32 * tb, 16 * kd, lane), rd_row(Sb, 32 * eb, 16 * kd, lane), O);
        }
#pragma unroll
        for (int r = 0; r < 16; ++r) Os[(32 * tb + crow(r, hh)) * 68 + 32 * eb + qi] = O[r];
        if (c + 1 < 16) {
            f32x16 acc = {};
#pragma unroll
            for (int ks = 0; ks < 4; ++ks) acc = MFMA32(rd_tr<false>(Vs, 64 * kh + 16 * ks, 32 * eb, lane), rd_tr<false>(Ks, 64 * kh + 16 * ks, 32 * db, lane), acc);
#pragma unroll
            for (int r = 0; r < 16; ++r) st[r] = st[r] * g128 + g127 * acc[r];
            if (kh == 1) {
#pragma unroll
                for (int r = 0; r < 16; ++r) Xs[((eb * 2 + db) * 16 + r) * 64 + lane] = st[r];
            }
        }
        __syncthreads();
        if (c + 1 < 16 && kh == 0) {
#pragma unroll
            for (int r = 0; r < 16; ++r) { const int e = 32 * eb + crow(r, hh), d = 32 * db + qi; const float sv = (st[r] + Xs[((eb * 2 + db) * 16 + r) * 64 + lane]) * g1; *((LAS bf16_t*)(Sb + e * TS) + d) = (bf16_t)cvt_pk_bf16(sv, sv); }
        }
        {
            float v[16]; float s = 0.f;
#pragma unroll
            for (int j = 0; j < 16; ++j) { v[j] = Os[erow * 68 + 16 * part + j]; s += v[j]; }
            s += shx(s, 1, lane); s += shx(s, 2, lane);
            const float mu = s * (1.0f / 64.0f); float q = 0.f;
#pragma unroll
            for (int j = 0; j < 16; ++j) { v[j] -= mu; q += v[j] * v[j]; }
            q += shx(q, 1, lane); q += shx(q, 2, lane);
            const float rs = fast_rsq(q * (1.0f / 64.0f) + EPS);
            float ga[8], gb[8], o0[8], o1[8];
            unpack_bf8(gq0, ga); unpack_bf8(gq1, gb);
#pragma unroll
            for (int j = 0; j < 8; ++j) { o0[j] = (ga[j] * gw0[j]) * (v[j] * rs); o1[j] = (gb[j] * gw1[j]) * (v[8 + j] * rs); }
            bf16_t* yp = Y + (row0 + erow) * D_MODEL + 256 + h * 64 + 16 * part;
            *(u32x4*)yp = pack8(o0); *(u32x4*)(yp + 8) = pack8(o1);
        }
    }
    if (tid == 0) *slotp = fut;
    __syncthreads();
}

constexpr int CW_TMO = 1024;
constexpr int CW_QUEUE = 2048;
constexpr int MQ_RET = 192, MQ_SWA = MQ_RET + 512, MQ_ALL = MQ_SWA + 2048;
__device__ __forceinline__ void mixers(KArgs ap, int L, LAS unsigned char* lds, int tid, int wave, int lane) {
    unsigned char* ws = ap->ws;
    const bf16_t* P = (const bf16_t*)(ws + WS_BIG); bf16_t* Y = (bf16_t*)(ws + WS_Y);
    const bf16_t* Wm = (const bf16_t*)(ws + WS_WM) + (size_t)L * 4 * CHUNK * CHUNK;
    const float* gbs = ap->in[7] + L * 4 * CHUNK; const float* gn_w = ap->in[8] + L * 384; const float* sinks = ap->in[9] + L * 6;
    unsigned* head = (unsigned*)ws + CW_QUEUE + 64 * L;
    volatile LAS unsigned* slot = (volatile LAS unsigned*)(lds + MISC_OFF + 64);
    if (tid == 0) slot[0] = atomicAdd(head, 1u);
    __syncthreads();
    unsigned cur = (unsigned)__builtin_amdgcn_readfirstlane((int)slot[0]);
    __syncthreads();
    if (tid == 0) slot[1] = atomicAdd(head, 1u);
    __syncthreads();
    unsigned nxt = (unsigned)__builtin_amdgcn_readfirstlane((int)slot[1]);
    int k = 0;
#define MQ_FETCH() unsigned fut = 0u; if (tid == 0) fut = atomicAdd(head, 1u)
#define MQ_ADVANCE() do { cur = nxt; nxt = (unsigned)__builtin_amdgcn_readfirstlane((int)slot[k]); k ^= 1; } while (0)
    while (cur < (unsigned)MQ_ALL) {
        if (cur < (unsigned)MQ_RET) {
            MQ_FETCH();
            ret_item(lds, P, gn_w, Y, (int)cur, tid, wave, lane, slot + k, fut);
            MQ_ADVANCE();
        } else if (cur < (unsigned)MQ_SWA) {
            MQ_FETCH();
            { SwaRegs R; swa_load(R, P, (int)cur - MQ_RET, tid); swa_write(R, lds, tid); }
            __syncthreads();
            swa_compute(lds, P, sinks, Y, (int)cur - MQ_RET, wave, lane);
            if (tid == 0) slot[k] = fut;
            __syncthreads();
            MQ_ADVANCE();
        } else {
            GmRegs R; gm_load(R, P, (int)cur - MQ_SWA, tid);
            int bsel = 0;
            for (;;) {
                MQ_FETCH();
                LAS unsigned char* buf = lds + bsel * GM_BUF;
                gm_write(R, buf, tid);
                __syncthreads();
                const bool more = nxt < (unsigned)MQ_ALL;
                if (more) gm_load(R, P, (int)nxt - MQ_SWA, tid);
                gm_compute(buf, Wm, gbs, Y, (int)cur - MQ_SWA, tid, wave, lane, slot + k, fut);
                MQ_ADVANCE(); bsel ^= 1;
                if (!more) break;
            }
            __syncthreads();
        }
    }
#undef MQ_FETCH
#undef MQ_ADVANCE
    __syncthreads();
}

#ifndef PG8_SP2
#define PG8_SP2 true
#endif
#ifndef PG8_ALIGN
#define PG8_ALIGN true
#endif
constexpr int N_PHASES = 1 + 8 * DEPTH;
#ifndef PHMASK
#define PHMASK 0x1ff
#endif
#ifndef DUP_MASK
#define DUP_MASK 0
#endif
#define NREP(bit) ((DUP_MASK & (bit)) ? 2 : 1)
#ifndef KREP3
#define KREP3 1
#endif
__global__ void __launch_bounds__(NTHREADS, 2) mega(Args a_) {
    extern __shared__ __attribute__((aligned(16))) unsigned char lds_raw[];
    LAS unsigned char* lds = (LAS unsigned char*)lds_raw;
    const int G = gridDim.x, bid = blockIdx.x;
    const int vcu = (G % 8 == 0) ? (bid % 8) * (G / 8) + bid / 8 : bid;
    const int NGW = G * NWAVES;
    const int wave0 = __builtin_amdgcn_readfirstlane((int)threadIdx.x >> 6);
#define opq_tid() pg8::pg8_tid(wave0)
    { const int tid = opq_tid(); for (int u = tid; u < (LDS_BYTES - RING_BYTES) / 4; u += NTHREADS) ((LAS unsigned*)(lds + RING_BYTES))[u] = 0u; }
    __syncthreads();
    XcdBarrier bar = xcd_barrier_post((unsigned*)kargs()->ws + CW_BAR + kargs()->li * XCD_BAR_WORDS, (volatile LAS unsigned*)(lds + MISC_OFF));
    const int lo = kargs()->ph_lo, hi = kargs()->ph_hi;
#define IN(k) (lo <= (k) && (k) < hi)
#define SEAM(k) do { if (IN(k) && IN((k) + 1)) xcd_barrier(bar, opq_tid()); } while (0)
#define LANE_VARS const int tid_ = opq_tid(), lane = tid_ & 63, wave = __builtin_amdgcn_readfirstlane(tid_ >> 6), gw = vcu * NWAVES + wave
    if (IN(0) && (PHMASK & 1)) for (int rep = 0; rep < NREP(1); ++rep) { LANE_VARS; prologue(kargs(), lds, gw, NGW, wave, lane); }
    SEAM(0);
#define OPQ(p) ({ auto _p = (p); asm volatile("" : "+s"(_p)); _p; })
    for (int L = 0; L < DEPTH; ++L) {
        const int p0 = 1 + 8 * L;
        if (IN(p0 + 0) && (PHMASK & 2)) for (int rep = 0; rep < NREP(2); ++rep) {
            KArgs ap = kargs(); unsigned char* wsp = ap->ws; const int Lp = OPQ(L);
            pg8::Gemm g{(const bf16_t*)(wsp + ((Lp & 1) ? WS_XB1 : WS_XB0)), (const bf16_t*)(wsp + WS_W + (size_t)Lp * W_LAYER + W_IN), M, 2816, 1024}; pg8::StaticOrder S; S.init(M, 2816, G, bid);
            EpiProj E{(bf16_t*)(wsp + WS_BIG), stat_ptr(wsp, Lp, ST_X1), ap->in[4] + Lp * 256, ap->in[5] + Lp * 256, (const float*)(wsp + WS_TAB)};
            pg8::gemm_phase<EpiProj, pg8::StaticOrder, PG8_ALIGN, PG8_SP2>(lds, g, S, E, wave0);
        }
        SEAM(p0 + 0);
        if (IN(p0 + 1) && (PHMASK & 4)) {
            LANE_VARS; (void)gw; mixers(kargs(), OPQ(L), lds, tid_, wave, lane);
        }
        SEAM(p0 + 1);
        if (IN(p0 + 2) && (PHMASK & 8)) {
            KArgs ap = kargs(); unsigned char* wsp = ap->ws; const int Lp = OPQ(L);
            pg8::Gemm g{(const bf16_t*)(wsp + WS_Y), (const bf16_t*)(wsp + WS_W + (size_t)Lp * W_LAYER + W_OUT), M, 1024, 1024}; pg8::StaticOrder S; S.init(M, 1024, G, bid);
            EpiNormRes E{(bf16_t*)(wsp + ((Lp & 1) ? WS_XB1 : WS_XB0)), ap->in[11] + Lp * D_MODEL, stat_ptr(wsp, Lp, ST_MIX), stat_ptr(wsp, Lp, ST_X2), (unsigned*)wsp + CW_TMO};
            pg8::gemm_phase<EpiNormRes, pg8::StaticOrder, PG8_ALIGN, PG8_SP2>(lds, g, S, E, wave0);
        }
        SEAM(p0 + 2);
        if (IN(p0 + 4) && (PHMASK & 32)) for (int rep = 0; rep < NREP(32); ++rep) {
            KArgs ap = kargs(); unsigned char* wsp = ap->ws; const int Lp = OPQ(L);
            pg8::Gemm g{(const bf16_t*)(wsp + ((Lp & 1) ? WS_XB1 : WS_XB0)), (const bf16_t*)(wsp + WS_W + (size_t)Lp * W_LAYER + W_FFI), M, 5632, 1024}; pg8::StaticOrder S; S.init(M, 5632, G, bid);
            EpiSwiglu E{(bf16_t*)(wsp + WS_BIG), stat_ptr(wsp, Lp, ST_X2), 1.0f / KREP3};
            pg8::gemm_phase<EpiSwiglu, pg8::StaticOrder, PG8_ALIGN, PG8_SP2, KREP3>(lds, g, S, E, wave0);
        }
        SEAM(p0 + 4);
        if (IN(p0 + 5) && (PHMASK & 64)) {
            { KArgs ap = kargs(); unsigned char* wsp = ap->ws; const int Lp = OPQ(L);
              pg8::Gemm g{(const bf16_t*)(wsp + WS_BIG), (const bf16_t*)(wsp + WS_W + (size_t)Lp * W_LAYER + W_FFO), M, 1024, D_FF}; pg8::StaticOrder S; S.init(M, 1024, G, bid);
              EpiNormRes E{(bf16_t*)(wsp + ((Lp & 1) ? WS_XB1 : WS_XB0)), ap->in[15] + Lp * D_MODEL, stat_ptr(wsp, Lp, ST_F), nullptr, (unsigned*)wsp + CW_TMO};
              pg8::gemm_phase<EpiNormRes, pg8::StaticOrder, PG8_ALIGN, PG8_SP2>(lds, g, S, E, wave0); }
            { KArgs ap = kargs(); unsigned char* wsp = ap->ws; const int Lp = OPQ(L);
              pg8::Gemm g{(const bf16_t*)(wsp + WS_PB) + (size_t)Lp * M * PLE_DIM, (const bf16_t*)(wsp + WS_W + (size_t)Lp * W_LAYER + W_P), M, 1024, PLE_DIM}; pg8::StaticOrder S; S.init(M, 1024, G, bid);
              EpiStat E{(bf16_t*)(wsp + WS_MIX), stat_ptr(wsp, Lp, ST_PP)};
              pg8::gemm_phase<EpiStat, pg8::StaticOrder, PG8_ALIGN, PG8_SP2>(lds, g, S, E, wave0); }
        }
        SEAM(p0 + 5);
        if (IN(p0 + 7) && (PHMASK & 256)) {
            KArgs ap = kargs(); unsigned char* wsp = ap->ws; const int Lp = OPQ(L);
            const bf16_t* XBc = (const bf16_t*)(wsp + ((Lp & 1) ? WS_XB1 : WS_XB0));
            pg8::Gemm g{XBc, (const bf16_t*)(wsp + WS_W + (size_t)Lp * W_LAYER + W_G), M, 1024, 1024}; pg8::StaticOrder S; S.init(M, 1024, G, bid);
            const bool last = (Lp == DEPTH - 1);
            EpiPle E{XBc, (const bf16_t*)(wsp + WS_MIX), stat_ptr(wsp, Lp, ST_PP), ap->in[18] + Lp * D_MODEL, last ? nullptr : (bf16_t*)(wsp + ((Lp & 1) ? WS_XB0 : WS_XB1)), last ? nullptr : stat_ptr(wsp, Lp + 1, ST_X1), last ? ap->out : nullptr};
            pg8::gemm_phase<EpiPle, pg8::StaticOrder, PG8_ALIGN, PG8_SP2>(lds, g, S, E, wave0);
        }
        SEAM(p0 + 7);
    }
#undef IN
#undef SEAM
#undef LANE_VARS
#undef opq_tid
}

extern "C" void kernel_launch(void* const* d_in, const int* in_sizes, int n_in, void* d_out, int out_size, void* d_ws, size_t ws_size, hipStream_t stream) {
    static int grid = 0;
    if (grid == 0) {
        if (n_in != 19 || out_size != M * D_MODEL || ws_size < WS_END) { fprintf(stderr, "kernel_launch: unexpected shapes (n_in %d out %d ws %zu)\n", n_in, out_size, ws_size); grid = -1; return; }
        int dev = 0, cus = 0, per_cu = 0;
        if (hipGetDevice(&dev) != hipSuccess || hipDeviceGetAttribute(&cus, hipDeviceAttributeMultiprocessorCount, dev) != hipSuccess) { grid = -1; return; }
        if (hipFuncSetAttribute((const void*)mega, hipFuncAttributeMaxDynamicSharedMemorySize, LDS_BYTES) != hipSuccess) { fprintf(stderr, "kernel_launch: hipFuncSetAttribute failed\n"); grid = -1; return; }
        if (hipOccupancyMaxActiveBlocksPerMultiprocessor(&per_cu, (const void*)mega, NTHREADS, LDS_BYTES) != hipSuccess || per_cu < 1) { fprintf(stderr, "kernel_launch: occupancy query says %d\n", per_cu); }
        (void)hipGetLastError();
        grid = cus >= 256 ? 256 : cus;
    }
    if (grid < 0) return;
    unsigned char* ws = (unsigned char*)d_ws;
    (void)hipMemsetAsync(ws + WS_CTL, 0, CTL_ZERO_BYTES, stream);
    Args a{};
    for (int i = 0; i < 19; ++i) a.in[i] = (const float*)d_in[i];
    a.out = (float*)d_out; a.ws = ws; a.li = 0; a.pad = 0;
    a.ph_lo = 0; a.ph_hi = N_PHASES;
    hipLaunchKernelGGL(mega, dim3(grid), dim3(NTHREADS), LDS_BYTES, stream, a);
}
```

```cpp
#include <hip/hip_runtime.h>
#include <stdint.h>
#include <stdio.h>

constexpr int D_MODEL = 1024, BATCH = 32, SEQ = 2048, DEPTH = 2, PLE_DIM = 256, HD = 64, CHUNK = 128;
constexpr int M = BATCH * SEQ;
constexpr int IN_W = 2688, D_FF = 2816, NHEADS = 42;
constexpr int H_AU = 0, H_AV = 4, H_BQ = 8, H_BK = 14, H_BV = 20, H_BG = 26, H_CQ = 32, H_CK = 38, H_CV = 40;
constexpr float EPS = 1e-6f;
typedef unsigned short bf16_t;

__device__ __forceinline__ float bf2f(bf16_t v) { return __uint_as_float(((unsigned)v) << 16); }
__device__ __forceinline__ bf16_t f2bf(float f) { unsigned u = __float_as_uint(f); return (bf16_t)((u + 0x7fffu + ((u >> 16) & 1u)) >> 16); }
__device__ __forceinline__ float shx(float v, int mask, int lane) { return __int_as_float(__builtin_amdgcn_ds_bpermute((lane ^ mask) << 2, __float_as_int(v))); }
__device__ __forceinline__ float wave_sum(float v) {
#pragma unroll
    for (int o = 1; o < 64; o <<= 1) v += __shfl_xor(v, o);
    return v;
}
constexpr float LOG2E_ = 1.4426950408889634f;

__constant__ double c_inv_ret[32] = {1.0, 0.7498942093324559, 0.5623413251903491, 0.4216965034285822, 0.31622776601683794, 0.23713737056616552, 0.1778279410038923, 0.1333521432163324, 0.1, 0.07498942093324558, 0.05623413251903491, 0.042169650342858224, 0.03162277660168379, 0.023713737056616554, 0.01778279410038923, 0.01333521432163324, 0.01, 0.007498942093324558, 0.005623413251903491, 0.004216965034285823, 0.0031622776601683794, 0.0023713737056616554, 0.0017782794100389228, 0.001333521432163324, 0.001, 0.0007498942093324559, 0.0005623413251903491, 0.00042169650342858224, 0.00031622776601683794, 0.00023713737056616554, 0.00017782794100389227, 0.0001333521432163324};
__constant__ double c_inv_swa[8] = {1.0, 0.19392274474868576, 0.03760603093086393, 0.007292664737217109, 0.001414213562373095, 0.0002742481756762073, 5.318295896944988e-05, 1.031338537721246e-05};
__constant__ float c_log2g[6] = {-0.04580368961312479f, -0.02272007650008353f, -0.011315313227834146f, -0.005646563141142063f, -0.0028205190623786626f, -0.0014095702546713536f};

constexpr size_t MiB = 1u << 20;
constexpr size_t WS_CTL = 0, CTL_ZERO_BYTES = 7 * MiB;
constexpr size_t WS_STAT = 1 * MiB;
constexpr size_t WS_TAB = 7 * MiB;
constexpr size_t WS_WM = 7 * MiB + 768 * 1024;
constexpr size_t WS_W = 8 * MiB;
constexpr size_t WS_XB0 = 64 * MiB;
constexpr size_t WS_BIG = 192 * MiB;
constexpr size_t WS_Y = 544 * MiB;
constexpr size_t WS_MIX = 672 * MiB;
constexpr size_t WS_XB1 = 800 * MiB;
constexpr size_t WS_PB = 928 * MiB;
constexpr size_t WS_END = 992 * MiB;
constexpr int TAB_RC = 0, TAB_RS = 2048 * 32, TAB_SC = 2 * 2048 * 32, TAB_SS = 2 * 2048 * 32 + 2048 * 8;


namespace pg8 {
#define PG8_LAS __attribute__((address_space(3)))
typedef unsigned short bf16_t;
typedef short bf16x8 __attribute__((ext_vector_type(8)));
typedef float f32x4 __attribute__((ext_vector_type(4)));
typedef unsigned u32x4 __attribute__((ext_vector_type(4)));
constexpr int BM = 256, BK = 64, HALF = 128, HTB = HALF * BK * 2  , STAGE_BYTES = 8 * HTB, NXCD = 8, WGM = 8;

__host__ __device__ __forceinline__ int lds_byte(int r, int c) { const int st = (r >> 4) * 2 + (c >> 5), rr = r & 15, cc = c & 31, ob = rr * 64 + cc * 2; return st * 1024 + (ob ^ (((ob >> 9) & 1) << 5)); }
__host__ __device__ __forceinline__ void stage_rc(int b, int& R, int& C) { const int st = b / 1024, sb = b % 1024, swz = sb ^ (((sb >> 9) & 1) << 5); R = (st >> 1) * 16 + swz / 64; C = (st & 1) * 32 + (swz % 64) / 2; }
__host__ __device__ __forceinline__ int perm32(int rho) { const int n = rho >> 4, i = rho & 15; return 8 * (i >> 2) + 4 * n + (i & 3); }

struct Unit { int pm, pn; };
struct Gemm { const bf16_t* A; const bf16_t* Bt; int M, N, K; };

struct StaticOrder {
    int nM, nN, nwg, G, c, wgm;
    __host__ __device__ void init(int M, int N, int G_, int c_) { nM = M / BM; nN = N / BM; nwg = nM * nN; G = G_; c = c_; wgm = nN >= 8 ? 4 : WGM; }
    __host__ __device__ bool next(int i, Unit& u) const {
        const long L = (long)i * G + c; if (L >= nwg) return false;
        int wgid = (int)L; { const int q = nwg / NXCD, r = nwg % NXCD, xcd = wgid % NXCD, off = wgid / NXCD; wgid = (xcd < r ? xcd * (q + 1) : r * (q + 1) + (xcd - r) * q) + off; }
        const int nig = wgm * nN, gid = wgid / nig, fm = gid * wgm, gsz = (nM - fm) < wgm ? (nM - fm) : wgm;
        u.pm = fm + ((wgid % nig) % gsz); u.pn = (wgid % nig) / gsz; return true;
    }
    __device__ __forceinline__ void a_ready(const Unit&) const {}
    __device__ __forceinline__ void done(const Unit&) const {}
};

typedef float f32x2_cv __attribute__((ext_vector_type(2))); typedef __bf16 bf16x2_cv __attribute__((ext_vector_type(2)));
__device__ __forceinline__ unsigned cvt_pk_bf16(float lo, float hi) { const f32x2_cv v = {lo, hi}; const bf16x2_cv b = __builtin_convertvector(v, bf16x2_cv); return __builtin_bit_cast(unsigned, b); }
__device__ __forceinline__ int pg8_tid(int wave0) {
    unsigned ones = ~0u; asm volatile("" : "+s"(ones));
    return wave0 * 64 + (int)__builtin_amdgcn_mbcnt_hi(ones, __builtin_amdgcn_mbcnt_lo(ones, 0u));
}
template <class Epi, class Sched, bool ALIGN_EPI = false, bool SP2 = false, int KREP = 1>
__device__ __forceinline__ void gemm_phase(PG8_LAS unsigned char* lds, const Gemm g, const Sched& S, const Epi& E, int wave0) {
    const int tid = pg8_tid(wave0);
    const int wid = __builtin_amdgcn_readfirstlane(tid >> 6), lane = tid & 63, wr = wid >> 2, wc = wid & 3, fr = lane & 15, fq = lane >> 4;
    const int K = g.K, nt = K / BK;
    unsigned voffA[2], voffB[2];
#pragma unroll
    for (int i = 0; i < 2; ++i) { int R, C; stage_rc(tid * 16 + i * 8192, R, C); const int Rb = Epi::PERM ? ((R & ~31) + perm32(R & 31)) : R;
        voffA[i] = (unsigned)(R * K + C) * 2u; voffB[i] = (unsigned)(Rb * K + C) * 2u; }
    const size_t kstep = (size_t)(BK * 2);
    const size_t hstep = (size_t)HALF * K * 2;
    const size_t tstep = 2 * hstep;
    const unsigned ldsw = (unsigned)wid * 1024u;
    const int aoff = lds_byte(wr * 64 + fr, fq * 8), boff = lds_byte(wc * 32 + fr, fq * 8);
#define PG8_SA(b, h) (((b) * 2 + (h)) * HTB)
#define PG8_SB(b, h) ((4 + (b) * 2 + (h)) * HTB)
#define PG8_STAGE(bufoff, gbase, voff) do { _Pragma("unroll") for (int _i = 0; _i < 2; ++_i) \
        __builtin_amdgcn_global_load_lds((const unsigned*)((const char*)(gbase) + (voff)[_i]), (PG8_LAS unsigned*)(lds + (bufoff) + ldsw + _i * 8192), 16, 0, 0); } while (0)
#define PG8_LDA(dst, b, h) do { _Pragma("unroll") for (int m = 0; m < 4; ++m) _Pragma("unroll") for (int k = 0; k < 2; ++k) dst[m][k] = *(const PG8_LAS bf16x8*)(lds + PG8_SA(b, h) + aoff + m * 2048 + k * 1024); } while (0)
#define PG8_LDB(dst, b, h) do { _Pragma("unroll") for (int n = 0; n < 2; ++n) _Pragma("unroll") for (int k = 0; k < 2; ++k) dst[n][k] = *(const PG8_LAS bf16x8*)(lds + PG8_SB(b, h) + boff + n * 2048 + k * 1024); } while (0)
#define PG8_MMA(ai, bj, At, Bt) do { __builtin_amdgcn_s_setprio(1); _Pragma("unroll") for (int m = 0; m < 4; ++m) _Pragma("unroll") for (int n = 0; n < 2; ++n) _Pragma("unroll") for (int k = 0; k < 2; ++k) \
        acc[ai][bj][m][n] = __builtin_amdgcn_mfma_f32_16x16x32_bf16(Bt[n][k], At[m][k], acc[ai][bj][m][n], 0, 0, 0); __builtin_amdgcn_s_setprio(0); } while (0)
#define PG8_WAIT_V(n) asm volatile("s_waitcnt vmcnt(" #n ")" ::: "memory")
#define PG8_WAIT_L(n) asm volatile("s_waitcnt lgkmcnt(" #n ")" ::: "memory")
#define PG8_BAR __builtin_amdgcn_s_barrier()
#define PG8_SCHED __builtin_amdgcn_sched_barrier(0)
    Unit cur, nxt; int ui = 0;
    if (!S.next(0, cur)) return;
    f32x4 acc[2][2][4][2];
#pragma unroll
    for (int a = 0; a < 2; ++a)
#pragma unroll
        for (int b = 0; b < 2; ++b)
#pragma unroll
            for (int m = 0; m < 4; ++m)
#pragma unroll
                for (int n = 0; n < 2; ++n) acc[a][b][m][n] = (f32x4){0.f, 0.f, 0.f, 0.f};
    bf16x8 At[4][2], B0[2][2], B1[2][2];
    const char* cA = (const char*)g.A + (size_t)cur.pm * tstep; const char* cB = (const char*)g.Bt + (size_t)cur.pn * tstep;
    S.a_ready(cur);
    if constexpr (SP2) {
        PG8_STAGE(PG8_SB(0, 0), cB, voffB); PG8_STAGE(PG8_SB(0, 1), cB + hstep, voffB); PG8_STAGE(PG8_SA(0, 0), cA, voffA); PG8_STAGE(PG8_SA(0, 1), cA + hstep, voffA);
        if (wr == 1) PG8_BAR;
        PG8_WAIT_V(2); PG8_BAR;
        PG8_STAGE(PG8_SB(1, 0), cB + kstep, voffB); PG8_STAGE(PG8_SA(1, 0), cA + kstep, voffA); PG8_STAGE(PG8_SB(1, 1), cB + hstep + kstep, voffB);
        PG8_WAIT_V(6); PG8_BAR;
    } else {
        PG8_STAGE(PG8_SB(0, 0), cB, voffB); PG8_STAGE(PG8_SA(0, 0), cA, voffA); PG8_STAGE(PG8_SB(0, 1), cB + hstep, voffB); PG8_STAGE(PG8_SA(0, 1), cA + hstep, voffA);
        if (wr == 1) PG8_BAR;
        PG8_WAIT_V(4); PG8_BAR;
        PG8_STAGE(PG8_SB(1, 0), cB + kstep, voffB); PG8_STAGE(PG8_SA(1, 0), cA + kstep, voffA); PG8_STAGE(PG8_SB(1, 1), cB + hstep + kstep, voffB);
        PG8_WAIT_V(6); PG8_BAR;
    }
    for (;;) {
        const bool has_next = S.next(ui + 1, nxt);
        const char* nA = has_next ? (const char*)g.A + (size_t)nxt.pm * tstep : cA; const char* nB = has_next ? (const char*)g.Bt + (size_t)nxt.pn * tstep : cB;
        for (int t = 0; t < nt * KREP; t += 2) {
            const bool last = (t == nt * KREP - 2);
            const int t1 = KREP > 1 ? (t + 1) % nt : t + 1, t2 = KREP > 1 ? (t + 2) % nt : t + 2;
            const char* a1 = cA + (size_t)t1 * kstep;
            const char* a2 = last ? nA : cA + (size_t)t2 * kstep; const char* b2 = last ? nB : cB + (size_t)t2 * kstep;
            const char* a3 = a2 + kstep; const char* b3 = b2 + kstep;
            if (last && has_next) S.a_ready(nxt);
            if constexpr (SP2) {
            PG8_LDB(B0, 0, 0); PG8_LDB(B1, 0, 1); PG8_SCHED; PG8_LDA(At, 0, 0); PG8_STAGE(PG8_SA(1, 1), a1 + hstep, voffA);
            PG8_WAIT_V(8); PG8_WAIT_L(0); PG8_BAR; PG8_MMA(0, 0, At, B0); PG8_MMA(0, 1, At, B1); PG8_BAR; PG8_SCHED;
            PG8_LDA(At, 0, 1); PG8_STAGE(PG8_SB(0, 0), b2, voffB); PG8_STAGE(PG8_SB(0, 1), b2 + hstep, voffB); PG8_STAGE(PG8_SA(0, 0), a2, voffA);
            PG8_WAIT_V(8); PG8_WAIT_L(0); PG8_BAR; PG8_MMA(1, 0, At, B0); PG8_MMA(1, 1, At, B1); PG8_BAR; PG8_SCHED;
            PG8_LDB(B0, 1, 0); PG8_LDB(B1, 1, 1); PG8_SCHED; PG8_LDA(At, 1, 0); PG8_STAGE(PG8_SA(0, 1), a2 + hstep, voffA);
            PG8_WAIT_V(8); PG8_WAIT_L(0); PG8_BAR; PG8_MMA(0, 0, At, B0); PG8_MMA(0, 1, At, B1); PG8_BAR; PG8_SCHED;
            PG8_LDA(At, 1, 1); PG8_STAGE(PG8_SB(1, 0), b3, voffB); PG8_STAGE(PG8_SB(1, 1), b3 + hstep, voffB); PG8_STAGE(PG8_SA(1, 0), a3, voffA);
            PG8_WAIT_V(8); PG8_WAIT_L(0); PG8_BAR; PG8_MMA(1, 0, At, B0); PG8_MMA(1, 1, At, B1); PG8_BAR; PG8_SCHED;
            } else {
            PG8_LDB(B0, 0, 0); PG8_SCHED; PG8_LDA(At, 0, 0); PG8_STAGE(PG8_SA(1, 1), a1 + hstep, voffA);
            PG8_WAIT_L(8); PG8_BAR; PG8_WAIT_L(0); PG8_MMA(0, 0, At, B0); PG8_BAR; PG8_SCHED;
            PG8_LDB(B1, 0, 1); PG8_STAGE(PG8_SB(0, 0), b2, voffB);
            PG8_BAR; PG8_WAIT_L(0); PG8_MMA(0, 1, At, B1); PG8_BAR;
            PG8_LDA(At, 0, 1); PG8_STAGE(PG8_SA(0, 0), a2, voffA);
            PG8_BAR; PG8_WAIT_L(0); PG8_MMA(1, 0, At, B0); PG8_BAR; PG8_SCHED;
            PG8_STAGE(PG8_SB(0, 1), b2 + hstep, voffB);
            PG8_WAIT_V(6); PG8_BAR; PG8_MMA(1, 1, At, B1); PG8_BAR;
            PG8_LDB(B0, 1, 0); PG8_SCHED; PG8_LDA(At, 1, 0); PG8_STAGE(PG8_SA(0, 1), a2 + hstep, voffA);
            PG8_WAIT_L(8); PG8_BAR; PG8_WAIT_L(0); PG8_MMA(0, 0, At, B0); PG8_BAR; PG8_SCHED;
            PG8_LDB(B1, 1, 1); PG8_STAGE(PG8_SB(1, 0), b3, voffB);
            PG8_BAR; PG8_WAIT_L(0); PG8_MMA(0, 1, At, B1); PG8_BAR;
            PG8_LDA(At, 1, 1); PG8_STAGE(PG8_SA(1, 0), a3, voffA);
            PG8_BAR; PG8_WAIT_L(0); PG8_MMA(1, 0, At, B0); PG8_BAR; PG8_SCHED;
            PG8_STAGE(PG8_SB(1, 1), b3 + hstep, voffB);
            PG8_WAIT_V(6); PG8_BAR; PG8_MMA(1, 1, At, B1); PG8_BAR;
            }
        }
        if constexpr (ALIGN_EPI) { if (wr == 0) PG8_BAR; }
        if constexpr (!Epi::AFTER_DRAIN) { E(acc, cur, wr, wc, fr, fq); S.done(cur); }
        if (!has_next) break;
#pragma unroll
        for (int a = 0; a < 2; ++a)
#pragma unroll
            for (int b = 0; b < 2; ++b)
#pragma unroll
                for (int m = 0; m < 4; ++m)
#pragma unroll
                    for (int n = 0; n < 2; ++n) acc[a][b][m][n] = (f32x4){0.f, 0.f, 0.f, 0.f};
        cur = nxt; cA = nA; cB = nB; ++ui;
        if constexpr (ALIGN_EPI) { if (wr == 1) PG8_BAR; }
    }
    PG8_WAIT_V(0);
    if constexpr (!ALIGN_EPI) { if (wr == 0) PG8_BAR; }
    PG8_BAR;
    if constexpr (Epi::AFTER_DRAIN) { E.fused(acc, cur, wr, wc, fr, fq, lds, wid, lane); S.done(cur); }
#undef PG8_SA
#undef PG8_SB
#undef PG8_STAGE
#undef PG8_LDA
#undef PG8_LDB
#undef PG8_MMA
#undef PG8_WAIT_V
#undef PG8_WAIT_L
#undef PG8_BAR
#undef PG8_SCHED
}
}

#define LAS __attribute__((address_space(3)))
#define GAS __attribute__((address_space(1)))
using pg8::f32x4; using pg8::u32x4; using pg8::Unit; using pg8::cvt_pk_bf16;
typedef unsigned u32x2 __attribute__((ext_vector_type(2)));
typedef GAS unsigned gu32;
#define RLX_AGENT __ATOMIC_RELAXED, __HIP_MEMORY_SCOPE_AGENT

constexpr int NWAVES = 8, NTHREADS = 512;
constexpr int LDS_BYTES = 163840;
constexpr int RING_BYTES = 147456, MISC_OFF = RING_BYTES + 320;
constexpr size_t W_IN = 0, W_OUT = W_IN + (size_t)2816 * 1024 * 2, W_FFI = W_OUT + (size_t)1024 * 1024 * 2, W_FFO = W_FFI + (size_t)5632 * 1024 * 2,
                 W_G = W_FFO + (size_t)1024 * 2816 * 2, W_P = W_G + (size_t)1024 * 1024 * 2, W_LAYER = W_P + (size_t)1024 * 256 * 2;
static_assert(WS_W + 2 * W_LAYER <= WS_XB0, "weights fit");
enum { ST_X1 = 0, ST_MIX = 1, ST_X2 = 2, ST_F = 3, ST_PP = 4, ST_N = 5 };
typedef unsigned long long stat_t;
__host__ __device__ __forceinline__ stat_t* stat_ptr(unsigned char* ws, int L, int idx) { return (stat_t*)(ws + WS_STAT) + (size_t)(L * ST_N + idx) * M; }
static_assert(WS_STAT + (size_t)2 * ST_N * M * 8 <= CTL_ZERO_BYTES && CTL_ZERO_BYTES <= WS_TAB, "stats inside the zeroed region");
__device__ __forceinline__ stat_t ss_enc(float s) { return (stat_t)(s * 16777216.0f); }
__device__ __forceinline__ float ss_dec(stat_t v) { return (float)v * (1.0f / 16777216.0f); }
constexpr int CW_BAR = 4096;

#define XB_TMO      128
#define XB_XCNT(j)  (256  + 64 * (j))
#define XB_XSUB(j)  (1280 + 64 * (j))
#define XB_XGEN(j)  (2304 + 64 * (j))
#define XB_TOP      3328
#define XB_TOPGEN   3392
#define XCD_BAR_WORDS 3456
#define XB_SPIN_CAP (1u << 22)
__device__ __forceinline__ unsigned xb_ld(unsigned* p)              { return __hip_atomic_load(p, __ATOMIC_RELAXED, __HIP_MEMORY_SCOPE_AGENT); }
__device__ __forceinline__ unsigned xb_add(unsigned* p, unsigned v) { return __hip_atomic_fetch_add(p, v, __ATOMIC_RELAXED, __HIP_MEMORY_SCOPE_AGENT); }
__device__ __forceinline__ unsigned xb_xcc_id() { return (unsigned)__builtin_amdgcn_s_getreg((3 << 11) | 20) & 0xFu; }
#define XB_SPIN(cond, bar) do { unsigned _sp = 0; while (cond) { __builtin_amdgcn_s_sleep(1); \
    if ((++_sp & 255u) == 0u) { if (xb_ld(&(bar)[XB_TMO])) break; if (_sp > XB_SPIN_CAP) { atomicAdd(&(bar)[XB_TMO], 1u); break; } } } } while (0)
struct XcdBarrier { unsigned* bar; unsigned x; volatile LAS unsigned* st; };
__device__ __forceinline__ XcdBarrier xcd_barrier_post(unsigned* bar, volatile LAS unsigned* st) {
    XcdBarrier b; b.bar = bar; b.x = xb_xcc_id(); b.st = st;
    if (threadIdx.x == 0) (void)xb_add(&bar[XB_XCNT(b.x)], 1u);
    return b;
}
__device__ __forceinline__ void xcd_barrier_complete(unsigned* bar, unsigned x, unsigned& nloc, unsigned& nx) {
    const unsigned G = gridDim.x * gridDim.y * gridDim.z;
    unsigned sum, cnt, mine, sp = 0u;
    for (;;) {
        sum = 0u; cnt = 0u; mine = 0u;
#pragma unroll
        for (unsigned j = 0; j < 16; ++j) { const unsigned c = xb_ld(&bar[XB_XCNT(j)]); sum += c; cnt += (c > 0u) ? 1u : 0u; mine = (j == x) ? c : mine; }
        if (sum == G) break;
        __builtin_amdgcn_s_sleep(1);
        if ((++sp & 255u) == 0u) { if (xb_ld(&bar[XB_TMO])) break; if (sp > XB_SPIN_CAP) { atomicAdd(&bar[XB_TMO], 1u); break; } }
    }
    nloc = mine > 0u ? mine : 1u; nx = cnt > 0u ? cnt : 1u;
}
__device__ __forceinline__ void xcd_barrier(const XcdBarrier& b, int tid) {
    asm volatile("s_waitcnt vmcnt(0)" ::: "memory");
    __syncthreads();
    if (tid == 0) {
        unsigned* bar = b.bar;
        __builtin_amdgcn_s_waitcnt(0);
        unsigned nloc = b.st[0], nx = b.st[1];
        if (nloc == 0u) { xcd_barrier_complete(bar, b.x, nloc, nx); b.st[0] = nloc; b.st[1] = nx; }
        const unsigned old = xb_add(&bar[XB_XSUB(b.x)], 1u);
        const unsigned gen = old / nloc;
        if (old + 1u == (gen + 1u) * nloc) {
            __builtin_amdgcn_fence(__ATOMIC_RELEASE, "agent");
            asm volatile("s_waitcnt vmcnt(0)" ::: "memory");
            const unsigned og = xb_add(&bar[XB_TOP], 1u);
            const unsigned tg = og / nx;
            if (og + 1u == (tg + 1u) * nx) xb_add(&bar[XB_TOPGEN], 1u);
            else XB_SPIN(xb_ld(&bar[XB_TOPGEN]) == tg, bar);
            __builtin_amdgcn_fence(__ATOMIC_ACQUIRE, "agent");
            xb_add(&bar[XB_XGEN(b.x)], 1u);
            asm volatile("s_waitcnt vmcnt(0)" ::: "memory");
        } else {
            XB_SPIN(xb_ld(&bar[XB_XGEN(b.x)]) == gen, bar);
            __builtin_amdgcn_fence(__ATOMIC_ACQUIRE, "agent");
            asm volatile("s_waitcnt vmcnt(0)" ::: "memory");
        }
    }
    __syncthreads();
}

__device__ __forceinline__ float fast_rsq(float x) { return __builtin_amdgcn_rsqf(x); }
__device__ __forceinline__ float sigm(float x) { return __builtin_amdgcn_rcpf(1.0f + __builtin_amdgcn_exp2f(-LOG2E_ * x)); }
__device__ __forceinline__ float gelu_t(float x) { return x * sigm(1.5957691216057308f * (x + 0.044715f * x * x * x)); }
__device__ __forceinline__ void unpack8s(const f32x4& v0, const f32x4& v1, float s, float (&o)[8]) {
    o[0] = v0[0] * s; o[1] = v0[1] * s; o[2] = v0[2] * s; o[3] = v0[3] * s; o[4] = v1[0] * s; o[5] = v1[1] * s; o[6] = v1[2] * s; o[7] = v1[3] * s;
}
__device__ __forceinline__ u32x4 pack8(const float (&o)[8]) {
    u32x4 w; w.x = cvt_pk_bf16(o[0], o[1]); w.y = cvt_pk_bf16(o[2], o[3]); w.z = cvt_pk_bf16(o[4], o[5]); w.w = cvt_pk_bf16(o[6], o[7]); return w;
}
__device__ __forceinline__ void ld8f(const float* p, float (&o)[8]) {
    const f32x4 a = *(const f32x4*)p, b = *(const f32x4*)(p + 4);
    o[0] = a[0]; o[1] = a[1]; o[2] = a[2]; o[3] = a[3]; o[4] = b[0]; o[5] = b[1]; o[6] = b[2]; o[7] = b[3];
}
__device__ __forceinline__ void unpack_bf8(const u32x4& r, float (&o)[8]) {
    o[0] = __uint_as_float(r.x << 16); o[1] = __uint_as_float(r.x & 0xffff0000u); o[2] = __uint_as_float(r.y << 16); o[3] = __uint_as_float(r.y & 0xffff0000u);
    o[4] = __uint_as_float(r.z << 16); o[5] = __uint_as_float(r.z & 0xffff0000u); o[6] = __uint_as_float(r.w << 16); o[7] = __uint_as_float(r.w & 0xffff0000u);
}
__device__ __forceinline__ int fresh_lane() { unsigned ones = ~0u; asm volatile("" : "+s"(ones)); return (int)__builtin_amdgcn_mbcnt_hi(ones, __builtin_amdgcn_mbcnt_lo(ones, 0u)); }
#define EPI_ROW(u, ai, wr, m, fr) ((u).pm * 256 + (ai) * 128 + (wr) * 64 + (m) * 16 + (fr))

enum { T_AU, T_AV, T_BQ, T_BK, T_BV, T_BG, T_CQ, T_CK, T_CV };
struct EpiProj {
    static constexpr bool PERM = true, AFTER_DRAIN = false;
    bf16_t* P; const stat_t* ss; const float* ln_w; const float* ln_b; const float* tab;
    template <int TYPE> __device__ __forceinline__ void rows(const f32x4 (&acc)[2][2][4][2], const Unit& u, int wr, int hs, int hrel, int fr, int fq) const {
        const int d0 = 8 * fq, ln_ = fr + 16 * fq;
        float rs[8];
#pragma unroll
        for (int q = 0; q < 8; ++q) rs[q] = ss_dec(ss[EPI_ROW(u, q >> 2, wr, q & 3, fr)]);
        float wa[8], wb[8], ba[8], bb[8];
        if constexpr (TYPE == T_AV) { ld8f(ln_w + hrel * 64 + d0, wa); ld8f(ln_w + hrel * 64 + 32 + d0, wb); ld8f(ln_b + hrel * 64 + d0, ba); ld8f(ln_b + hrel * 64 + 32 + d0, bb); }
#pragma unroll
        for (int hp = 0; hp < 4; ++hp) {
            const int ai = hp >> 1;
            float tc[2][8], tsn[2][8];
            if constexpr (TYPE == T_BQ || TYPE == T_BK) {
#pragma unroll
                for (int mm = 0; mm < 2; ++mm) { const int pos = EPI_ROW(u, ai, wr, 2 * (hp & 1) + mm, fr) & (SEQ - 1); ld8f(tab + TAB_RC + pos * 32 + d0, tc[mm]); ld8f(tab + TAB_RS + pos * 32 + d0, tsn[mm]); }
            }
            if constexpr (TYPE == T_CQ || TYPE == T_CK) {
#pragma unroll
                for (int mm = 0; mm < 2; ++mm) { const int pos = EPI_ROW(u, ai, wr, 2 * (hp & 1) + mm, fr) & (SEQ - 1); ld8f(tab + TAB_SC + pos * 8, tc[mm]); ld8f(tab + TAB_SS + pos * 8, tsn[mm]); }
            }
#pragma unroll
            for (int mm = 0; mm < 2; ++mm) {
                const int m = 2 * (hp & 1) + mm;
                const int row = EPI_ROW(u, ai, wr, m, fr);
                const float rstd = fast_rsq(rs[ai * 4 + m] * (1.0f / D_MODEL) + EPS);
                float a[8], b[8];
                unpack8s(acc[ai][0][m][0], acc[ai][0][m][1], rstd, a); unpack8s(acc[ai][1][m][0], acc[ai][1][m][1], rstd, b);
                if constexpr (TYPE == T_AU) {
#pragma unroll
                    for (int j = 0; j < 8; ++j) { a[j] = gelu_t(a[j]); b[j] = gelu_t(b[j]); }
                } else if constexpr (TYPE == T_AV) {
                    float sm = 0.f;
#pragma unroll
                    for (int j = 0; j < 8; ++j) { a[j] = gelu_t(a[j]); b[j] = gelu_t(b[j]); sm += a[j] + b[j]; }
                    sm += shx(sm, 16, ln_); sm += shx(sm, 32, ln_);
                    const float mu = sm * (1.0f / 64.0f); float q = 0.f;
#pragma unroll
                    for (int j = 0; j < 8; ++j) { a[j] -= mu; b[j] -= mu; q += a[j] * a[j] + b[j] * b[j]; }
                    q += shx(q, 16, ln_); q += shx(q, 32, ln_);
                    const float rsd = fast_rsq(q * (1.0f / 64.0f) + EPS);
#pragma unroll
                    for (int j = 0; j < 8; ++j) { a[j] = a[j] * rsd * wa[j] + ba[j]; b[j] = b[j] * rsd * wb[j] + bb[j]; }
                } else if constexpr (TYPE == T_BQ || TYPE == T_BK) {
                    const float tch = (float)(row & (CHUNK - 1)) * c_log2g[hrel];
                    const float sc = __builtin_amdgcn_exp2f(TYPE == T_BK ? -tch - 3.0f : tch);
#pragma unroll
                    for (int j = 0; j < 8; ++j) { const float x1 = a[j], x2 = b[j]; a[j] = (x1 * tc[mm][j] - x2 * tsn[mm][j]) * sc; b[j] = (x2 * tc[mm][j] + x1 * tsn[mm][j]) * sc; }
                } else if constexpr (TYPE == T_BG) {
#pragma unroll
                    for (int j = 0; j < 8; ++j) { a[j] = a[j] * sigm(a[j]); b[j] = b[j] * sigm(b[j]); }
                } else if constexpr (TYPE == T_CQ || TYPE == T_CK) {
                    float o[8];
#pragma unroll
                    for (int j = 0; j < 8; ++j) o[j] = shx(a[j], 16, ln_);
                    if (fq < 2) {
                        const float sg = fq == 0 ? -1.0f : 1.0f;
#pragma unroll
                        for (int j = 0; j < 8; ++j) a[j] = a[j] * tc[mm][j] + sg * o[j] * tsn[mm][j];
                    }
                }
                bf16_t* dst = P + (size_t)row * IN_W + hs * 64 + d0;
                *(u32x4*)dst = pack8(a); *(u32x4*)(dst + 32) = pack8(b);
            }
        }
    }
    __device__ __forceinline__ void operator()(const f32x4 (&acc)[2][2][4][2], const Unit& u, int wr, int wc, int fr, int fq) const {
        const int ln_ = fresh_lane(); fr = ln_ & 15; fq = ln_ >> 4;
        const int hs = u.pn * 4 + wc;
        if (hs >= NHEADS) return;
        if (hs < H_AV) rows<T_AU>(acc, u, wr, hs, hs - H_AU, fr, fq);
        else if (hs < H_BQ) rows<T_AV>(acc, u, wr, hs, hs - H_AV, fr, fq);
        else if (hs < H_BK) rows<T_BQ>(acc, u, wr, hs, hs - H_BQ, fr, fq);
        else if (hs < H_BV) rows<T_BK>(acc, u, wr, hs, hs - H_BK, fr, fq);
        else if (hs < H_BG) rows<T_BV>(acc, u, wr, hs, hs - H_BV, fr, fq);
        else if (hs < H_CQ) rows<T_BG>(acc, u, wr, hs, hs - H_BG, fr, fq);
        else if (hs < H_CK) rows<T_CQ>(acc, u, wr, hs, hs - H_CQ, fr, fq);
        else if (hs < H_CV) rows<T_CK>(acc, u, wr, hs, hs - H_CK, fr, fq);
        else rows<T_CV>(acc, u, wr, hs, hs - H_CV, fr, fq);
    }
};
struct EpiSwiglu {
    static constexpr bool PERM = true, AFTER_DRAIN = false;
    bf16_t* H; const stat_t* ss; float kscale;
    __device__ __forceinline__ void operator()(const f32x4 (&acc)[2][2][4][2], const Unit& u, int wr, int wc, int fr, int fq) const {
        const int ln_ = fresh_lane(); fr = ln_ & 15; fq = ln_ >> 4;
        float rs[8];
#pragma unroll
        for (int q = 0; q < 8; ++q) rs[q] = ss_dec(ss[EPI_ROW(u, q >> 2, wr, q & 3, fr)]);
#pragma unroll
        for (int ai = 0; ai < 2; ++ai)
#pragma unroll
            for (int m = 0; m < 4; ++m) {
                const int row = EPI_ROW(u, ai, wr, m, fr);
                const float rstd = fast_rsq(rs[ai * 4 + m] * (1.0f / D_MODEL) + EPS) * kscale;
                typedef float f32x2 __attribute__((ext_vector_type(2)));
                const float cexp = -LOG2E_ * rstd, r2 = rstd * rstd;
                unsigned wv4[4];
#pragma unroll
                for (int n = 0; n < 2; ++n)
#pragma unroll
                    for (int hf = 0; hf < 2; ++hf) {
                        const f32x2 ag = {acc[ai][0][m][n][2 * hf], acc[ai][0][m][n][2 * hf + 1]}, au = {acc[ai][1][m][n][2 * hf], acc[ai][1][m][n][2 * hf + 1]};
                        f32x2 e = ag * cexp; e.x = __builtin_amdgcn_exp2f(e.x); e.y = __builtin_amdgcn_exp2f(e.y);
                        f32x2 d = e + 1.0f; d.x = __builtin_amdgcn_rcpf(d.x); d.y = __builtin_amdgcn_rcpf(d.y);
                        const f32x2 hh = ((ag * au) * r2) * d;
                        wv4[2 * n + hf] = cvt_pk_bf16(hh.x, hh.y);
                    }
                const u32x4 g = {wv4[0], wv4[1], wv4[2], wv4[3]};
                *(u32x4*)(H + (size_t)row * D_FF + u.pn * 128 + wc * 32 + 8 * fq) = g;
            }
    }
};
struct EpiStore {
    static constexpr bool PERM = true, AFTER_DRAIN = false;
    bf16_t* O;
    __device__ __forceinline__ void operator()(const f32x4 (&acc)[2][2][4][2], const Unit& u, int wr, int wc, int fr, int fq) const {
        const int ln_ = fresh_lane(); fr = ln_ & 15; fq = ln_ >> 4;
#pragma unroll
        for (int q = 0; q < 8; ++q) {
            const int ai = q >> 2, m = q & 3, row = EPI_ROW(u, ai, wr, m, fr);
#pragma unroll
            for (int bj = 0; bj < 2; ++bj) {
                float v[8]; unpack8s(acc[ai][bj][m][0], acc[ai][bj][m][1], 1.0f, v);
                *(u32x4*)(O + (size_t)row * D_MODEL + u.pn * 256 + bj * 128 + wc * 32 + 8 * fq) = pack8(v);
            }
        }
    }
};
struct EpiNormRes {
    static constexpr bool PERM = true, AFTER_DRAIN = false;
    bf16_t* XB; const float* w; stat_t* ssT; stat_t* ss_out; unsigned* tmo;
    __device__ __forceinline__ void operator()(const f32x4 (&acc)[2][2][4][2], const Unit& u, int wr, int wc, int fr, int fq) const {
        const int ln_ = fresh_lane(); fr = ln_ & 15; fq = ln_ >> 4;
        const int col0 = u.pn * 256 + wc * 32 + 8 * fq;
        float s[8];
#pragma unroll
        for (int q = 0; q < 8; ++q) {
            const int ai = q >> 2, m = q & 3; float sq = 0.f;
#pragma unroll
            for (int bj = 0; bj < 2; ++bj)
#pragma unroll
                for (int n = 0; n < 2; ++n) { const f32x4 v = acc[ai][bj][m][n]; sq += (v[0] * v[0] + v[1] * v[1]) + (v[2] * v[2] + v[3] * v[3]); }
            s[q] = sq;
        }
#pragma unroll
        for (int q = 0; q < 8; ++q) s[q] += shx(s[q], 16, ln_);
#pragma unroll
        for (int q = 0; q < 8; ++q) s[q] += shx(s[q], 32, ln_);
        if (fq == 0) {
#pragma unroll
            for (int q = 0; q < 8; ++q) atomicAdd(ssT + EPI_ROW(u, q >> 2, wr, q & 3, fr), (ss_enc(s[q]) << 8) | 1ull);
        }
        float wv[2][8]; ld8f(w + col0, wv[0]); ld8f(w + col0 + 128, wv[1]);
        u32x4 xr[4][2];
#pragma unroll
        for (int m = 0; m < 4; ++m)
#pragma unroll
            for (int bj = 0; bj < 2; ++bj) xr[m][bj] = *(const u32x4*)(XB + (size_t)EPI_ROW(u, 0, wr, m, fr) * D_MODEL + col0 + bj * 128);
        float rs[8];
        {
            stat_t v[8]; unsigned sp = 0;
            for (;;) {
                bool ok = true;
#pragma unroll
                for (int q = 0; q < 8; ++q) { v[q] = __hip_atomic_load(ssT + EPI_ROW(u, q >> 2, wr, q & 3, fr), __ATOMIC_RELAXED, __HIP_MEMORY_SCOPE_AGENT); ok = ok && ((unsigned)v[q] & 255u) == 16u; }
                if (__all(ok)) break;
                __builtin_amdgcn_s_sleep(1);
                if (++sp > (1u << 22)) { if (ln_ == 0) __hip_atomic_store(tmo, 1u, __ATOMIC_RELAXED, __HIP_MEMORY_SCOPE_AGENT); break; }
            }
#pragma unroll
            for (int q = 0; q < 8; ++q) rs[q] = ss_dec(v[q] >> 8);
        }
        float so[8];
#pragma unroll
        for (int ai = 0; ai < 2; ++ai) {
            if (ai == 1) {
#pragma unroll
                for (int m = 0; m < 4; ++m)
#pragma unroll
                    for (int bj = 0; bj < 2; ++bj) xr[m][bj] = *(const u32x4*)(XB + (size_t)EPI_ROW(u, 1, wr, m, fr) * D_MODEL + col0 + bj * 128);
            }
#pragma unroll
            for (int m = 0; m < 4; ++m) {
                const float rstd = fast_rsq(rs[ai * 4 + m] * (1.0f / D_MODEL) + EPS);
                float sq = 0.f;
#pragma unroll
                for (int bj = 0; bj < 2; ++bj) {
                    float t[8], xv[8]; unpack8s(acc[ai][bj][m][0], acc[ai][bj][m][1], rstd, t); unpack_bf8(xr[m][bj], xv);
#pragma unroll
                    for (int j = 0; j < 8; ++j) { xv[j] += t[j] * wv[bj][j]; sq += xv[j] * xv[j]; }
                    *(u32x4*)(XB + (size_t)EPI_ROW(u, ai, wr, m, fr) * D_MODEL + col0 + bj * 128) = pack8(xv);
                }
                so[ai * 4 + m] = sq;
            }
        }
        if (ss_out) {
#pragma unroll
            for (int q = 0; q < 8; ++q) so[q] += shx(so[q], 16, ln_);
#pragma unroll
            for (int q = 0; q < 8; ++q) so[q] += shx(so[q], 32, ln_);
            if (fq == 0) {
#pragma unroll
                for (int q = 0; q < 8; ++q) atomicAdd(ss_out + EPI_ROW(u, q >> 2, wr, q & 3, fr), ss_enc(so[q]));
            }
        }
    }
};
struct EpiStat {
    static constexpr bool PERM = true, AFTER_DRAIN = false;
    bf16_t* O; stat_t* ss;
    __device__ __forceinline__ void operator()(const f32x4 (&acc)[2][2][4][2], const Unit& u, int wr, int wc, int fr, int fq) const {
        const int ln_ = fresh_lane(); fr = ln_ & 15; fq = ln_ >> 4;
        float s[8];
#pragma unroll
        for (int q = 0; q < 8; ++q) {
            const int ai = q >> 2, m = q & 3, row = EPI_ROW(u, ai, wr, m, fr);
            float sq = 0.f;
#pragma unroll
            for (int bj = 0; bj < 2; ++bj) {
                float v[8]; unpack8s(acc[ai][bj][m][0], acc[ai][bj][m][1], 1.0f, v);
#pragma unroll
                for (int j = 0; j < 8; ++j) sq += v[j] * v[j];
                *(u32x4*)(O + (size_t)row * D_MODEL + u.pn * 256 + bj * 128 + wc * 32 + 8 * fq) = pack8(v);
            }
            s[q] = sq;
        }
#pragma unroll
        for (int q = 0; q < 8; ++q) s[q] += shx(s[q], 16, ln_);
#pragma unroll
        for (int q = 0; q < 8; ++q) s[q] += shx(s[q], 32, ln_);
        if (fq == 0) {
#pragma unroll
            for (int q = 0; q < 8; ++q) atomicAdd(ss + EPI_ROW(u, q >> 2, wr, q & 3, fr), ss_enc(s[q]));
        }
    }
};
struct EpiPle {
    static constexpr bool PERM = true, AFTER_DRAIN = false;
    const bf16_t* XBc; const bf16_t* PP; const stat_t* ss_pp; const float* wple; bf16_t* XBn; stat_t* ss_next; float* xout;
    __device__ __forceinline__ void operator()(const f32x4 (&acc)[2][2][4][2], const Unit& u, int wr, int wc, int fr, int fq) const {
        typedef float f32x2 __attribute__((ext_vector_type(2)));
        const int ln_ = fresh_lane(); fr = ln_ & 15; fq = ln_ >> 4;
        const int col0 = u.pn * 256 + wc * 32 + 8 * fq;
        float rs[8];
        u32x4 wpk[2];
        { float w0[8], w1[8]; ld8f(wple + col0, w0); ld8f(wple + col0 + 128, w1); wpk[0] = pack8(w0); wpk[1] = pack8(w1); }
#pragma unroll
        for (int q = 0; q < 4; ++q) rs[q] = ss_dec(ss_pp[EPI_ROW(u, 0, wr, q, fr)]);
        u32x4 xr[3][2], pr[3][2];
#define PLE_LOAD(b_, set_) do { _Pragma("unroll") for (int mm = 0; mm < 2; ++mm) { const unsigned off_ = ((unsigned)EPI_ROW(u, (b_) >> 2, wr, 2 * (((b_) >> 1) & 1) + mm, fr) * D_MODEL + col0 + ((b_) & 1) * 128) * 2u; \
            xr[set_][mm] = *(const u32x4*)((const char*)XBc + off_); pr[set_][mm] = *(const u32x4*)((const char*)PP + off_); } } while (0)
        PLE_LOAD(0, 0); PLE_LOAD(1, 1);
        stat_t rawB[4];
#pragma unroll
        for (int q = 0; q < 4; ++q) rawB[q] = ss_pp[EPI_ROW(u, 1, wr, q, fr)];
        float rpp2[2] = {0.f, 0.f}, sacc[2] = {0.f, 0.f};
#pragma unroll
        for (int b = 0; b < 8; ++b) {
            const int ai = b >> 2, mp = (b >> 1) & 1, bj = b & 1, set = b % 3;
            if (b + 2 < 8) PLE_LOAD(b + 2, (b + 2) % 3);
            if (b == 2) {
#pragma unroll
                for (int q = 0; q < 4; ++q) rs[4 + q] = ss_dec(rawB[q]);
            }
            const unsigned wq[4] = {wpk[bj].x, wpk[bj].y, wpk[bj].z, wpk[bj].w};
#pragma unroll
            for (int mm = 0; mm < 2; ++mm) {
                const int m = 2 * mp + mm, q = ai * 4 + m;
                if (bj == 0) { rpp2[mm] = fast_rsq(rs[q] * (1.0f / D_MODEL) + EPS); sacc[mm] = 0.f; }
                const float rpp = rpp2[mm];
                const unsigned off = (unsigned)EPI_ROW(u, ai, wr, m, fr) * D_MODEL + col0 + bj * 128;
                const unsigned xw[4] = {xr[set][mm].x, xr[set][mm].y, xr[set][mm].z, xr[set][mm].w}, pw[4] = {pr[set][mm].x, pr[set][mm].y, pr[set][mm].z, pr[set][mm].w};
                f32x2 sq2 = {0.f, 0.f}; f32x2 xo[4];
#pragma unroll
                for (int k = 0; k < 4; ++k) {
                    const f32x2 g = {acc[ai][bj][m][k >> 1][2 * (k & 1)], acc[ai][bj][m][k >> 1][2 * (k & 1) + 1]};
                    f32x2 xv = {__uint_as_float(xw[k] << 16), __uint_as_float(xw[k] & 0xffff0000u)}; const f32x2 pv = {__uint_as_float(pw[k] << 16), __uint_as_float(pw[k] & 0xffff0000u)};
                    const f32x2 wk = {__uint_as_float(wq[k] << 16), __uint_as_float(wq[k] & 0xffff0000u)};
                    f32x2 e = g * (-LOG2E_); e.x = __builtin_amdgcn_exp2f(e.x); e.y = __builtin_amdgcn_exp2f(e.y);
                    f32x2 d = e + 1.0f; d.x = __builtin_amdgcn_rcpf(d.x); d.y = __builtin_amdgcn_rcpf(d.y);
                    xv = xv + d * ((pv * wk) * rpp); sq2 = sq2 + xv * xv; xo[k] = xv;
                }
                if (XBn) { u32x4 o; o.x = cvt_pk_bf16(xo[0].x, xo[0].y); o.y = cvt_pk_bf16(xo[1].x, xo[1].y); o.z = cvt_pk_bf16(xo[2].x, xo[2].y); o.w = cvt_pk_bf16(xo[3].x, xo[3].y); *(u32x4*)((char*)XBn + off * 2u) = o; }
                if (xout) { *(f32x4*)((char*)xout + off * 4u) = (f32x4){xo[0].x, xo[0].y, xo[1].x, xo[1].y}; *(f32x4*)((char*)xout + off * 4u + 16) = (f32x4){xo[2].x, xo[2].y, xo[3].x, xo[3].y}; }
                sacc[mm] += sq2.x + sq2.y;
                if (bj == 1) rs[q] = sacc[mm];
            }
        }
#undef PLE_LOAD
        if (ss_next) {
#pragma unroll
            for (int q = 0; q < 8; ++q) rs[q] += shx(rs[q], 16, ln_);
#pragma unroll
            for (int q = 0; q < 8; ++q) rs[q] += shx(rs[q], 32, ln_);
            if (fq == 0) {
#pragma unroll
                for (int q = 0; q < 8; ++q) atomicAdd(ss_next + EPI_ROW(u, q >> 2, wr, q & 3, fr), ss_enc(rs[q]));
            }
        }
    }
};

__device__ __forceinline__ void ew_rows(bf16_t* XB, const bf16_t* T, const float* w, stat_t* ss_out, int gw, int NGW, int lane) {
    const int hl = lane & 31, hr = lane >> 5;
    float wv[4][8];
#pragma unroll
    for (int j = 0; j < 4; ++j) ld8f(w + 8 * hl + 256 * j, wv[j]);
#pragma unroll 2
    for (int r2 = gw; r2 < M / 2; r2 += NGW) {
        const int row = 2 * r2 + hr; const size_t base = (size_t)row * D_MODEL + 8 * hl;
        u32x4 xr[4], tr[4];
#pragma unroll
        for (int j = 0; j < 4; ++j) { xr[j] = *(const u32x4*)(XB + base + 256 * j); tr[j] = *(const u32x4*)(T + base + 256 * j); }
        float tv[4][8]; float st = 0.f;
#pragma unroll
        for (int j = 0; j < 4; ++j) { unpack_bf8(tr[j], tv[j]);
#pragma unroll
            for (int k = 0; k < 8; ++k) st += tv[j][k] * tv[j][k]; }
#pragma unroll
        for (int o = 1; o < 32; o <<= 1) st += shx(st, o, lane);
        const float rT = fast_rsq(st * (1.0f / D_MODEL) + EPS);
        float s = 0.f;
#pragma unroll
        for (int j = 0; j < 4; ++j) {
            float xv[8]; unpack_bf8(xr[j], xv);
#pragma unroll
            for (int k = 0; k < 8; ++k) { xv[k] += tv[j][k] * rT * wv[j][k]; s += xv[k] * xv[k]; }
            *(u32x4*)(XB + base + 256 * j) = pack8(xv);
        }
        if (ss_out) {
#pragma unroll
            for (int o = 1; o < 32; o <<= 1) s += shx(s, o, lane);
            if (hl == 0) ss_out[row] = ss_enc(s);
        }
    }
}
__device__ __forceinline__ void xprep_rows(const float* x, bf16_t* XB, stat_t* ss_out, int gw, int NGW, int lane) {
    const int hl = lane & 31, hr = lane >> 5;
#pragma unroll 2
    for (int r2 = gw; r2 < M / 2; r2 += NGW) {
        const int row = 2 * r2 + hr; const size_t base = (size_t)row * D_MODEL + 8 * hl;
        float xv[4][8];
#pragma unroll
        for (int j = 0; j < 4; ++j) ld8f(x + base + 256 * j, xv[j]);
        float s = 0.f;
#pragma unroll
        for (int j = 0; j < 4; ++j) {
#pragma unroll
            for (int k = 0; k < 8; ++k) s += xv[j][k] * xv[j][k];
            *(u32x4*)(XB + base + 256 * j) = pack8(xv[j]);
        }
#pragma unroll
        for (int o = 1; o < 32; o <<= 1) s += shx(s, o, lane);
        if (hl == 0) ss_out[row] = ss_enc(s);
    }
}

struct TrDesc { const float* W; const float* gain; bf16_t* WT; int ldw, K, sc, rho0, k0; };
struct TrRegs { f32x4 v[8]; float g[8]; };
__device__ __forceinline__ void tr_load(const TrDesc& d, TrRegs& R, int lane) {
    const int q = lane & 7, r = lane >> 3;
#pragma unroll
    for (int i = 0; i < 8; ++i) {
        const int kk = d.k0 + 8 * i + r;
        R.v[i] = d.sc >= 0 ? *(const f32x4*)(d.W + (size_t)kk * d.ldw + d.sc + 4 * q) : (f32x4){0.f, 0.f, 0.f, 0.f};
        R.g[i] = d.gain ? d.gain[kk] : 1.0f;
    }
}
__device__ __forceinline__ void tr_store(const TrDesc& d, const TrRegs& R, LAS float* scr, int lane) {
    const int q = lane & 7, r = lane >> 3;
#pragma unroll
    for (int i = 0; i < 8; ++i) {
        LAS float* s = scr + (8 * i + r) * 33 + 4 * q;
        s[0] = R.v[i].x * R.g[i]; s[1] = R.v[i].y * R.g[i]; s[2] = R.v[i].z * R.g[i]; s[3] = R.v[i].w * R.g[i];
    }
    asm volatile("s_waitcnt lgkmcnt(0)" ::: "memory");
    const int c = lane & 7;
#pragma unroll
    for (int j = 0; j < 4; ++j) {
        const int n = (lane >> 3) + 8 * j; const LAS float* s = scr + (8 * c) * 33 + n;
        u32x4 o; o.x = cvt_pk_bf16(s[0 * 33], s[1 * 33]); o.y = cvt_pk_bf16(s[2 * 33], s[3 * 33]); o.z = cvt_pk_bf16(s[4 * 33], s[5 * 33]); o.w = cvt_pk_bf16(s[6 * 33], s[7 * 33]);
        *(u32x4*)(d.WT + (size_t)(d.rho0 + n) * d.K + d.k0 + 8 * c) = o;
    }
    asm volatile("s_waitcnt lgkmcnt(0)" ::: "memory");
}

struct Args { const float* in[19]; float* out; unsigned char* ws; int ph_lo, ph_hi, li, pad; };

typedef const __attribute__((address_space(4))) Args* KArgs;
__device__ __forceinline__ KArgs kargs() { KArgs p = (KArgs)__builtin_amdgcn_kernarg_segment_ptr(); asm volatile("" : "+s"(p)); return p; }


__device__ __forceinline__ void prologue(KArgs ap, LAS unsigned char* lds, int gw, int NGW, int wave, int lane) {
    unsigned char* ws = ap->ws;
    LAS float* scr = (LAS float*)(lds + wave * 16384);
    {
        constexpr int I0 = 16 * 88, I1 = 16 * 32, I2 = 16 * 176, I3 = 44 * 32, I4 = 16 * 32, I5 = 4 * 32, IT = I0 + I1 + I2 + I3 + I4 + I5;
        auto desc = [&](int it) -> TrDesc {
            const int L = it >= IT ? 1 : 0; int r = it - L * IT;
            unsigned char* wl = ws + WS_W + (size_t)L * W_LAYER;
            if (r < I0) { const int nb = r % 88, kb = r / 88, pn = nb >> 3, bj = (nb >> 2) & 1, wc = nb & 3, hs = 4 * pn + wc;
                return TrDesc{ap->in[3] + (size_t)L * D_MODEL * IN_W, ap->in[2] + L * D_MODEL, (bf16_t*)(wl + W_IN), IN_W, 1024, hs < NHEADS ? hs * 64 + 32 * bj : -1, nb * 32, kb * 64}; } r -= I0;
            if (r < I1) { const int nb = r % 32, kb = r / 32;
                return TrDesc{ap->in[10] + (size_t)L * D_MODEL * D_MODEL, nullptr, (bf16_t*)(wl + W_OUT), D_MODEL, 1024, nb * 32, nb * 32, kb * 64}; } r -= I1;
            if (r < I2) { const int nb = r % 176, kb = r / 176, pn = nb >> 3, bj = (nb >> 2) & 1, q = nb & 3;
                return TrDesc{ap->in[13] + (size_t)L * D_MODEL * 2 * D_FF, ap->in[12] + L * D_MODEL, (bf16_t*)(wl + W_FFI), 2 * D_FF, 1024, bj * D_FF + 128 * pn + 32 * q, nb * 32, kb * 64}; } r -= I2;
            if (r < I3) { const int nb = r % 32, kb = r / 32;
                return TrDesc{ap->in[14] + (size_t)L * D_FF * D_MODEL, nullptr, (bf16_t*)(wl + W_FFO), D_MODEL, D_FF, nb * 32, nb * 32, kb * 64}; } r -= I3;
            if (r < I4) { const int nb = r % 32, kb = r / 32;
                return TrDesc{ap->in[16] + (size_t)L * D_MODEL * D_MODEL, nullptr, (bf16_t*)(wl + W_G), D_MODEL, 1024, nb * 32, nb * 32, kb * 64}; } r -= I4;
            { const int nb = r % 32, kb = r / 32;
                return TrDesc{ap->in[17] + (size_t)L * PLE_DIM * D_MODEL, nullptr, (bf16_t*)(wl + W_P), D_MODEL, PLE_DIM, nb * 32, nb * 32, kb * 64}; }
        };
        int it = gw;
        if (it < DEPTH * IT) {
            TrDesc d = desc(it); TrRegs R; tr_load(d, R, lane);
            for (;;) {
                const int nx = it + NGW; const bool hn = nx < DEPTH * IT;
                TrDesc dn = d; TrRegs Rn = R;
                if (hn) { dn = desc(nx); tr_load(dn, Rn, lane); }
                tr_store(d, R, scr, lane);
                if (!hn) break;
                d = dn; R = Rn; it = nx;
            }
        }
    }
    {
        float* tab = (float*)(ws + WS_TAB);
        for (int i = gw * 64 + lane; i < 2048 * 32; i += NGW * 64) {
            { const int pos = i >> 5, j = i & 31; const double rev = (double)pos * c_inv_ret[j] * 0.15915494309189535; const float fr = (float)(rev - floor(rev));
              tab[TAB_RC + i] = __builtin_amdgcn_cosf(fr); tab[TAB_RS + i] = __builtin_amdgcn_sinf(fr); }
            if (i < 2048 * 8) { const int pos = i >> 3, j = i & 7; const double rev = (double)pos * c_inv_swa[j] * 0.15915494309189535; const float fr = (float)(rev - floor(rev));
              tab[TAB_SC + i] = __builtin_amdgcn_cosf(fr); tab[TAB_SS + i] = __builtin_amdgcn_sinf(fr); }
        }
    }
    {
        const float* p = ap->in[1]; bf16_t* PB = (bf16_t*)(ws + WS_PB);
        const size_t n8 = (size_t)DEPTH * M * PLE_DIM / 8;
        for (size_t i = (size_t)gw * 64 + lane; i < n8; i += (size_t)NGW * 64) {
            float v[8]; ld8f(p + i * 8, v); *(u32x4*)(PB + i * 8) = pack8(v);
        }
    }
    {
        const float* wsrc = ap->in[6]; bf16_t* Wm = (bf16_t*)(ws + WS_WM);
        for (int i = gw * 64 + lane; i < DEPTH * 4 * CHUNK * CHUNK; i += NGW * 64) { const int s_ = i & 127, t_ = (i >> 7) & 127; Wm[i] = f2bf(s_ <= t_ ? wsrc[i] : 0.f); }
    }
    xprep_rows(ap->in[0], (bf16_t*)(ws + WS_XB0), stat_ptr(ws, 0, ST_X1), gw, NGW, lane);
}

typedef float f32x16 __attribute__((ext_vector_type(16)));
typedef short s16x4 __attribute__((ext_vector_type(4)));
using pg8::bf16x8;
constexpr int TS = 144;
constexpr float LOG2E = 1.4426950408889634f;
__device__ __forceinline__ int crow(int r, int hi) { return (r & 3) + 8 * (r >> 2) + 4 * hi; }
__device__ __forceinline__ s16x4 tr16(LAS const unsigned char* p) { return __builtin_bit_cast(s16x4, __builtin_amdgcn_ds_read_tr16_b64_v4i16((LAS s16x4*)p)); }
__device__ __forceinline__ bf16x8 rd_row(LAS const unsigned char* tile, int row0, int k0, int lane) {
    return *(LAS const bf16x8*)(tile + (row0 + (lane & 31)) * TS + (k0 + 8 * (lane >> 5)) * 2);
}
template <bool PERMK> __device__ __forceinline__ bf16x8 rd_tr(LAS const unsigned char* tile, int k0, int n0, int lane) {
    const int h = lane >> 5, g1 = (lane >> 4) & 1, q = (lane & 15) >> 2, p = lane & 3;
    const int rA = k0 + (PERMK ? 4 * h : 8 * h) + q, rB = rA + (PERMK ? 8 : 4);
    const int cb = (n0 + 16 * g1 + 4 * p) * 2;
    const s16x4 lo = tr16(tile + rA * TS + cb), hi = tr16(tile + rB * TS + cb);
    return (bf16x8){lo[0], lo[1], lo[2], lo[3], hi[0], hi[1], hi[2], hi[3]};
}
__device__ __forceinline__ bf16x8 pack_frag(const f32x16& v, int s) {
    u32x4 w; w.x = cvt_pk_bf16(v[8 * s + 0], v[8 * s + 1]); w.y = cvt_pk_bf16(v[8 * s + 2], v[8 * s + 3]); w.z = cvt_pk_bf16(v[8 * s + 4], v[8 * s + 5]); w.w = cvt_pk_bf16(v[8 * s + 6], v[8 * s + 7]);
    return __builtin_bit_cast(bf16x8, w);
}
#define MFMA32(a, b, c) __builtin_amdgcn_mfma_f32_32x32x16_bf16((a), (b), (c), 0, 0, 0)
template <bool SCALE> __device__ __forceinline__ void load_tile(LAS unsigned char* tile, const bf16_t* g, int rows, int zero_below, float sl, int tid) {
    for (int i = tid; i < rows * 8; i += NTHREADS) {
        const int r = i >> 3, c = i & 7;
        u32x4 v = (u32x4){0u, 0u, 0u, 0u};
        if (r >= zero_below) v = *(const u32x4*)(g + (ptrdiff_t)r * IN_W + c * 8);
        if (SCALE) { float f[8]; unpack_bf8(v, f); const float s = exp2f((float)r * sl);
#pragma unroll
            for (int j = 0; j < 8; ++j) f[j] *= s;
            v = pack8(f); }
        *(LAS u32x4*)(tile + r * TS + c * 16) = v;
    }
}

constexpr int GM_BUF = 2 * CHUNK * TS;
struct GmRegs { u32x4 r[4]; };
__device__ __forceinline__ void gm_load(GmRegs& R, const bf16_t* P, int item, int tid) {
    const int h = item & 3, bc = item >> 2; const size_t row0 = (size_t)bc * CHUNK;
    const int r = tid >> 3, c = tid & 7;
#pragma unroll
    for (int i = 0; i < 2; ++i) {
        R.r[i] = *(const u32x4*)(P + (row0 + r + 64 * i) * IN_W + (H_AU + h) * 64 + c * 8);
        R.r[2 + i] = *(const u32x4*)(P + (row0 + r + 64 * i) * IN_W + (H_AV + h) * 64 + c * 8);
    }
}
__device__ __forceinline__ void gm_write(const GmRegs& R, LAS unsigned char* buf, int tid) {
    const int r = tid >> 3, c = tid & 7;
#pragma unroll
    for (int i = 0; i < 2; ++i) { *(LAS u32x4*)(buf + (r + 64 * i) * TS + c * 16) = R.r[i]; *(LAS u32x4*)(buf + CHUNK * TS + (r + 64 * i) * TS + c * 16) = R.r[2 + i]; }
}
__device__ __forceinline__ void gm_compute(LAS unsigned char* buf, const bf16_t* Wm, const float* bs, bf16_t* Y, int item, int tid, int wave, int lane, volatile LAS unsigned* slotp, unsigned fut) {
    const int h = item & 3, bc = item >> 2; const size_t row0 = (size_t)bc * CHUNK;
    LAS unsigned char* AUs = buf; LAS unsigned char* AVs = buf + CHUNK * TS;
    const int tb = wave >> 1, db = wave & 1, hh = lane >> 5;
    f32x16 acc = {};
    const bf16_t* wrow = Wm + (size_t)(h * CHUNK + 32 * tb + (lane & 31)) * CHUNK + 8 * hh;
    for (int ks = 0; ks < 2 * (tb + 1); ++ks) {
        const bf16x8 a = *(const bf16x8*)(wrow + 16 * ks);
        const bf16x8 b = rd_tr<false>(AVs, 16 * ks, 32 * db, lane);
        acc = MFMA32(a, b, acc);
    }
    const int d = 32 * db + (lane & 31);
#pragma unroll
    for (int r = 0; r < 16; ++r) {
        const int t = 32 * tb + crow(r, hh);
        LAS bf16_t* pu = (LAS bf16_t*)(AUs + t * TS) + d;
        *pu = f2bf(bf2f(*pu) * (acc[r] + bs[h * CHUNK + t]));
    }
    if (tid == 0) *slotp = fut;
    __syncthreads();
    for (int i = tid; i < CHUNK * 8; i += NTHREADS) { const int r = i >> 3, c = i & 7; *(u32x4*)(Y + (row0 + r) * D_MODEL + h * 64 + c * 8) = *(LAS const u32x4*)(AUs + r * TS + c * 16); }
}

constexpr int SWA_K = 0, SWA_V = 384 * TS, SWA_WSF = 2 * 384 * TS, SWA_OST = SWA_WSF + NWAVES * 128, SWA_END = SWA_OST + NWAVES * 4096;
struct SwaRegs { u32x4 k[6], v[6]; };
__device__ __forceinline__ void swa_load(SwaRegs& R, const bf16_t* P, int item, int tid) {
    const int hk = item & 1, cp = (item >> 1) & 7, b = item >> 4;
    const ptrdiff_t rowk0 = (ptrdiff_t)b * SEQ + 256 * cp - 128;
    const int r0 = tid >> 3, c = tid & 7;
#pragma unroll
    for (int i = 0; i < 6; ++i) {
        const int r = r0 + 64 * i;
        if (cp == 0 && r < 128) { R.k[i] = (u32x4){0u, 0u, 0u, 0u}; R.v[i] = (u32x4){0u, 0u, 0u, 0u}; }
        else { R.k[i] = *(const u32x4*)(P + (rowk0 + r) * IN_W + (H_CK + hk) * 64 + c * 8); R.v[i] = *(const u32x4*)(P + (rowk0 + r) * IN_W + (H_CV + hk) * 64 + c * 8); }
    }
}
__device__ __forceinline__ void swa_write(const SwaRegs& R, LAS unsigned char* lds, int tid) {
    const int r0 = tid >> 3, c = tid & 7;
#pragma unroll
    for (int i = 0; i < 6; ++i) { *(LAS u32x4*)(lds + SWA_K + (r0 + 64 * i) * TS + c * 16) = R.k[i]; *(LAS u32x4*)(lds + SWA_V + (r0 + 64 * i) * TS + c * 16) = R.v[i]; }
}
__device__ __forceinline__ void swa_compute(LAS unsigned char* lds, const bf16_t* P, const float* sinks, bf16_t* Y, int item, int wave, int lane) {
    const int hk = item & 1, cp = (item >> 1) & 7, b = item >> 4;
    const size_t rowq0 = (size_t)b * SEQ + 256 * cp;
    LAS unsigned char* Ks = lds + SWA_K; LAS unsigned char* Vs = lds + SWA_V;
    const int qi = lane & 31, hh = lane >> 5;
    LAS float* wsf = (LAS float*)(lds + SWA_WSF + wave * 128);
    LAS unsigned char* ost = lds + SWA_OST + wave * 4096;
    constexpr float SC = 0.125f * LOG2E;
    for (int g = 0; g < 3; ++g) {
        const int qh = 3 * hk + g;
        const bf16_t* qrow = P + (rowq0 + 32 * wave + qi) * IN_W + (H_CQ + qh) * 64 + 8 * hh;
        bf16x8 bq[4];
#pragma unroll
        for (int kd = 0; kd < 4; ++kd) bq[kd] = *(const bf16x8*)(qrow + 16 * kd);
        f32x16 S[5];
#pragma unroll
        for (int kb = 0; kb < 5; ++kb) {
            S[kb] = (f32x16){};
#pragma unroll
            for (int kd = 0; kd < 4; ++kd) S[kb] = MFMA32(rd_row(Ks, 32 * (wave + kb), 16 * kd, lane), bq[kd], S[kb]);
        }
        const float sk = sinks[qh] * LOG2E;
        float m = sk;
#pragma unroll
        for (int kb = 0; kb < 5; ++kb) {
            const bool blk_ok = cp > 0 || wave + kb >= 4;
#pragma unroll
            for (int r = 0; r < 16; ++r) {
                const int cr = crow(r, hh);
                bool ok = blk_ok;
                if (kb == 0) ok = ok && cr > qi;
                if (kb == 4) ok = ok && cr <= qi;
                const float s = ok ? S[kb][r] * SC : -1e30f;
                S[kb][r] = s; m = fmaxf(m, s);
            }
        }
        m = fmaxf(m, shx(m, 32, lane));
        float l = 0.f;
#pragma unroll
        for (int kb = 0; kb < 5; ++kb)
#pragma unroll
            for (int r = 0; r < 16; ++r) { const float p = __builtin_amdgcn_exp2f(S[kb][r] - m); S[kb][r] = p; l += p; }
        l += shx(l, 32, lane);
        l += __builtin_amdgcn_exp2f(sk - m);
        f32x16 O[2]; O[0] = (f32x16){}; O[1] = (f32x16){};
#pragma unroll
        for (int kb = 0; kb < 5; ++kb)
#pragma unroll
            for (int s2 = 0; s2 < 2; ++s2) {
                const bf16x8 a = pack_frag(S[kb], s2);
#pragma unroll
                for (int db = 0; db < 2; ++db) O[db] = MFMA32(a, rd_tr<true>(Vs, 32 * (wave + kb) + 16 * s2, 32 * db, lane), O[db]);
            }
        if (hh == 0) wsf[qi] = __builtin_amdgcn_rcpf(l);
        asm volatile("s_waitcnt lgkmcnt(0)" ::: "memory");
#pragma unroll
        for (int r = 0; r < 16; ++r) {
            const int q = crow(r, hh); const float rl = wsf[q];
#pragma unroll
            for (int db = 0; db < 2; ++db) *((LAS bf16_t*)(ost + q * 128) + 32 * db + qi) = f2bf(O[db][r] * rl);
        }
        asm volatile("s_waitcnt lgkmcnt(0)" ::: "memory");
#pragma unroll
        for (int i = 0; i < 4; ++i) { const int row = i * 8 + (lane >> 3), ch = lane & 7;
            *(u32x4*)(Y + (rowq0 + 32 * wave + row) * D_MODEL + 640 + qh * 64 + ch * 8) = *(LAS const u32x4*)(ost + row * 128 + ch * 16); }
        asm volatile("s_waitcnt lgkmcnt(0)" ::: "memory");
    }
}

constexpr int RT_Q = 0, RT_K = CHUNK * TS, RT_V = 2 * CHUNK * TS, RT_S = 3 * CHUNK * TS, RT_O = RT_S + 64 * TS, RT_X = RT_O + CHUNK * 68 * 4, RT_END = RT_X + 16384;
struct RetRegs { u32x4 q[2], k[2], v[2], g[2]; };
__device__ __forceinline__ void ret_load(RetRegs& R, const bf16_t* P, size_t row0, int h, int tid) {
    const int r0 = tid >> 3, c = tid & 7;
#pragma unroll
    for (int i = 0; i < 2; ++i) {
        const bf16_t* pr = P + (row0 + r0 + 64 * i) * IN_W + c * 8;
        R.q[i] = *(const u32x4*)(pr + (H_BQ + h) * 64); R.k[i] = *(const u32x4*)(pr + (H_BK + h) * 64); R.v[i] = *(const u32x4*)(pr + (H_BV + h) * 64);
    }
    const int row = tid >> 2, part = tid & 3;
    const bf16_t* gp = P + (row0 + row) * IN_W + (H_BG + h) * 64 + 16 * part;
    R.g[0] = *(const u32x4*)gp; R.g[1] = *(const u32x4*)(gp + 8);
}
typedef float f32x2m __attribute__((ext_vector_type(2)));
__device__ __forceinline__ u32x4 scale_bf8(const u32x4& r, float sc) {
    const unsigned w[4] = {r.x, r.y, r.z, r.w}; unsigned o[4];
#pragma unroll
    for (int k = 0; k < 4; ++k) { f32x2m v = {__uint_as_float(w[k] << 16), __uint_as_float(w[k] & 0xffff0000u)}; v = v * sc; o[k] = cvt_pk_bf16(v.x, v.y); }
    return (u32x4){o[0], o[1], o[2], o[3]};
}
__device__ __forceinline__ void ret_write(const RetRegs& R, LAS unsigned char* lds, int tid) {
    const int r0 = tid >> 3, c = tid & 7;
#pragma unroll
    for (int i = 0; i < 2; ++i) {
        const int r = r0 + 64 * i;
        *(LAS u32x4*)(lds + RT_Q + r * TS + c * 16) = R.q[i];
        *(LAS u32x4*)(lds + RT_K + r * TS + c * 16) = R.k[i];
        *(LAS u32x4*)(lds + RT_V + r * TS + c * 16) = R.v[i];
    }
}
__device__ __forceinline__ void ret_item(LAS unsigned char* lds, const bf16_t* P, const float* gn_w, bf16_t* Y, int item, int tid, int wave, int lane, volatile LAS unsigned* slotp, unsigned fut) {
    const int h = item % 6, b = item / 6;
    const float lg = c_log2g[h];
    const float g1 = exp2f(lg), g127 = exp2f(127.f * lg), g128 = exp2f(128.f * lg);
    LAS unsigned char* Qs = lds + RT_Q; LAS unsigned char* Ks = lds + RT_K; LAS unsigned char* Vs = lds + RT_V; LAS unsigned char* Sb = lds + RT_S;
    LAS float* Os = (LAS float*)(lds + RT_O); LAS float* Xs = (LAS float*)(lds + RT_X);
    const int tb = wave >> 1, eb = wave & 1, qi = lane & 31, hh = lane >> 5;
    const int db = (wave >> 1) & 1, kh = wave >> 2;
    const int erow = tid >> 2, part = tid & 3;
    float gw0[8], gw1[8]; ld8f(gn_w + h * 64 + 16 * part, gw0); ld8f(gn_w + h * 64 + 16 * part + 8, gw1);
    f32x16 st = {};
    RetRegs R; ret_load(R, P, (size_t)b * SEQ, h, tid);
    for (int c = 0; c < 16; ++c) {
        const size_t row0 = (size_t)b * SEQ + (size_t)c * CHUNK;
        ret_write(R, lds, tid);
        const u32x4 gq0 = R.g[0], gq1 = R.g[1];
        __syncthreads();
        if (c + 1 < 16) ret_load(R, P, row0 + CHUNK, h, tid);
        f32x16 O = {};
        for (int sb = 0; sb <= tb; ++sb) {
            f32x16 S = {};
#pragma unroll
            for (int kd = 0; kd < 4; ++kd) S = MFMA32(rd_row(Ks, 32 * sb, 16 * kd, lane), rd_row(Qs, 32 * tb, 16 * kd, lane), S);
            if (sb == tb) {
#pragma unroll
                for (int r = 0; r < 16; ++r) S[r] = crow(r, hh) <= qi ? S[r] : 0.f;
            }
#pragma unroll
            for (int s2 = 0; s2 < 2; ++s2) O = MFMA32(pack_frag(S, s2), rd_tr<true>(Vs, 32 * sb + 16 * s2, 32 * eb, lane), O);
        }
        if (c > 0) {
#pragma unroll
            for (int kd = 0; kd < 4; ++kd) O = MFMA32(rd_row(Qs, 32 * tb, 16 * kd, lane), rd_row(Sb, 32 * eb, 16 * kd, lane), O);
        }
#pragma unroll
        for (int r = 0; r < 16; ++r) Os[(32 * tb + crow(r, hh)) * 68 + 32 * eb + qi] = O[r];
        if (c + 1 < 16) {
            f32x16 acc = {};
#pragma unroll
            for (int ks = 0; ks < 4; ++ks) acc = MFMA32(rd_tr<false>(Vs, 64 * kh + 16 * ks, 32 * eb, lane), rd_tr<false>(Ks, 64 * kh + 16 * ks, 32 * db, lane), acc);
#pragma unroll
            for (int r = 0; r < 16; ++r) st[r] = st[r] * g128 + g127 * acc[r];
            if (kh == 1) {
#pragma unroll
                for (int r = 0; r < 16; ++r) Xs[((eb * 2 + db) * 16 + r) * 64 + lane] = st[r];
            }
        }
        __syncthreads();
        if (c + 1 < 16 && kh == 0) {
#pragma unroll
            for (int r = 0; r < 16; ++r) { const int e = 32 * eb + crow(r, hh), d = 32 * db + qi; const float sv = (st[r] + Xs[((eb * 2 + db) * 16 + r) * 64 + lane]) * g1; *((LAS bf16_t*)(Sb + e * TS) + d) = (bf16_t)cvt_pk_bf16(sv, sv); }
        }
        {
            float v[16]; float s = 0.f;
#pragma unroll
            for (int j = 0; j < 16; ++j) { v[j] = Os[erow * 68 + 16 * part + j]; s += v[j]; }
            s += shx(s, 1, lane); s += shx(s, 2, lane);
            const float mu = s * (1.0f / 64.0f); float q = 0.f;
#pragma unroll
            for (int j = 0; j < 16; ++j) { v[j] -= mu; q += v[j] * v[j]; }
            q += shx(q, 1, lane); q += shx(q, 2, lane);
            const float rs = fast_rsq(q * (1.0f / 64.0f) + EPS);
            float ga[8], gb[8], o0[8], o1[8];
            unpack_bf8(gq0, ga); unpack_bf8(gq1, gb);
#pragma unroll
            for (int j = 0; j < 8; ++j) { o0[j] = (ga[j] * gw0[j]) * (v[j] * rs); o1[j] = (gb[j] * gw1[j]) * (v[8 + j] * rs); }
            bf16_t* yp = Y + (row0 + erow) * D_MODEL + 256 + h * 64 + 16 * part;
            *(u32x4*)yp = pack8(o0); *(u32x4*)(yp + 8) = pack8(o1);
        }
    }
    if (tid == 0) *slotp = fut;
    __syncthreads();
}

constexpr int CW_TMO = 1024;
constexpr int CW_QUEUE = 2048;
constexpr int MQ_RET = 192, MQ_SWA = MQ_RET + 512, MQ_ALL = MQ_SWA + 2048;
__device__ __forceinline__ void mixers(KArgs ap, int L, LAS unsigned char* lds, int tid, int wave, int lane) {
    unsigned char* ws = ap->ws;
    const bf16_t* P = (const bf16_t*)(ws + WS_BIG); bf16_t* Y = (bf16_t*)(ws + WS_Y);
    const bf16_t* Wm = (const bf16_t*)(ws + WS_WM) + (size_t)L * 4 * CHUNK * CHUNK;
    const float* gbs = ap->in[7] + L * 4 * CHUNK; const float* gn_w = ap->in[8] + L * 384; const float* sinks = ap->in[9] + L * 6;
    unsigned* head = (unsigned*)ws + CW_QUEUE + 64 * L;
    volatile LAS unsigned* slot = (volatile LAS unsigned*)(lds + MISC_OFF + 64);
    if (tid == 0) slot[0] = atomicAdd(head, 1u);
    __syncthreads();
    unsigned cur = (unsigned)__builtin_amdgcn_readfirstlane((int)slot[0]);
    __syncthreads();
    if (tid == 0) slot[1] = atomicAdd(head, 1u);
    __syncthreads();
    unsigned nxt = (unsigned)__builtin_amdgcn_readfirstlane((int)slot[1]);
    int k = 0;
#define MQ_FETCH() unsigned fut = 0u; if (tid == 0) fut = atomicAdd(head, 1u)
#define MQ_ADVANCE() do { cur = nxt; nxt = (unsigned)__builtin_amdgcn_readfirstlane((int)slot[k]); k ^= 1; } while (0)
    while (cur < (unsigned)MQ_ALL) {
        if (cur < (unsigned)MQ_RET) {
            MQ_FETCH();
            ret_item(lds, P, gn_w, Y, (int)cur, tid, wave, lane, slot + k, fut);
            MQ_ADVANCE();
        } else if (cur < (unsigned)MQ_SWA) {
            MQ_FETCH();
            { SwaRegs R; swa_load(R, P, (int)cur - MQ_RET, tid); swa_write(R, lds, tid); }
            __syncthreads();
            swa_compute(lds, P, sinks, Y, (int)cur - MQ_RET, wave, lane);
            if (tid == 0) slot[k] = fut;
            __syncthreads();
            MQ_ADVANCE();
        } else {
            GmRegs R; gm_load(R, P, (int)cur - MQ_SWA, tid);
            int bsel = 0;
            for (;;) {
                MQ_FETCH();
                LAS unsigned char* buf = lds + bsel * GM_BUF;
                gm_write(R, buf, tid);
                __syncthreads();
                const bool more = nxt < (unsigned)MQ_ALL;
                if (more) gm_load(R, P, (int)nxt - MQ_SWA, tid);
                gm_compute(buf, Wm, gbs, Y, (int)cur - MQ_SWA, tid, wave, lane, slot + k, fut);
                MQ_ADVANCE(); bsel ^= 1;
                if (!more) break;
            }
            __syncthreads();
        }
    }
#undef MQ_FETCH
#undef MQ_ADVANCE
    __syncthreads();
}

#ifndef PG8_SP2
#define PG8_SP2 true
#endif
#ifndef PG8_ALIGN
#define PG8_ALIGN true
#endif
constexpr int N_PHASES = 1 + 8 * DEPTH;
#ifndef PHMASK
#define PHMASK 0x1ff
#endif
#ifndef DUP_MASK
#define DUP_MASK 0
#endif
#define NREP(bit) ((DUP_MASK & (bit)) ? 2 : 1)
#ifndef KREP3
#define KREP3 1
#endif
__global__ void __launch_bounds__(NTHREADS, 2) mega(Args a_) {
    extern __shared__ __attribute__((aligned(16))) unsigned char lds_raw[];
    LAS unsigned char* lds = (LAS unsigned char*)lds_raw;
    const int G = gridDim.x, bid = blockIdx.x;
    const int vcu = (G % 8 == 0) ? (bid % 8) * (G / 8) + bid / 8 : bid;
    const int NGW = G * NWAVES;
    const int wave0 = __builtin_amdgcn_readfirstlane((int)threadIdx.x >> 6);
#define opq_tid() pg8::pg8_tid(wave0)
    { const int tid = opq_tid(); for (int u = tid; u < (LDS_BYTES - RING_BYTES) / 4; u += NTHREADS) ((LAS unsigned*)(lds + RING_BYTES))[u] = 0u; }
    __syncthreads();
    XcdBarrier bar = xcd_barrier_post((unsigned*)kargs()->ws + CW_BAR + kargs()->li * XCD_BAR_WORDS, (volatile LAS unsigned*)(lds + MISC_OFF));
    const int lo = kargs()->ph_lo, hi = kargs()->ph_hi;
#define IN(k) (lo <= (k) && (k) < hi)
#define SEAM(k) do { if (IN(k) && IN((k) + 1)) xcd_barrier(bar, opq_tid()); } while (0)
#define LANE_VARS const int tid_ = opq_tid(), lane = tid_ & 63, wave = __builtin_amdgcn_readfirstlane(tid_ >> 6), gw = vcu * NWAVES + wave
    if (IN(0) && (PHMASK & 1)) for (int rep = 0; rep < NREP(1); ++rep) { LANE_VARS; prologue(kargs(), lds, gw, NGW, wave, lane); }
    SEAM(0);
#define OPQ(p) ({ auto _p = (p); asm volatile("" : "+s"(_p)); _p; })
    for (int L = 0; L < DEPTH; ++L) {
        const int p0 = 1 + 8 * L;
        if (IN(p0 + 0) && (PHMASK & 2)) for (int rep = 0; rep < NREP(2); ++rep) {
            KArgs ap = kargs(); unsigned char* wsp = ap->ws; const int Lp = OPQ(L);
            pg8::Gemm g{(const bf16_t*)(wsp + ((Lp & 1) ? WS_XB1 : WS_XB0)), (const bf16_t*)(wsp + WS_W + (size_t)Lp * W_LAYER + W_IN), M, 2816, 1024}; pg8::StaticOrder S; S.init(M, 2816, G, bid);
            EpiProj E{(bf16_t*)(wsp + WS_BIG), stat_ptr(wsp, Lp, ST_X1), ap->in[4] + Lp * 256, ap->in[5] + Lp * 256, (const float*)(wsp + WS_TAB)};
            pg8::gemm_phase<EpiProj, pg8::StaticOrder, PG8_ALIGN, PG8_SP2>(lds, g, S, E, wave0);
        }
        SEAM(p0 + 0);
        if (IN(p0 + 1) && (PHMASK & 4)) {
            LANE_VARS; (void)gw; mixers(kargs(), OPQ(L), lds, tid_, wave, lane);
        }
        SEAM(p0 + 1);
        if (IN(p0 + 2) && (PHMASK & 8)) {
            KArgs ap = kargs(); unsigned char* wsp = ap->ws; const int Lp = OPQ(L);
            pg8::Gemm g{(const bf16_t*)(wsp + WS_Y), (const bf16_t*)(wsp + WS_W + (size_t)Lp * W_LAYER + W_OUT), M, 1024, 1024}; pg8::StaticOrder S; S.init(M, 1024, G, bid);
            EpiNormRes E{(bf16_t*)(wsp + ((Lp & 1) ? WS_XB1 : WS_XB0)), ap->in[11] + Lp * D_MODEL, stat_ptr(wsp, Lp, ST_MIX), stat_ptr(wsp, Lp, ST_X2), (unsigned*)wsp + CW_TMO};
            pg8::gemm_phase<EpiNormRes, pg8::StaticOrder, PG8_ALIGN, PG8_SP2>(lds, g, S, E, wave0);
        }
        SEAM(p0 + 2);
        if (IN(p0 + 4) && (PHMASK & 32)) for (int rep = 0; rep < NREP(32); ++rep) {
            KArgs ap = kargs(); unsigned char* wsp = ap->ws; const int Lp = OPQ(L);
            pg8::Gemm g{(const bf16_t*)(wsp + ((Lp & 1) ? WS_XB1 : WS_XB0)), (const bf16_t*)(wsp + WS_W + (size_t)Lp * W_LAYER + W_FFI), M, 5632, 1024}; pg8::StaticOrder S; S.init(M, 5632, G, bid);
            EpiSwiglu E{(bf16_t*)(wsp + WS_BIG), stat_ptr(wsp, Lp, ST_X2), 1.0f / KREP3};
            pg8::gemm_phase<EpiSwiglu, pg8::StaticOrder, PG8_ALIGN, PG8_SP2, KREP3>(lds, g, S, E, wave0);
        }
        SEAM(p0 + 4);
        if (IN(p0 + 5) && (PHMASK & 64)) {
            { KArgs ap = kargs(); unsigned char* wsp = ap->ws; const int Lp = OPQ(L);
              pg8::Gemm g{(const bf16_t*)(wsp + WS_BIG), (const bf16_t*)(wsp + WS_W + (size_t)Lp * W_LAYER + W_FFO), M, 1024, D_FF}; pg8::StaticOrder S; S.init(M, 1024, G, bid);
              EpiNormRes E{(bf16_t*)(wsp + ((Lp & 1) ? WS_XB1 : WS_XB0)), ap->in[15] + Lp * D_MODEL, stat_ptr(wsp, Lp, ST_F), nullptr, (unsigned*)wsp + CW_TMO};
              pg8::gemm_phase<EpiNormRes, pg8::StaticOrder, PG8_ALIGN, PG8_SP2>(lds, g, S, E, wave0); }
            { KArgs ap = kargs(); unsigned char* wsp = ap->ws; const int Lp = OPQ(L);
              pg8::Gemm g{(const bf16_t*)(wsp + WS_PB) + (size_t)Lp * M * PLE_DIM, (const bf16_t*)(wsp + WS_W + (size_t)Lp * W_LAYER + W_P), M, 1024, PLE_DIM}; pg8::StaticOrder S; S.init(M, 1024, G, bid);
              EpiStat E{(bf16_t*)(wsp + WS_MIX), stat_ptr(wsp, Lp, ST_PP)};
              pg8::gemm_phase<EpiStat, pg8::StaticOrder, PG8_ALIGN, PG8_SP2>(lds, g, S, E, wave0); }
        }
        SEAM(p0 + 5);
        if (IN(p0 + 7) && (PHMASK & 256)) {
            KArgs ap = kargs(); unsigned char* wsp = ap->ws; const int Lp = OPQ(L);
            const bf16_t* XBc = (const bf16_t*)(wsp + ((Lp & 1) ? WS_XB1 : WS_XB0));
            pg8::Gemm g{XBc, (const bf16_t*)(wsp + WS_W + (size_t)Lp * W_LAYER + W_G), M, 1024, 1024}; pg8::StaticOrder S; S.init(M, 1024, G, bid);
            const bool last = (Lp == DEPTH - 1);
            EpiPle E{XBc, (const bf16_t*)(wsp + WS_MIX), stat_ptr(wsp, Lp, ST_PP), ap->in[18] + Lp * D_MODEL, last ? nullptr : (bf16_t*)(wsp + ((Lp & 1) ? WS_XB0 : WS_XB1)), last ? nullptr : stat_ptr(wsp, Lp + 1, ST_X1), last ? ap->out : nullptr};
            pg8::gemm_phase<EpiPle, pg8::StaticOrder, PG8_ALIGN, PG8_SP2>(lds, g, S, E, wave0);
        }
        SEAM(p0 + 7);
    }
#undef IN
#undef SEAM
#undef LANE_VARS
#undef opq_tid
}

extern "C" void kernel_launch(void* const* d_in, const int* in_sizes, int n_in, void* d_out, int out_size, void* d_ws, size_t ws_size, hipStream_t stream) {
    static int grid = 0;
    if (grid == 0) {
        if (n_in != 19 || out_size != M * D_MODEL || ws_size < WS_END) { fprintf(stderr, "kernel_launch: unexpected shapes (n_in %d out %d ws %zu)\n", n_in, out_size, ws_size); grid = -1; return; }
        int dev = 0, cus = 0, per_cu = 0;
        if (hipGetDevice(&dev) != hipSuccess || hipDeviceGetAttribute(&cus, hipDeviceAttributeMultiprocessorCount, dev) != hipSuccess) { grid = -1; return; }
        if (hipFuncSetAttribute((const void*)mega, hipFuncAttributeMaxDynamicSharedMemorySize, LDS_BYTES) != hipSuccess) { fprintf(stderr, "kernel_launch: hipFuncSetAttribute failed\n"); grid = -1; return; }
        if (hipOccupancyMaxActiveBlocksPerMultiprocessor(&per_cu, (const void*)mega, NTHREADS, LDS_BYTES) != hipSuccess || per_cu < 1) { fprintf(stderr, "kernel_launch: occupancy query says %d\n", per_cu); }
        (void)hipGetLastError();
        grid = cus >= 256 ? 256 : cus;
    }
    if (grid < 0) return;
    unsigned char* ws = (unsigned char*)d_ws;
    (void)hipMemsetAsync(ws + WS_CTL, 0, CTL_ZERO_BYTES, stream);
    Args a{};
    for (int i = 0; i < 19; ++i) a.in[i] = (const float*)d_in[i];
    a.out = (float*)d_out; a.ws = ws; a.li = 0; a.pad = 0;
    a.ph_lo = 0; a.ph_hi = N_PHASES;
    hipLaunchKernelGGL(mega, dim3(grid), dim3(NTHREADS), LDS_BYTES, stream, a);
}
```

```cpp
#include <hip/hip_runtime.h>
#include <stdint.h>
#include <stdio.h>

constexpr int D_MODEL = 1024, BATCH = 32, SEQ = 2048, DEPTH = 2, PLE_DIM = 256, HD = 64, CHUNK = 128;
constexpr int M = BATCH * SEQ;
constexpr int IN_W = 2688, D_FF = 2816, NHEADS = 42;
constexpr int H_AU = 0, H_AV = 4, H_BQ = 8, H_BK = 14, H_BV = 20, H_BG = 26, H_CQ = 32, H_CK = 38, H_CV = 40;
constexpr float EPS = 1e-6f;
typedef unsigned short bf16_t;

__device__ __forceinline__ float bf2f(bf16_t v) { return __uint_as_float(((unsigned)v) << 16); }
__device__ __forceinline__ bf16_t f2bf(float f) { unsigned u = __float_as_uint(f); return (bf16_t)((u + 0x7fffu + ((u >> 16) & 1u)) >> 16); }
__device__ __forceinline__ float shx(float v, int mask, int lane) { return __int_as_float(__builtin_amdgcn_ds_bpermute((lane ^ mask) << 2, __float_as_int(v))); }
__device__ __forceinline__ float wave_sum(float v) {
#pragma unroll
    for (int o = 1; o < 64; o <<= 1) v += __shfl_xor(v, o);
    return v;
}
constexpr float LOG2E_ = 1.4426950408889634f;

__constant__ double c_inv_ret[32] = {1.0, 0.7498942093324559, 0.5623413251903491, 0.4216965034285822, 0.31622776601683794, 0.23713737056616552, 0.1778279410038923, 0.1333521432163324, 0.1, 0.07498942093324558, 0.05623413251903491, 0.042169650342858224, 0.03162277660168379, 0.023713737056616554, 0.01778279410038923, 0.01333521432163324, 0.01, 0.007498942093324558, 0.005623413251903491, 0.004216965034285823, 0.0031622776601683794, 0.0023713737056616554, 0.0017782794100389228, 0.001333521432163324, 0.001, 0.0007498942093324559, 0.0005623413251903491, 0.00042169650342858224, 0.00031622776601683794, 0.00023713737056616554, 0.00017782794100389227, 0.0001333521432163324};
__constant__ double c_inv_swa[8] = {1.0, 0.19392274474868576, 0.03760603093086393, 0.007292664737217109, 0.001414213562373095, 0.0002742481756762073, 5.318295896944988e-05, 1.031338537721246e-05};
__constant__ float c_log2g[6] = {-0.04580368961312479f, -0.02272007650008353f, -0.011315313227834146f, -0.005646563141142063f, -0.0028205190623786626f, -0.0014095702546713536f};

constexpr size_t MiB = 1u << 20;
constexpr size_t WS_CTL = 0, CTL_ZERO_BYTES = 7 * MiB;
constexpr size_t WS_STAT = 1 * MiB;
constexpr size_t WS_TAB = 7 * MiB;
constexpr size_t WS_WM = 7 * MiB + 768 * 1024;
constexpr size_t WS_W = 8 * MiB;
constexpr size_t WS_XB0 = 64 * MiB;
constexpr size_t WS_BIG = 192 * MiB;
constexpr size_t WS_Y = 544 * MiB;
constexpr size_t WS_MIX = 672 * MiB;
constexpr size_t WS_XB1 = 800 * MiB;
constexpr size_t WS_PB = 928 * MiB;
constexpr size_t WS_END = 992 * MiB;
constexpr int TAB_RC = 0, TAB_RS = 2048 * 32, TAB_SC = 2 * 2048 * 32, TAB_SS = 2 * 2048 * 32 + 2048 * 8;


namespace pg8 {
#define PG8_LAS __attribute__((address_space(3)))
typedef unsigned short bf16_t;
typedef short bf16x8 __attribute__((ext_vector_type(8)));
typedef float f32x4 __attribute__((ext_vector_type(4)));
typedef unsigned u32x4 __attribute__((ext_vector_type(4)));
constexpr int BM = 256, BK = 64, HALF = 128, HTB = HALF * BK * 2  , STAGE_BYTES = 8 * HTB, NXCD = 8, WGM = 8;

__host__ __device__ __forceinline__ int lds_byte(int r, int c) { const int st = (r >> 4) * 2 + (c >> 5), rr = r & 15, cc = c & 31, ob = rr * 64 + cc * 2; return st * 1024 + (ob ^ (((ob >> 9) & 1) << 5)); }
__host__ __device__ __forceinline__ void stage_rc(int b, int& R, int& C) { const int st = b / 1024, sb = b % 1024, swz = sb ^ (((sb >> 9) & 1) << 5); R = (st >> 1) * 16 + swz / 64; C = (st & 1) * 32 + (swz % 64) / 2; }
__host__ __device__ __forceinline__ int perm32(int rho) { const int n = rho >> 4, i = rho & 15; return 8 * (i >> 2) + 4 * n + (i & 3); }

struct Unit { int pm, pn; };
struct Gemm { const bf16_t* A; const bf16_t* Bt; int M, N, K; };

struct StaticOrder {
    int nM, nN, nwg, G, c, wgm;
    __host__ __device__ void init(int M, int N, int G_, int c_) { nM = M / BM; nN = N / BM; nwg = nM * nN; G = G_; c = c_; wgm = nN >= 8 ? 4 : WGM; }
    __host__ __device__ bool next(int i, Unit& u) const {
        const long L = (long)i * G + c; if (L >= nwg) return false;
        int wgid = (int)L; { const int q = nwg / NXCD, r = nwg % NXCD, xcd = wgid % NXCD, off = wgid / NXCD; wgid = (xcd < r ? xcd * (q + 1) : r * (q + 1) + (xcd - r) * q) + off; }
        const int nig = wgm * nN, gid = wgid / nig, fm = gid * wgm, gsz = (nM - fm) < wgm ? (nM - fm) : wgm;
        u.pm = fm + ((wgid % nig) % gsz); u.pn = (wgid % nig) / gsz; return true;
    }
    __device__ __forceinline__ void a_ready(const Unit&) const {}
    __device__ __forceinline__ void done(const Unit&) const {}
};

typedef float f32x2_cv __attribute__((ext_vector_type(2))); typedef __bf16 bf16x2_cv __attribute__((ext_vector_type(2)));
__device__ __forceinline__ unsigned cvt_pk_bf16(float lo, float hi) { const f32x2_cv v = {lo, hi}; const bf16x2_cv b = __builtin_convertvector(v, bf16x2_cv); return __builtin_bit_cast(unsigned, b); }
__device__ __forceinline__ int pg8_tid(int wave0) {
    unsigned ones = ~0u; asm volatile("" : "+s"(ones));
    return wave0 * 64 + (int)__builtin_amdgcn_mbcnt_hi(ones, __builtin_amdgcn_mbcnt_lo(ones, 0u));
}
template <class Epi, class Sched, bool ALIGN_EPI = false, bool SP2 = false, int KREP = 1>
__device__ __forceinline__ void gemm_phase(PG8_LAS unsigned char* lds, const Gemm g, const Sched& S, const Epi& E, int wave0) {
    const int tid = pg8_tid(wave0);
    const int wid = __builtin_amdgcn_readfirstlane(tid >> 6), lane = tid & 63, wr = wid >> 2, wc = wid & 3, fr = lane & 15, fq = lane >> 4;
    const int K = g.K, nt = K / BK;
    unsigned voffA[2], voffB[2];
#pragma unroll
    for (int i = 0; i < 2; ++i) { int R, C; stage_rc(tid * 16 + i * 8192, R, C); const int Rb = Epi::PERM ? ((R & ~31) + perm32(R & 31)) : R;
        voffA[i] = (unsigned)(R * K + C) * 2u; voffB[i] = (unsigned)(Rb * K + C) * 2u; }
    const size_t kstep = (size_t)(BK * 2);
    const size_t hstep = (size_t)HALF * K * 2;
    const size_t tstep = 2 * hstep;
    const unsigned ldsw = (unsigned)wid * 1024u;
    const int aoff = lds_byte(wr * 64 + fr, fq * 8), boff = lds_byte(wc * 32 + fr, fq * 8);
#define PG8_SA(b, h) (((b) * 2 + (h)) * HTB)
#define PG8_SB(b, h) ((4 + (b) * 2 + (h)) * HTB)
#define PG8_STAGE(bufoff, gbase, voff) do { _Pragma("unroll") for (int _i = 0; _i < 2; ++_i) \
        __builtin_amdgcn_global_load_lds((const unsigned*)((const char*)(gbase) + (voff)[_i]), (PG8_LAS unsigned*)(lds + (bufoff) + ldsw + _i * 8192), 16, 0, 0); } while (0)
#define PG8_LDA(dst, b, h) do { _Pragma("unroll") for (int m = 0; m < 4; ++m) _Pragma("unroll") for (int k = 0; k < 2; ++k) dst[m][k] = *(const PG8_LAS bf16x8*)(lds + PG8_SA(b, h) + aoff + m * 2048 + k * 1024); } while (0)
#define PG8_LDB(dst, b, h) do { _Pragma("unroll") for (int n = 0; n < 2; ++n) _Pragma("unroll") for (int k = 0; k < 2; ++k) dst[n][k] = *(const PG8_LAS bf16x8*)(lds + PG8_SB(b, h) + boff + n * 2048 + k * 1024); } while (0)
#define PG8_MMA(ai, bj, At, Bt) do { __builtin_amdgcn_s_setprio(1); _Pragma("unroll") for (int m = 0; m < 4; ++m) _Pragma("unroll") for (int n = 0; n < 2; ++n) _Pragma("unroll") for (int k = 0; k < 2; ++k) \
        acc[ai][bj][m][n] = __builtin_amdgcn_mfma_f32_16x16x32_bf16(Bt[n][k], At[m][k], acc[ai][bj][m][n], 0, 0, 0); __builtin_amdgcn_s_setprio(0); } while (0)
#define PG8_WAIT_V(n) asm volatile("s_waitcnt vmcnt(" #n ")" ::: "memory")
#define PG8_WAIT_L(n) asm volatile("s_waitcnt lgkmcnt(" #n ")" ::: "memory")
#define PG8_BAR __builtin_amdgcn_s_barrier()
#define PG8_SCHED __builtin_amdgcn_sched_barrier(0)
    Unit cur, nxt; int ui = 0;
    if (!S.next(0, cur)) return;
    f32x4 acc[2][2][4][2];
#pragma unroll
    for (int a = 0; a < 2; ++a)
#pragma unroll
        for (int b = 0; b < 2; ++b)
#pragma unroll
            for (int m = 0; m < 4; ++m)
#pragma unroll
                for (int n = 0; n < 2; ++n) acc[a][b][m][n] = (f32x4){0.f, 0.f, 0.f, 0.f};
    bf16x8 At[4][2], B0[2][2], B1[2][2];
    const char* cA = (const char*)g.A + (size_t)cur.pm * tstep; const char* cB = (const char*)g.Bt + (size_t)cur.pn * tstep;
    S.a_ready(cur);
    if constexpr (SP2) {
        PG8_STAGE(PG8_SB(0, 0), cB, voffB); PG8_STAGE(PG8_SB(0, 1), cB + hstep, voffB); PG8_STAGE(PG8_SA(0, 0), cA, voffA); PG8_STAGE(PG8_SA(0, 1), cA + hstep, voffA);
        if (wr == 1) PG8_BAR;
        PG8_WAIT_V(2); PG8_BAR;
        PG8_STAGE(PG8_SB(1, 0), cB + kstep, voffB); PG8_STAGE(PG8_SA(1, 0), cA + kstep, voffA); PG8_STAGE(PG8_SB(1, 1), cB + hstep + kstep, voffB);
        PG8_WAIT_V(6); PG8_BAR;
    } else {
        PG8_STAGE(PG8_SB(0, 0), cB, voffB); PG8_STAGE(PG8_SA(0, 0), cA, voffA); PG8_STAGE(PG8_SB(0, 1), cB + hstep, voffB); PG8_STAGE(PG8_SA(0, 1), cA + hstep, voffA);
        if (wr == 1) PG8_BAR;
        PG8_WAIT_V(4); PG8_BAR;
        PG8_STAGE(PG8_SB(1, 0), cB + kstep, voffB); PG8_STAGE(PG8_SA(1, 0), cA + kstep, voffA); PG8_STAGE(PG8_SB(1, 1), cB + hstep + kstep, voffB);
        PG8_WAIT_V(6); PG8_BAR;
    }
    for (;;) {
        const bool has_next = S.next(ui + 1, nxt);
        const char* nA = has_next ? (const char*)g.A + (size_t)nxt.pm * tstep : cA; const char* nB = has_next ? (const char*)g.Bt + (size_t)nxt.pn * tstep : cB;
        for (int t = 0; t < nt * KREP; t += 2) {
            const bool last = (t == nt * KREP - 2);
            const int t1 = KREP > 1 ? (t + 1) % nt : t + 1, t2 = KREP > 1 ? (t + 2) % nt : t + 2;
            const char* a1 = cA + (size_t)t1 * kstep;
            const char* a2 = last ? nA : cA + (size_t)t2 * kstep; const char* b2 = last ? nB : cB + (size_t)t2 * kstep;
            const char* a3 = a2 + kstep; const char* b3 = b2 + kstep;
            if (last && has_next) S.a_ready(nxt);
            if constexpr (SP2) {
            PG8_LDB(B0, 0, 0); PG8_LDB(B1, 0, 1); PG8_SCHED; PG8_LDA(At, 0, 0); PG8_STAGE(PG8_SA(1, 1), a1 + hstep, voffA);
            PG8_WAIT_V(8); PG8_WAIT_L(0); PG8_BAR; PG8_MMA(0, 0, At, B0); PG8_MMA(0, 1, At, B1); PG8_BAR; PG8_SCHED;
            PG8_LDA(At, 0, 1); PG8_STAGE(PG8_SB(0, 0), b2, voffB); PG8_STAGE(PG8_SB(0, 1), b2 + hstep, voffB); PG8_STAGE(PG8_SA(0, 0), a2, voffA);
            PG8_WAIT_V(8); PG8_WAIT_L(0); PG8_BAR; PG8_MMA(1, 0, At, B0); PG8_MMA(1, 1, At, B1); PG8_BAR; PG8_SCHED;
            PG8_LDB(B0, 1, 0); PG8_LDB(B1, 1, 1); PG8_SCHED; PG8_LDA(At, 1, 0); PG8_STAGE(PG8_SA(0, 1), a2 + hstep, voffA);
            PG8_WAIT_V(8); PG8_WAIT_L(0); PG8_BAR; PG8_MMA(0, 0, At, B0); PG8_MMA(0, 1, At, B1); PG8_BAR; PG8_SCHED;
            PG8_LDA(At, 1, 1); PG8_STAGE(PG8_SB(1, 0), b3, voffB); PG8_STAGE(PG8_SB(1, 1), b3 + hstep, voffB); PG8_STAGE(PG8_SA(1, 0), a3, voffA);
            PG8_WAIT_V(8); PG8_WAIT_L(0); PG8_BAR; PG8_MMA(1, 0, At, B0); PG8_MMA(1, 1, At, B1); PG8_BAR; PG8_SCHED;
            } else {
            PG8_LDB(B0, 0, 0); PG8_SCHED; PG8_LDA(At, 0, 0); PG8_STAGE(PG8_SA(1, 1), a1 + hstep, voffA);
            PG8_WAIT_L(8); PG8_BAR; PG8_WAIT_L(0); PG8_MMA(0, 0, At, B0); PG8_BAR; PG8_SCHED;
            PG8_LDB(B1, 0, 1); PG8_STAGE(PG8_SB(0, 0), b2, voffB);
            PG8_BAR; PG8_WAIT_L(0); PG8_MMA(0, 1, At, B1); PG8_BAR;
            PG8_LDA(At, 0, 1); PG8_STAGE(PG8_SA(0, 0), a2, voffA);
            PG8_BAR; PG8_WAIT_L(0); PG8_MMA(1, 0, At, B0); PG8_BAR; PG8_SCHED;
            PG8_STAGE(PG8_SB(0, 1), b2 + hstep, voffB);
            PG8_WAIT_V(6); PG8_BAR; PG8_MMA(1, 1, At, B1); PG8_BAR;
            PG8_LDB(B0, 1, 0); PG8_SCHED; PG8_LDA(At, 1, 0); PG8_STAGE(PG8_SA(0, 1), a2 + hstep, voffA);
            PG8_WAIT_L(8); PG8_BAR; PG8_WAIT_L(0); PG8_MMA(0, 0, At, B0); PG8_BAR; PG8_SCHED;
            PG8_LDB(B1, 1, 1); PG8_STAGE(PG8_SB(1, 0), b3, voffB);
            PG8_BAR; PG8_WAIT_L(0); PG8_MMA(0, 1, At, B1); PG8_BAR;
            PG8_LDA(At, 1, 1); PG8_STAGE(PG8_SA(1, 0), a3, voffA);
            PG8_BAR; PG8_WAIT_L(0); PG8_MMA(1, 0, At, B0); PG8_BAR; PG8_SCHED;
            PG8_STAGE(PG8_SB(1, 1), b3 + hstep, voffB);
            PG8_WAIT_V(6); PG8_BAR; PG8_MMA(1, 1, At, B1); PG8_BAR;
            }
        }
        if constexpr (ALIGN_EPI) { if (wr == 0) PG8_BAR; }
        if constexpr (!Epi::AFTER_DRAIN) { E(acc, cur, wr, wc, fr, fq); S.done(cur); }
        if (!has_next) break;
#pragma unroll
        for (int a = 0; a < 2; ++a)
#pragma unroll
            for (int b = 0; b < 2; ++b)
#pragma unroll
                for (int m = 0; m < 4; ++m)
#pragma unroll
                    for (int n = 0; n < 2; ++n) acc[a][b][m][n] = (f32x4){0.f, 0.f, 0.f, 0.f};
        cur = nxt; cA = nA; cB = nB; ++ui;
        if constexpr (ALIGN_EPI) { if (wr == 1) PG8_BAR; }
    }
    PG8_WAIT_V(0);
    if constexpr (!ALIGN_EPI) { if (wr == 0) PG8_BAR; }
    PG8_BAR;
    if constexpr (Epi::AFTER_DRAIN) { E.fused(acc, cur, wr, wc, fr, fq, lds, wid, lane); S.done(cur); }
#undef PG8_SA
#undef PG8_SB
#undef PG8_STAGE
#undef PG8_LDA
#undef PG8_LDB
#undef PG8_MMA
#undef PG8_WAIT_V
#undef PG8_WAIT_L
#undef PG8_BAR
#undef PG8_SCHED
}
}

#define LAS __attribute__((address_space(3)))
#define GAS __attribute__((address_space(1)))
using pg8::f32x4; using pg8::u32x4; using pg8::Unit; using pg8::cvt_pk_bf16;
typedef unsigned u32x2 __attribute__((ext_vector_type(2)));
typedef GAS unsigned gu32;
#define RLX_AGENT __ATOMIC_RELAXED, __HIP_MEMORY_SCOPE_AGENT

constexpr int NWAVES = 8, NTHREADS = 512;
constexpr int LDS_BYTES = 163840;
constexpr int RING_BYTES = 147456, MISC_OFF = RING_BYTES + 320;
constexpr size_t W_IN = 0, W_OUT = W_IN + (size_t)2816 * 1024 * 2, W_FFI = W_OUT + (size_t)1024 * 1024 * 2, W_FFO = W_FFI + (size_t)5632 * 1024 * 2,
                 W_G = W_FFO + (size_t)1024 * 2816 * 2, W_P = W_G + (size_t)1024 * 1024 * 2, W_LAYER = W_P + (size_t)1024 * 256 * 2;
static_assert(WS_W + 2 * W_LAYER <= WS_XB0, "weights fit");
enum { ST_X1 = 0, ST_MIX = 1, ST_X2 = 2, ST_F = 3, ST_PP = 4, ST_N = 5 };
typedef unsigned long long stat_t;
__host__ __device__ __forceinline__ stat_t* stat_ptr(unsigned char* ws, int L, int idx) { return (stat_t*)(ws + WS_STAT) + (size_t)(L * ST_N + idx) * M; }
static_assert(WS_STAT + (size_t)2 * ST_N * M * 8 <= CTL_ZERO_BYTES && CTL_ZERO_BYTES <= WS_TAB, "stats inside the zeroed region");
__device__ __forceinline__ stat_t ss_enc(float s) { return (stat_t)(s * 16777216.0f); }
__device__ __forceinline__ float ss_dec(stat_t v) { return (float)v * (1.0f / 16777216.0f); }
constexpr int CW_BAR = 4096;

#define XB_TMO      128
#define XB_XCNT(j)  (256  + 64 * (j))
#define XB_XSUB(j)  (1280 + 64 * (j))
#define XB_XGEN(j)  (2304 + 64 * (j))
#define XB_TOP      3328
#define XB_TOPGEN   3392
#define XCD_BAR_WORDS 3456
#define XB_SPIN_CAP (1u << 22)
__device__ __forceinline__ unsigned xb_ld(unsigned* p)              { return __hip_atomic_load(p, __ATOMIC_RELAXED, __HIP_MEMORY_SCOPE_AGENT); }
__device__ __forceinline__ unsigned xb_add(unsigned* p, unsigned v) { return __hip_atomic_fetch_add(p, v, __ATOMIC_RELAXED, __HIP_MEMORY_SCOPE_AGENT); }
__device__ __forceinline__ unsigned xb_xcc_id() { return (unsigned)__builtin_amdgcn_s_getreg((3 << 11) | 20) & 0xFu; }
#define XB_SPIN(cond, bar) do { unsigned _sp = 0; while (cond) { __builtin_amdgcn_s_sleep(1); \
    if ((++_sp & 255u) == 0u) { if (xb_ld(&(bar)[XB_TMO])) break; if (_sp > XB_SPIN_CAP) { atomicAdd(&(bar)[XB_TMO], 1u); break; } } } } while (0)
struct XcdBarrier { unsigned* bar; unsigned x; volatile LAS unsigned* st; };
__device__ __forceinline__ XcdBarrier xcd_barrier_post(unsigned* bar, volatile LAS unsigned* st) {
    XcdBarrier b; b.bar = bar; b.x = xb_xcc_id(); b.st = st;
    if (threadIdx.x == 0) st[2] = xb_add(&bar[XB_XCNT(b.x)], 1u);
    return b;
}
__device__ __forceinline__ void xcd_barrier_complete(unsigned* bar, unsigned x, unsigned& nloc, unsigned& nx, unsigned& uni) {
    const unsigned G = gridDim.x * gridDim.y * gridDim.z;
    unsigned sum, cnt, mine, odd, sp = 0u;
    for (;;) {
        sum = 0u; cnt = 0u; mine = 0u; odd = 0u;
#pragma unroll
        for (unsigned j = 0; j < 16; ++j) { const unsigned c = xb_ld(&bar[XB_XCNT(j)]); sum += c; cnt += (c > 0u) ? 1u : 0u; mine = (j == x) ? c : mine; odd |= (c != 0u && c != 32u) ? 1u : 0u; odd |= (c != 0u && j >= 8u) ? 1u : 0u; }
        if (sum == G) break;
        __builtin_amdgcn_s_sleep(1);
        if ((++sp & 255u) == 0u) { if (xb_ld(&bar[XB_TMO])) break; if (sp > XB_SPIN_CAP) { atomicAdd(&bar[XB_TMO], 1u); break; } }
    }
    nloc = mine > 0u ? mine : 1u; nx = cnt > 0u ? cnt : 1u;
    uni = (sum == G && G == 256u && cnt == 8u && odd == 0u) ? 1u : 0u;
}
__device__ __forceinline__ void xcd_barrier(const XcdBarrier& b, int tid, bool may_local = false) {
    asm volatile("s_waitcnt vmcnt(0)" ::: "memory");
    __syncthreads();
    if (tid == 0) {
        unsigned* bar = b.bar;
        __builtin_amdgcn_s_waitcnt(0);
        unsigned nloc = b.st[0], nx = b.st[1];
        if (nloc == 0u) { unsigned uni; xcd_barrier_complete(bar, b.x, nloc, nx, uni); b.st[0] = nloc; b.st[1] = nx; b.st[3] = uni; }
        const bool local = may_local && b.st[3] != 0u;
        const unsigned old = xb_add(&bar[XB_XSUB(b.x)], 1u);
        const unsigned gen = old / nloc;
        if (old + 1u == (gen + 1u) * nloc) {
            __builtin_amdgcn_fence(__ATOMIC_RELEASE, "agent");
            asm volatile("s_waitcnt vmcnt(0)" ::: "memory");
            if (!local) {
                const unsigned og = xb_add(&bar[XB_TOP], 1u);
                const unsigned tg = og / nx;
                if (og + 1u == (tg + 1u) * nx) xb_add(&bar[XB_TOPGEN], 1u);
                else XB_SPIN(xb_ld(&bar[XB_TOPGEN]) == tg, bar);
            }
            __builtin_amdgcn_fence(__ATOMIC_ACQUIRE, "agent");
            xb_add(&bar[XB_XGEN(b.x)], 1u);
            asm volatile("s_waitcnt vmcnt(0)" ::: "memory");
        } else {
            XB_SPIN(xb_ld(&bar[XB_XGEN(b.x)]) == gen, bar);
            __builtin_amdgcn_fence(__ATOMIC_ACQUIRE, "agent");
            asm volatile("s_waitcnt vmcnt(0)" ::: "memory");
        }
    }
    __syncthreads();
}

__device__ __forceinline__ float fast_rsq(float x) { return __builtin_amdgcn_rsqf(x); }
__device__ __forceinline__ float sigm(float x) { return __builtin_amdgcn_rcpf(1.0f + __builtin_amdgcn_exp2f(-LOG2E_ * x)); }
__device__ __forceinline__ float gelu_t(float x) { return x * sigm(1.5957691216057308f * (x + 0.044715f * x * x * x)); }
__device__ __forceinline__ void unpack8s(const f32x4& v0, const f32x4& v1, float s, float (&o)[8]) {
    o[0] = v0[0] * s; o[1] = v0[1] * s; o[2] = v0[2] * s; o[3] = v0[3] * s; o[4] = v1[0] * s; o[5] = v1[1] * s; o[6] = v1[2] * s; o[7] = v1[3] * s;
}
__device__ __forceinline__ u32x4 pack8(const float (&o)[8]) {
    u32x4 w; w.x = cvt_pk_bf16(o[0], o[1]); w.y = cvt_pk_bf16(o[2], o[3]); w.z = cvt_pk_bf16(o[4], o[5]); w.w = cvt_pk_bf16(o[6], o[7]); return w;
}
__device__ __forceinline__ void ld8f(const float* p, float (&o)[8]) {
    const f32x4 a = *(const f32x4*)p, b = *(const f32x4*)(p + 4);
    o[0] = a[0]; o[1] = a[1]; o[2] = a[2]; o[3] = a[3]; o[4] = b[0]; o[5] = b[1]; o[6] = b[2]; o[7] = b[3];
}
__device__ __forceinline__ void unpack_bf8(const u32x4& r, float (&o)[8]) {
    o[0] = __uint_as_float(r.x << 16); o[1] = __uint_as_float(r.x & 0xffff0000u); o[2] = __uint_as_float(r.y << 16); o[3] = __uint_as_float(r.y & 0xffff0000u);
    o[4] = __uint_as_float(r.z << 16); o[5] = __uint_as_float(r.z & 0xffff0000u); o[6] = __uint_as_float(r.w << 16); o[7] = __uint_as_float(r.w & 0xffff0000u);
}
__device__ __forceinline__ int fresh_lane() { unsigned ones = ~0u; asm volatile("" : "+s"(ones)); return (int)__builtin_amdgcn_mbcnt_hi(ones, __builtin_amdgcn_mbcnt_lo(ones, 0u)); }
#define EPI_ROW(u, ai, wr, m, fr) ((u).pm * 256 + (ai) * 128 + (wr) * 64 + (m) * 16 + (fr))

enum { T_AU, T_AV, T_BQ, T_BK, T_BV, T_BG, T_CQ, T_CK, T_CV };
struct EpiProj {
    static constexpr bool PERM = true, AFTER_DRAIN = false;
    bf16_t* P; const stat_t* ss; const float* ln_w; const float* ln_b; const float* tab;
    template <int TYPE> __device__ __forceinline__ void rows(const f32x4 (&acc)[2][2][4][2], const Unit& u, int wr, int hs, int hrel, int fr, int fq) const {
        const int d0 = 8 * fq, ln_ = fr + 16 * fq;
        float rs[8];
#pragma unroll
        for (int q = 0; q < 8; ++q) rs[q] = ss_dec(ss[EPI_ROW(u, q >> 2, wr, q & 3, fr)]);
        float wa[8], wb[8], ba[8], bb[8];
        if constexpr (TYPE == T_AV) { ld8f(ln_w + hrel * 64 + d0, wa); ld8f(ln_w + hrel * 64 + 32 + d0, wb); ld8f(ln_b + hrel * 64 + d0, ba); ld8f(ln_b + hrel * 64 + 32 + d0, bb); }
#pragma unroll
        for (int hp = 0; hp < 4; ++hp) {
            const int ai = hp >> 1;
            float tc[2][8], tsn[2][8];
            if constexpr (TYPE == T_BQ || TYPE == T_BK) {
#pragma unroll
                for (int mm = 0; mm < 2; ++mm) { const int pos = EPI_ROW(u, ai, wr, 2 * (hp & 1) + mm, fr) & (SEQ - 1); ld8f(tab + TAB_RC + pos * 32 + d0, tc[mm]); ld8f(tab + TAB_RS + pos * 32 + d0, tsn[mm]); }
            }
            if constexpr (TYPE == T_CQ || TYPE == T_CK) {
#pragma unroll
                for (int mm = 0; mm < 2; ++mm) { const int pos = EPI_ROW(u, ai, wr, 2 * (hp & 1) + mm, fr) & (SEQ - 1); ld8f(tab + TAB_SC + pos * 8, tc[mm]); ld8f(tab + TAB_SS + pos * 8, tsn[mm]); }
            }
#pragma unroll
            for (int mm = 0; mm < 2; ++mm) {
                const int m = 2 * (hp & 1) + mm;
                const int row = EPI_ROW(u, ai, wr, m, fr);
                const float rstd = fast_rsq(rs[ai * 4 + m] * (1.0f / D_MODEL) + EPS);
                float a[8], b[8];
                unpack8s(acc[ai][0][m][0], acc[ai][0][m][1], rstd, a); unpack8s(acc[ai][1][m][0], acc[ai][1][m][1], rstd, b);
                if constexpr (TYPE == T_AU) {
#pragma unroll
                    for (int j = 0; j < 8; ++j) { a[j] = gelu_t(a[j]); b[j] = gelu_t(b[j]); }
                } else if constexpr (TYPE == T_AV) {
                    float sm = 0.f;
#pragma unroll
                    for (int j = 0; j < 8; ++j) { a[j] = gelu_t(a[j]); b[j] = gelu_t(b[j]); sm += a[j] + b[j]; }
                    sm += shx(sm, 16, ln_); sm += shx(sm, 32, ln_);
                    const float mu = sm * (1.0f / 64.0f); float q = 0.f;
#pragma unroll
                    for (int j = 0; j < 8; ++j) { a[j] -= mu; b[j] -= mu; q += a[j] * a[j] + b[j] * b[j]; }
                    q += shx(q, 16, ln_); q += shx(q, 32, ln_);
                    const float rsd = fast_rsq(q * (1.0f / 64.0f) + EPS);
#pragma unroll
                    for (int j = 0; j < 8; ++j) { a[j] = a[j] * rsd * wa[j] + ba[j]; b[j] = b[j] * rsd * wb[j] + bb[j]; }
                } else if constexpr (TYPE == T_BQ || TYPE == T_BK) {
                    const float tch = (float)(row & (CHUNK - 1)) * c_log2g[hrel];
                    const float sc = __builtin_amdgcn_exp2f(TYPE == T_BK ? -tch - 3.0f : tch);
#pragma unroll
                    for (int j = 0; j < 8; ++j) { const float x1 = a[j], x2 = b[j]; a[j] = (x1 * tc[mm][j] - x2 * tsn[mm][j]) * sc; b[j] = (x2 * tc[mm][j] + x1 * tsn[mm][j]) * sc; }
                } else if constexpr (TYPE == T_BG) {
#pragma unroll
                    for (int j = 0; j < 8; ++j) { a[j] = a[j] * sigm(a[j]); b[j] = b[j] * sigm(b[j]); }
                } else if constexpr (TYPE == T_CQ || TYPE == T_CK) {
                    float o[8];
#pragma unroll
                    for (int j = 0; j < 8; ++j) o[j] = shx(a[j], 16, ln_);
                    if (fq < 2) {
                        const float sg = fq == 0 ? -1.0f : 1.0f;
#pragma unroll
                        for (int j = 0; j < 8; ++j) a[j] = a[j] * tc[mm][j] + sg * o[j] * tsn[mm][j];
                    }
                }
                bf16_t* dst = P + (size_t)row * IN_W + hs * 64 + d0;
                *(u32x4*)dst = pack8(a); *(u32x4*)(dst + 32) = pack8(b);
            }
        }
    }
    __device__ __forceinline__ void operator()(const f32x4 (&acc)[2][2][4][2], const Unit& u, int wr, int wc, int fr, int fq) const {
        const int ln_ = fresh_lane(); fr = ln_ & 15; fq = ln_ >> 4;
        const int hs = u.pn * 4 + wc;
        if (hs >= NHEADS) return;
        if (hs < H_AV) rows<T_AU>(acc, u, wr, hs, hs - H_AU, fr, fq);
        else if (hs < H_BQ) rows<T_AV>(acc, u, wr, hs, hs - H_AV, fr, fq);
        else if (hs < H_BK) rows<T_BQ>(acc, u, wr, hs, hs - H_BQ, fr, fq);
        else if (hs < H_BV) rows<T_BK>(acc, u, wr, hs, hs - H_BK, fr, fq);
        else if (hs < H_BG) rows<T_BV>(acc, u, wr, hs, hs - H_BV, fr, fq);
        else if (hs < H_CQ) rows<T_BG>(acc, u, wr, hs, hs - H_BG, fr, fq);
        else if (hs < H_CK) rows<T_CQ>(acc, u, wr, hs, hs - H_CQ, fr, fq);
        else if (hs < H_CV) rows<T_CK>(acc, u, wr, hs, hs - H_CK, fr, fq);
        else rows<T_CV>(acc, u, wr, hs, hs - H_CV, fr, fq);
    }
};
struct EpiSwiglu {
    static constexpr bool PERM = true, AFTER_DRAIN = false;
    bf16_t* H; const stat_t* ss; float kscale;
    __device__ __forceinline__ void operator()(const f32x4 (&acc)[2][2][4][2], const Unit& u, int wr, int wc, int fr, int fq) const {
        const int ln_ = fresh_lane(); fr = ln_ & 15; fq = ln_ >> 4;
        float rs[8];
#pragma unroll
        for (int q = 0; q < 8; ++q) rs[q] = ss_dec(ss[EPI_ROW(u, q >> 2, wr, q & 3, fr)]);
#pragma unroll
        for (int ai = 0; ai < 2; ++ai)
#pragma unroll
            for (int m = 0; m < 4; ++m) {
                const int row = EPI_ROW(u, ai, wr, m, fr);
                const float rstd = fast_rsq(rs[ai * 4 + m] * (1.0f / D_MODEL) + EPS) * kscale;
                typedef float f32x2 __attribute__((ext_vector_type(2)));
                const float cexp = -LOG2E_ * rstd, r2 = rstd * rstd;
                unsigned wv4[4];
#pragma unroll
                for (int n = 0; n < 2; ++n)
#pragma unroll
                    for (int hf = 0; hf < 2; ++hf) {
                        const f32x2 ag = {acc[ai][0][m][n][2 * hf], acc[ai][0][m][n][2 * hf + 1]}, au = {acc[ai][1][m][n][2 * hf], acc[ai][1][m][n][2 * hf + 1]};
                        f32x2 e = ag * cexp; e.x = __builtin_amdgcn_exp2f(e.x); e.y = __builtin_amdgcn_exp2f(e.y);
                        f32x2 d = e + 1.0f; d.x = __builtin_amdgcn_rcpf(d.x); d.y = __builtin_amdgcn_rcpf(d.y);
                        const f32x2 hh = ((ag * au) * r2) * d;
                        wv4[2 * n + hf] = cvt_pk_bf16(hh.x, hh.y);
                    }
                const u32x4 g = {wv4[0], wv4[1], wv4[2], wv4[3]};
                *(u32x4*)(H + (size_t)row * D_FF + u.pn * 128 + wc * 32 + 8 * fq) = g;
            }
    }
};
struct EpiStore {
    static constexpr bool PERM = true, AFTER_DRAIN = false;
    bf16_t* O;
    __device__ __forceinline__ void operator()(const f32x4 (&acc)[2][2][4][2], const Unit& u, int wr, int wc, int fr, int fq) const {
        const int ln_ = fresh_lane(); fr = ln_ & 15; fq = ln_ >> 4;
#pragma unroll
        for (int q = 0; q < 8; ++q) {
            const int ai = q >> 2, m = q & 3, row = EPI_ROW(u, ai, wr, m, fr);
#pragma unroll
            for (int bj = 0; bj < 2; ++bj) {
                float v[8]; unpack8s(acc[ai][bj][m][0], acc[ai][bj][m][1], 1.0f, v);
                *(u32x4*)(O + (size_t)row * D_MODEL + u.pn * 256 + bj * 128 + wc * 32 + 8 * fq) = pack8(v);
            }
        }
    }
};
struct EpiNormRes {
    static constexpr bool PERM = true, AFTER_DRAIN = false;
    bf16_t* XB; const float* w; stat_t* ssT; stat_t* ss_out; unsigned* tmo;
    __device__ __forceinline__ void operator()(const f32x4 (&acc)[2][2][4][2], const Unit& u, int wr, int wc, int fr, int fq) const {
        const int ln_ = fresh_lane(); fr = ln_ & 15; fq = ln_ >> 4;
        const int col0 = u.pn * 256 + wc * 32 + 8 * fq;
        float s[8];
#pragma unroll
        for (int q = 0; q < 8; ++q) {
            const int ai = q >> 2, m = q & 3; float sq = 0.f;
#pragma unroll
            for (int bj = 0; bj < 2; ++bj)
#pragma unroll
                for (int n = 0; n < 2; ++n) { const f32x4 v = acc[ai][bj][m][n]; sq += (v[0] * v[0] + v[1] * v[1]) + (v[2] * v[2] + v[3] * v[3]); }
            s[q] = sq;
        }
#pragma unroll
        for (int q = 0; q < 8; ++q) s[q] += shx(s[q], 16, ln_);
#pragma unroll
        for (int q = 0; q < 8; ++q) s[q] += shx(s[q], 32, ln_);
        if (fq == 0) {
#pragma unroll
            for (int q = 0; q < 8; ++q) atomicAdd(ssT + EPI_ROW(u, q >> 2, wr, q & 3, fr), (ss_enc(s[q]) << 8) | 1ull);
        }
        float wv[2][8]; ld8f(w + col0, wv[0]); ld8f(w + col0 + 128, wv[1]);
        u32x4 xr[4][2];
#pragma unroll
        for (int m = 0; m < 4; ++m)
#pragma unroll
            for (int bj = 0; bj < 2; ++bj) xr[m][bj] = *(const u32x4*)(XB + (size_t)EPI_ROW(u, 0, wr, m, fr) * D_MODEL + col0 + bj * 128);
        float rs[8];
        {
            stat_t v[8]; unsigned sp = 0;
            for (;;) {
                bool ok = true;
#pragma unroll
                for (int q = 0; q < 8; ++q) { v[q] = __hip_atomic_load(ssT + EPI_ROW(u, q >> 2, wr, q & 3, fr), __ATOMIC_RELAXED, __HIP_MEMORY_SCOPE_AGENT); ok = ok && ((unsigned)v[q] & 255u) == 16u; }
                if (__all(ok)) break;
                __builtin_amdgcn_s_sleep(1);
                if (++sp > (1u << 22)) { if (ln_ == 0) __hip_atomic_store(tmo, 1u, __ATOMIC_RELAXED, __HIP_MEMORY_SCOPE_AGENT); break; }
            }
#pragma unroll
            for (int q = 0; q < 8; ++q) rs[q] = ss_dec(v[q] >> 8);
        }
        float so[8];
#pragma unroll
        for (int ai = 0; ai < 2; ++ai) {
            if (ai == 1) {
#pragma unroll
                for (int m = 0; m < 4; ++m)
#pragma unroll
                    for (int bj = 0; bj < 2; ++bj) xr[m][bj] = *(const u32x4*)(XB + (size_t)EPI_ROW(u, 1, wr, m, fr) * D_MODEL + col0 + bj * 128);
            }
#pragma unroll
            for (int m = 0; m < 4; ++m) {
                const float rstd = fast_rsq(rs[ai * 4 + m] * (1.0f / D_MODEL) + EPS);
                float sq = 0.f;
#pragma unroll
                for (int bj = 0; bj < 2; ++bj) {
                    float t[8], xv[8]; unpack8s(acc[ai][bj][m][0], acc[ai][bj][m][1], rstd, t); unpack_bf8(xr[m][bj], xv);
#pragma unroll
                    for (int j = 0; j < 8; ++j) { xv[j] += t[j] * wv[bj][j]; sq += xv[j] * xv[j]; }
                    *(u32x4*)(XB + (size_t)EPI_ROW(u, ai, wr, m, fr) * D_MODEL + col0 + bj * 128) = pack8(xv);
                }
                so[ai * 4 + m] = sq;
            }
        }
        if (ss_out) {
#pragma unroll
            for (int q = 0; q < 8; ++q) so[q] += shx(so[q], 16, ln_);
#pragma unroll
            for (int q = 0; q < 8; ++q) so[q] += shx(so[q], 32, ln_);
            if (fq == 0) {
#pragma unroll
                for (int q = 0; q < 8; ++q) atomicAdd(ss_out + EPI_ROW(u, q >> 2, wr, q & 3, fr), ss_enc(so[q]));
            }
        }
    }
};
struct EpiStat {
    static constexpr bool PERM = true, AFTER_DRAIN = false;
    bf16_t* O; stat_t* ss;
    __device__ __forceinline__ void operator()(const f32x4 (&acc)[2][2][4][2], const Unit& u, int wr, int wc, int fr, int fq) const {
        const int ln_ = fresh_lane(); fr = ln_ & 15; fq = ln_ >> 4;
        float s[8];
#pragma unroll
        for (int q = 0; q < 8; ++q) {
            const int ai = q >> 2, m = q & 3, row = EPI_ROW(u, ai, wr, m, fr);
            float sq = 0.f;
#pragma unroll
            for (int bj = 0; bj < 2; ++bj) {
                float v[8]; unpack8s(acc[ai][bj][m][0], acc[ai][bj][m][1], 1.0f, v);
#pragma unroll
                for (int j = 0; j < 8; ++j) sq += v[j] * v[j];
                *(u32x4*)(O + (size_t)row * D_MODEL + u.pn * 256 + bj * 128 + wc * 32 + 8 * fq) = pack8(v);
            }
            s[q] = sq;
        }
#pragma unroll
        for (int q = 0; q < 8; ++q) s[q] += shx(s[q], 16, ln_);
#pragma unroll
        for (int q = 0; q < 8; ++q) s[q] += shx(s[q], 32, ln_);
        if (fq == 0) {
#pragma unroll
            for (int q = 0; q < 8; ++q) atomicAdd(ss + EPI_ROW(u, q >> 2, wr, q & 3, fr), ss_enc(s[q]));
        }
    }
};
struct EpiPle {
    static constexpr bool PERM = true, AFTER_DRAIN = false;
    const bf16_t* XBc; const bf16_t* PP; const stat_t* ss_pp; const float* wple; bf16_t* XBn; stat_t* ss_next; float* xout;
    __device__ __forceinline__ void operator()(const f32x4 (&acc)[2][2][4][2], const Unit& u, int wr, int wc, int fr, int fq) const {
        typedef float f32x2 __attribute__((ext_vector_type(2)));
        const int ln_ = fresh_lane(); fr = ln_ & 15; fq = ln_ >> 4;
        const int col0 = u.pn * 256 + wc * 32 + 8 * fq;
        float rs[8];
        u32x4 wpk[2];
        { float w0[8], w1[8]; ld8f(wple + col0, w0); ld8f(wple + col0 + 128, w1); wpk[0] = pack8(w0); wpk[1] = pack8(w1); }
#pragma unroll
        for (int q = 0; q < 4; ++q) rs[q] = ss_dec(ss_pp[EPI_ROW(u, 0, wr, q, fr)]);
        u32x4 xr[3][2], pr[3][2];
#define PLE_LOAD(b_, set_) do { _Pragma("unroll") for (int mm = 0; mm < 2; ++mm) { const unsigned off_ = ((unsigned)EPI_ROW(u, (b_) >> 2, wr, 2 * (((b_) >> 1) & 1) + mm, fr) * D_MODEL + col0 + ((b_) & 1) * 128) * 2u; \
            xr[set_][mm] = *(const u32x4*)((const char*)XBc + off_); pr[set_][mm] = *(const u32x4*)((const char*)PP + off_); } } while (0)
        PLE_LOAD(0, 0); PLE_LOAD(1, 1);
        stat_t rawB[4];
#pragma unroll
        for (int q = 0; q < 4; ++q) rawB[q] = ss_pp[EPI_ROW(u, 1, wr, q, fr)];
        float rpp2[2] = {0.f, 0.f}, sacc[2] = {0.f, 0.f};
#pragma unroll
        for (int b = 0; b < 8; ++b) {
            const int ai = b >> 2, mp = (b >> 1) & 1, bj = b & 1, set = b % 3;
            if (b + 2 < 8) PLE_LOAD(b + 2, (b + 2) % 3);
            if (b == 2) {
#pragma unroll
                for (int q = 0; q < 4; ++q) rs[4 + q] = ss_dec(rawB[q]);
            }
            const unsigned wq[4] = {wpk[bj].x, wpk[bj].y, wpk[bj].z, wpk[bj].w};
#pragma unroll
            for (int mm = 0; mm < 2; ++mm) {
                const int m = 2 * mp + mm, q = ai * 4 + m;
                if (bj == 0) { rpp2[mm] = fast_rsq(rs[q] * (1.0f / D_MODEL) + EPS); sacc[mm] = 0.f; }
                const float rpp = rpp2[mm];
                const unsigned off = (unsigned)EPI_ROW(u, ai, wr, m, fr) * D_MODEL + col0 + bj * 128;
                const unsigned xw[4] = {xr[set][mm].x, xr[set][mm].y, xr[set][mm].z, xr[set][mm].w}, pw[4] = {pr[set][mm].x, pr[set][mm].y, pr[set][mm].z, pr[set][mm].w};
                f32x2 sq2 = {0.f, 0.f}; f32x2 xo[4];
#pragma unroll
                for (int k = 0; k < 4; ++k) {
                    const f32x2 g = {acc[ai][bj][m][k >> 1][2 * (k & 1)], acc[ai][bj][m][k >> 1][2 * (k & 1) + 1]};
                    f32x2 xv = {__uint_as_float(xw[k] << 16), __uint_as_float(xw[k] & 0xffff0000u)}; const f32x2 pv = {__uint_as_float(pw[k] << 16), __uint_as_float(pw[k] & 0xffff0000u)};
                    const f32x2 wk = {__uint_as_float(wq[k] << 16), __uint_as_float(wq[k] & 0xffff0000u)};
                    f32x2 e = g * (-LOG2E_); e.x = __builtin_amdgcn_exp2f(e.x); e.y = __builtin_amdgcn_exp2f(e.y);
                    f32x2 d = e + 1.0f; d.x = __builtin_amdgcn_rcpf(d.x); d.y = __builtin_amdgcn_rcpf(d.y);
                    xv = xv + d * ((pv * wk) * rpp); sq2 = sq2 + xv * xv; xo[k] = xv;
                }
                if (XBn) { u32x4 o; o.x = cvt_pk_bf16(xo[0].x, xo[0].y); o.y = cvt_pk_bf16(xo[1].x, xo[1].y); o.z = cvt_pk_bf16(xo[2].x, xo[2].y); o.w = cvt_pk_bf16(xo[3].x, xo[3].y); *(u32x4*)((char*)XBn + off * 2u) = o; }
                if (xout) { *(f32x4*)((char*)xout + off * 4u) = (f32x4){xo[0].x, xo[0].y, xo[1].x, xo[1].y}; *(f32x4*)((char*)xout + off * 4u + 16) = (f32x4){xo[2].x, xo[2].y, xo[3].x, xo[3].y}; }
                sacc[mm] += sq2.x + sq2.y;
                if (bj == 1) rs[q] = sacc[mm];
            }
        }
#undef PLE_LOAD
        if (ss_next) {
#pragma unroll
            for (int q = 0; q < 8; ++q) rs[q] += shx(rs[q], 16, ln_);
#pragma unroll
            for (int q = 0; q < 8; ++q) rs[q] += shx(rs[q], 32, ln_);
            if (fq == 0) {
#pragma unroll
                for (int q = 0; q < 8; ++q) atomicAdd(ss_next + EPI_ROW(u, q >> 2, wr, q & 3, fr), ss_enc(rs[q]));
            }
        }
    }
};

__device__ __forceinline__ void ew_rows(bf16_t* XB, const bf16_t* T, const float* w, stat_t* ss_out, int gw, int NGW, int lane) {
    const int hl = lane & 31, hr = lane >> 5;
    float wv[4][8];
#pragma unroll
    for (int j = 0; j < 4; ++j) ld8f(w + 8 * hl + 256 * j, wv[j]);
#pragma unroll 2
    for (int r2 = gw; r2 < M / 2; r2 += NGW) {
        const int row = 2 * r2 + hr; const size_t base = (size_t)row * D_MODEL + 8 * hl;
        u32x4 xr[4], tr[4];
#pragma unroll
        for (int j = 0; j < 4; ++j) { xr[j] = *(const u32x4*)(XB + base + 256 * j); tr[j] = *(const u32x4*)(T + base + 256 * j); }
        float tv[4][8]; float st = 0.f;
#pragma unroll
        for (int j = 0; j < 4; ++j) { unpack_bf8(tr[j], tv[j]);
#pragma unroll
            for (int k = 0; k < 8; ++k) st += tv[j][k] * tv[j][k]; }
#pragma unroll
        for (int o = 1; o < 32; o <<= 1) st += shx(st, o, lane);
        const float rT = fast_rsq(st * (1.0f / D_MODEL) + EPS);
        float s = 0.f;
#pragma unroll
        for (int j = 0; j < 4; ++j) {
            float xv[8]; unpack_bf8(xr[j], xv);
#pragma unroll
            for (int k = 0; k < 8; ++k) { xv[k] += tv[j][k] * rT * wv[j][k]; s += xv[k] * xv[k]; }
            *(u32x4*)(XB + base + 256 * j) = pack8(xv);
        }
        if (ss_out) {
#pragma unroll
            for (int o = 1; o < 32; o <<= 1) s += shx(s, o, lane);
            if (hl == 0) ss_out[row] = ss_enc(s);
        }
    }
}
__device__ __forceinline__ void xprep_rows(const float* x, bf16_t* XB, stat_t* ss_out, int gw, int NGW, int lane) {
    const int hl = lane & 31, hr = lane >> 5;
#pragma unroll 2
    for (int r2 = gw; r2 < M / 2; r2 += NGW) {
        const int row = 2 * r2 + hr; const size_t base = (size_t)row * D_MODEL + 8 * hl;
        float xv[4][8];
#pragma unroll
        for (int j = 0; j < 4; ++j) ld8f(x + base + 256 * j, xv[j]);
        float s = 0.f;
#pragma unroll
        for (int j = 0; j < 4; ++j) {
#pragma unroll
            for (int k = 0; k < 8; ++k) s += xv[j][k] * xv[j][k];
            *(u32x4*)(XB + base + 256 * j) = pack8(xv[j]);
        }
#pragma unroll
        for (int o = 1; o < 32; o <<= 1) s += shx(s, o, lane);
        if (hl == 0) ss_out[row] = ss_enc(s);
    }
}

struct TrDesc { const float* W; const float* gain; bf16_t* WT; int ldw, K, sc, rho0, k0; };
struct TrRegs { f32x4 v[8]; float g[8]; };
__device__ __forceinline__ void tr_load(const TrDesc& d, TrRegs& R, int lane) {
    const int q = lane & 7, r = lane >> 3;
#pragma unroll
    for (int i = 0; i < 8; ++i) {
        const int kk = d.k0 + 8 * i + r;
        R.v[i] = d.sc >= 0 ? *(const f32x4*)(d.W + (size_t)kk * d.ldw + d.sc + 4 * q) : (f32x4){0.f, 0.f, 0.f, 0.f};
        R.g[i] = d.gain ? d.gain[kk] : 1.0f;
    }
}
__device__ __forceinline__ void tr_store(const TrDesc& d, const TrRegs& R, LAS float* scr, int lane) {
    const int q = lane & 7, r = lane >> 3;
#pragma unroll
    for (int i = 0; i < 8; ++i) {
        LAS float* s = scr + (8 * i + r) * 33 + 4 * q;
        s[0] = R.v[i].x * R.g[i]; s[1] = R.v[i].y * R.g[i]; s[2] = R.v[i].z * R.g[i]; s[3] = R.v[i].w * R.g[i];
    }
    asm volatile("s_waitcnt lgkmcnt(0)" ::: "memory");
    const int c = lane & 7;
#pragma unroll
    for (int j = 0; j < 4; ++j) {
        const int n = (lane >> 3) + 8 * j; const LAS float* s = scr + (8 * c) * 33 + n;
        u32x4 o; o.x = cvt_pk_bf16(s[0 * 33], s[1 * 33]); o.y = cvt_pk_bf16(s[2 * 33], s[3 * 33]); o.z = cvt_pk_bf16(s[4 * 33], s[5 * 33]); o.w = cvt_pk_bf16(s[6 * 33], s[7 * 33]);
        *(u32x4*)(d.WT + (size_t)(d.rho0 + n) * d.K + d.k0 + 8 * c) = o;
    }
    asm volatile("s_waitcnt lgkmcnt(0)" ::: "memory");
}

struct Args { const float* in[19]; float* out; unsigned char* ws; int ph_lo, ph_hi, li, pad; };

typedef const __attribute__((address_space(4))) Args* KArgs;
__device__ __forceinline__ KArgs kargs() { KArgs p = (KArgs)__builtin_amdgcn_kernarg_segment_ptr(); asm volatile("" : "+s"(p)); return p; }


__device__ __forceinline__ void prologue(KArgs ap, LAS unsigned char* lds, int gw, int NGW, int wave, int lane) {
    unsigned char* ws = ap->ws;
    LAS float* scr = (LAS float*)(lds + wave * 16384);
    {
        constexpr int I0 = 16 * 88, I1 = 16 * 32, I2 = 16 * 176, I3 = 44 * 32, I4 = 16 * 32, I5 = 4 * 32, IT = I0 + I1 + I2 + I3 + I4 + I5;
        auto desc = [&](int it) -> TrDesc {
            const int L = it >= IT ? 1 : 0; int r = it - L * IT;
            unsigned char* wl = ws + WS_W + (size_t)L * W_LAYER;
            if (r < I0) { const int nb = r % 88, kb = r / 88, pn = nb >> 3, bj = (nb >> 2) & 1, wc = nb & 3, hs = 4 * pn + wc;
                return TrDesc{ap->in[3] + (size_t)L * D_MODEL * IN_W, ap->in[2] + L * D_MODEL, (bf16_t*)(wl + W_IN), IN_W, 1024, hs < NHEADS ? hs * 64 + 32 * bj : -1, nb * 32, kb * 64}; } r -= I0;
            if (r < I1) { const int nb = r % 32, kb = r / 32;
                return TrDesc{ap->in[10] + (size_t)L * D_MODEL * D_MODEL, nullptr, (bf16_t*)(wl + W_OUT), D_MODEL, 1024, nb * 32, nb * 32, kb * 64}; } r -= I1;
            if (r < I2) { const int nb = r % 176, kb = r / 176, pn = nb >> 3, bj = (nb >> 2) & 1, q = nb & 3;
                return TrDesc{ap->in[13] + (size_t)L * D_MODEL * 2 * D_FF, ap->in[12] + L * D_MODEL, (bf16_t*)(wl + W_FFI), 2 * D_FF, 1024, bj * D_FF + 128 * pn + 32 * q, nb * 32, kb * 64}; } r -= I2;
            if (r < I3) { const int nb = r % 32, kb = r / 32;
                return TrDesc{ap->in[14] + (size_t)L * D_FF * D_MODEL, nullptr, (bf16_t*)(wl + W_FFO), D_MODEL, D_FF, nb * 32, nb * 32, kb * 64}; } r -= I3;
            if (r < I4) { const int nb = r % 32, kb = r / 32;
                return TrDesc{ap->in[16] + (size_t)L * D_MODEL * D_MODEL, nullptr, (bf16_t*)(wl + W_G), D_MODEL, 1024, nb * 32, nb * 32, kb * 64}; } r -= I4;
            { const int nb = r % 32, kb = r / 32;
                return TrDesc{ap->in[17] + (size_t)L * PLE_DIM * D_MODEL, nullptr, (bf16_t*)(wl + W_P), D_MODEL, PLE_DIM, nb * 32, nb * 32, kb * 64}; }
        };
        int it = gw;
        if (it < DEPTH * IT) {
            TrDesc d = desc(it); TrRegs R; tr_load(d, R, lane);
            for (;;) {
                const int nx = it + NGW; const bool hn = nx < DEPTH * IT;
                TrDesc dn = d; TrRegs Rn = R;
                if (hn) { dn = desc(nx); tr_load(dn, Rn, lane); }
                tr_store(d, R, scr, lane);
                if (!hn) break;
                d = dn; R = Rn; it = nx;
            }
        }
    }
    {
        float* tab = (float*)(ws + WS_TAB);
        for (int i = gw * 64 + lane; i < 2048 * 32; i += NGW * 64) {
            { const int pos = i >> 5, j = i & 31; const double rev = (double)pos * c_inv_ret[j] * 0.15915494309189535; const float fr = (float)(rev - floor(rev));
              tab[TAB_RC + i] = __builtin_amdgcn_cosf(fr); tab[TAB_RS + i] = __builtin_amdgcn_sinf(fr); }
            if (i < 2048 * 8) { const int pos = i >> 3, j = i & 7; const double rev = (double)pos * c_inv_swa[j] * 0.15915494309189535; const float fr = (float)(rev - floor(rev));
              tab[TAB_SC + i] = __builtin_amdgcn_cosf(fr); tab[TAB_SS + i] = __builtin_amdgcn_sinf(fr); }
        }
    }
    {
        const float* p = ap->in[1]; bf16_t* PB = (bf16_t*)(ws + WS_PB);
        const size_t n8 = (size_t)DEPTH * M * PLE_DIM / 8;
        for (size_t i = (size_t)gw * 64 + lane; i < n8; i += (size_t)NGW * 64) {
            float v[8]; ld8f(p + i * 8, v); *(u32x4*)(PB + i * 8) = pack8(v);
        }
    }
    {
        const float* wsrc = ap->in[6]; bf16_t* Wm = (bf16_t*)(ws + WS_WM);
        for (int i = gw * 64 + lane; i < DEPTH * 4 * CHUNK * CHUNK; i += NGW * 64) { const int s_ = i & 127, t_ = (i >> 7) & 127; Wm[i] = f2bf(s_ <= t_ ? wsrc[i] : 0.f); }
    }
    xprep_rows(ap->in[0], (bf16_t*)(ws + WS_XB0), stat_ptr(ws, 0, ST_X1), gw, NGW, lane);
}

typedef float f32x16 __attribute__((ext_vector_type(16)));
typedef short s16x4 __attribute__((ext_vector_type(4)));
using pg8::bf16x8;
constexpr int TS = 144;
constexpr float LOG2E = 1.4426950408889634f;
__device__ __forceinline__ int crow(int r, int hi) { return (r & 3) + 8 * (r >> 2) + 4 * hi; }
__device__ __forceinline__ s16x4 tr16(LAS const unsigned char* p) { return __builtin_bit_cast(s16x4, __builtin_amdgcn_ds_read_tr16_b64_v4i16((LAS s16x4*)p)); }
__device__ __forceinline__ bf16x8 rd_row(LAS const unsigned char* tile, int row0, int k0, int lane) {
    return *(LAS const bf16x8*)(tile + (row0 + (lane & 31)) * TS + (k0 + 8 * (lane >> 5)) * 2);
}
template <bool PERMK> __device__ __forceinline__ bf16x8 rd_tr(LAS const unsigned char* tile, int k0, int n0, int lane) {
    const int h = lane >> 5, g1 = (lane >> 4) & 1, q = (lane & 15) >> 2, p = lane & 3;
    const int rA = k0 + (PERMK ? 4 * h : 8 * h) + q, rB = rA + (PERMK ? 8 : 4);
    const int cb = (n0 + 16 * g1 + 4 * p) * 2;
    const s16x4 lo = tr16(tile + rA * TS + cb), hi = tr16(tile + rB * TS + cb);
    return (bf16x8){lo[0], lo[1], lo[2], lo[3], hi[0], hi[1], hi[2], hi[3]};
}
__device__ __forceinline__ bf16x8 pack_frag(const f32x16& v, int s) {
    u32x4 w; w.x = cvt_pk_bf16(v[8 * s + 0], v[8 * s + 1]); w.y = cvt_pk_bf16(v[8 * s + 2], v[8 * s + 3]); w.z = cvt_pk_bf16(v[8 * s + 4], v[8 * s + 5]); w.w = cvt_pk_bf16(v[8 * s + 6], v[8 * s + 7]);
    return __builtin_bit_cast(bf16x8, w);
}
#define MFMA32(a, b, c) __builtin_amdgcn_mfma_f32_32x32x16_bf16((a), (b), (c), 0, 0, 0)
template <bool SCALE> __device__ __forceinline__ void load_tile(LAS unsigned char* tile, const bf16_t* g, int rows, int zero_below, float sl, int tid) {
    for (int i = tid; i < rows * 8; i += NTHREADS) {
        const int r = i >> 3, c = i & 7;
        u32x4 v = (u32x4){0u, 0u, 0u, 0u};
        if (r >= zero_below) v = *(const u32x4*)(g + (ptrdiff_t)r * IN_W + c * 8);
        if (SCALE) { float f[8]; unpack_bf8(v, f); const float s = exp2f((float)r * sl);
#pragma unroll
            for (int j = 0; j < 8; ++j) f[j] *= s;
            v = pack8(f); }
        *(LAS u32x4*)(tile + r * TS + c * 16) = v;
    }
}

constexpr int GM_BUF = 2 * CHUNK * TS;
struct GmRegs { u32x4 r[4]; };
__device__ __forceinline__ void gm_load(GmRegs& R, const bf16_t* P, int item, int tid) {
    const int h = item & 3, bc = item >> 2; const size_t row0 = (size_t)bc * CHUNK;
    const int r = tid >> 3, c = tid & 7;
#pragma unroll
    for (int i = 0; i < 2; ++i) {
        R.r[i] = *(const u32x4*)(P + (row0 + r + 64 * i) * IN_W + (H_AU + h) * 64 + c * 8);
        R.r[2 + i] = *(const u32x4*)(P + (row0 + r + 64 * i) * IN_W + (H_AV + h) * 64 + c * 8);
    }
}
__device__ __forceinline__ void gm_write(const GmRegs& R, LAS unsigned char* buf, int tid) {
    const int r = tid >> 3, c = tid & 7;
#pragma unroll
    for (int i = 0; i < 2; ++i) { *(LAS u32x4*)(buf + (r + 64 * i) * TS + c * 16) = R.r[i]; *(LAS u32x4*)(buf + CHUNK * TS + (r + 64 * i) * TS + c * 16) = R.r[2 + i]; }
}
__device__ __forceinline__ void gm_compute(LAS unsigned char* buf, const bf16_t* Wm, const float* bs, bf16_t* Y, int item, int tid, int wave, int lane, volatile LAS unsigned* slotp, unsigned fut) {
    const int h = item & 3, bc = item >> 2; const size_t row0 = (size_t)bc * CHUNK;
    LAS unsigned char* AUs = buf; LAS unsigned char* AVs = buf + CHUNK * TS;
    const int tb = wave >> 1, db = wave & 1, hh = lane >> 5;
    f32x16 acc = {};
    const bf16_t* wrow = Wm + (size_t)(h * CHUNK + 32 * tb + (lane & 31)) * CHUNK + 8 * hh;
    for (int ks = 0; ks < 2 * (tb + 1); ++ks) {
        const bf16x8 a = *(const bf16x8*)(wrow + 16 * ks);
        const bf16x8 b = rd_tr<false>(AVs, 16 * ks, 32 * db, lane);
        acc = MFMA32(a, b, acc);
    }
    const int d = 32 * db + (lane & 31);
#pragma unroll
    for (int r = 0; r < 16; ++r) {
        const int t = 32 * tb + crow(r, hh);
        LAS bf16_t* pu = (LAS bf16_t*)(AUs + t * TS) + d;
        *pu = f2bf(bf2f(*pu) * (acc[r] + bs[h * CHUNK + t]));
    }
    if (tid == 0) *slotp = fut;
    __syncthreads();
    for (int i = tid; i < CHUNK * 8; i += NTHREADS) { const int r = i >> 3, c = i & 7; *(u32x4*)(Y + (row0 + r) * D_MODEL + h * 64 + c * 8) = *(LAS const u32x4*)(AUs + r * TS + c * 16); }
}

constexpr int SWA_K = 0, SWA_V = 384 * TS, SWA_WSF = 2 * 384 * TS, SWA_OST = SWA_WSF + NWAVES * 128, SWA_END = SWA_OST + NWAVES * 4096;
struct SwaRegs { u32x4 k[6], v[6]; };
__device__ __forceinline__ void swa_load(SwaRegs& R, const bf16_t* P, int item, int tid) {
    const int hk = item & 1, cp = (item >> 1) & 7, b = item >> 4;
    const ptrdiff_t rowk0 = (ptrdiff_t)b * SEQ + 256 * cp - 128;
    const int r0 = tid >> 3, c = tid & 7;
#pragma unroll
    for (int i = 0; i < 6; ++i) {
        const int r = r0 + 64 * i;
        if (cp == 0 && r < 128) { R.k[i] = (u32x4){0u, 0u, 0u, 0u}; R.v[i] = (u32x4){0u, 0u, 0u, 0u}; }
        else { R.k[i] = *(const u32x4*)(P + (rowk0 + r) * IN_W + (H_CK + hk) * 64 + c * 8); R.v[i] = *(const u32x4*)(P + (rowk0 + r) * IN_W + (H_CV + hk) * 64 + c * 8); }
    }
}
__device__ __forceinline__ void swa_write(const SwaRegs& R, LAS unsigned char* lds, int tid) {
    const int r0 = tid >> 3, c = tid & 7;
#pragma unroll
    for (int i = 0; i < 6; ++i) { *(LAS u32x4*)(lds + SWA_K + (r0 + 64 * i) * TS + c * 16) = R.k[i]; *(LAS u32x4*)(lds + SWA_V + (r0 + 64 * i) * TS + c * 16) = R.v[i]; }
}
__device__ __forceinline__ void swa_compute(LAS unsigned char* lds, const bf16_t* P, const float* sinks, bf16_t* Y, int item, int wave, int lane) {
    const int hk = item & 1, cp = (item >> 1) & 7, b = item >> 4;
    const size_t rowq0 = (size_t)b * SEQ + 256 * cp;
    LAS unsigned char* Ks = lds + SWA_K; LAS unsigned char* Vs = lds + SWA_V;
    const int qi = lane & 31, hh = lane >> 5;
    LAS float* wsf = (LAS float*)(lds + SWA_WSF + wave * 128);
    LAS unsigned char* ost = lds + SWA_OST + wave * 4096;
    constexpr float SC = 0.125f * LOG2E;
    for (int g = 0; g < 3; ++g) {
        const int qh = 3 * hk + g;
        const bf16_t* qrow = P + (rowq0 + 32 * wave + qi) * IN_W + (H_CQ + qh) * 64 + 8 * hh;
        bf16x8 bq[4];
#pragma unroll
        for (int kd = 0; kd < 4; ++kd) bq[kd] = *(const bf16x8*)(qrow + 16 * kd);
        f32x16 S[5];
#pragma unroll
        for (int kb = 0; kb < 5; ++kb) {
            S[kb] = (f32x16){};
#pragma unroll
            for (int kd = 0; kd < 4; ++kd) S[kb] = MFMA32(rd_row(Ks, 32 * (wave + kb), 16 * kd, lane), bq[kd], S[kb]);
        }
        const float sk = sinks[qh] * LOG2E;
        float m = sk;
#pragma unroll
        for (int kb = 0; kb < 5; ++kb) {
            const bool blk_ok = cp > 0 || wave + kb >= 4;
#pragma unroll
            for (int r = 0; r < 16; ++r) {
                const int cr = crow(r, hh);
                bool ok = blk_ok;
                if (kb == 0) ok = ok && cr > qi;
                if (kb == 4) ok = ok && cr <= qi;
                const float s = ok ? S[kb][r] * SC : -1e30f;
                S[kb][r] = s; m = fmaxf(m, s);
            }
        }
        m = fmaxf(m, shx(m, 32, lane));
        float l = 0.f;
#pragma unroll
        for (int kb = 0; kb < 5; ++kb)
#pragma unroll
            for (int r = 0; r < 16; ++r) { const float p = __builtin_amdgcn_exp2f(S[kb][r] - m); S[kb][r] = p; l += p; }
        l += shx(l, 32, lane);
        l += __builtin_amdgcn_exp2f(sk - m);
        f32x16 O[2]; O[0] = (f32x16){}; O[1] = (f32x16){};
#pragma unroll
        for (int kb = 0; kb < 5; ++kb)
#pragma unroll
            for (int s2 = 0; s2 < 2; ++s2) {
                const bf16x8 a = pack_frag(S[kb], s2);
#pragma unroll
                for (int db = 0; db < 2; ++db) O[db] = MFMA32(a, rd_tr<true>(Vs, 32 * (wave + kb) + 16 * s2, 32 * db, lane), O[db]);
            }
        if (hh == 0) wsf[qi] = __builtin_amdgcn_rcpf(l);
        asm volatile("s_waitcnt lgkmcnt(0)" ::: "memory");
#pragma unroll
        for (int r = 0; r < 16; ++r) {
            const int q = crow(r, hh); const float rl = wsf[q];
#pragma unroll
            for (int db = 0; db < 2; ++db) *((LAS bf16_t*)(ost + q * 128) + 32 * db + qi) = f2bf(O[db][r] * rl);
        }
        asm volatile("s_waitcnt lgkmcnt(0)" ::: "memory");
#pragma unroll
        for (int i = 0; i < 4; ++i) { const int row = i * 8 + (lane >> 3), ch = lane & 7;
            *(u32x4*)(Y + (rowq0 + 32 * wave + row) * D_MODEL + 640 + qh * 64 + ch * 8) = *(LAS const u32x4*)(ost + row * 128 + ch * 16); }
        asm volatile("s_waitcnt lgkmcnt(0)" ::: "memory");
    }
}

constexpr int RT_Q = 0, RT_K = CHUNK * TS, RT_V = 2 * CHUNK * TS, RT_S = 3 * CHUNK * TS, RT_O = RT_S + 64 * TS, RT_X = RT_O + CHUNK * 68 * 4, RT_END = RT_X + 16384;
struct RetRegs { u32x4 q[2], k[2], v[2], g[2]; };
__device__ __forceinline__ void ret_load(RetRegs& R, const bf16_t* P, size_t row0, int h, int tid) {
    const int r0 = tid >> 3, c = tid & 7;
#pragma unroll
    for (int i = 0; i < 2; ++i) {
        const bf16_t* pr = P + (row0 + r0 + 64 * i) * IN_W + c * 8;
        R.q[i] = *(const u32x4*)(pr + (H_BQ + h) * 64); R.k[i] = *(const u32x4*)(pr + (H_BK + h) * 64); R.v[i] = *(const u32x4*)(pr + (H_BV + h) * 64);
    }
    const int row = tid >> 2, part = tid & 3;
    const bf16_t* gp = P + (row0 + row) * IN_W + (H_BG + h) * 64 + 16 * part;
    R.g[0] = *(const u32x4*)gp; R.g[1] = *(const u32x4*)(gp + 8);
}
typedef float f32x2m __attribute__((ext_vector_type(2)));
__device__ __forceinline__ u32x4 scale_bf8(const u32x4& r, float sc) {
    const unsigned w[4] = {r.x, r.y, r.z, r.w}; unsigned o[4];
#pragma unroll
    for (int k = 0; k < 4; ++k) { f32x2m v = {__uint_as_float(w[k] << 16), __uint_as_float(w[k] & 0xffff0000u)}; v = v * sc; o[k] = cvt_pk_bf16(v.x, v.y); }
    return (u32x4){o[0], o[1], o[2], o[3]};
}
__device__ __forceinline__ void ret_write(const RetRegs& R, LAS unsigned char* lds, int tid) {
    const int r0 = tid >> 3, c = tid & 7;
#pragma unroll
    for (int i = 0; i < 2; ++i) {
        const int r = r0 + 64 * i;
        *(LAS u32x4*)(lds + RT_Q + r * TS + c * 16) = R.q[i];
        *(LAS u32x4*)(lds + RT_K + r * TS + c * 16) = R.k[i];
        *(LAS u32x4*)(lds + RT_V + r * TS + c * 16) = R.v[i];
    }
}
__device__ __forceinline__ void ret_item(LAS unsigned char* lds, const bf16_t* P, const float* gn_w, bf16_t* Y, int item, int tid, int wave, int lane, volatile LAS unsigned* slotp, unsigned fut) {
    const int h = item % 6, b = item / 6;
    const float lg = c_log2g[h];
    const float g1 = exp2f(lg), g127 = exp2f(127.f * lg), g128 = exp2f(128.f * lg);
    LAS unsigned char* Qs = lds + RT_Q; LAS unsigned char* Ks = lds + RT_K; LAS unsigned char* Vs = lds + RT_V; LAS unsigned char* Sb = lds + RT_S;
    LAS float* Os = (LAS float*)(lds + RT_O); LAS float* Xs = (LAS float*)(lds + RT_X);
    const int tb = wave >> 1, eb = wave & 1, qi = lane & 31, hh = lane >> 5;
    const int db = (wave >> 1) & 1, kh = wave >> 2;
    const int erow = tid >> 2, part = tid & 3;
    float gw0[8], gw1[8]; ld8f(gn_w + h * 64 + 16 * part, gw0); ld8f(gn_w + h * 64 + 16 * part + 8, gw1);
    f32x16 st = {};
    RetRegs R; ret_load(R, P, (size_t)b * SEQ, h, tid);
    for (int c = 0; c < 16; ++c) {
        const size_t row0 = (size_t)b * SEQ + (size_t)c * CHUNK;
        ret_write(R, lds, tid);
        const u32x4 gq0 = R.g[0], gq1 = R.g[1];
        __syncthreads();
        if (c + 1 < 16) ret_load(R, P, row0 + CHUNK, h, tid);
        f32x16 O = {};
        for (int sb = 0; sb <= tb; ++sb) {
            f32x16 S = {};
#pragma unroll
            for (int kd = 0; kd < 4; ++kd) S = MFMA32(rd_row(Ks, 32 * sb, 16 * kd, lane), rd_row(Qs, 32 * tb, 16 * kd, lane), S);
            if (sb == tb) {
#pragma unroll
                for (int r = 0; r < 16; ++r) S[r] = crow(r, hh) <= qi ? S[r] : 0.f;
            }
#pragma unroll
            for (int s2 = 0; s2 < 2; ++s2) O = MFMA32(pack_frag(S, s2), rd_tr<true>(Vs, 32 * sb + 16 * s2, 32 * eb, lane), O);
        }
        if (c > 0) {
#pragma unroll
            for (int kd = 0; kd < 4; ++kd) O = MFMA32(rd_row(Qs, 32 * tb, 16 * kd, lane), rd_row(Sb, 32 * eb, 16 * kd, lane), O);
        }
#pragma unroll
        for (int r = 0; r < 16; ++r) Os[(32 * tb + crow(r, hh)) * 68 + 32 * eb + qi] = O[r];
        if (c + 1 < 16) {
            f32x16 acc = {};
#pragma unroll
            for (int ks = 0; ks < 4; ++ks) acc = MFMA32(rd_tr<false>(Vs, 64 * kh + 16 * ks, 32 * eb, lane), rd_tr<false>(Ks, 64 * kh + 16 * ks, 32 * db, lane), acc);
#pragma unroll
            for (int r = 0; r < 16; ++r) st[r] = st[r] * g128 + g127 * acc[r];
            if (kh == 1) {
#pragma unroll
                for (int r = 0; r < 16; ++r) Xs[((eb * 2 + db) * 16 + r) * 64 + lane] = st[r];
            }
        }
        __syncthreads();
        if (c + 1 < 16 && kh == 0) {
#pragma unroll
            for (int r = 0; r < 16; ++r) { const int e = 32 * eb + crow(r, hh), d = 32 * db + qi; const float sv = (st[r] + Xs[((eb * 2 + db) * 16 + r) * 64 + lane]) * g1; *((LAS bf16_t*)(Sb + e * TS) + d) = (bf16_t)cvt_pk_bf16(sv, sv); }
        }
        {
            float v[16]; float s = 0.f;
#pragma unroll
            for (int j = 0; j < 16; ++j) { v[j] = Os[erow * 68 + 16 * part + j]; s += v[j]; }
            s += shx(s, 1, lane); s += shx(s, 2, lane);
            const float mu = s * (1.0f / 64.0f); float q = 0.f;
#pragma unroll
            for (int j = 0; j < 16; ++j) { v[j] -= mu; q += v[j] * v[j]; }
            q += shx(q, 1, lane); q += shx(q, 2, lane);
            const float rs = fast_rsq(q * (1.0f / 64.0f) + EPS);
            float ga[8], gb[8], o0[8], o1[8];
            unpack_bf8(gq0, ga); unpack_bf8(gq1, gb);
#pragma unroll
            for (int j = 0; j < 8; ++j) { o0[j] = (ga[j] * gw0[j]) * (v[j] * rs); o1[j] = (gb[j] * gw1[j]) * (v[8 + j] * rs); }
            bf16_t* yp = Y + (row0 + erow) * D_MODEL + 256 + h * 64 + 16 * part;
            *(u32x4*)yp = pack8(o0); *(u32x4*)(yp + 8) = pack8(o1);
        }
    }
    if (tid == 0) *slotp = fut;
    __syncthreads();
}

constexpr int CW_TMO = 1024;
constexpr int CW_QUEUE = 2048;
constexpr int MQ_RET = 192, MQ_SWA = MQ_RET + 512, MQ_ALL = MQ_SWA + 2048;
__device__ __forceinline__ void mixers(KArgs ap, int L, LAS unsigned char* lds, int tid, int wave, int lane, int grp) {
    unsigned char* ws = ap->ws;
    const bf16_t* P = (const bf16_t*)(ws + WS_BIG); bf16_t* Y = (bf16_t*)(ws + WS_Y);
    const bf16_t* Wm = (const bf16_t*)(ws + WS_WM) + (size_t)L * 4 * CHUNK * CHUNK;
    const float* gbs = ap->in[7] + L * 4 * CHUNK; const float* gn_w = ap->in[8] + L * 384; const float* sinks = ap->in[9] + L * 6;
    const bool gq = grp >= 0;
    const unsigned q_ret = gq ? MQ_RET / 8 : MQ_RET, q_swa = gq ? MQ_SWA / 8 : MQ_SWA, q_all = gq ? MQ_ALL / 8 : MQ_ALL;
    const int o_ret = gq ? grp * (MQ_RET / 8) : 0, o_swa = gq ? grp * ((MQ_SWA - MQ_RET) / 8) : 0, o_gm = gq ? grp * ((MQ_ALL - MQ_SWA) / 8) : 0;
    unsigned* head = (unsigned*)ws + CW_QUEUE + 64 * (gq ? 2 + 8 * L + grp : L);
    volatile LAS unsigned* slot = (volatile LAS unsigned*)(lds + MISC_OFF + 64);
    if (tid == 0) slot[0] = atomicAdd(head, 1u);
    __syncthreads();
    unsigned cur = (unsigned)__builtin_amdgcn_readfirstlane((int)slot[0]);
    __syncthreads();
    if (tid == 0) slot[1] = atomicAdd(head, 1u);
    __syncthreads();
    unsigned nxt = (unsigned)__builtin_amdgcn_readfirstlane((int)slot[1]);
    int k = 0;
#define MQ_FETCH() unsigned fut = 0u; if (tid == 0) fut = atomicAdd(head, 1u)
#define MQ_ADVANCE() do { cur = nxt; nxt = (unsigned)__builtin_amdgcn_readfirstlane((int)slot[k]); k ^= 1; } while (0)
    while (cur < q_all) {
        if (cur < q_ret) {
            MQ_FETCH();
            ret_item(lds, P, gn_w, Y, (int)cur + o_ret, tid, wave, lane, slot + k, fut);
            MQ_ADVANCE();
        } else if (cur < q_swa) {
            MQ_FETCH();
            { SwaRegs R; swa_load(R, P, (int)(cur - q_ret) + o_swa, tid); swa_write(R, lds, tid); }
            __syncthreads();
            swa_compute(lds, P, sinks, Y, (int)(cur - q_ret) + o_swa, wave, lane);
            if (tid == 0) slot[k] = fut;
            __syncthreads();
            MQ_ADVANCE();
        } else {
            GmRegs R; gm_load(R, P, (int)(cur - q_swa) + o_gm, tid);
            int bsel = 0;
            for (;;) {
                MQ_FETCH();
                LAS unsigned char* buf = lds + bsel * GM_BUF;
                gm_write(R, buf, tid);
                __syncthreads();
                const bool more = nxt < q_all;
                if (more) gm_load(R, P, (int)(nxt - q_swa) + o_gm, tid);
                gm_compute(buf, Wm, gbs, Y, (int)(cur - q_swa) + o_gm, tid, wave, lane, slot + k, fut);
                MQ_ADVANCE(); bsel ^= 1;
                if (!more) break;
            }
            __syncthreads();
        }
    }
#undef MQ_FETCH
#undef MQ_ADVANCE
    __syncthreads();
}

#ifndef PG8_SP2
#define PG8_SP2 true
#endif
#ifndef PG8_ALIGN
#define PG8_ALIGN true
#endif
constexpr int N_PHASES = 1 + 8 * DEPTH;
#ifndef PHMASK
#define PHMASK 0x1ff
#endif
#ifndef DUP_MASK
#define DUP_MASK 0
#endif
#define NREP(bit) ((DUP_MASK & (bit)) ? 2 : 1)
#ifndef KREP3
#define KREP3 1
#endif
__global__ void __launch_bounds__(NTHREADS, 2) mega(Args a_) {
    extern __shared__ __attribute__((aligned(16))) unsigned char lds_raw[];
    LAS unsigned char* lds = (LAS unsigned char*)lds_raw;
    const int G = gridDim.x, bid = blockIdx.x;
    const int vcu = (G % 8 == 0) ? (bid % 8) * (G / 8) + bid / 8 : bid;
    const int NGW = G * NWAVES;
    const int wave0 = __builtin_amdgcn_readfirstlane((int)threadIdx.x >> 6);
#define opq_tid() pg8::pg8_tid(wave0)
    { const int tid = opq_tid(); for (int u = tid; u < (LDS_BYTES - RING_BYTES) / 4; u += NTHREADS) ((LAS unsigned*)(lds + RING_BYTES))[u] = 0u; }
    __syncthreads();
    XcdBarrier bar = xcd_barrier_post((unsigned*)kargs()->ws + CW_BAR + kargs()->li * XCD_BAR_WORDS, (volatile LAS unsigned*)(lds + MISC_OFF));
    const int lo = kargs()->ph_lo, hi = kargs()->ph_hi;
#define IN(k) (lo <= (k) && (k) < hi)
#define SEAM(k) do { if (IN(k) && IN((k) + 1)) xcd_barrier(bar, opq_tid(), (k) > 0); } while (0)
#define VBID() ({ volatile LAS unsigned* st_ = (volatile LAS unsigned*)(lds + MISC_OFF); (int)__builtin_amdgcn_readfirstlane(st_[3] ? (int)(st_[2] * 8u + bar.x) : bid); })
#define VGRP() ({ volatile LAS unsigned* st_ = (volatile LAS unsigned*)(lds + MISC_OFF); (int)__builtin_amdgcn_readfirstlane(st_[3] ? (int)bar.x : -1); })
#define LANE_VARS const int tid_ = opq_tid(), lane = tid_ & 63, wave = __builtin_amdgcn_readfirstlane(tid_ >> 6), gw = vcu * NWAVES + wave
    if (IN(0) && (PHMASK & 1)) for (int rep = 0; rep < NREP(1); ++rep) { LANE_VARS; prologue(kargs(), lds, gw, NGW, wave, lane); }
    SEAM(0);
#define OPQ(p) ({ auto _p = (p); asm volatile("" : "+s"(_p)); _p; })
    for (int L = 0; L < DEPTH; ++L) {
        const int p0 = 1 + 8 * L;
        if (IN(p0 + 0) && (PHMASK & 2)) for (int rep = 0; rep < NREP(2); ++rep) {
            KArgs ap = kargs(); unsigned char* wsp = ap->ws; const int Lp = OPQ(L);
            pg8::Gemm g{(const bf16_t*)(wsp + ((Lp & 1) ? WS_XB1 : WS_XB0)), (const bf16_t*)(wsp + WS_W + (size_t)Lp * W_LAYER + W_IN), M, 2816, 1024}; pg8::StaticOrder S; S.init(M, 2816, G, VBID());
            EpiProj E{(bf16_t*)(wsp + WS_BIG), stat_ptr(wsp, Lp, ST_X1), ap->in[4] + Lp * 256, ap->in[5] + Lp * 256, (const float*)(wsp + WS_TAB)};
            pg8::gemm_phase<EpiProj, pg8::StaticOrder, PG8_ALIGN, PG8_SP2>(lds, g, S, E, wave0);
        }
        SEAM(p0 + 0);
        if (IN(p0 + 1) && (PHMASK & 4)) {
            LANE_VARS; (void)gw; mixers(kargs(), OPQ(L), lds, tid_, wave, lane, VGRP());
        }
        SEAM(p0 + 1);
        if (IN(p0 + 2) && (PHMASK & 8)) {
            KArgs ap = kargs(); unsigned char* wsp = ap->ws; const int Lp = OPQ(L);
            pg8::Gemm g{(const bf16_t*)(wsp + WS_Y), (const bf16_t*)(wsp + WS_W + (size_t)Lp * W_LAYER + W_OUT), M, 1024, 1024}; pg8::StaticOrder S; S.init(M, 1024, G, VBID());
            EpiNormRes E{(bf16_t*)(wsp + ((Lp & 1) ? WS_XB1 : WS_XB0)), ap->in[11] + Lp * D_MODEL, stat_ptr(wsp, Lp, ST_MIX), stat_ptr(wsp, Lp, ST_X2), (unsigned*)wsp + CW_TMO};
            pg8::gemm_phase<EpiNormRes, pg8::StaticOrder, PG8_ALIGN, PG8_SP2>(lds, g, S, E, wave0);
        }
        SEAM(p0 + 2);
        if (IN(p0 + 4) && (PHMASK & 32)) for (int rep = 0; rep < NREP(32); ++rep) {
            KArgs ap = kargs(); unsigned char* wsp = ap->ws; const int Lp = OPQ(L);
            pg8::Gemm g{(const bf16_t*)(wsp + ((Lp & 1) ? WS_XB1 : WS_XB0)), (const bf16_t*)(wsp + WS_W + (size_t)Lp * W_LAYER + W_FFI), M, 5632, 1024}; pg8::StaticOrder S; S.init(M, 5632, G, VBID());
            EpiSwiglu E{(bf16_t*)(wsp + WS_BIG), stat_ptr(wsp, Lp, ST_X2), 1.0f / KREP3};
            pg8::gemm_phase<EpiSwiglu, pg8::StaticOrder, PG8_ALIGN, PG8_SP2, KREP3>(lds, g, S, E, wave0);
        }
        SEAM(p0 + 4);
        if (IN(p0 + 5) && (PHMASK & 64)) {
            { KArgs ap = kargs(); unsigned char* wsp = ap->ws; const int Lp = OPQ(L);
              pg8::Gemm g{(const bf16_t*)(wsp + WS_BIG), (const bf16_t*)(wsp + WS_W + (size_t)Lp * W_LAYER + W_FFO), M, 1024, D_FF}; pg8::StaticOrder S; S.init(M, 1024, G, VBID());
              EpiNormRes E{(bf16_t*)(wsp + ((Lp & 1) ? WS_XB1 : WS_XB0)), ap->in[15] + Lp * D_MODEL, stat_ptr(wsp, Lp, ST_F), nullptr, (unsigned*)wsp + CW_TMO};
              pg8::gemm_phase<EpiNormRes, pg8::StaticOrder, PG8_ALIGN, PG8_SP2>(lds, g, S, E, wave0); }
            { KArgs ap = kargs(); unsigned char* wsp = ap->ws; const int Lp = OPQ(L);
              pg8::Gemm g{(const bf16_t*)(wsp + WS_PB) + (size_t)Lp * M * PLE_DIM, (const bf16_t*)(wsp + WS_W + (size_t)Lp * W_LAYER + W_P), M, 1024, PLE_DIM}; pg8::StaticOrder S; S.init(M, 1024, G, VBID());
              EpiStat E{(bf16_t*)(wsp + WS_MIX), stat_ptr(wsp, Lp, ST_PP)};
              pg8::gemm_phase<EpiStat, pg8::StaticOrder, PG8_ALIGN, PG8_SP2>(lds, g, S, E, wave0); }
        }
        SEAM(p0 + 5);
        if (IN(p0 + 7) && (PHMASK & 256)) {
            KArgs ap = kargs(); unsigned char* wsp = ap->ws; const int Lp = OPQ(L);
            const bf16_t* XBc = (const bf16_t*)(wsp + ((Lp & 1) ? WS_XB1 : WS_XB0));
            pg8::Gemm g{XBc, (const bf16_t*)(wsp + WS_W + (size_t)Lp * W_LAYER + W_G), M, 1024, 1024}; pg8::StaticOrder S; S.init(M, 1024, G, VBID());
            const bool last = (Lp == DEPTH - 1);
            EpiPle E{XBc, (const bf16_t*)(wsp + WS_MIX), stat_ptr(wsp, Lp, ST_PP), ap->in[18] + Lp * D_MODEL, last ? nullptr : (bf16_t*)(wsp + ((Lp & 1) ? WS_XB0 : WS_XB1)), last ? nullptr : stat_ptr(wsp, Lp + 1, ST_X1), last ? ap->out : nullptr};
            pg8::gemm_phase<EpiPle, pg8::StaticOrder, PG8_ALIGN, PG8_SP2>(lds, g, S, E, wave0);
        }
        SEAM(p0 + 7);
    }
#undef IN
#undef SEAM
#undef VBID
#undef VGRP
#undef LANE_VARS
#undef opq_tid
}

extern "C" void kernel_launch(void* const* d_in, const int* in_sizes, int n_in, void* d_out, int out_size, void* d_ws, size_t ws_size, hipStream_t stream) {
    static int grid = 0;
    if (grid == 0) {
        if (n_in != 19 || out_size != M * D_MODEL || ws_size < WS_END) { fprintf(stderr, "kernel_launch: unexpected shapes (n_in %d out %d ws %zu)\n", n_in, out_size, ws_size); grid = -1; return; }
        int dev = 0, cus = 0, per_cu = 0;
        if (hipGetDevice(&dev) != hipSuccess || hipDeviceGetAttribute(&cus, hipDeviceAttributeMultiprocessorCount, dev) != hipSuccess) { grid = -1; return; }
        if (hipFuncSetAttribute((const void*)mega, hipFuncAttributeMaxDynamicSharedMemorySize, LDS_BYTES) != hipSuccess) { fprintf(stderr, "kernel_launch: hipFuncSetAttribute failed\n"); grid = -1; return; }
        if (hipOccupancyMaxActiveBlocksPerMultiprocessor(&per_cu, (const void*)mega, NTHREADS, LDS_BYTES) != hipSuccess || per_cu < 1) { fprintf(stderr, "kernel_launch: occupancy query says %d\n", per_cu); }
        (void)hipGetLastError();
        grid = cus >= 256 ? 256 : cus;
    }
    if (grid < 0) return;
    unsigned char* ws = (unsigned char*)d_ws;
    (void)hipMemsetAsync(ws + WS_CTL, 0, CTL_ZERO_BYTES, stream);
    Args a{};
    for (int i = 0; i < 19; ++i) a.in[i] = (const float*)d_in[i];
    a.out = (float*)d_out; a.ws = ws; a.li = 0; a.pad = 0;
    a.ph_lo = 0; a.ph_hi = N_PHASES;
    hipLaunchKernelGGL(mega, dim3(grid), dim3(NTHREADS), LDS_BYTES, stream, a);
}
```

```cpp
#include <hip/hip_runtime.h>
#include <stdint.h>
#include <stdio.h>

constexpr int D_MODEL = 1024, BATCH = 32, SEQ = 2048, DEPTH = 2, PLE_DIM = 256, HD = 64, CHUNK = 128;
constexpr int M = BATCH * SEQ;
constexpr int IN_W = 2688, D_FF = 2816, NHEADS = 42;
constexpr int H_AU = 0, H_AV = 4, H_BQ = 8, H_BK = 14, H_BV = 20, H_BG = 26, H_CQ = 32, H_CK = 38, H_CV = 40;
constexpr float EPS = 1e-6f;
typedef unsigned short bf16_t;

__device__ __forceinline__ float bf2f(bf16_t v) { return __uint_as_float(((unsigned)v) << 16); }
__device__ __forceinline__ bf16_t f2bf(float f) { unsigned u = __float_as_uint(f); return (bf16_t)((u + 0x7fffu + ((u >> 16) & 1u)) >> 16); }
__device__ __forceinline__ float shx(float v, int mask, int lane) { return __int_as_float(__builtin_amdgcn_ds_bpermute((lane ^ mask) << 2, __float_as_int(v))); }
__device__ __forceinline__ float wave_sum(float v) {
#pragma unroll
    for (int o = 1; o < 64; o <<= 1) v += __shfl_xor(v, o);
    return v;
}
constexpr float LOG2E_ = 1.4426950408889634f;

__constant__ double c_inv_ret[32] = {1.0, 0.7498942093324559, 0.5623413251903491, 0.4216965034285822, 0.31622776601683794, 0.23713737056616552, 0.1778279410038923, 0.1333521432163324, 0.1, 0.07498942093324558, 0.05623413251903491, 0.042169650342858224, 0.03162277660168379, 0.023713737056616554, 0.01778279410038923, 0.01333521432163324, 0.01, 0.007498942093324558, 0.005623413251903491, 0.004216965034285823, 0.0031622776601683794, 0.0023713737056616554, 0.0017782794100389228, 0.001333521432163324, 0.001, 0.0007498942093324559, 0.0005623413251903491, 0.00042169650342858224, 0.00031622776601683794, 0.00023713737056616554, 0.00017782794100389227, 0.0001333521432163324};
__constant__ double c_inv_swa[8] = {1.0, 0.19392274474868576, 0.03760603093086393, 0.007292664737217109, 0.001414213562373095, 0.0002742481756762073, 5.318295896944988e-05, 1.031338537721246e-05};
__constant__ float c_log2g[6] = {-0.04580368961312479f, -0.02272007650008353f, -0.011315313227834146f, -0.005646563141142063f, -0.0028205190623786626f, -0.0014095702546713536f};

constexpr size_t MiB = 1u << 20;
constexpr size_t WS_CTL = 0, CTL_ZERO_BYTES = 7 * MiB;
constexpr size_t WS_STAT = 1 * MiB;
constexpr size_t WS_TAB = 7 * MiB;
constexpr size_t WS_WM = 7 * MiB + 768 * 1024;
constexpr size_t WS_W = 8 * MiB;
constexpr size_t WS_XB0 = 64 * MiB;
constexpr size_t WS_BIG = 192 * MiB;
constexpr size_t WS_Y = 544 * MiB;
constexpr size_t WS_MIX = 672 * MiB;
constexpr size_t WS_XB1 = 800 * MiB;
constexpr size_t WS_PB = 928 * MiB;
constexpr size_t WS_END = 992 * MiB;
constexpr int TAB_RC = 0, TAB_RS = 2048 * 32, TAB_SC = 2 * 2048 * 32, TAB_SS = 2 * 2048 * 32 + 2048 * 8;


namespace pg8 {
#define PG8_LAS __attribute__((address_space(3)))
typedef unsigned short bf16_t;
typedef short bf16x8 __attribute__((ext_vector_type(8)));
typedef float f32x4 __attribute__((ext_vector_type(4)));
typedef unsigned u32x4 __attribute__((ext_vector_type(4)));
constexpr int BM = 256, BK = 64, HALF = 128, HTB = HALF * BK * 2  , STAGE_BYTES = 8 * HTB, NXCD = 8, WGM = 8;

__host__ __device__ __forceinline__ int lds_byte(int r, int c) { const int st = (r >> 4) * 2 + (c >> 5), rr = r & 15, cc = c & 31, ob = rr * 64 + cc * 2; return st * 1024 + (ob ^ (((ob >> 9) & 1) << 5)); }
__host__ __device__ __forceinline__ void stage_rc(int b, int& R, int& C) { const int st = b / 1024, sb = b % 1024, swz = sb ^ (((sb >> 9) & 1) << 5); R = (st >> 1) * 16 + swz / 64; C = (st & 1) * 32 + (swz % 64) / 2; }
__host__ __device__ __forceinline__ int perm32(int rho) { const int n = rho >> 4, i = rho & 15; return 8 * (i >> 2) + 4 * n + (i & 3); }

constexpr int PREF_OFF = 147456 + 4096;
struct Unit { int pm, pn; };
struct Gemm { const bf16_t* A; const bf16_t* Bt; int M, N, K; };

struct StaticOrder {
    int nM, nN, nwg, G, c, wgm;
    __host__ __device__ void init(int M, int N, int G_, int c_) { nM = M / BM; nN = N / BM; nwg = nM * nN; G = G_; c = c_; wgm = nN >= 8 ? 4 : WGM; }
    __host__ __device__ bool next(int i, Unit& u) const {
        const long L = (long)i * G + c; if (L >= nwg) return false;
        int wgid = (int)L; { const int q = nwg / NXCD, r = nwg % NXCD, xcd = wgid % NXCD, off = wgid / NXCD; wgid = (xcd < r ? xcd * (q + 1) : r * (q + 1) + (xcd - r) * q) + off; }
        const int nig = wgm * nN, gid = wgid / nig, fm = gid * wgm, gsz = (nM - fm) < wgm ? (nM - fm) : wgm;
        u.pm = fm + ((wgid % nig) % gsz); u.pn = (wgid % nig) / gsz; return true;
    }
    __device__ __forceinline__ void a_ready(const Unit&) const {}
    __device__ __forceinline__ void done(const Unit&) const {}
};

typedef float f32x2_cv __attribute__((ext_vector_type(2))); typedef __bf16 bf16x2_cv __attribute__((ext_vector_type(2)));
__device__ __forceinline__ unsigned cvt_pk_bf16(float lo, float hi) { const f32x2_cv v = {lo, hi}; const bf16x2_cv b = __builtin_convertvector(v, bf16x2_cv); return __builtin_bit_cast(unsigned, b); }
__device__ __forceinline__ int pg8_tid(int wave0) {
    unsigned ones = ~0u; asm volatile("" : "+s"(ones));
    return wave0 * 64 + (int)__builtin_amdgcn_mbcnt_hi(ones, __builtin_amdgcn_mbcnt_lo(ones, 0u));
}
template <class Epi, class Sched, bool ALIGN_EPI = false, bool SP2 = false, int KREP = 1>
__device__ __forceinline__ void gemm_phase(PG8_LAS unsigned char* lds, const Gemm g, const Sched& S, const Epi& E, int wave0) {
    const int tid = pg8_tid(wave0);
    const int wid = __builtin_amdgcn_readfirstlane(tid >> 6), lane = tid & 63, wr = wid >> 2, wc = wid & 3, fr = lane & 15, fq = lane >> 4;
    const int K = g.K, nt = K / BK;
    unsigned voffA[2], voffB[2];
#pragma unroll
    for (int i = 0; i < 2; ++i) { int R, C; stage_rc(tid * 16 + i * 8192, R, C); const int Rb = Epi::PERM ? ((R & ~31) + perm32(R & 31)) : R;
        voffA[i] = (unsigned)(R * K + C) * 2u; voffB[i] = (unsigned)(Rb * K + C) * 2u; }
    const size_t kstep = (size_t)(BK * 2);
    const size_t hstep = (size_t)HALF * K * 2;
    const size_t tstep = 2 * hstep;
    const unsigned ldsw = (unsigned)wid * 1024u;
    const int aoff = lds_byte(wr * 64 + fr, fq * 8), boff = lds_byte(wc * 32 + fr, fq * 8);
#define PG8_SA(b, h) (((b) * 2 + (h)) * HTB)
#define PG8_SB(b, h) ((4 + (b) * 2 + (h)) * HTB)
#define PG8_STAGE(bufoff, gbase, voff) do { _Pragma("unroll") for (int _i = 0; _i < 2; ++_i) \
        __builtin_amdgcn_global_load_lds((const unsigned*)((const char*)(gbase) + (voff)[_i]), (PG8_LAS unsigned*)(lds + (bufoff) + ldsw + _i * 8192), 16, 0, 0); } while (0)
#define PG8_LDA(dst, b, h) do { _Pragma("unroll") for (int m = 0; m < 4; ++m) _Pragma("unroll") for (int k = 0; k < 2; ++k) dst[m][k] = *(const PG8_LAS bf16x8*)(lds + PG8_SA(b, h) + aoff + m * 2048 + k * 1024); } while (0)
#define PG8_LDB(dst, b, h) do { _Pragma("unroll") for (int n = 0; n < 2; ++n) _Pragma("unroll") for (int k = 0; k < 2; ++k) dst[n][k] = *(const PG8_LAS bf16x8*)(lds + PG8_SB(b, h) + boff + n * 2048 + k * 1024); } while (0)
#define PG8_MMA(ai, bj, At, Bt) do { __builtin_amdgcn_s_setprio(1); _Pragma("unroll") for (int m = 0; m < 4; ++m) _Pragma("unroll") for (int n = 0; n < 2; ++n) _Pragma("unroll") for (int k = 0; k < 2; ++k) \
        acc[ai][bj][m][n] = __builtin_amdgcn_mfma_f32_16x16x32_bf16(Bt[n][k], At[m][k], acc[ai][bj][m][n], 0, 0, 0); __builtin_amdgcn_s_setprio(0); } while (0)
#define PG8_WAIT_V(n) asm volatile("s_waitcnt vmcnt(" #n ")" ::: "memory")
#define PG8_WAIT_L(n) asm volatile("s_waitcnt lgkmcnt(" #n ")" ::: "memory")
#define PG8_BAR __builtin_amdgcn_s_barrier()
#define PG8_SCHED __builtin_amdgcn_sched_barrier(0)
    Unit cur, nxt; int ui = 0;
    if (!S.next(0, cur)) return;
    f32x4 acc[2][2][4][2];
#pragma unroll
    for (int a = 0; a < 2; ++a)
#pragma unroll
        for (int b = 0; b < 2; ++b)
#pragma unroll
            for (int m = 0; m < 4; ++m)
#pragma unroll
                for (int n = 0; n < 2; ++n) acc[a][b][m][n] = (f32x4){0.f, 0.f, 0.f, 0.f};
    bf16x8 At[4][2], B0[2][2], B1[2][2];
    const char* cA = (const char*)g.A + (size_t)cur.pm * tstep; const char* cB = (const char*)g.Bt + (size_t)cur.pn * tstep;
    S.a_ready(cur);
    if constexpr (SP2) {
        PG8_STAGE(PG8_SB(0, 0), cB, voffB); PG8_STAGE(PG8_SB(0, 1), cB + hstep, voffB); PG8_STAGE(PG8_SA(0, 0), cA, voffA); PG8_STAGE(PG8_SA(0, 1), cA + hstep, voffA);
        if (wr == 1) PG8_BAR;
        PG8_WAIT_V(2); PG8_BAR;
        PG8_STAGE(PG8_SB(1, 0), cB + kstep, voffB); PG8_STAGE(PG8_SA(1, 0), cA + kstep, voffA); PG8_STAGE(PG8_SB(1, 1), cB + hstep + kstep, voffB);
        PG8_WAIT_V(6); PG8_BAR;
    } else {
        PG8_STAGE(PG8_SB(0, 0), cB, voffB); PG8_STAGE(PG8_SA(0, 0), cA, voffA); PG8_STAGE(PG8_SB(0, 1), cB + hstep, voffB); PG8_STAGE(PG8_SA(0, 1), cA + hstep, voffA);
        if (wr == 1) PG8_BAR;
        PG8_WAIT_V(4); PG8_BAR;
        PG8_STAGE(PG8_SB(1, 0), cB + kstep, voffB); PG8_STAGE(PG8_SA(1, 0), cA + kstep, voffA); PG8_STAGE(PG8_SB(1, 1), cB + hstep + kstep, voffB);
        PG8_WAIT_V(6); PG8_BAR;
    }
    for (;;) {
        const bool has_next = S.next(ui + 1, nxt);
        const char* nA = has_next ? (const char*)g.A + (size_t)nxt.pm * tstep : cA; const char* nB = has_next ? (const char*)g.Bt + (size_t)nxt.pn * tstep : cB;
        for (int t = 0; t < nt * KREP; t += 2) {
            const bool last = (t == nt * KREP - 2);
            const int t1 = KREP > 1 ? (t + 1) % nt : t + 1, t2 = KREP > 1 ? (t + 2) % nt : t + 2;
            const char* a1 = cA + (size_t)t1 * kstep;
            const char* a2 = last ? nA : cA + (size_t)t2 * kstep; const char* b2 = last ? nB : cB + (size_t)t2 * kstep;
            const char* a3 = a2 + kstep; const char* b3 = b2 + kstep;
            if (last && has_next) S.a_ready(nxt);
            if constexpr (Epi::PREF) { if (last) E.prefetch(lds, cur, wid, lane); }
            if constexpr (SP2) {
            PG8_LDB(B0, 0, 0); PG8_LDB(B1, 0, 1); PG8_SCHED; PG8_LDA(At, 0, 0); PG8_STAGE(PG8_SA(1, 1), a1 + hstep, voffA);
            PG8_WAIT_V(8); PG8_WAIT_L(0); PG8_BAR; PG8_MMA(0, 0, At, B0); PG8_MMA(0, 1, At, B1); PG8_BAR; PG8_SCHED;
            PG8_LDA(At, 0, 1); PG8_STAGE(PG8_SB(0, 0), b2, voffB); PG8_STAGE(PG8_SB(0, 1), b2 + hstep, voffB); PG8_STAGE(PG8_SA(0, 0), a2, voffA);
            PG8_WAIT_V(8); PG8_WAIT_L(0); PG8_BAR; PG8_MMA(1, 0, At, B0); PG8_MMA(1, 1, At, B1); PG8_BAR; PG8_SCHED;
            PG8_LDB(B0, 1, 0); PG8_LDB(B1, 1, 1); PG8_SCHED; PG8_LDA(At, 1, 0); PG8_STAGE(PG8_SA(0, 1), a2 + hstep, voffA);
            PG8_WAIT_V(8); PG8_WAIT_L(0); PG8_BAR; PG8_MMA(0, 0, At, B0); PG8_MMA(0, 1, At, B1); PG8_BAR; PG8_SCHED;
            PG8_LDA(At, 1, 1); PG8_STAGE(PG8_SB(1, 0), b3, voffB); PG8_STAGE(PG8_SB(1, 1), b3 + hstep, voffB); PG8_STAGE(PG8_SA(1, 0), a3, voffA);
            PG8_WAIT_V(8); PG8_WAIT_L(0); PG8_BAR; PG8_MMA(1, 0, At, B0); PG8_MMA(1, 1, At, B1); PG8_BAR; PG8_SCHED;
            } else {
            PG8_LDB(B0, 0, 0); PG8_SCHED; PG8_LDA(At, 0, 0); PG8_STAGE(PG8_SA(1, 1), a1 + hstep, voffA);
            PG8_WAIT_L(8); PG8_BAR; PG8_WAIT_L(0); PG8_MMA(0, 0, At, B0); PG8_BAR; PG8_SCHED;
            PG8_LDB(B1, 0, 1); PG8_STAGE(PG8_SB(0, 0), b2, voffB);
            PG8_BAR; PG8_WAIT_L(0); PG8_MMA(0, 1, At, B1); PG8_BAR;
            PG8_LDA(At, 0, 1); PG8_STAGE(PG8_SA(0, 0), a2, voffA);
            PG8_BAR; PG8_WAIT_L(0); PG8_MMA(1, 0, At, B0); PG8_BAR; PG8_SCHED;
            PG8_STAGE(PG8_SB(0, 1), b2 + hstep, voffB);
            PG8_WAIT_V(6); PG8_BAR; PG8_MMA(1, 1, At, B1); PG8_BAR;
            PG8_LDB(B0, 1, 0); PG8_SCHED; PG8_LDA(At, 1, 0); PG8_STAGE(PG8_SA(0, 1), a2 + hstep, voffA);
            PG8_WAIT_L(8); PG8_BAR; PG8_WAIT_L(0); PG8_MMA(0, 0, At, B0); PG8_BAR; PG8_SCHED;
            PG8_LDB(B1, 1, 1); PG8_STAGE(PG8_SB(1, 0), b3, voffB);
            PG8_BAR; PG8_WAIT_L(0); PG8_MMA(0, 1, At, B1); PG8_BAR;
            PG8_LDA(At, 1, 1); PG8_STAGE(PG8_SA(1, 0), a3, voffA);
            PG8_BAR; PG8_WAIT_L(0); PG8_MMA(1, 0, At, B0); PG8_BAR; PG8_SCHED;
            PG8_STAGE(PG8_SB(1, 1), b3 + hstep, voffB);
            PG8_WAIT_V(6); PG8_BAR; PG8_MMA(1, 1, At, B1); PG8_BAR;
            }
        }
        if constexpr (ALIGN_EPI) { if (wr == 0) PG8_BAR; }
        if constexpr (!Epi::AFTER_DRAIN) { E(acc, cur, wr, wc, fr, fq); S.done(cur); }
        if (!has_next) break;
#pragma unroll
        for (int a = 0; a < 2; ++a)
#pragma unroll
            for (int b = 0; b < 2; ++b)
#pragma unroll
                for (int m = 0; m < 4; ++m)
#pragma unroll
                    for (int n = 0; n < 2; ++n) acc[a][b][m][n] = (f32x4){0.f, 0.f, 0.f, 0.f};
        cur = nxt; cA = nA; cB = nB; ++ui;
        if constexpr (ALIGN_EPI) { if (wr == 1) PG8_BAR; }
    }
    PG8_WAIT_V(0);
    if constexpr (!ALIGN_EPI) { if (wr == 0) PG8_BAR; }
    PG8_BAR;
    if constexpr (Epi::AFTER_DRAIN) { E.fused(acc, cur, wr, wc, fr, fq, lds, wid, lane); S.done(cur); }
#undef PG8_SA
#undef PG8_SB
#undef PG8_STAGE
#undef PG8_LDA
#undef PG8_LDB
#undef PG8_MMA
#undef PG8_WAIT_V
#undef PG8_WAIT_L
#undef PG8_BAR
#undef PG8_SCHED
}
}

#define LAS __attribute__((address_space(3)))
#define GAS __attribute__((address_space(1)))
using pg8::f32x4; using pg8::u32x4; using pg8::Unit; using pg8::cvt_pk_bf16;
typedef unsigned u32x2 __attribute__((ext_vector_type(2)));
typedef GAS unsigned gu32;
#define RLX_AGENT __ATOMIC_RELAXED, __HIP_MEMORY_SCOPE_AGENT

constexpr int NWAVES = 8, NTHREADS = 512;
constexpr int LDS_BYTES = 163840;
constexpr int RING_BYTES = 147456, MISC_OFF = RING_BYTES + 320;
constexpr size_t W_IN = 0, W_OUT = W_IN + (size_t)2816 * 1024 * 2, W_FFI = W_OUT + (size_t)1024 * 1024 * 2, W_FFO = W_FFI + (size_t)5632 * 1024 * 2,
                 W_G = W_FFO + (size_t)1024 * 2816 * 2, W_P = W_G + (size_t)1024 * 1024 * 2, W_LAYER = W_P + (size_t)1024 * 256 * 2;
static_assert(WS_W + 2 * W_LAYER <= WS_XB0, "weights fit");
enum { ST_X1 = 0, ST_MIX = 1, ST_X2 = 2, ST_F = 3, ST_PP = 4, ST_N = 5 };
typedef unsigned long long stat_t;
__host__ __device__ __forceinline__ stat_t* stat_ptr(unsigned char* ws, int L, int idx) { return (stat_t*)(ws + WS_STAT) + (size_t)(L * ST_N + idx) * M; }
static_assert(WS_STAT + (size_t)2 * ST_N * M * 8 <= CTL_ZERO_BYTES && CTL_ZERO_BYTES <= WS_TAB, "stats inside the zeroed region");
__device__ __forceinline__ stat_t ss_enc(float s) { return (stat_t)(s * 16777216.0f); }
__device__ __forceinline__ float ss_dec(stat_t v) { return (float)v * (1.0f / 16777216.0f); }
constexpr int CW_BAR = 4096;

#define XB_TMO      128
#define XB_XCNT(j)  (256  + 64 * (j))
#define XB_XSUB(j)  (1280 + 64 * (j))
#define XB_XGEN(j)  (2304 + 64 * (j))
#define XB_TOP      3328
#define XB_TOPGEN   3392
#define XCD_BAR_WORDS 3456
#define XB_SPIN_CAP (1u << 22)
__device__ __forceinline__ unsigned xb_ld(unsigned* p)              { return __hip_atomic_load(p, __ATOMIC_RELAXED, __HIP_MEMORY_SCOPE_AGENT); }
__device__ __forceinline__ unsigned xb_add(unsigned* p, unsigned v) { return __hip_atomic_fetch_add(p, v, __ATOMIC_RELAXED, __HIP_MEMORY_SCOPE_AGENT); }
__device__ __forceinline__ unsigned xb_xcc_id() { return (unsigned)__builtin_amdgcn_s_getreg((3 << 11) | 20) & 0xFu; }
#define XB_SPIN(cond, bar) do { unsigned _sp = 0; while (cond) { __builtin_amdgcn_s_sleep(1); \
    if ((++_sp & 255u) == 0u) { if (xb_ld(&(bar)[XB_TMO])) break; if (_sp > XB_SPIN_CAP) { atomicAdd(&(bar)[XB_TMO], 1u); break; } } } } while (0)
struct XcdBarrier { unsigned* bar; unsigned x; volatile LAS unsigned* st; };
__device__ __forceinline__ XcdBarrier xcd_barrier_post(unsigned* bar, volatile LAS unsigned* st) {
    XcdBarrier b; b.bar = bar; b.x = xb_xcc_id(); b.st = st;
    if (threadIdx.x == 0) st[2] = xb_add(&bar[XB_XCNT(b.x)], 1u);
    return b;
}
__device__ __forceinline__ void xcd_barrier_complete(unsigned* bar, unsigned x, unsigned& nloc, unsigned& nx, unsigned& uni) {
    const unsigned G = gridDim.x * gridDim.y * gridDim.z;
    unsigned sum, cnt, mine, odd, sp = 0u;
    for (;;) {
        sum = 0u; cnt = 0u; mine = 0u; odd = 0u;
#pragma unroll
        for (unsigned j = 0; j < 16; ++j) { const unsigned c = xb_ld(&bar[XB_XCNT(j)]); sum += c; cnt += (c > 0u) ? 1u : 0u; mine = (j == x) ? c : mine; odd |= (c != 0u && c != 32u) ? 1u : 0u; odd |= (c != 0u && j >= 8u) ? 1u : 0u; }
        if (sum == G) break;
        __builtin_amdgcn_s_sleep(1);
        if ((++sp & 255u) == 0u) { if (xb_ld(&bar[XB_TMO])) break; if (sp > XB_SPIN_CAP) { atomicAdd(&bar[XB_TMO], 1u); break; } }
    }
    nloc = mine > 0u ? mine : 1u; nx = cnt > 0u ? cnt : 1u;
    uni = (sum == G && G == 256u && cnt == 8u && odd == 0u) ? 1u : 0u;
}
__device__ __forceinline__ void xcd_barrier(const XcdBarrier& b, int tid, bool may_local = false) {
    asm volatile("s_waitcnt vmcnt(0)" ::: "memory");
    __syncthreads();
    if (tid == 0) {
        unsigned* bar = b.bar;
        __builtin_amdgcn_s_waitcnt(0);
        unsigned nloc = b.st[0], nx = b.st[1];
        if (nloc == 0u) { unsigned uni; xcd_barrier_complete(bar, b.x, nloc, nx, uni); b.st[0] = nloc; b.st[1] = nx; b.st[3] = uni; }
        const bool local = may_local && b.st[3] != 0u;
        const unsigned old = xb_add(&bar[XB_XSUB(b.x)], 1u);
        const unsigned gen = old / nloc;
        if (old + 1u == (gen + 1u) * nloc) {
            __builtin_amdgcn_fence(__ATOMIC_RELEASE, "agent");
            asm volatile("s_waitcnt vmcnt(0)" ::: "memory");
            if (!local) {
                const unsigned og = xb_add(&bar[XB_TOP], 1u);
                const unsigned tg = og / nx;
                if (og + 1u == (tg + 1u) * nx) xb_add(&bar[XB_TOPGEN], 1u);
                else XB_SPIN(xb_ld(&bar[XB_TOPGEN]) == tg, bar);
            }
            __builtin_amdgcn_fence(__ATOMIC_ACQUIRE, "agent");
            xb_add(&bar[XB_XGEN(b.x)], 1u);
            asm volatile("s_waitcnt vmcnt(0)" ::: "memory");
        } else {
            XB_SPIN(xb_ld(&bar[XB_XGEN(b.x)]) == gen, bar);
            __builtin_amdgcn_fence(__ATOMIC_ACQUIRE, "agent");
            asm volatile("s_waitcnt vmcnt(0)" ::: "memory");
        }
    }
    __syncthreads();
}

__device__ __forceinline__ float fast_rsq(float x) { return __builtin_amdgcn_rsqf(x); }
__device__ __forceinline__ float sigm(float x) { return __builtin_amdgcn_rcpf(1.0f + __builtin_amdgcn_exp2f(-LOG2E_ * x)); }
__device__ __forceinline__ float gelu_t(float x) { return x * sigm(1.5957691216057308f * (x + 0.044715f * x * x * x)); }
__device__ __forceinline__ void unpack8s(const f32x4& v0, const f32x4& v1, float s, float (&o)[8]) {
    o[0] = v0[0] * s; o[1] = v0[1] * s; o[2] = v0[2] * s; o[3] = v0[3] * s; o[4] = v1[0] * s; o[5] = v1[1] * s; o[6] = v1[2] * s; o[7] = v1[3] * s;
}
__device__ __forceinline__ u32x4 pack8(const float (&o)[8]) {
    u32x4 w; w.x = cvt_pk_bf16(o[0], o[1]); w.y = cvt_pk_bf16(o[2], o[3]); w.z = cvt_pk_bf16(o[4], o[5]); w.w = cvt_pk_bf16(o[6], o[7]); return w;
}
__device__ __forceinline__ void ld8f(const float* p, float (&o)[8]) {
    const f32x4 a = *(const f32x4*)p, b = *(const f32x4*)(p + 4);
    o[0] = a[0]; o[1] = a[1]; o[2] = a[2]; o[3] = a[3]; o[4] = b[0]; o[5] = b[1]; o[6] = b[2]; o[7] = b[3];
}
__device__ __forceinline__ void unpack_bf8(const u32x4& r, float (&o)[8]) {
    o[0] = __uint_as_float(r.x << 16); o[1] = __uint_as_float(r.x & 0xffff0000u); o[2] = __uint_as_float(r.y << 16); o[3] = __uint_as_float(r.y & 0xffff0000u);
    o[4] = __uint_as_float(r.z << 16); o[5] = __uint_as_float(r.z & 0xffff0000u); o[6] = __uint_as_float(r.w << 16); o[7] = __uint_as_float(r.w & 0xffff0000u);
}
__device__ __forceinline__ int fresh_lane() { unsigned ones = ~0u; asm volatile("" : "+s"(ones)); return (int)__builtin_amdgcn_mbcnt_hi(ones, __builtin_amdgcn_mbcnt_lo(ones, 0u)); }
#define EPI_ROW(u, ai, wr, m, fr) ((u).pm * 256 + (ai) * 128 + (wr) * 64 + (m) * 16 + (fr))

enum { T_AU, T_AV, T_BQ, T_BK, T_BV, T_BG, T_CQ, T_CK, T_CV };
struct EpiProj {
    static constexpr bool PERM = true, AFTER_DRAIN = false, PREF = true;
    bf16_t* P; const stat_t* ss; const float* ln_w; const float* ln_b; const float* tab;
    __device__ __forceinline__ void prefetch(LAS unsigned char* lds, const Unit& u, int wid, int lane) const {
        const stat_t* src = ss + u.pm * 256 + (lane >> 5) * 128 + (wid >> 2) * 64 + 2 * (lane & 31);
        __builtin_amdgcn_global_load_lds((const unsigned*)src, (LAS unsigned*)(lds + pg8::PREF_OFF + wid * 1024), 16, 0, 0);
    }
    template <int TYPE> __device__ __forceinline__ void rows(const f32x4 (&acc)[2][2][4][2], const Unit& u, int wr, int hs, int hrel, int fr, int fq) const {
        const int d0 = 8 * fq, ln_ = fr + 16 * fq;
        float rs[8];
#pragma unroll
        for (int q = 0; q < 8; ++q) rs[q] = ss_dec(*(const LAS stat_t*)((LAS unsigned char*)(pg8::PREF_OFF + (wr * 4 + (hs & 3)) * 1024) + (q >> 2) * 512 + ((q & 3) * 16 + fr) * 8));
        float wa[8], wb[8], ba[8], bb[8];
        if constexpr (TYPE == T_AV) { ld8f(ln_w + hrel * 64 + d0, wa); ld8f(ln_w + hrel * 64 + 32 + d0, wb); ld8f(ln_b + hrel * 64 + d0, ba); ld8f(ln_b + hrel * 64 + 32 + d0, bb); }
#pragma unroll
        for (int hp = 0; hp < 4; ++hp) {
            const int ai = hp >> 1;
            float tc[2][8], tsn[2][8];
            if constexpr (TYPE == T_BQ || TYPE == T_BK) {
#pragma unroll
                for (int mm = 0; mm < 2; ++mm) { const int pos = EPI_ROW(u, ai, wr, 2 * (hp & 1) + mm, fr) & (SEQ - 1); ld8f(tab + TAB_RC + pos * 32 + d0, tc[mm]); ld8f(tab + TAB_RS + pos * 32 + d0, tsn[mm]); }
            }
            if constexpr (TYPE == T_CQ || TYPE == T_CK) {
#pragma unroll
                for (int mm = 0; mm < 2; ++mm) { const int pos = EPI_ROW(u, ai, wr, 2 * (hp & 1) + mm, fr) & (SEQ - 1); ld8f(tab + TAB_SC + pos * 8, tc[mm]); ld8f(tab + TAB_SS + pos * 8, tsn[mm]); }
            }
#pragma unroll
            for (int mm = 0; mm < 2; ++mm) {
                const int m = 2 * (hp & 1) + mm;
                const int row = EPI_ROW(u, ai, wr, m, fr);
                const float rstd = fast_rsq(rs[ai * 4 + m] * (1.0f / D_MODEL) + EPS);
                float a[8], b[8];
                unpack8s(acc[ai][0][m][0], acc[ai][0][m][1], rstd, a); unpack8s(acc[ai][1][m][0], acc[ai][1][m][1], rstd, b);
                if constexpr (TYPE == T_AU) {
#pragma unroll
                    for (int j = 0; j < 8; ++j) { a[j] = gelu_t(a[j]); b[j] = gelu_t(b[j]); }
                } else if constexpr (TYPE == T_AV) {
                    float sm = 0.f;
#pragma unroll
                    for (int j = 0; j < 8; ++j) { a[j] = gelu_t(a[j]); b[j] = gelu_t(b[j]); sm += a[j] + b[j]; }
                    sm += shx(sm, 16, ln_); sm += shx(sm, 32, ln_);
                    const float mu = sm * (1.0f / 64.0f); float q = 0.f;
#pragma unroll
                    for (int j = 0; j < 8; ++j) { a[j] -= mu; b[j] -= mu; q += a[j] * a[j] + b[j] * b[j]; }
                    q += shx(q, 16, ln_); q += shx(q, 32, ln_);
                    const float rsd = fast_rsq(q * (1.0f / 64.0f) + EPS);
#pragma unroll
                    for (int j = 0; j < 8; ++j) { a[j] = a[j] * rsd * wa[j] + ba[j]; b[j] = b[j] * rsd * wb[j] + bb[j]; }
                } else if constexpr (TYPE == T_BQ || TYPE == T_BK) {
                    const float tch = (float)(row & (CHUNK - 1)) * c_log2g[hrel];
                    const float sc = __builtin_amdgcn_exp2f(TYPE == T_BK ? -tch - 3.0f : tch);
#pragma unroll
                    for (int j = 0; j < 8; ++j) { const float x1 = a[j], x2 = b[j]; a[j] = (x1 * tc[mm][j] - x2 * tsn[mm][j]) * sc; b[j] = (x2 * tc[mm][j] + x1 * tsn[mm][j]) * sc; }
                } else if constexpr (TYPE == T_BG) {
#pragma unroll
                    for (int j = 0; j < 8; ++j) { a[j] = a[j] * sigm(a[j]); b[j] = b[j] * sigm(b[j]); }
                } else if constexpr (TYPE == T_CQ || TYPE == T_CK) {
                    float o[8];
#pragma unroll
                    for (int j = 0; j < 8; ++j) o[j] = shx(a[j], 16, ln_);
                    if (fq < 2) {
                        const float sg = fq == 0 ? -1.0f : 1.0f;
#pragma unroll
                        for (int j = 0; j < 8; ++j) a[j] = a[j] * tc[mm][j] + sg * o[j] * tsn[mm][j];
                    }
                }
                bf16_t* dst = P + (size_t)row * IN_W + hs * 64 + d0;
                *(u32x4*)dst = pack8(a); *(u32x4*)(dst + 32) = pack8(b);
            }
        }
    }
    __device__ __forceinline__ void operator()(const f32x4 (&acc)[2][2][4][2], const Unit& u, int wr, int wc, int fr, int fq) const {
        const int ln_ = fresh_lane(); fr = ln_ & 15; fq = ln_ >> 4;
        const int hs = u.pn * 4 + wc;
        if (hs >= NHEADS) return;
        if (hs < H_AV) rows<T_AU>(acc, u, wr, hs, hs - H_AU, fr, fq);
        else if (hs < H_BQ) rows<T_AV>(acc, u, wr, hs, hs - H_AV, fr, fq);
        else if (hs < H_BK) rows<T_BQ>(acc, u, wr, hs, hs - H_BQ, fr, fq);
        else if (hs < H_BV) rows<T_BK>(acc, u, wr, hs, hs - H_BK, fr, fq);
        else if (hs < H_BG) rows<T_BV>(acc, u, wr, hs, hs - H_BV, fr, fq);
        else if (hs < H_CQ) rows<T_BG>(acc, u, wr, hs, hs - H_BG, fr, fq);
        else if (hs < H_CK) rows<T_CQ>(acc, u, wr, hs, hs - H_CQ, fr, fq);
        else if (hs < H_CV) rows<T_CK>(acc, u, wr, hs, hs - H_CK, fr, fq);
        else rows<T_CV>(acc, u, wr, hs, hs - H_CV, fr, fq);
    }
};
struct EpiSwiglu {
    static constexpr bool PERM = true, AFTER_DRAIN = false, PREF = true;
    bf16_t* H; const stat_t* ss; float kscale;
    __device__ __forceinline__ void prefetch(LAS unsigned char* lds, const Unit& u, int wid, int lane) const {
        const stat_t* src = ss + u.pm * 256 + (lane >> 5) * 128 + (wid >> 2) * 64 + 2 * (lane & 31);
        __builtin_amdgcn_global_load_lds((const unsigned*)src, (LAS unsigned*)(lds + pg8::PREF_OFF + wid * 1024), 16, 0, 0);
    }
    __device__ __forceinline__ void operator()(const f32x4 (&acc)[2][2][4][2], const Unit& u, int wr, int wc, int fr, int fq) const {
        const int ln_ = fresh_lane(); fr = ln_ & 15; fq = ln_ >> 4;
        float rs[8];
#pragma unroll
        for (int q = 0; q < 8; ++q) rs[q] = ss_dec(*(const LAS stat_t*)((LAS unsigned char*)(pg8::PREF_OFF + (wr * 4 + wc) * 1024) + (q >> 2) * 512 + ((q & 3) * 16 + fr) * 8));
#pragma unroll
        for (int ai = 0; ai < 2; ++ai)
#pragma unroll
            for (int m = 0; m < 4; ++m) {
                const int row = EPI_ROW(u, ai, wr, m, fr);
                const float rstd = fast_rsq(rs[ai * 4 + m] * (1.0f / D_MODEL) + EPS) * kscale;
                typedef float f32x2 __attribute__((ext_vector_type(2)));
                const float cexp = -LOG2E_ * rstd, r2 = rstd * rstd;
                unsigned wv4[4];
#pragma unroll
                for (int n = 0; n < 2; ++n)
#pragma unroll
                    for (int hf = 0; hf < 2; ++hf) {
                        const f32x2 ag = {acc[ai][0][m][n][2 * hf], acc[ai][0][m][n][2 * hf + 1]}, au = {acc[ai][1][m][n][2 * hf], acc[ai][1][m][n][2 * hf + 1]};
                        f32x2 e = ag * cexp; e.x = __builtin_amdgcn_exp2f(e.x); e.y = __builtin_amdgcn_exp2f(e.y);
                        f32x2 d = e + 1.0f; d.x = __builtin_amdgcn_rcpf(d.x); d.y = __builtin_amdgcn_rcpf(d.y);
                        const f32x2 hh = ((ag * au) * r2) * d;
                        wv4[2 * n + hf] = cvt_pk_bf16(hh.x, hh.y);
                    }
                const u32x4 g = {wv4[0], wv4[1], wv4[2], wv4[3]};
                *(u32x4*)(H + (size_t)row * D_FF + u.pn * 128 + wc * 32 + 8 * fq) = g;
            }
    }
};
struct EpiStore {
    static constexpr bool PERM = true, AFTER_DRAIN = false, PREF = false;
    bf16_t* O;
    __device__ __forceinline__ void operator()(const f32x4 (&acc)[2][2][4][2], const Unit& u, int wr, int wc, int fr, int fq) const {
        const int ln_ = fresh_lane(); fr = ln_ & 15; fq = ln_ >> 4;
#pragma unroll
        for (int q = 0; q < 8; ++q) {
            const int ai = q >> 2, m = q & 3, row = EPI_ROW(u, ai, wr, m, fr);
#pragma unroll
            for (int bj = 0; bj < 2; ++bj) {
                float v[8]; unpack8s(acc[ai][bj][m][0], acc[ai][bj][m][1], 1.0f, v);
                *(u32x4*)(O + (size_t)row * D_MODEL + u.pn * 256 + bj * 128 + wc * 32 + 8 * fq) = pack8(v);
            }
        }
    }
};
struct EpiNormRes {
    static constexpr bool PERM = true, AFTER_DRAIN = false, PREF = false;
    bf16_t* XB; const float* w; stat_t* ssT; stat_t* ss_out; unsigned* tmo;
    __device__ __forceinline__ void operator()(const f32x4 (&acc)[2][2][4][2], const Unit& u, int wr, int wc, int fr, int fq) const {
        const int ln_ = fresh_lane(); fr = ln_ & 15; fq = ln_ >> 4;
        const int col0 = u.pn * 256 + wc * 32 + 8 * fq;
        float s[8];
#pragma unroll
        for (int q = 0; q < 8; ++q) {
            const int ai = q >> 2, m = q & 3; float sq = 0.f;
#pragma unroll
            for (int bj = 0; bj < 2; ++bj)
#pragma unroll
                for (int n = 0; n < 2; ++n) { const f32x4 v = acc[ai][bj][m][n]; sq += (v[0] * v[0] + v[1] * v[1]) + (v[2] * v[2] + v[3] * v[3]); }
            s[q] = sq;
        }
#pragma unroll
        for (int q = 0; q < 8; ++q) s[q] += shx(s[q], 16, ln_);
#pragma unroll
        for (int q = 0; q < 8; ++q) s[q] += shx(s[q], 32, ln_);
        if (fq == 0) {
#pragma unroll
            for (int q = 0; q < 8; ++q) atomicAdd(ssT + EPI_ROW(u, q >> 2, wr, q & 3, fr), (ss_enc(s[q]) << 8) | 1ull);
        }
        float wv[2][8]; ld8f(w + col0, wv[0]); ld8f(w + col0 + 128, wv[1]);
        u32x4 xr[4][2];
#pragma unroll
        for (int m = 0; m < 4; ++m)
#pragma unroll
            for (int bj = 0; bj < 2; ++bj) xr[m][bj] = *(const u32x4*)(XB + (size_t)EPI_ROW(u, 0, wr, m, fr) * D_MODEL + col0 + bj * 128);
        float rs[8];
        {
            stat_t v[8]; unsigned sp = 0;
            for (;;) {
                bool ok = true;
#pragma unroll
                for (int q = 0; q < 8; ++q) { v[q] = __hip_atomic_load(ssT + EPI_ROW(u, q >> 2, wr, q & 3, fr), __ATOMIC_RELAXED, __HIP_MEMORY_SCOPE_AGENT); ok = ok && ((unsigned)v[q] & 255u) == 16u; }
                if (__all(ok)) break;
                __builtin_amdgcn_s_sleep(1);
                if (++sp > (1u << 22)) { if (ln_ == 0) __hip_atomic_store(tmo, 1u, __ATOMIC_RELAXED, __HIP_MEMORY_SCOPE_AGENT); break; }
            }
#pragma unroll
            for (int q = 0; q < 8; ++q) rs[q] = ss_dec(v[q] >> 8);
        }
        float so[8];
#pragma unroll
        for (int ai = 0; ai < 2; ++ai) {
            if (ai == 1) {
#pragma unroll
                for (int m = 0; m < 4; ++m)
#pragma unroll
                    for (int bj = 0; bj < 2; ++bj) xr[m][bj] = *(const u32x4*)(XB + (size_t)EPI_ROW(u, 1, wr, m, fr) * D_MODEL + col0 + bj * 128);
            }
#pragma unroll
            for (int m = 0; m < 4; ++m) {
                const float rstd = fast_rsq(rs[ai * 4 + m] * (1.0f / D_MODEL) + EPS);
                float sq = 0.f;
#pragma unroll
                for (int bj = 0; bj < 2; ++bj) {
                    float t[8], xv[8]; unpack8s(acc[ai][bj][m][0], acc[ai][bj][m][1], rstd, t); unpack_bf8(xr[m][bj], xv);
#pragma unroll
                    for (int j = 0; j < 8; ++j) { xv[j] += t[j] * wv[bj][j]; sq += xv[j] * xv[j]; }
                    *(u32x4*)(XB + (size_t)EPI_ROW(u, ai, wr, m, fr) * D_MODEL + col0 + bj * 128) = pack8(xv);
                }
                so[ai * 4 + m] = sq;
            }
        }
        if (ss_out) {
#pragma unroll
            for (int q = 0; q < 8; ++q) so[q] += shx(so[q], 16, ln_);
#pragma unroll
            for (int q = 0; q < 8; ++q) so[q] += shx(so[q], 32, ln_);
            if (fq == 0) {
#pragma unroll
                for (int q = 0; q < 8; ++q) atomicAdd(ss_out + EPI_ROW(u, q >> 2, wr, q & 3, fr), ss_enc(so[q]));
            }
        }
    }
};
struct EpiStat {
    static constexpr bool PERM = true, AFTER_DRAIN = false, PREF = false;
    bf16_t* O; stat_t* ss;
    __device__ __forceinline__ void operator()(const f32x4 (&acc)[2][2][4][2], const Unit& u, int wr, int wc, int fr, int fq) const {
        const int ln_ = fresh_lane(); fr = ln_ & 15; fq = ln_ >> 4;
        float s[8];
#pragma unroll
        for (int q = 0; q < 8; ++q) {
            const int ai = q >> 2, m = q & 3, row = EPI_ROW(u, ai, wr, m, fr);
            float sq = 0.f;
#pragma unroll
            for (int bj = 0; bj < 2; ++bj) {
                float v[8]; unpack8s(acc[ai][bj][m][0], acc[ai][bj][m][1], 1.0f, v);
#pragma unroll
                for (int j = 0; j < 8; ++j) sq += v[j] * v[j];
                *(u32x4*)(O + (size_t)row * D_MODEL + u.pn * 256 + bj * 128 + wc * 32 + 8 * fq) = pack8(v);
            }
            s[q] = sq;
        }
#pragma unroll
        for (int q = 0; q < 8; ++q) s[q] += shx(s[q], 16, ln_);
#pragma unroll
        for (int q = 0; q < 8; ++q) s[q] += shx(s[q], 32, ln_);
        if (fq == 0) {
#pragma unroll
            for (int q = 0; q < 8; ++q) atomicAdd(ss + EPI_ROW(u, q >> 2, wr, q & 3, fr), ss_enc(s[q]));
        }
    }
};
struct EpiPle {
    static constexpr bool PERM = true, AFTER_DRAIN = false, PREF = false;
    const bf16_t* XBc; const bf16_t* PP; const stat_t* ss_pp; const float* wple; bf16_t* XBn; stat_t* ss_next; float* xout;
    __device__ __forceinline__ void operator()(const f32x4 (&acc)[2][2][4][2], const Unit& u, int wr, int wc, int fr, int fq) const {
        typedef float f32x2 __attribute__((ext_vector_type(2)));
        const int ln_ = fresh_lane(); fr = ln_ & 15; fq = ln_ >> 4;
        const int col0 = u.pn * 256 + wc * 32 + 8 * fq;
        float rs[8];
        u32x4 wpk[2];
        { float w0[8], w1[8]; ld8f(wple + col0, w0); ld8f(wple + col0 + 128, w1); wpk[0] = pack8(w0); wpk[1] = pack8(w1); }
#pragma unroll
        for (int q = 0; q < 4; ++q) rs[q] = ss_dec(ss_pp[EPI_ROW(u, 0, wr, q, fr)]);
        u32x4 xr[3][2], pr[3][2];
#define PLE_LOAD(b_, set_) do { _Pragma("unroll") for (int mm = 0; mm < 2; ++mm) { const unsigned off_ = ((unsigned)EPI_ROW(u, (b_) >> 2, wr, 2 * (((b_) >> 1) & 1) + mm, fr) * D_MODEL + col0 + ((b_) & 1) * 128) * 2u; \
            xr[set_][mm] = *(const u32x4*)((const char*)XBc + off_); pr[set_][mm] = *(const u32x4*)((const char*)PP + off_); } } while (0)
        PLE_LOAD(0, 0); PLE_LOAD(1, 1);
        stat_t rawB[4];
#pragma unroll
        for (int q = 0; q < 4; ++q) rawB[q] = ss_pp[EPI_ROW(u, 1, wr, q, fr)];
        float rpp2[2] = {0.f, 0.f}, sacc[2] = {0.f, 0.f};
#pragma unroll
        for (int b = 0; b < 8; ++b) {
            const int ai = b >> 2, mp = (b >> 1) & 1, bj = b & 1, set = b % 3;
            if (b + 2 < 8) PLE_LOAD(b + 2, (b + 2) % 3);
            if (b == 2) {
#pragma unroll
                for (int q = 0; q < 4; ++q) rs[4 + q] = ss_dec(rawB[q]);
            }
            const unsigned wq[4] = {wpk[bj].x, wpk[bj].y, wpk[bj].z, wpk[bj].w};
#pragma unroll
            for (int mm = 0; mm < 2; ++mm) {
                const int m = 2 * mp + mm, q = ai * 4 + m;
                if (bj == 0) { rpp2[mm] = fast_rsq(rs[q] * (1.0f / D_MODEL) + EPS); sacc[mm] = 0.f; }
                const float rpp = rpp2[mm];
                const unsigned off = (unsigned)EPI_ROW(u, ai, wr, m, fr) * D_MODEL + col0 + bj * 128;
                const unsigned xw[4] = {xr[set][mm].x, xr[set][mm].y, xr[set][mm].z, xr[set][mm].w}, pw[4] = {pr[set][mm].x, pr[set][mm].y, pr[set][mm].z, pr[set][mm].w};
                f32x2 sq2 = {0.f, 0.f}; f32x2 xo[4];
#pragma unroll
                for (int k = 0; k < 4; ++k) {
                    const f32x2 g = {acc[ai][bj][m][k >> 1][2 * (k & 1)], acc[ai][bj][m][k >> 1][2 * (k & 1) + 1]};
                    f32x2 xv = {__uint_as_float(xw[k] << 16), __uint_as_float(xw[k] & 0xffff0000u)}; const f32x2 pv = {__uint_as_float(pw[k] << 16), __uint_as_float(pw[k] & 0xffff0000u)};
                    const f32x2 wk = {__uint_as_float(wq[k] << 16), __uint_as_float(wq[k] & 0xffff0000u)};
                    f32x2 e = g * (-LOG2E_); e.x = __builtin_amdgcn_exp2f(e.x); e.y = __builtin_amdgcn_exp2f(e.y);
                    f32x2 d = e + 1.0f; d.x = __builtin_amdgcn_rcpf(d.x); d.y = __builtin_amdgcn_rcpf(d.y);
                    xv = xv + d * ((pv * wk) * rpp); sq2 = sq2 + xv * xv; xo[k] = xv;
                }
                if (XBn) { u32x4 o; o.x = cvt_pk_bf16(xo[0].x, xo[0].y); o.y = cvt_pk_bf16(xo[1].x, xo[1].y); o.z = cvt_pk_bf16(xo[2].x, xo[2].y); o.w = cvt_pk_bf16(xo[3].x, xo[3].y); *(u32x4*)((char*)XBn + off * 2u) = o; }
                if (xout) { *(f32x4*)((char*)xout + off * 4u) = (f32x4){xo[0].x, xo[0].y, xo[1].x, xo[1].y}; *(f32x4*)((char*)xout + off * 4u + 16) = (f32x4){xo[2].x, xo[2].y, xo[3].x, xo[3].y}; }
                sacc[mm] += sq2.x + sq2.y;
                if (bj == 1) rs[q] = sacc[mm];
            }
        }
#undef PLE_LOAD
        if (ss_next) {
#pragma unroll
            for (int q = 0; q < 8; ++q) rs[q] += shx(rs[q], 16, ln_);
#pragma unroll
            for (int q = 0; q < 8; ++q) rs[q] += shx(rs[q], 32, ln_);
            if (fq == 0) {
#pragma unroll
                for (int q = 0; q < 8; ++q) atomicAdd(ss_next + EPI_ROW(u, q >> 2, wr, q & 3, fr), ss_enc(rs[q]));
            }
        }
    }
};

__device__ __forceinline__ void ew_rows(bf16_t* XB, const bf16_t* T, const float* w, stat_t* ss_out, int gw, int NGW, int lane) {
    const int hl = lane & 31, hr = lane >> 5;
    float wv[4][8];
#pragma unroll
    for (int j = 0; j < 4; ++j) ld8f(w + 8 * hl + 256 * j, wv[j]);
#pragma unroll 2
    for (int r2 = gw; r2 < M / 2; r2 += NGW) {
        const int row = 2 * r2 + hr; const size_t base = (size_t)row * D_MODEL + 8 * hl;
        u32x4 xr[4], tr[4];
#pragma unroll
        for (int j = 0; j < 4; ++j) { xr[j] = *(const u32x4*)(XB + base + 256 * j); tr[j] = *(const u32x4*)(T + base + 256 * j); }
        float tv[4][8]; float st = 0.f;
#pragma unroll
        for (int j = 0; j < 4; ++j) { unpack_bf8(tr[j], tv[j]);
#pragma unroll
            for (int k = 0; k < 8; ++k) st += tv[j][k] * tv[j][k]; }
#pragma unroll
        for (int o = 1; o < 32; o <<= 1) st += shx(st, o, lane);
        const float rT = fast_rsq(st * (1.0f / D_MODEL) + EPS);
        float s = 0.f;
#pragma unroll
        for (int j = 0; j < 4; ++j) {
            float xv[8]; unpack_bf8(xr[j], xv);
#pragma unroll
            for (int k = 0; k < 8; ++k) { xv[k] += tv[j][k] * rT * wv[j][k]; s += xv[k] * xv[k]; }
            *(u32x4*)(XB + base + 256 * j) = pack8(xv);
        }
        if (ss_out) {
#pragma unroll
            for (int o = 1; o < 32; o <<= 1) s += shx(s, o, lane);
            if (hl == 0) ss_out[row] = ss_enc(s);
        }
    }
}
__device__ __forceinline__ void xprep_rows(const float* x, bf16_t* XB, stat_t* ss_out, int gw, int NGW, int lane) {
    const int hl = lane & 31, hr = lane >> 5;
#pragma unroll 2
    for (int r2 = gw; r2 < M / 2; r2 += NGW) {
        const int row = 2 * r2 + hr; const size_t base = (size_t)row * D_MODEL + 8 * hl;
        float xv[4][8];
#pragma unroll
        for (int j = 0; j < 4; ++j) ld8f(x + base + 256 * j, xv[j]);
        float s = 0.f;
#pragma unroll
        for (int j = 0; j < 4; ++j) {
#pragma unroll
            for (int k = 0; k < 8; ++k) s += xv[j][k] * xv[j][k];
            *(u32x4*)(XB + base + 256 * j) = pack8(xv[j]);
        }
#pragma unroll
        for (int o = 1; o < 32; o <<= 1) s += shx(s, o, lane);
        if (hl == 0) ss_out[row] = ss_enc(s);
    }
}

struct TrDesc { const float* W; const float* gain; bf16_t* WT; int ldw, K, sc, rho0, k0; };
struct TrRegs { f32x4 v[8]; float g[8]; };
__device__ __forceinline__ void tr_load(const TrDesc& d, TrRegs& R, int lane) {
    const int q = lane & 7, r = lane >> 3;
#pragma unroll
    for (int i = 0; i < 8; ++i) {
        const int kk = d.k0 + 8 * i + r;
        R.v[i] = d.sc >= 0 ? *(const f32x4*)(d.W + (size_t)kk * d.ldw + d.sc + 4 * q) : (f32x4){0.f, 0.f, 0.f, 0.f};
        R.g[i] = d.gain ? d.gain[kk] : 1.0f;
    }
}
__device__ __forceinline__ void tr_store(const TrDesc& d, const TrRegs& R, LAS float* scr, int lane) {
    const int q = lane & 7, r = lane >> 3;
#pragma unroll
    for (int i = 0; i < 8; ++i) {
        LAS float* s = scr + (8 * i + r) * 33 + 4 * q;
        s[0] = R.v[i].x * R.g[i]; s[1] = R.v[i].y * R.g[i]; s[2] = R.v[i].z * R.g[i]; s[3] = R.v[i].w * R.g[i];
    }
    asm volatile("s_waitcnt lgkmcnt(0)" ::: "memory");
    const int c = lane & 7;
#pragma unroll
    for (int j = 0; j < 4; ++j) {
        const int n = (lane >> 3) + 8 * j; const LAS float* s = scr + (8 * c) * 33 + n;
        u32x4 o; o.x = cvt_pk_bf16(s[0 * 33], s[1 * 33]); o.y = cvt_pk_bf16(s[2 * 33], s[3 * 33]); o.z = cvt_pk_bf16(s[4 * 33], s[5 * 33]); o.w = cvt_pk_bf16(s[6 * 33], s[7 * 33]);
        *(u32x4*)(d.WT + (size_t)(d.rho0 + n) * d.K + d.k0 + 8 * c) = o;
    }
    asm volatile("s_waitcnt lgkmcnt(0)" ::: "memory");
}

struct Args { const float* in[19]; float* out; unsigned char* ws; int ph_lo, ph_hi, li, pad; };

typedef const __attribute__((address_space(4))) Args* KArgs;
__device__ __forceinline__ KArgs kargs() { KArgs p = (KArgs)__builtin_amdgcn_kernarg_segment_ptr(); asm volatile("" : "+s"(p)); return p; }


__device__ __forceinline__ void prologue(KArgs ap, LAS unsigned char* lds, int gw, int NGW, int wave, int lane) {
    unsigned char* ws = ap->ws;
    LAS float* scr = (LAS float*)(lds + wave * 16384);
    {
        constexpr int I0 = 16 * 88, I1 = 16 * 32, I2 = 16 * 176, I3 = 44 * 32, I4 = 16 * 32, I5 = 4 * 32, IT = I0 + I1 + I2 + I3 + I4 + I5;
        auto desc = [&](int it) -> TrDesc {
            const int L = it >= IT ? 1 : 0; int r = it - L * IT;
            unsigned char* wl = ws + WS_W + (size_t)L * W_LAYER;
            if (r < I0) { const int nb = r % 88, kb = r / 88, pn = nb >> 3, bj = (nb >> 2) & 1, wc = nb & 3, hs = 4 * pn + wc;
                return TrDesc{ap->in[3] + (size_t)L * D_MODEL * IN_W, ap->in[2] + L * D_MODEL, (bf16_t*)(wl + W_IN), IN_W, 1024, hs < NHEADS ? hs * 64 + 32 * bj : -1, nb * 32, kb * 64}; } r -= I0;
            if (r < I1) { const int nb = r % 32, kb = r / 32;
                return TrDesc{ap->in[10] + (size_t)L * D_MODEL * D_MODEL, nullptr, (bf16_t*)(wl + W_OUT), D_MODEL, 1024, nb * 32, nb * 32, kb * 64}; } r -= I1;
            if (r < I2) { const int nb = r % 176, kb = r / 176, pn = nb >> 3, bj = (nb >> 2) & 1, q = nb & 3;
                return TrDesc{ap->in[13] + (size_t)L * D_MODEL * 2 * D_FF, ap->in[12] + L * D_MODEL, (bf16_t*)(wl + W_FFI), 2 * D_FF, 1024, bj * D_FF + 128 * pn + 32 * q, nb * 32, kb * 64}; } r -= I2;
            if (r < I3) { const int nb = r % 32, kb = r / 32;
                return TrDesc{ap->in[14] + (size_t)L * D_FF * D_MODEL, nullptr, (bf16_t*)(wl + W_FFO), D_MODEL, D_FF, nb * 32, nb * 32, kb * 64}; } r -= I3;
            if (r < I4) { const int nb = r % 32, kb = r / 32;
                return TrDesc{ap->in[16] + (size_t)L * D_MODEL * D_MODEL, nullptr, (bf16_t*)(wl + W_G), D_MODEL, 1024, nb * 32, nb * 32, kb * 64}; } r -= I4;
            { const int nb = r % 32, kb = r / 32;
                return TrDesc{ap->in[17] + (size_t)L * PLE_DIM * D_MODEL, nullptr, (bf16_t*)(wl + W_P), D_MODEL, PLE_DIM, nb * 32, nb * 32, kb * 64}; }
        };
        int it = gw;
        if (it < DEPTH * IT) {
            TrDesc d = desc(it); TrRegs R; tr_load(d, R, lane);
            for (;;) {
                const int nx = it + NGW; const bool hn = nx < DEPTH * IT;
                TrDesc dn = d; TrRegs Rn = R;
                if (hn) { dn = desc(nx); tr_load(dn, Rn, lane); }
                tr_store(d, R, scr, lane);
                if (!hn) break;
                d = dn; R = Rn; it = nx;
            }
        }
    }
    {
        float* tab = (float*)(ws + WS_TAB);
        for (int i = gw * 64 + lane; i < 2048 * 32; i += NGW * 64) {
            { const int pos = i >> 5, j = i & 31; const double rev = (double)pos * c_inv_ret[j] * 0.15915494309189535; const float fr = (float)(rev - floor(rev));
              tab[TAB_RC + i] = __builtin_amdgcn_cosf(fr); tab[TAB_RS + i] = __builtin_amdgcn_sinf(fr); }
            if (i < 2048 * 8) { const int pos = i >> 3, j = i & 7; const double rev = (double)pos * c_inv_swa[j] * 0.15915494309189535; const float fr = (float)(rev - floor(rev));
              tab[TAB_SC + i] = __builtin_amdgcn_cosf(fr); tab[TAB_SS + i] = __builtin_amdgcn_sinf(fr); }
        }
    }
    {
        const float* p = ap->in[1]; bf16_t* PB = (bf16_t*)(ws + WS_PB);
        const size_t n8 = (size_t)DEPTH * M * PLE_DIM / 8;
        for (size_t i = (size_t)gw * 64 + lane; i < n8; i += (size_t)NGW * 64) {
            float v[8]; ld8f(p + i * 8, v); *(u32x4*)(PB + i * 8) = pack8(v);
        }
    }
    {
        const float* wsrc = ap->in[6]; bf16_t* Wm = (bf16_t*)(ws + WS_WM);
        for (int i = gw * 64 + lane; i < DEPTH * 4 * CHUNK * CHUNK; i += NGW * 64) { const int s_ = i & 127, t_ = (i >> 7) & 127; Wm[i] = f2bf(s_ <= t_ ? wsrc[i] : 0.f); }
    }
    xprep_rows(ap->in[0], (bf16_t*)(ws + WS_XB0), stat_ptr(ws, 0, ST_X1), gw, NGW, lane);
}

typedef float f32x16 __attribute__((ext_vector_type(16)));
typedef short s16x4 __attribute__((ext_vector_type(4)));
using pg8::bf16x8;
constexpr int TS = 144;
constexpr float LOG2E = 1.4426950408889634f;
__device__ __forceinline__ int crow(int r, int hi) { return (r & 3) + 8 * (r >> 2) + 4 * hi; }
__device__ __forceinline__ s16x4 tr16(LAS const unsigned char* p) { return __builtin_bit_cast(s16x4, __builtin_amdgcn_ds_read_tr16_b64_v4i16((LAS s16x4*)p)); }
__device__ __forceinline__ bf16x8 rd_row(LAS const unsigned char* tile, int row0, int k0, int lane) {
    return *(LAS const bf16x8*)(tile + (row0 + (lane & 31)) * TS + (k0 + 8 * (lane >> 5)) * 2);
}
template <bool PERMK> __device__ __forceinline__ bf16x8 rd_tr(LAS const unsigned char* tile, int k0, int n0, int lane) {
    const int h = lane >> 5, g1 = (lane >> 4) & 1, q = (lane & 15) >> 2, p = lane & 3;
    const int rA = k0 + (PERMK ? 4 * h : 8 * h) + q, rB = rA + (PERMK ? 8 : 4);
    const int cb = (n0 + 16 * g1 + 4 * p) * 2;
    const s16x4 lo = tr16(tile + rA * TS + cb), hi = tr16(tile + rB * TS + cb);
    return (bf16x8){lo[0], lo[1], lo[2], lo[3], hi[0], hi[1], hi[2], hi[3]};
}
__device__ __forceinline__ bf16x8 pack_frag(const f32x16& v, int s) {
    u32x4 w; w.x = cvt_pk_bf16(v[8 * s + 0], v[8 * s + 1]); w.y = cvt_pk_bf16(v[8 * s + 2], v[8 * s + 3]); w.z = cvt_pk_bf16(v[8 * s + 4], v[8 * s + 5]); w.w = cvt_pk_bf16(v[8 * s + 6], v[8 * s + 7]);
    return __builtin_bit_cast(bf16x8, w);
}
#define MFMA32(a, b, c) __builtin_amdgcn_mfma_f32_32x32x16_bf16((a), (b), (c), 0, 0, 0)
template <bool SCALE> __device__ __forceinline__ void load_tile(LAS unsigned char* tile, const bf16_t* g, int rows, int zero_below, float sl, int tid) {
    for (int i = tid; i < rows * 8; i += NTHREADS) {
        const int r = i >> 3, c = i & 7;
        u32x4 v = (u32x4){0u, 0u, 0u, 0u};
        if (r >= zero_below) v = *(const u32x4*)(g + (ptrdiff_t)r * IN_W + c * 8);
        if (SCALE) { float f[8]; unpack_bf8(v, f); const float s = exp2f((float)r * sl);
#pragma unroll
            for (int j = 0; j < 8; ++j) f[j] *= s;
            v = pack8(f); }
        *(LAS u32x4*)(tile + r * TS + c * 16) = v;
    }
}

constexpr int GM_BUF = 2 * CHUNK * TS;
struct GmRegs { u32x4 r[4]; };
__device__ __forceinline__ void gm_load(GmRegs& R, const bf16_t* P, int item, int tid) {
    const int h = item & 3, bc = item >> 2; const size_t row0 = (size_t)bc * CHUNK;
    const int r = tid >> 3, c = tid & 7;
#pragma unroll
    for (int i = 0; i < 2; ++i) {
        R.r[i] = *(const u32x4*)(P + (row0 + r + 64 * i) * IN_W + (H_AU + h) * 64 + c * 8);
        R.r[2 + i] = *(const u32x4*)(P + (row0 + r + 64 * i) * IN_W + (H_AV + h) * 64 + c * 8);
    }
}
__device__ __forceinline__ void gm_write(const GmRegs& R, LAS unsigned char* buf, int tid) {
    const int r = tid >> 3, c = tid & 7;
#pragma unroll
    for (int i = 0; i < 2; ++i) { *(LAS u32x4*)(buf + (r + 64 * i) * TS + c * 16) = R.r[i]; *(LAS u32x4*)(buf + CHUNK * TS + (r + 64 * i) * TS + c * 16) = R.r[2 + i]; }
}
__device__ __forceinline__ void gm_compute(LAS unsigned char* buf, const bf16_t* Wm, const float* bs, bf16_t* Y, int item, int tid, int wave, int lane, volatile LAS unsigned* slotp, unsigned fut) {
    const int h = item & 3, bc = item >> 2; const size_t row0 = (size_t)bc * CHUNK;
    LAS unsigned char* AUs = buf; LAS unsigned char* AVs = buf + CHUNK * TS;
    const int tb = wave >> 1, db = wave & 1, hh = lane >> 5;
    f32x16 acc = {};
    const bf16_t* wrow = Wm + (size_t)(h * CHUNK + 32 * tb + (lane & 31)) * CHUNK + 8 * hh;
    for (int ks = 0; ks < 2 * (tb + 1); ++ks) {
        const bf16x8 a = *(const bf16x8*)(wrow + 16 * ks);
        const bf16x8 b = rd_tr<false>(AVs, 16 * ks, 32 * db, lane);
        acc = MFMA32(a, b, acc);
    }
    const int d = 32 * db + (lane & 31);
#pragma unroll
    for (int r = 0; r < 16; ++r) {
        const int t = 32 * tb + crow(r, hh);
        LAS bf16_t* pu = (LAS bf16_t*)(AUs + t * TS) + d;
        *pu = f2bf(bf2f(*pu) * (acc[r] + bs[h * CHUNK + t]));
    }
    if (tid == 0) *slotp = fut;
    __syncthreads();
    for (int i = tid; i < CHUNK * 8; i += NTHREADS) { const int r = i >> 3, c = i & 7; *(u32x4*)(Y + (row0 + r) * D_MODEL + h * 64 + c * 8) = *(LAS const u32x4*)(AUs + r * TS + c * 16); }
}

constexpr int SWA_K = 0, SWA_V = 384 * TS, SWA_WSF = 2 * 384 * TS, SWA_OST = SWA_WSF + NWAVES * 128, SWA_END = SWA_OST + NWAVES * 4096;
struct SwaRegs { u32x4 k[6], v[6]; };
__device__ __forceinline__ void swa_load(SwaRegs& R, const bf16_t* P, int item, int tid) {
    const int hk = item & 1, cp = (item >> 1) & 7, b = item >> 4;
    const ptrdiff_t rowk0 = (ptrdiff_t)b * SEQ + 256 * cp - 128;
    const int r0 = tid >> 3, c = tid & 7;
#pragma unroll
    for (int i = 0; i < 6; ++i) {
        const int r = r0 + 64 * i;
        if (cp == 0 && r < 128) { R.k[i] = (u32x4){0u, 0u, 0u, 0u}; R.v[i] = (u32x4){0u, 0u, 0u, 0u}; }
        else { R.k[i] = *(const u32x4*)(P + (rowk0 + r) * IN_W + (H_CK + hk) * 64 + c * 8); R.v[i] = *(const u32x4*)(P + (rowk0 + r) * IN_W + (H_CV + hk) * 64 + c * 8); }
    }
}
__device__ __forceinline__ void swa_write(const SwaRegs& R, LAS unsigned char* lds, int tid) {
    const int r0 = tid >> 3, c = tid & 7;
#pragma unroll
    for (int i = 0; i < 6; ++i) { *(LAS u32x4*)(lds + SWA_K + (r0 + 64 * i) * TS + c * 16) = R.k[i]; *(LAS u32x4*)(lds + SWA_V + (r0 + 64 * i) * TS + c * 16) = R.v[i]; }
}
__device__ __forceinline__ void swa_compute(LAS unsigned char* lds, const bf16_t* P, const float* sinks, bf16_t* Y, int item, int wave, int lane) {
    const int hk = item & 1, cp = (item >> 1) & 7, b = item >> 4;
    const size_t rowq0 = (size_t)b * SEQ + 256 * cp;
    LAS unsigned char* Ks = lds + SWA_K; LAS unsigned char* Vs = lds + SWA_V;
    const int qi = lane & 31, hh = lane >> 5;
    LAS float* wsf = (LAS float*)(lds + SWA_WSF + wave * 128);
    LAS unsigned char* ost = lds + SWA_OST + wave * 4096;
    constexpr float SC = 0.125f * LOG2E;
    for (int g = 0; g < 3; ++g) {
        const int qh = 3 * hk + g;
        const bf16_t* qrow = P + (rowq0 + 32 * wave + qi) * IN_W + (H_CQ + qh) * 64 + 8 * hh;
        bf16x8 bq[4];
#pragma unroll
        for (int kd = 0; kd < 4; ++kd) bq[kd] = *(const bf16x8*)(qrow + 16 * kd);
        f32x16 S[5];
#pragma unroll
        for (int kb = 0; kb < 5; ++kb) {
            S[kb] = (f32x16){};
#pragma unroll
            for (int kd = 0; kd < 4; ++kd) S[kb] = MFMA32(rd_row(Ks, 32 * (wave + kb), 16 * kd, lane), bq[kd], S[kb]);
        }
        const float sk = sinks[qh] * LOG2E;
        float m = sk;
#pragma unroll
        for (int kb = 0; kb < 5; ++kb) {
            const bool blk_ok = cp > 0 || wave + kb >= 4;
#pragma unroll
            for (int r = 0; r < 16; ++r) {
                const int cr = crow(r, hh);
                bool ok = blk_ok;
                if (kb == 0) ok = ok && cr > qi;
                if (kb == 4) ok = ok && cr <= qi;
                const float s = ok ? S[kb][r] * SC : -1e30f;
                S[kb][r] = s; m = fmaxf(m, s);
            }
        }
        m = fmaxf(m, shx(m, 32, lane));
        float l = 0.f;
#pragma unroll
        for (int kb = 0; kb < 5; ++kb)
#pragma unroll
            for (int r = 0; r < 16; ++r) { const float p = __builtin_amdgcn_exp2f(S[kb][r] - m); S[kb][r] = p; l += p; }
        l += shx(l, 32, lane);
        l += __builtin_amdgcn_exp2f(sk - m);
        f32x16 O[2]; O[0] = (f32x16){}; O[1] = (f32x16){};
#pragma unroll
        for (int kb = 0; kb < 5; ++kb)
#pragma unroll
            for (int s2 = 0; s2 < 2; ++s2) {
                const bf16x8 a = pack_frag(S[kb], s2);
#pragma unroll
                for (int db = 0; db < 2; ++db) O[db] = MFMA32(a, rd_tr<true>(Vs, 32 * (wave + kb) + 16 * s2, 32 * db, lane), O[db]);
            }
        if (hh == 0) wsf[qi] = __builtin_amdgcn_rcpf(l);
        asm volatile("s_waitcnt lgkmcnt(0)" ::: "memory");
#pragma unroll
        for (int r = 0; r < 16; ++r) {
            const int q = crow(r, hh); const float rl = wsf[q];
#pragma unroll
            for (int db = 0; db < 2; ++db) *((LAS bf16_t*)(ost + q * 128) + 32 * db + qi) = f2bf(O[db][r] * rl);
        }
        asm volatile("s_waitcnt lgkmcnt(0)" ::: "memory");
#pragma unroll
        for (int i = 0; i < 4; ++i) { const int row = i * 8 + (lane >> 3), ch = lane & 7;
            *(u32x4*)(Y + (rowq0 + 32 * wave + row) * D_MODEL + 640 + qh * 64 + ch * 8) = *(LAS const u32x4*)(ost + row * 128 + ch * 16); }
        asm volatile("s_waitcnt lgkmcnt(0)" ::: "memory");
    }
}

constexpr int RT_Q = 0, RT_K = CHUNK * TS, RT_V = 2 * CHUNK * TS, RT_S = 3 * CHUNK * TS, RT_O = RT_S + 64 * TS, RT_X = RT_O + CHUNK * 68 * 4, RT_END = RT_X + 16384;
struct RetRegs { u32x4 q[2], k[2], v[2], g[2]; };
__device__ __forceinline__ void ret_load(RetRegs& R, const bf16_t* P, size_t row0, int h, int tid) {
    const int r0 = tid >> 3, c = tid & 7;
#pragma unroll
    for (int i = 0; i < 2; ++i) {
        const bf16_t* pr = P + (row0 + r0 + 64 * i) * IN_W + c * 8;
        R.q[i] = *(const u32x4*)(pr + (H_BQ + h) * 64); R.k[i] = *(const u32x4*)(pr + (H_BK + h) * 64); R.v[i] = *(const u32x4*)(pr + (H_BV + h) * 64);
    }
    const int row = tid >> 2, part = tid & 3;
    const bf16_t* gp = P + (row0 + row) * IN_W + (H_BG + h) * 64 + 16 * part;
    R.g[0] = *(const u32x4*)gp; R.g[1] = *(const u32x4*)(gp + 8);
}
typedef float f32x2m __attribute__((ext_vector_type(2)));
__device__ __forceinline__ u32x4 scale_bf8(const u32x4& r, float sc) {
    const unsigned w[4] = {r.x, r.y, r.z, r.w}; unsigned o[4];
#pragma unroll
    for (int k = 0; k < 4; ++k) { f32x2m v = {__uint_as_float(w[k] << 16), __uint_as_float(w[k] & 0xffff0000u)}; v = v * sc; o[k] = cvt_pk_bf16(v.x, v.y); }
    return (u32x4){o[0], o[1], o[2], o[3]};
}
__device__ __forceinline__ void ret_write(const RetRegs& R, LAS unsigned char* lds, int tid) {
    const int r0 = tid >> 3, c = tid & 7;
#pragma unroll
    for (int i = 0; i < 2; ++i) {
        const int r = r0 + 64 * i;
        *(LAS u32x4*)(lds + RT_Q + r * TS + c * 16) = R.q[i];
        *(LAS u32x4*)(lds + RT_K + r * TS + c * 16) = R.k[i];
        *(LAS u32x4*)(lds + RT_V + r * TS + c * 16) = R.v[i];
    }
}
__device__ __forceinline__ void ret_item(LAS unsigned char* lds, const bf16_t* P, const float* gn_w, bf16_t* Y, int item, int tid, int wave, int lane, volatile LAS unsigned* slotp, unsigned fut) {
    const int h = item % 6, b = item / 6;
    const float lg = c_log2g[h];
    const float g1 = exp2f(lg), g127 = exp2f(127.f * lg), g128 = exp2f(128.f * lg);
    LAS unsigned char* Qs = lds + RT_Q; LAS unsigned char* Ks = lds + RT_K; LAS unsigned char* Vs = lds + RT_V; LAS unsigned char* Sb = lds + RT_S;
    LAS float* Os = (LAS float*)(lds + RT_O); LAS float* Xs = (LAS float*)(lds + RT_X);
    const int tb = wave >> 1, eb = wave & 1, qi = lane & 31, hh = lane >> 5;
    const int db = (wave >> 1) & 1, kh = wave >> 2;
    const int erow = tid >> 2, part = tid & 3;
    float gw0[8], gw1[8]; ld8f(gn_w + h * 64 + 16 * part, gw0); ld8f(gn_w + h * 64 + 16 * part + 8, gw1);
    f32x16 st = {};
    RetRegs R; ret_load(R, P, (size_t)b * SEQ, h, tid);
    for (int c = 0; c < 16; ++c) {
        const size_t row0 = (size_t)b * SEQ + (size_t)c * CHUNK;
        ret_write(R, lds, tid);
        const u32x4 gq0 = R.g[0], gq1 = R.g[1];
        __syncthreads();
        if (c + 1 < 16) ret_load(R, P, row0 + CHUNK, h, tid);
        f32x16 O = {};
        for (int sb = 0; sb <= tb; ++sb) {
            f32x16 S = {};
#pragma unroll
            for (int kd = 0; kd < 4; ++kd) S = MFMA32(rd_row(Ks, 32 * sb, 16 * kd, lane), rd_row(Qs, 32 * tb, 16 * kd, lane), S);
            if (sb == tb) {
#pragma unroll
                for (int r = 0; r < 16; ++r) S[r] = crow(r, hh) <= qi ? S[r] : 0.f;
            }
#pragma unroll
            for (int s2 = 0; s2 < 2; ++s2) O = MFMA32(pack_frag(S, s2), rd_tr<true>(Vs, 32 * sb + 16 * s2, 32 * eb, lane), O);
        }
        if (c > 0) {
#pragma unroll
            for (int kd = 0; kd < 4; ++kd) O = MFMA32(rd_row(Qs, 32 * tb, 16 * kd, lane), rd_row(Sb, 32 * eb, 16 * kd, lane), O);
        }
#pragma unroll
        for (int r = 0; r < 16; ++r) Os[(32 * tb + crow(r, hh)) * 68 + 32 * eb + qi] = O[r];
        if (c + 1 < 16) {
            f32x16 acc = {};
#pragma unroll
            for (int ks = 0; ks < 4; ++ks) acc = MFMA32(rd_tr<false>(Vs, 64 * kh + 16 * ks, 32 * eb, lane), rd_tr<false>(Ks, 64 * kh + 16 * ks, 32 * db, lane), acc);
#pragma unroll
            for (int r = 0; r < 16; ++r) st[r] = st[r] * g128 + g127 * acc[r];
            if (kh == 1) {
#pragma unroll
                for (int r = 0; r < 16; ++r) Xs[((eb * 2 + db) * 16 + r) * 64 + lane] = st[r];
            }
        }
        __syncthreads();
        if (c + 1 < 16 && kh == 0) {
#pragma unroll
            for (int r = 0; r < 16; ++r) { const int e = 32 * eb + crow(r, hh), d = 32 * db + qi; const float sv = (st[r] + Xs[((eb * 2 + db) * 16 + r) * 64 + lane]) * g1; *((LAS bf16_t*)(Sb + e * TS) + d) = (bf16_t)cvt_pk_bf16(sv, sv); }
        }
        {
            float v[16]; float s = 0.f;
#pragma unroll
            for (int j = 0; j < 16; ++j) { v[j] = Os[erow * 68 + 16 * part + j]; s += v[j]; }
            s += shx(s, 1, lane); s += shx(s, 2, lane);
            const float mu = s * (1.0f / 64.0f); float q = 0.f;
#pragma unroll
            for (int j = 0; j < 16; ++j) { v[j] -= mu; q += v[j] * v[j]; }
            q += shx(q, 1, lane); q += shx(q, 2, lane);
            const float rs = fast_rsq(q * (1.0f / 64.0f) + EPS);
            float ga[8], gb[8], o0[8], o1[8];
            unpack_bf8(gq0, ga); unpack_bf8(gq1, gb);
#pragma unroll
            for (int j = 0; j < 8; ++j) { o0[j] = (ga[j] * gw0[j]) * (v[j] * rs); o1[j] = (gb[j] * gw1[j]) * (v[8 + j] * rs); }
            bf16_t* yp = Y + (row0 + erow) * D_MODEL + 256 + h * 64 + 16 * part;
            *(u32x4*)yp = pack8(o0); *(u32x4*)(yp + 8) = pack8(o1);
        }
    }
    if (tid == 0) *slotp = fut;
    __syncthreads();
}

constexpr int CW_TMO = 1024;
constexpr int CW_QUEUE = 2048;
constexpr int MQ_RET = 192, MQ_SWA = MQ_RET + 512, MQ_ALL = MQ_SWA + 2048;
__device__ __forceinline__ void mixers(KArgs ap, int L, LAS unsigned char* lds, int tid, int wave, int lane, int grp) {
    unsigned char* ws = ap->ws;
    const bf16_t* P = (const bf16_t*)(ws + WS_BIG); bf16_t* Y = (bf16_t*)(ws + WS_Y);
    const bf16_t* Wm = (const bf16_t*)(ws + WS_WM) + (size_t)L * 4 * CHUNK * CHUNK;
    const float* gbs = ap->in[7] + L * 4 * CHUNK; const float* gn_w = ap->in[8] + L * 384; const float* sinks = ap->in[9] + L * 6;
    const bool gq = grp >= 0;
    const unsigned q_ret = gq ? MQ_RET / 8 : MQ_RET, q_swa = gq ? MQ_SWA / 8 : MQ_SWA, q_all = gq ? MQ_ALL / 8 : MQ_ALL;
    const int o_ret = gq ? grp * (MQ_RET / 8) : 0, o_swa = gq ? grp * ((MQ_SWA - MQ_RET) / 8) : 0, o_gm = gq ? grp * ((MQ_ALL - MQ_SWA) / 8) : 0;
    unsigned* head = (unsigned*)ws + CW_QUEUE + 64 * (gq ? 2 + 8 * L + grp : L);
    volatile LAS unsigned* slot = (volatile LAS unsigned*)(lds + MISC_OFF + 64);
    if (tid == 0) slot[0] = atomicAdd(head, 1u);
    __syncthreads();
    unsigned cur = (unsigned)__builtin_amdgcn_readfirstlane((int)slot[0]);
    __syncthreads();
    if (tid == 0) slot[1] = atomicAdd(head, 1u);
    __syncthreads();
    unsigned nxt = (unsigned)__builtin_amdgcn_readfirstlane((int)slot[1]);
    int k = 0;
#define MQ_FETCH() unsigned fut = 0u; if (tid == 0) fut = atomicAdd(head, 1u)
#define MQ_ADVANCE() do { cur = nxt; nxt = (unsigned)__builtin_amdgcn_readfirstlane((int)slot[k]); k ^= 1; } while (0)
    while (cur < q_all) {
        if (cur < q_ret) {
            MQ_FETCH();
            ret_item(lds, P, gn_w, Y, (int)cur + o_ret, tid, wave, lane, slot + k, fut);
            MQ_ADVANCE();
        } else if (cur < q_swa) {
            MQ_FETCH();
            { SwaRegs R; swa_load(R, P, (int)(cur - q_ret) + o_swa, tid); swa_write(R, lds, tid); }
            __syncthreads();
            swa_compute(lds, P, sinks, Y, (int)(cur - q_ret) + o_swa, wave, lane);
            if (tid == 0) slot[k] = fut;
            __syncthreads();
            MQ_ADVANCE();
        } else {
            GmRegs R; gm_load(R, P, (int)(cur - q_swa) + o_gm, tid);
            int bsel = 0;
            for (;;) {
                MQ_FETCH();
                LAS unsigned char* buf = lds + bsel * GM_BUF;
                gm_write(R, buf, tid);
                __syncthreads();
                const bool more = nxt < q_all;
                if (more) gm_load(R, P, (int)(nxt - q_swa) + o_gm, tid);
                gm_compute(buf, Wm, gbs, Y, (int)(cur - q_swa) + o_gm, tid, wave, lane, slot + k, fut);
                MQ_ADVANCE(); bsel ^= 1;
                if (!more) break;
            }
            __syncthreads();
        }
    }
#undef MQ_FETCH
#undef MQ_ADVANCE
    __syncthreads();
}

#ifndef PG8_SP2
#define PG8_SP2 true
#endif
#ifndef PG8_ALIGN
#define PG8_ALIGN true
#endif
constexpr int N_PHASES = 1 + 8 * DEPTH;
#ifndef PHMASK
#define PHMASK 0x1ff
#endif
#ifndef DUP_MASK
#define DUP_MASK 0
#endif
#define NREP(bit) ((DUP_MASK & (bit)) ? 2 : 1)
#ifndef KREP3
#define KREP3 1
#endif
__global__ void __launch_bounds__(NTHREADS, 2) mega(Args a_) {
    extern __shared__ __attribute__((aligned(16))) unsigned char lds_raw[];
    LAS unsigned char* lds = (LAS unsigned char*)lds_raw;
    const int G = gridDim.x, bid = blockIdx.x;
    const int vcu = (G % 8 == 0) ? (bid % 8) * (G / 8) + bid / 8 : bid;
    const int NGW = G * NWAVES;
    const int wave0 = __builtin_amdgcn_readfirstlane((int)threadIdx.x >> 6);
#define opq_tid() pg8::pg8_tid(wave0)
    { const int tid = opq_tid(); for (int u = tid; u < (LDS_BYTES - RING_BYTES) / 4; u += NTHREADS) ((LAS unsigned*)(lds + RING_BYTES))[u] = 0u; }
    __syncthreads();
    XcdBarrier bar = xcd_barrier_post((unsigned*)kargs()->ws + CW_BAR + kargs()->li * XCD_BAR_WORDS, (volatile LAS unsigned*)(lds + MISC_OFF));
    const int lo = kargs()->ph_lo, hi = kargs()->ph_hi;
#define IN(k) (lo <= (k) && (k) < hi)
#define SEAM(k) do { if (IN(k) && IN((k) + 1)) xcd_barrier(bar, opq_tid(), (k) > 0); } while (0)
#define VBID() ({ volatile LAS unsigned* st_ = (volatile LAS unsigned*)(lds + MISC_OFF); (int)__builtin_amdgcn_readfirstlane(st_[3] ? (int)(st_[2] * 8u + bar.x) : bid); })
#define VGRP() ({ volatile LAS unsigned* st_ = (volatile LAS unsigned*)(lds + MISC_OFF); (int)__builtin_amdgcn_readfirstlane(st_[3] ? (int)bar.x : -1); })
#define LANE_VARS const int tid_ = opq_tid(), lane = tid_ & 63, wave = __builtin_amdgcn_readfirstlane(tid_ >> 6), gw = vcu * NWAVES + wave
    if (IN(0) && (PHMASK & 1)) for (int rep = 0; rep < NREP(1); ++rep) { LANE_VARS; prologue(kargs(), lds, gw, NGW, wave, lane); }
    SEAM(0);
#define OPQ(p) ({ auto _p = (p); asm volatile("" : "+s"(_p)); _p; })
    for (int L = 0; L < DEPTH; ++L) {
        const int p0 = 1 + 8 * L;
        if (IN(p0 + 0) && (PHMASK & 2)) for (int rep = 0; rep < NREP(2); ++rep) {
            KArgs ap = kargs(); unsigned char* wsp = ap->ws; const int Lp = OPQ(L);
            pg8::Gemm g{(const bf16_t*)(wsp + ((Lp & 1) ? WS_XB1 : WS_XB0)), (const bf16_t*)(wsp + WS_W + (size_t)Lp * W_LAYER + W_IN), M, 2816, 1024}; pg8::StaticOrder S; S.init(M, 2816, G, VBID());
            EpiProj E{(bf16_t*)(wsp + WS_BIG), stat_ptr(wsp, Lp, ST_X1), ap->in[4] + Lp * 256, ap->in[5] + Lp * 256, (const float*)(wsp + WS_TAB)};
            pg8::gemm_phase<EpiProj, pg8::StaticOrder, PG8_ALIGN, PG8_SP2>(lds, g, S, E, wave0);
        }
        SEAM(p0 + 0);
        if (IN(p0 + 1) && (PHMASK & 4)) {
            LANE_VARS; (void)gw; mixers(kargs(), OPQ(L), lds, tid_, wave, lane, VGRP());
        }
        SEAM(p0 + 1);
        if (IN(p0 + 2) && (PHMASK & 8)) {
            KArgs ap = kargs(); unsigned char* wsp = ap->ws; const int Lp = OPQ(L);
            pg8::Gemm g{(const bf16_t*)(wsp + WS_Y), (const bf16_t*)(wsp + WS_W + (size_t)Lp * W_LAYER + W_OUT), M, 1024, 1024}; pg8::StaticOrder S; S.init(M, 1024, G, VBID());
            EpiNormRes E{(bf16_t*)(wsp + ((Lp & 1) ? WS_XB1 : WS_XB0)), ap->in[11] + Lp * D_MODEL, stat_ptr(wsp, Lp, ST_MIX), stat_ptr(wsp, Lp, ST_X2), (unsigned*)wsp + CW_TMO};
            pg8::gemm_phase<EpiNormRes, pg8::StaticOrder, PG8_ALIGN, PG8_SP2>(lds, g, S, E, wave0);
        }
        SEAM(p0 + 2);
        if (IN(p0 + 4) && (PHMASK & 32)) for (int rep = 0; rep < NREP(32); ++rep) {
            KArgs ap = kargs(); unsigned char* wsp = ap->ws; const int Lp = OPQ(L);
            pg8::Gemm g{(const bf16_t*)(wsp + ((Lp & 1) ? WS_XB1 : WS_XB0)), (const bf16_t*)(wsp + WS_W + (size_t)Lp * W_LAYER + W_FFI), M, 5632, 1024}; pg8::StaticOrder S; S.init(M, 5632, G, VBID());
            EpiSwiglu E{(bf16_t*)(wsp + WS_BIG), stat_ptr(wsp, Lp, ST_X2), 1.0f / KREP3};
            pg8::gemm_phase<EpiSwiglu, pg8::StaticOrder, PG8_ALIGN, PG8_SP2, KREP3>(lds, g, S, E, wave0);
        }
        SEAM(p0 + 4);
        if (IN(p0 + 5) && (PHMASK & 64)) {
            { KArgs ap = kargs(); unsigned char* wsp = ap->ws; const int Lp = OPQ(L);
              pg8::Gemm g{(const bf16_t*)(wsp + WS_BIG), (const bf16_t*)(wsp + WS_W + (size_t)Lp * W_LAYER + W_FFO), M, 1024, D_FF}; pg8::StaticOrder S; S.init(M, 1024, G, VBID());
              EpiNormRes E{(bf16_t*)(wsp + ((Lp & 1) ? WS_XB1 : WS_XB0)), ap->in[15] + Lp * D_MODEL, stat_ptr(wsp, Lp, ST_F), nullptr, (unsigned*)wsp + CW_TMO};
              pg8::gemm_phase<EpiNormRes, pg8::StaticOrder, PG8_ALIGN, PG8_SP2>(lds, g, S, E, wave0); }
            { KArgs ap = kargs(); unsigned char* wsp = ap->ws; const int Lp = OPQ(L);
              pg8::Gemm g{(const bf16_t*)(wsp + WS_PB) + (size_t)Lp * M * PLE_DIM, (const bf16_t*)(wsp + WS_W + (size_t)Lp * W_LAYER + W_P), M, 1024, PLE_DIM}; pg8::StaticOrder S; S.init(M, 1024, G, VBID());
              EpiStat E{(bf16_t*)(wsp + WS_MIX), stat_ptr(wsp, Lp, ST_PP)};
              pg8::gemm_phase<EpiStat, pg8::StaticOrder, PG8_ALIGN, PG8_SP2>(lds, g, S, E, wave0); }
        }
        SEAM(p0 + 5);
        if (IN(p0 + 7) && (PHMASK & 256)) {
            KArgs ap = kargs(); unsigned char* wsp = ap->ws; const int Lp = OPQ(L);
            const bf16_t* XBc = (const bf16_t*)(wsp + ((Lp & 1) ? WS_XB1 : WS_XB0));
            pg8::Gemm g{XBc, (const bf16_t*)(wsp + WS_W + (size_t)Lp * W_LAYER + W_G), M, 1024, 1024}; pg8::StaticOrder S; S.init(M, 1024, G, VBID());
            const bool last = (Lp == DEPTH - 1);
            EpiPle E{XBc, (const bf16_t*)(wsp + WS_MIX), stat_ptr(wsp, Lp, ST_PP), ap->in[18] + Lp * D_MODEL, last ? nullptr : (bf16_t*)(wsp + ((Lp & 1) ? WS_XB0 : WS_XB1)), last ? nullptr : stat_ptr(wsp, Lp + 1, ST_X1), last ? ap->out : nullptr};
            pg8::gemm_phase<EpiPle, pg8::StaticOrder, PG8_ALIGN, PG8_SP2>(lds, g, S, E, wave0);
        }
        SEAM(p0 + 7);
    }
#undef IN
#undef SEAM
#undef VBID
#undef VGRP
#undef LANE_VARS
#undef opq_tid
}

extern "C" void kernel_launch(void* const* d_in, const int* in_sizes, int n_in, void* d_out, int out_size, void* d_ws, size_t ws_size, hipStream_t stream) {
    static int grid = 0;
    if (grid == 0) {
        if (n_in != 19 || out_size != M * D_MODEL || ws_size < WS_END) { fprintf(stderr, "kernel_launch: unexpected shapes (n_in %d out %d ws %zu)\n", n_in, out_size, ws_size); grid = -1; return; }
        int dev = 0, cus = 0, per_cu = 0;
        if (hipGetDevice(&dev) != hipSuccess || hipDeviceGetAttribute(&cus, hipDeviceAttributeMultiprocessorCount, dev) != hipSuccess) { grid = -1; return; }
        if (hipFuncSetAttribute((const void*)mega, hipFuncAttributeMaxDynamicSharedMemorySize, LDS_BYTES) != hipSuccess) { fprintf(stderr, "kernel_launch: hipFuncSetAttribute failed\n"); grid = -1; return; }
        if (hipOccupancyMaxActiveBlocksPerMultiprocessor(&per_cu, (const void*)mega, NTHREADS, LDS_BYTES) != hipSuccess || per_cu < 1) { fprintf(stderr, "kernel_launch: occupancy query says %d\n", per_cu); }
        (void)hipGetLastError();
        grid = cus >= 256 ? 256 : cus;
    }
    if (grid < 0) return;
    unsigned char* ws = (unsigned char*)d_ws;
    (void)hipMemsetAsync(ws + WS_CTL, 0, CTL_ZERO_BYTES, stream);
    Args a{};
    for (int i = 0; i < 19; ++i) a.in[i] = (const float*)d_in[i];
    a.out = (float*)d_out; a.ws = ws; a.li = 0; a.pad = 0;
    a.ph_lo = 0; a.ph_hi = N_PHASES;
    hipLaunchKernelGGL(mega, dim3(grid), dim3(NTHREADS), LDS_BYTES, stream, a);
}
```

```cpp
#include <hip/hip_runtime.h>
#include <stdint.h>
#include <stdio.h>

constexpr int D_MODEL = 1024, BATCH = 32, SEQ = 2048, DEPTH = 2, PLE_DIM = 256, HD = 64, CHUNK = 128;
constexpr int M = BATCH * SEQ;
constexpr int IN_W = 2688, D_FF = 2816, NHEADS = 42;
constexpr int H_AU = 0, H_AV = 4, H_BQ = 8, H_BK = 14, H_BV = 20, H_BG = 26, H_CQ = 32, H_CK = 38, H_CV = 40;
constexpr float EPS = 1e-6f;
typedef unsigned short bf16_t;

__device__ __forceinline__ float bf2f(bf16_t v) { return __uint_as_float(((unsigned)v) << 16); }
__device__ __forceinline__ bf16_t f2bf(float f) { unsigned u = __float_as_uint(f); return (bf16_t)((u + 0x7fffu + ((u >> 16) & 1u)) >> 16); }
__device__ __forceinline__ float shx(float v, int mask, int lane) { return __int_as_float(__builtin_amdgcn_ds_bpermute((lane ^ mask) << 2, __float_as_int(v))); }
__device__ __forceinline__ float wave_sum(float v) {
#pragma unroll
    for (int o = 1; o < 64; o <<= 1) v += __shfl_xor(v, o);
    return v;
}
constexpr float LOG2E_ = 1.4426950408889634f;

__constant__ double c_inv_ret[32] = {1.0, 0.7498942093324559, 0.5623413251903491, 0.4216965034285822, 0.31622776601683794, 0.23713737056616552, 0.1778279410038923, 0.1333521432163324, 0.1, 0.07498942093324558, 0.05623413251903491, 0.042169650342858224, 0.03162277660168379, 0.023713737056616554, 0.01778279410038923, 0.01333521432163324, 0.01, 0.007498942093324558, 0.005623413251903491, 0.004216965034285823, 0.0031622776601683794, 0.0023713737056616554, 0.0017782794100389228, 0.001333521432163324, 0.001, 0.0007498942093324559, 0.0005623413251903491, 0.00042169650342858224, 0.00031622776601683794, 0.00023713737056616554, 0.00017782794100389227, 0.0001333521432163324};
__constant__ double c_inv_swa[8] = {1.0, 0.19392274474868576, 0.03760603093086393, 0.007292664737217109, 0.001414213562373095, 0.0002742481756762073, 5.318295896944988e-05, 1.031338537721246e-05};
__constant__ float c_log2g[6] = {-0.04580368961312479f, -0.02272007650008353f, -0.011315313227834146f, -0.005646563141142063f, -0.0028205190623786626f, -0.0014095702546713536f};

constexpr size_t MiB = 1u << 20;
constexpr size_t WS_CTL = 0, CTL_ZERO_BYTES = 7 * MiB;
constexpr size_t WS_STAT = 1 * MiB;
constexpr size_t WS_TAB = 7 * MiB;
constexpr size_t WS_WM = 7 * MiB + 768 * 1024;
constexpr size_t WS_W = 8 * MiB;
constexpr size_t WS_XB0 = 64 * MiB;
constexpr size_t WS_BIG = 192 * MiB;
constexpr size_t WS_Y = 544 * MiB;
constexpr size_t WS_MIX = 672 * MiB;
constexpr size_t WS_XB1 = 800 * MiB;
constexpr size_t WS_PB = 928 * MiB;
constexpr size_t WS_END = 992 * MiB;
constexpr int TAB_RC = 0, TAB_RS = 2048 * 32, TAB_SC = 2 * 2048 * 32, TAB_SS = 2 * 2048 * 32 + 2048 * 8;


namespace pg8 {
#define PG8_LAS __attribute__((address_space(3)))
typedef unsigned short bf16_t;
typedef short bf16x8 __attribute__((ext_vector_type(8)));
typedef float f32x4 __attribute__((ext_vector_type(4)));
typedef unsigned u32x4 __attribute__((ext_vector_type(4)));
constexpr int BM = 256, BK = 64, HALF = 128, HTB = HALF * BK * 2  , STAGE_BYTES = 8 * HTB, NXCD = 8, WGM = 8;

__host__ __device__ __forceinline__ int lds_byte(int r, int c) { const int st = (r >> 4) * 2 + (c >> 5), rr = r & 15, cc = c & 31, ob = rr * 64 + cc * 2; return st * 1024 + (ob ^ (((ob >> 9) & 1) << 5)); }
__host__ __device__ __forceinline__ void stage_rc(int b, int& R, int& C) { const int st = b / 1024, sb = b % 1024, swz = sb ^ (((sb >> 9) & 1) << 5); R = (st >> 1) * 16 + swz / 64; C = (st & 1) * 32 + (swz % 64) / 2; }
__host__ __device__ __forceinline__ int perm32(int rho) { const int n = rho >> 4, i = rho & 15; return 8 * (i >> 2) + 4 * n + (i & 3); }

constexpr int PREF_OFF = 147456 + 4096;
struct Unit { int pm, pn; };
struct Gemm { const bf16_t* A; const bf16_t* Bt; int M, N, K; };

struct StaticOrder {
    int nM, nN, nwg, G, c, wgm;
    __host__ __device__ void init(int M, int N, int G_, int c_) { nM = M / BM; nN = N / BM; nwg = nM * nN; G = G_; c = c_; wgm = nN >= 8 ? 4 : WGM; }
    __host__ __device__ bool next(int i, Unit& u) const {
        const long L = (long)i * G + c; if (L >= nwg) return false;
        int wgid = (int)L; { const int q = nwg / NXCD, r = nwg % NXCD, xcd = wgid % NXCD, off = wgid / NXCD; wgid = (xcd < r ? xcd * (q + 1) : r * (q + 1) + (xcd - r) * q) + off; }
        const int nig = wgm * nN, gid = wgid / nig, fm = gid * wgm, gsz = (nM - fm) < wgm ? (nM - fm) : wgm;
        u.pm = fm + ((wgid % nig) % gsz); u.pn = (wgid % nig) / gsz; return true;
    }
    __device__ __forceinline__ void a_ready(const Unit&) const {}
    __device__ __forceinline__ void done(const Unit&) const {}
};

typedef float f32x2_cv __attribute__((ext_vector_type(2))); typedef __bf16 bf16x2_cv __attribute__((ext_vector_type(2)));
__device__ __forceinline__ unsigned cvt_pk_bf16(float lo, float hi) { const f32x2_cv v = {lo, hi}; const bf16x2_cv b = __builtin_convertvector(v, bf16x2_cv); return __builtin_bit_cast(unsigned, b); }
__device__ __forceinline__ int pg8_tid(int wave0) {
    unsigned ones = ~0u; asm volatile("" : "+s"(ones));
    return wave0 * 64 + (int)__builtin_amdgcn_mbcnt_hi(ones, __builtin_amdgcn_mbcnt_lo(ones, 0u));
}
template <class Epi, class Sched, bool ALIGN_EPI = false, bool SP2 = false, int KREP = 1>
__device__ __forceinline__ void gemm_phase(PG8_LAS unsigned char* lds, const Gemm g, const Sched& S, const Epi& E, int wave0) {
    const int tid = pg8_tid(wave0);
    const int wid = __builtin_amdgcn_readfirstlane(tid >> 6), lane = tid & 63, wr = wid >> 2, wc = wid & 3, fr = lane & 15, fq = lane >> 4;
    const int K = g.K, nt = K / BK;
    unsigned voffA[2], voffB[2];
#pragma unroll
    for (int i = 0; i < 2; ++i) { int R, C; stage_rc(tid * 16 + i * 8192, R, C); const int Rb = Epi::PERM ? ((R & ~31) + perm32(R & 31)) : R;
        voffA[i] = (unsigned)(R * K + C) * 2u; voffB[i] = (unsigned)(Rb * K + C) * 2u; }
    const size_t kstep = (size_t)(BK * 2);
    const size_t hstep = (size_t)HALF * K * 2;
    const size_t tstep = 2 * hstep;
    const unsigned ldsw = (unsigned)wid * 1024u;
    const int aoff = lds_byte(wr * 64 + fr, fq * 8), boff = lds_byte(wc * 32 + fr, fq * 8);
#define PG8_SA(b, h) (((b) * 2 + (h)) * HTB)
#define PG8_SB(b, h) ((4 + (b) * 2 + (h)) * HTB)
#define PG8_STAGE(bufoff, gbase, voff) do { _Pragma("unroll") for (int _i = 0; _i < 2; ++_i) \
        __builtin_amdgcn_global_load_lds((const unsigned*)((const char*)(gbase) + (voff)[_i]), (PG8_LAS unsigned*)(lds + (bufoff) + ldsw + _i * 8192), 16, 0, 0); } while (0)
#define PG8_LDA(dst, b, h) do { _Pragma("unroll") for (int m = 0; m < 4; ++m) _Pragma("unroll") for (int k = 0; k < 2; ++k) dst[m][k] = *(const PG8_LAS bf16x8*)(lds + PG8_SA(b, h) + aoff + m * 2048 + k * 1024); } while (0)
#define PG8_LDB(dst, b, h) do { _Pragma("unroll") for (int n = 0; n < 2; ++n) _Pragma("unroll") for (int k = 0; k < 2; ++k) dst[n][k] = *(const PG8_LAS bf16x8*)(lds + PG8_SB(b, h) + boff + n * 2048 + k * 1024); } while (0)
#define PG8_MMA(ai, bj, At, Bt) do { __builtin_amdgcn_s_setprio(1); _Pragma("unroll") for (int m = 0; m < 4; ++m) _Pragma("unroll") for (int n = 0; n < 2; ++n) _Pragma("unroll") for (int k = 0; k < 2; ++k) \
        acc[ai][bj][m][n] = __builtin_amdgcn_mfma_f32_16x16x32_bf16(Bt[n][k], At[m][k], acc[ai][bj][m][n], 0, 0, 0); __builtin_amdgcn_s_setprio(0); } while (0)
#define PG8_WAIT_V(n) asm volatile("s_waitcnt vmcnt(" #n ")" ::: "memory")
#define PG8_WAIT_L(n) asm volatile("s_waitcnt lgkmcnt(" #n ")" ::: "memory")
#define PG8_BAR __builtin_amdgcn_s_barrier()
#define PG8_SCHED __builtin_amdgcn_sched_barrier(0)
    Unit cur, nxt; int ui = 0;
    if (!S.next(0, cur)) return;
    f32x4 acc[2][2][4][2];
#pragma unroll
    for (int a = 0; a < 2; ++a)
#pragma unroll
        for (int b = 0; b < 2; ++b)
#pragma unroll
            for (int m = 0; m < 4; ++m)
#pragma unroll
                for (int n = 0; n < 2; ++n) acc[a][b][m][n] = (f32x4){0.f, 0.f, 0.f, 0.f};
    bf16x8 At[4][2], B0[2][2], B1[2][2];
    const char* cA = (const char*)g.A + (size_t)cur.pm * tstep; const char* cB = (const char*)g.Bt + (size_t)cur.pn * tstep;
    S.a_ready(cur);
    if constexpr (SP2) {
        PG8_STAGE(PG8_SB(0, 0), cB, voffB); PG8_STAGE(PG8_SB(0, 1), cB + hstep, voffB); PG8_STAGE(PG8_SA(0, 0), cA, voffA); PG8_STAGE(PG8_SA(0, 1), cA + hstep, voffA);
        if (wr == 1) PG8_BAR;
        PG8_WAIT_V(2); PG8_BAR;
        PG8_STAGE(PG8_SB(1, 0), cB + kstep, voffB); PG8_STAGE(PG8_SA(1, 0), cA + kstep, voffA); PG8_STAGE(PG8_SB(1, 1), cB + hstep + kstep, voffB);
        PG8_WAIT_V(6); PG8_BAR;
    } else {
        PG8_STAGE(PG8_SB(0, 0), cB, voffB); PG8_STAGE(PG8_SA(0, 0), cA, voffA); PG8_STAGE(PG8_SB(0, 1), cB + hstep, voffB); PG8_STAGE(PG8_SA(0, 1), cA + hstep, voffA);
        if (wr == 1) PG8_BAR;
        PG8_WAIT_V(4); PG8_BAR;
        PG8_STAGE(PG8_SB(1, 0), cB + kstep, voffB); PG8_STAGE(PG8_SA(1, 0), cA + kstep, voffA); PG8_STAGE(PG8_SB(1, 1), cB + hstep + kstep, voffB);
        PG8_WAIT_V(6); PG8_BAR;
    }
    for (;;) {
        const bool has_next = S.next(ui + 1, nxt);
        const char* nA = has_next ? (const char*)g.A + (size_t)nxt.pm * tstep : cA; const char* nB = has_next ? (const char*)g.Bt + (size_t)nxt.pn * tstep : cB;
        for (int t = 0; t < nt * KREP; t += 2) {
            const bool last = (t == nt * KREP - 2);
            const int t1 = KREP > 1 ? (t + 1) % nt : t + 1, t2 = KREP > 1 ? (t + 2) % nt : t + 2;
            const char* a1 = cA + (size_t)t1 * kstep;
            const char* a2 = last ? nA : cA + (size_t)t2 * kstep; const char* b2 = last ? nB : cB + (size_t)t2 * kstep;
            const char* a3 = a2 + kstep; const char* b3 = b2 + kstep;
            if (last && has_next) S.a_ready(nxt);
            if constexpr (Epi::PREF) { if (last) E.prefetch(lds, cur, wid, lane); }
            if constexpr (SP2) {
            PG8_LDB(B0, 0, 0); PG8_LDB(B1, 0, 1); PG8_SCHED; PG8_LDA(At, 0, 0); PG8_STAGE(PG8_SA(1, 1), a1 + hstep, voffA);
            PG8_WAIT_V(8); PG8_WAIT_L(0); PG8_BAR; PG8_MMA(0, 0, At, B0); PG8_MMA(0, 1, At, B1); PG8_BAR; PG8_SCHED;
            PG8_LDA(At, 0, 1); PG8_STAGE(PG8_SB(0, 0), b2, voffB); PG8_STAGE(PG8_SB(0, 1), b2 + hstep, voffB); PG8_STAGE(PG8_SA(0, 0), a2, voffA);
            PG8_WAIT_V(8); PG8_WAIT_L(0); PG8_BAR; PG8_MMA(1, 0, At, B0); PG8_MMA(1, 1, At, B1); PG8_BAR; PG8_SCHED;
            PG8_LDB(B0, 1, 0); PG8_LDB(B1, 1, 1); PG8_SCHED; PG8_LDA(At, 1, 0); PG8_STAGE(PG8_SA(0, 1), a2 + hstep, voffA);
            PG8_WAIT_V(8); PG8_WAIT_L(0); PG8_BAR; PG8_MMA(0, 0, At, B0); PG8_MMA(0, 1, At, B1); PG8_BAR; PG8_SCHED;
            PG8_LDA(At, 1, 1); PG8_STAGE(PG8_SB(1, 0), b3, voffB); PG8_STAGE(PG8_SB(1, 1), b3 + hstep, voffB); PG8_STAGE(PG8_SA(1, 0), a3, voffA);
            PG8_WAIT_V(8); PG8_WAIT_L(0); PG8_BAR; PG8_MMA(1, 0, At, B0); PG8_MMA(1, 1, At, B1); PG8_BAR; PG8_SCHED;
            } else {
            PG8_LDB(B0, 0, 0); PG8_SCHED; PG8_LDA(At, 0, 0); PG8_STAGE(PG8_SA(1, 1), a1 + hstep, voffA);
            PG8_WAIT_L(8); PG8_BAR; PG8_WAIT_L(0); PG8_MMA(0, 0, At, B0); PG8_BAR; PG8_SCHED;
            PG8_LDB(B1, 0, 1); PG8_STAGE(PG8_SB(0, 0), b2, voffB);
            PG8_BAR; PG8_WAIT_L(0); PG8_MMA(0, 1, At, B1); PG8_BAR;
            PG8_LDA(At, 0, 1); PG8_STAGE(PG8_SA(0, 0), a2, voffA);
            PG8_BAR; PG8_WAIT_L(0); PG8_MMA(1, 0, At, B0); PG8_BAR; PG8_SCHED;
            PG8_STAGE(PG8_SB(0, 1), b2 + hstep, voffB);
            PG8_WAIT_V(6); PG8_BAR; PG8_MMA(1, 1, At, B1); PG8_BAR;
            PG8_LDB(B0, 1, 0); PG8_SCHED; PG8_LDA(At, 1, 0); PG8_STAGE(PG8_SA(0, 1), a2 + hstep, voffA);
            PG8_WAIT_L(8); PG8_BAR; PG8_WAIT_L(0); PG8_MMA(0, 0, At, B0); PG8_BAR; PG8_SCHED;
            PG8_LDB(B1, 1, 1); PG8_STAGE(PG8_SB(1, 0), b3, voffB);
            PG8_BAR; PG8_WAIT_L(0); PG8_MMA(0, 1, At, B1); PG8_BAR;
            PG8_LDA(At, 1, 1); PG8_STAGE(PG8_SA(1, 0), a3, voffA);
            PG8_BAR; PG8_WAIT_L(0); PG8_MMA(1, 0, At, B0); PG8_BAR; PG8_SCHED;
            PG8_STAGE(PG8_SB(1, 1), b3 + hstep, voffB);
            PG8_WAIT_V(6); PG8_BAR; PG8_MMA(1, 1, At, B1); PG8_BAR;
            }
        }
        if constexpr (ALIGN_EPI) { if (wr == 0) PG8_BAR; }
        if constexpr (!Epi::AFTER_DRAIN) { E(acc, cur, wr, wc, fr, fq); S.done(cur); }
        if (!has_next) break;
#pragma unroll
        for (int a = 0; a < 2; ++a)
#pragma unroll
            for (int b = 0; b < 2; ++b)
#pragma unroll
                for (int m = 0; m < 4; ++m)
#pragma unroll
                    for (int n = 0; n < 2; ++n) acc[a][b][m][n] = (f32x4){0.f, 0.f, 0.f, 0.f};
        cur = nxt; cA = nA; cB = nB; ++ui;
        if constexpr (ALIGN_EPI) { if (wr == 1) PG8_BAR; }
    }
    PG8_WAIT_V(0);
    if constexpr (!ALIGN_EPI) { if (wr == 0) PG8_BAR; }
    PG8_BAR;
    if constexpr (Epi::AFTER_DRAIN) { E.fused(acc, cur, wr, wc, fr, fq, lds, wid, lane); S.done(cur); }
#undef PG8_SA
#undef PG8_SB
#undef PG8_STAGE
#undef PG8_LDA
#undef PG8_LDB
#undef PG8_MMA
#undef PG8_WAIT_V
#undef PG8_WAIT_L
#undef PG8_BAR
#undef PG8_SCHED
}
}

#define LAS __attribute__((address_space(3)))
#define GAS __attribute__((address_space(1)))
using pg8::f32x4; using pg8::u32x4; using pg8::Unit; using pg8::cvt_pk_bf16;
typedef unsigned u32x2 __attribute__((ext_vector_type(2)));
typedef GAS unsigned gu32;
#define RLX_AGENT __ATOMIC_RELAXED, __HIP_MEMORY_SCOPE_AGENT

constexpr int NWAVES = 8, NTHREADS = 512;
constexpr int LDS_BYTES = 163840;
constexpr int RING_BYTES = 147456, MISC_OFF = RING_BYTES + 320;
constexpr size_t W_IN = 0, W_OUT = W_IN + (size_t)2816 * 1024 * 2, W_FFI = W_OUT + (size_t)1024 * 1024 * 2, W_FFO = W_FFI + (size_t)5632 * 1024 * 2,
                 W_G = W_FFO + (size_t)1024 * 2816 * 2, W_P = W_G + (size_t)1024 * 1024 * 2, W_LAYER = W_P + (size_t)1024 * 256 * 2;
static_assert(WS_W + 2 * W_LAYER <= WS_XB0, "weights fit");
enum { ST_X1 = 0, ST_MIX = 1, ST_X2 = 2, ST_F = 3, ST_PP = 4, ST_N = 5 };
typedef unsigned long long stat_t;
__host__ __device__ __forceinline__ stat_t* stat_ptr(unsigned char* ws, int L, int idx) { return (stat_t*)(ws + WS_STAT) + (size_t)(L * ST_N + idx) * M; }
static_assert(WS_STAT + (size_t)2 * ST_N * M * 8 <= CTL_ZERO_BYTES && CTL_ZERO_BYTES <= WS_TAB, "stats inside the zeroed region");
__device__ __forceinline__ stat_t ss_enc(float s) { return (stat_t)(s * 16777216.0f); }
__device__ __forceinline__ float ss_dec(stat_t v) { return (float)v * (1.0f / 16777216.0f); }
constexpr int CW_BAR = 4096;

#define XB_TMO      128
#define XB_XCNT(j)  (256  + 64 * (j))
#define XB_XSUB(j)  (1280 + 64 * (j))
#define XB_XGEN(j)  (2304 + 64 * (j))
#define XB_TOP      3328
#define XB_TOPGEN   3392
#define XCD_BAR_WORDS 3456
#define XB_SPIN_CAP (1u << 22)
__device__ __forceinline__ unsigned xb_ld(unsigned* p)              { return __hip_atomic_load(p, __ATOMIC_RELAXED, __HIP_MEMORY_SCOPE_AGENT); }
__device__ __forceinline__ unsigned xb_add(unsigned* p, unsigned v) { return __hip_atomic_fetch_add(p, v, __ATOMIC_RELAXED, __HIP_MEMORY_SCOPE_AGENT); }
__device__ __forceinline__ unsigned xb_xcc_id() { return (unsigned)__builtin_amdgcn_s_getreg((3 << 11) | 20) & 0xFu; }
#define XB_SPIN(cond, bar) do { unsigned _sp = 0; while (cond) { __builtin_amdgcn_s_sleep(1); \
    if ((++_sp & 255u) == 0u) { if (xb_ld(&(bar)[XB_TMO])) break; if (_sp > XB_SPIN_CAP) { atomicAdd(&(bar)[XB_TMO], 1u); break; } } } } while (0)
struct XcdBarrier { unsigned* bar; unsigned x; volatile LAS unsigned* st; };
__device__ __forceinline__ XcdBarrier xcd_barrier_post(unsigned* bar, volatile LAS unsigned* st) {
    XcdBarrier b; b.bar = bar; b.x = xb_xcc_id(); b.st = st;
    if (threadIdx.x == 0) st[2] = xb_add(&bar[XB_XCNT(b.x)], 1u);
    return b;
}
__device__ __forceinline__ void xcd_barrier_complete(unsigned* bar, unsigned x, unsigned& nloc, unsigned& nx, unsigned& uni) {
    const unsigned G = gridDim.x * gridDim.y * gridDim.z;
    unsigned sum, cnt, mine, odd, sp = 0u;
    for (;;) {
        sum = 0u; cnt = 0u; mine = 0u; odd = 0u;
#pragma unroll
        for (unsigned j = 0; j < 16; ++j) { const unsigned c = xb_ld(&bar[XB_XCNT(j)]); sum += c; cnt += (c > 0u) ? 1u : 0u; mine = (j == x) ? c : mine; odd |= (c != 0u && c != 32u) ? 1u : 0u; odd |= (c != 0u && j >= 8u) ? 1u : 0u; }
        if (sum == G) break;
        __builtin_amdgcn_s_sleep(1);
        if ((++sp & 255u) == 0u) { if (xb_ld(&bar[XB_TMO])) break; if (sp > XB_SPIN_CAP) { atomicAdd(&bar[XB_TMO], 1u); break; } }
    }
    nloc = mine > 0u ? mine : 1u; nx = cnt > 0u ? cnt : 1u;
    uni = (sum == G && G == 256u && cnt == 8u && odd == 0u) ? 1u : 0u;
}
__device__ __forceinline__ void xcd_barrier(const XcdBarrier& b, int tid, bool may_local = false) {
    asm volatile("s_waitcnt vmcnt(0)" ::: "memory");
    __syncthreads();
    if (tid == 0) {
        unsigned* bar = b.bar;
        __builtin_amdgcn_s_waitcnt(0);
        unsigned nloc = b.st[0], nx = b.st[1];
        if (nloc == 0u) { unsigned uni; xcd_barrier_complete(bar, b.x, nloc, nx, uni); b.st[0] = nloc; b.st[1] = nx; b.st[3] = uni; }
        const bool local = may_local && b.st[3] != 0u;
        const unsigned old = xb_add(&bar[XB_XSUB(b.x)], 1u);
        const unsigned gen = old / nloc;
        if (old + 1u == (gen + 1u) * nloc) {
            __builtin_amdgcn_fence(__ATOMIC_RELEASE, "agent");
            asm volatile("s_waitcnt vmcnt(0)" ::: "memory");
            if (!local) {
                const unsigned og = xb_add(&bar[XB_TOP], 1u);
                const unsigned tg = og / nx;
                if (og + 1u == (tg + 1u) * nx) xb_add(&bar[XB_TOPGEN], 1u);
                else XB_SPIN(xb_ld(&bar[XB_TOPGEN]) == tg, bar);
            }
            __builtin_amdgcn_fence(__ATOMIC_ACQUIRE, "agent");
            xb_add(&bar[XB_XGEN(b.x)], 1u);
            asm volatile("s_waitcnt vmcnt(0)" ::: "memory");
        } else {
            XB_SPIN(xb_ld(&bar[XB_XGEN(b.x)]) == gen, bar);
            __builtin_amdgcn_fence(__ATOMIC_ACQUIRE, "agent");
            asm volatile("s_waitcnt vmcnt(0)" ::: "memory");
        }
    }
    __syncthreads();
}

constexpr int CW_CLAIM = 8192;
struct StealOrder {
    int x, j; unsigned* claim; unsigned* bar; unsigned need; unsigned* tmo;
    mutable int own_i, vy, vr;
    __device__ __forceinline__ void init(int x_, int j_, unsigned* claim_, unsigned* bar_, unsigned need_, unsigned* tmo_) { x = x_; j = j_; claim = claim_; bar = bar_; need = need_; tmo = tmo_; own_i = 0; vy = 1; vr = 3; }
    __device__ __forceinline__ bool mine(int wgid) const {
        const unsigned me = (unsigned)(x * 32 + j) + 1u;
        unsigned* w_ = claim + wgid;
        typedef unsigned u32x2_t __attribute__((ext_vector_type(2)));
        const u32x2_t dc = {me, 0u};
        unsigned old_; unsigned long long sv_;
        asm volatile("s_mov_b64 %1, exec\n\ts_mov_b64 exec, 1\n\tglobal_atomic_cmpswap %0, %2, %3, off sc0\n\ts_waitcnt vmcnt(0)\n\ts_mov_b64 exec, %1"
                     : "=&v"(old_), "=&s"(sv_) : "v"(w_), "v"(dc) : "memory");
        const unsigned r = (unsigned)__builtin_amdgcn_readfirstlane((int)old_);
        return r == 0u || r == me;
    }
    static __device__ __forceinline__ void tile(int wgid, pg8::Unit& u) { const int gid = wgid >> 5, s = wgid & 31; u.pm = gid * 8 + (s & 7); u.pn = s >> 3; }
    __device__ __forceinline__ bool next(int, pg8::Unit& u) const {
        while (own_i < 4) { const int wgid = x * 128 + own_i * 32 + j; ++own_i; if (mine(wgid)) { tile(wgid, u); return true; } }
        while (vy < 8) {
            const int y = (x + vy) & 7;
            while (vr >= 1) { const int wgid = y * 128 + vr * 32 + j; --vr; if (mine(wgid)) { tile(wgid, u); return true; } }
            vr = 3; ++vy;
        }
        return false;
    }
    __device__ __forceinline__ void a_ready(const pg8::Unit& u) const {
        const int y = u.pm >> 5;
        if (y == x) return;
        unsigned sp = 0;
        while (xb_ld(&bar[XB_XGEN(y)]) < need) { __builtin_amdgcn_s_sleep(2); if (++sp > XB_SPIN_CAP) { __hip_atomic_store(tmo, 1u, __ATOMIC_RELAXED, __HIP_MEMORY_SCOPE_AGENT); break; } }
        __builtin_amdgcn_fence(__ATOMIC_ACQUIRE, "agent");
    }
    __device__ __forceinline__ void done(const pg8::Unit&) const {}
};

__device__ __forceinline__ float fast_rsq(float x) { return __builtin_amdgcn_rsqf(x); }
__device__ __forceinline__ float sigm(float x) { return __builtin_amdgcn_rcpf(1.0f + __builtin_amdgcn_exp2f(-LOG2E_ * x)); }
__device__ __forceinline__ float gelu_t(float x) { return x * sigm(1.5957691216057308f * (x + 0.044715f * x * x * x)); }
__device__ __forceinline__ void unpack8s(const f32x4& v0, const f32x4& v1, float s, float (&o)[8]) {
    o[0] = v0[0] * s; o[1] = v0[1] * s; o[2] = v0[2] * s; o[3] = v0[3] * s; o[4] = v1[0] * s; o[5] = v1[1] * s; o[6] = v1[2] * s; o[7] = v1[3] * s;
}
__device__ __forceinline__ u32x4 pack8(const float (&o)[8]) {
    u32x4 w; w.x = cvt_pk_bf16(o[0], o[1]); w.y = cvt_pk_bf16(o[2], o[3]); w.z = cvt_pk_bf16(o[4], o[5]); w.w = cvt_pk_bf16(o[6], o[7]); return w;
}
__device__ __forceinline__ void ld8f(const float* p, float (&o)[8]) {
    const f32x4 a = *(const f32x4*)p, b = *(const f32x4*)(p + 4);
    o[0] = a[0]; o[1] = a[1]; o[2] = a[2]; o[3] = a[3]; o[4] = b[0]; o[5] = b[1]; o[6] = b[2]; o[7] = b[3];
}
__device__ __forceinline__ void unpack_bf8(const u32x4& r, float (&o)[8]) {
    o[0] = __uint_as_float(r.x << 16); o[1] = __uint_as_float(r.x & 0xffff0000u); o[2] = __uint_as_float(r.y << 16); o[3] = __uint_as_float(r.y & 0xffff0000u);
    o[4] = __uint_as_float(r.z << 16); o[5] = __uint_as_float(r.z & 0xffff0000u); o[6] = __uint_as_float(r.w << 16); o[7] = __uint_as_float(r.w & 0xffff0000u);
}
__device__ __forceinline__ int fresh_lane() { unsigned ones = ~0u; asm volatile("" : "+s"(ones)); return (int)__builtin_amdgcn_mbcnt_hi(ones, __builtin_amdgcn_mbcnt_lo(ones, 0u)); }
#define EPI_ROW(u, ai, wr, m, fr) ((u).pm * 256 + (ai) * 128 + (wr) * 64 + (m) * 16 + (fr))

enum { T_AU, T_AV, T_BQ, T_BK, T_BV, T_BG, T_CQ, T_CK, T_CV };
struct EpiProj {
    static constexpr bool PERM = true, AFTER_DRAIN = false, PREF = true;
    bf16_t* P; const stat_t* ss; const float* ln_w; const float* ln_b; const float* tab;
    __device__ __forceinline__ void prefetch(LAS unsigned char* lds, const Unit& u, int wid, int lane) const {
        const stat_t* src = ss + u.pm * 256 + (lane >> 5) * 128 + (wid >> 2) * 64 + 2 * (lane & 31);
        __builtin_amdgcn_global_load_lds((const unsigned*)src, (LAS unsigned*)(lds + pg8::PREF_OFF + wid * 1024), 16, 0, 0);
    }
    template <int TYPE> __device__ __forceinline__ void rows(const f32x4 (&acc)[2][2][4][2], const Unit& u, int wr, int hs, int hrel, int fr, int fq) const {
        const int d0 = 8 * fq, ln_ = fr + 16 * fq;
        float rs[8];
#pragma unroll
        for (int q = 0; q < 8; ++q) rs[q] = ss_dec(*(const LAS stat_t*)((LAS unsigned char*)(pg8::PREF_OFF + (wr * 4 + (hs & 3)) * 1024) + (q >> 2) * 512 + ((q & 3) * 16 + fr) * 8));
        float wa[8], wb[8], ba[8], bb[8];
        if constexpr (TYPE == T_AV) { ld8f(ln_w + hrel * 64 + d0, wa); ld8f(ln_w + hrel * 64 + 32 + d0, wb); ld8f(ln_b + hrel * 64 + d0, ba); ld8f(ln_b + hrel * 64 + 32 + d0, bb); }
#pragma unroll
        for (int hp = 0; hp < 4; ++hp) {
            const int ai = hp >> 1;
            float tc[2][8], tsn[2][8];
            if constexpr (TYPE == T_BQ || TYPE == T_BK) {
#pragma unroll
                for (int mm = 0; mm < 2; ++mm) { const int pos = EPI_ROW(u, ai, wr, 2 * (hp & 1) + mm, fr) & (SEQ - 1); ld8f(tab + TAB_RC + pos * 32 + d0, tc[mm]); ld8f(tab + TAB_RS + pos * 32 + d0, tsn[mm]); }
            }
            if constexpr (TYPE == T_CQ || TYPE == T_CK) {
#pragma unroll
                for (int mm = 0; mm < 2; ++mm) { const int pos = EPI_ROW(u, ai, wr, 2 * (hp & 1) + mm, fr) & (SEQ - 1); ld8f(tab + TAB_SC + pos * 8, tc[mm]); ld8f(tab + TAB_SS + pos * 8, tsn[mm]); }
            }
#pragma unroll
            for (int mm = 0; mm < 2; ++mm) {
                const int m = 2 * (hp & 1) + mm;
                const int row = EPI_ROW(u, ai, wr, m, fr);
                const float rstd = fast_rsq(rs[ai * 4 + m] * (1.0f / D_MODEL) + EPS);
                float a[8], b[8];
                unpack8s(acc[ai][0][m][0], acc[ai][0][m][1], rstd, a); unpack8s(acc[ai][1][m][0], acc[ai][1][m][1], rstd, b);
                if constexpr (TYPE == T_AU) {
#pragma unroll
                    for (int j = 0; j < 8; ++j) { a[j] = gelu_t(a[j]); b[j] = gelu_t(b[j]); }
                } else if constexpr (TYPE == T_AV) {
                    float sm = 0.f;
#pragma unroll
                    for (int j = 0; j < 8; ++j) { a[j] = gelu_t(a[j]); b[j] = gelu_t(b[j]); sm += a[j] + b[j]; }
                    sm += shx(sm, 16, ln_); sm += shx(sm, 32, ln_);
                    const float mu = sm * (1.0f / 64.0f); float q = 0.f;
#pragma unroll
                    for (int j = 0; j < 8; ++j) { a[j] -= mu; b[j] -= mu; q += a[j] * a[j] + b[j] * b[j]; }
                    q += shx(q, 16, ln_); q += shx(q, 32, ln_);
                    const float rsd = fast_rsq(q * (1.0f / 64.0f) + EPS);
#pragma unroll
                    for (int j = 0; j < 8; ++j) { a[j] = a[j] * rsd * wa[j] + ba[j]; b[j] = b[j] * rsd * wb[j] + bb[j]; }
                } else if constexpr (TYPE == T_BQ || TYPE == T_BK) {
                    const float tch = (float)(row & (CHUNK - 1)) * c_log2g[hrel];
                    const float sc = __builtin_amdgcn_exp2f(TYPE == T_BK ? -tch - 3.0f : tch);
#pragma unroll
                    for (int j = 0; j < 8; ++j) { const float x1 = a[j], x2 = b[j]; a[j] = (x1 * tc[mm][j] - x2 * tsn[mm][j]) * sc; b[j] = (x2 * tc[mm][j] + x1 * tsn[mm][j]) * sc; }
                } else if constexpr (TYPE == T_BG) {
#pragma unroll
                    for (int j = 0; j < 8; ++j) { a[j] = a[j] * sigm(a[j]); b[j] = b[j] * sigm(b[j]); }
                } else if constexpr (TYPE == T_CQ || TYPE == T_CK) {
                    float o[8];
#pragma unroll
                    for (int j = 0; j < 8; ++j) o[j] = shx(a[j], 16, ln_);
                    if (fq < 2) {
                        const float sg = fq == 0 ? -1.0f : 1.0f;
#pragma unroll
                        for (int j = 0; j < 8; ++j) a[j] = a[j] * tc[mm][j] + sg * o[j] * tsn[mm][j];
                    }
                }
                bf16_t* dst = P + (size_t)row * IN_W + hs * 64 + d0;
                *(u32x4*)dst = pack8(a); *(u32x4*)(dst + 32) = pack8(b);
            }
        }
    }
    __device__ __forceinline__ void operator()(const f32x4 (&acc)[2][2][4][2], const Unit& u, int wr, int wc, int fr, int fq) const {
        const int ln_ = fresh_lane(); fr = ln_ & 15; fq = ln_ >> 4;
        const int hs = u.pn * 4 + wc;
        if (hs >= NHEADS) return;
        if (hs < H_AV) rows<T_AU>(acc, u, wr, hs, hs - H_AU, fr, fq);
        else if (hs < H_BQ) rows<T_AV>(acc, u, wr, hs, hs - H_AV, fr, fq);
        else if (hs < H_BK) rows<T_BQ>(acc, u, wr, hs, hs - H_BQ, fr, fq);
        else if (hs < H_BV) rows<T_BK>(acc, u, wr, hs, hs - H_BK, fr, fq);
        else if (hs < H_BG) rows<T_BV>(acc, u, wr, hs, hs - H_BV, fr, fq);
        else if (hs < H_CQ) rows<T_BG>(acc, u, wr, hs, hs - H_BG, fr, fq);
        else if (hs < H_CK) rows<T_CQ>(acc, u, wr, hs, hs - H_CQ, fr, fq);
        else if (hs < H_CV) rows<T_CK>(acc, u, wr, hs, hs - H_CK, fr, fq);
        else rows<T_CV>(acc, u, wr, hs, hs - H_CV, fr, fq);
    }
};
struct EpiSwiglu {
    static constexpr bool PERM = true, AFTER_DRAIN = false, PREF = true;
    bf16_t* H; const stat_t* ss; float kscale;
    __device__ __forceinline__ void prefetch(LAS unsigned char* lds, const Unit& u, int wid, int lane) const {
        const stat_t* src = ss + u.pm * 256 + (lane >> 5) * 128 + (wid >> 2) * 64 + 2 * (lane & 31);
        __builtin_amdgcn_global_load_lds((const unsigned*)src, (LAS unsigned*)(lds + pg8::PREF_OFF + wid * 1024), 16, 0, 0);
    }
    __device__ __forceinline__ void operator()(const f32x4 (&acc)[2][2][4][2], const Unit& u, int wr, int wc, int fr, int fq) const {
        const int ln_ = fresh_lane(); fr = ln_ & 15; fq = ln_ >> 4;
        float rs[8];
#pragma unroll
        for (int q = 0; q < 8; ++q) rs[q] = ss_dec(*(const LAS stat_t*)((LAS unsigned char*)(pg8::PREF_OFF + (wr * 4 + wc) * 1024) + (q >> 2) * 512 + ((q & 3) * 16 + fr) * 8));
#pragma unroll
        for (int ai = 0; ai < 2; ++ai)
#pragma unroll
            for (int m = 0; m < 4; ++m) {
                const int row = EPI_ROW(u, ai, wr, m, fr);
                const float rstd = fast_rsq(rs[ai * 4 + m] * (1.0f / D_MODEL) + EPS) * kscale;
                typedef float f32x2 __attribute__((ext_vector_type(2)));
                const float cexp = -LOG2E_ * rstd, r2 = rstd * rstd;
                unsigned wv4[4];
#pragma unroll
                for (int n = 0; n < 2; ++n)
#pragma unroll
                    for (int hf = 0; hf < 2; ++hf) {
                        const f32x2 ag = {acc[ai][0][m][n][2 * hf], acc[ai][0][m][n][2 * hf + 1]}, au = {acc[ai][1][m][n][2 * hf], acc[ai][1][m][n][2 * hf + 1]};
                        f32x2 e = ag * cexp; e.x = __builtin_amdgcn_exp2f(e.x); e.y = __builtin_amdgcn_exp2f(e.y);
                        f32x2 d = e + 1.0f; d.x = __builtin_amdgcn_rcpf(d.x); d.y = __builtin_amdgcn_rcpf(d.y);
                        const f32x2 hh = ((ag * au) * r2) * d;
                        wv4[2 * n + hf] = cvt_pk_bf16(hh.x, hh.y);
                    }
                const u32x4 g = {wv4[0], wv4[1], wv4[2], wv4[3]};
                *(u32x4*)(H + (size_t)row * D_FF + u.pn * 128 + wc * 32 + 8 * fq) = g;
            }
    }
};
struct EpiStore {
    static constexpr bool PERM = true, AFTER_DRAIN = false, PREF = false;
    bf16_t* O;
    __device__ __forceinline__ void operator()(const f32x4 (&acc)[2][2][4][2], const Unit& u, int wr, int wc, int fr, int fq) const {
        const int ln_ = fresh_lane(); fr = ln_ & 15; fq = ln_ >> 4;
#pragma unroll
        for (int q = 0; q < 8; ++q) {
            const int ai = q >> 2, m = q & 3, row = EPI_ROW(u, ai, wr, m, fr);
#pragma unroll
            for (int bj = 0; bj < 2; ++bj) {
                float v[8]; unpack8s(acc[ai][bj][m][0], acc[ai][bj][m][1], 1.0f, v);
                *(u32x4*)(O + (size_t)row * D_MODEL + u.pn * 256 + bj * 128 + wc * 32 + 8 * fq) = pack8(v);
            }
        }
    }
};
struct EpiNormRes {
    static constexpr bool PERM = true, AFTER_DRAIN = false, PREF = false;
    bf16_t* XB; const float* w; stat_t* ssT; stat_t* ss_out; unsigned* tmo;
    __device__ __forceinline__ void operator()(const f32x4 (&acc)[2][2][4][2], const Unit& u, int wr, int wc, int fr, int fq) const {
        const int ln_ = fresh_lane(); fr = ln_ & 15; fq = ln_ >> 4;
        const int col0 = u.pn * 256 + wc * 32 + 8 * fq;
        float s[8];
#pragma unroll
        for (int q = 0; q < 8; ++q) {
            const int ai = q >> 2, m = q & 3; float sq = 0.f;
#pragma unroll
            for (int bj = 0; bj < 2; ++bj)
#pragma unroll
                for (int n = 0; n < 2; ++n) { const f32x4 v = acc[ai][bj][m][n]; sq += (v[0] * v[0] + v[1] * v[1]) + (v[2] * v[2] + v[3] * v[3]); }
            s[q] = sq;
        }
#pragma unroll
        for (int q = 0; q < 8; ++q) s[q] += shx(s[q], 16, ln_);
#pragma unroll
        for (int q = 0; q < 8; ++q) s[q] += shx(s[q], 32, ln_);
        if (fq == 0) {
#pragma unroll
            for (int q = 0; q < 8; ++q) atomicAdd(ssT + EPI_ROW(u, q >> 2, wr, q & 3, fr), (ss_enc(s[q]) << 8) | 1ull);
        }
        float wv[2][8]; ld8f(w + col0, wv[0]); ld8f(w + col0 + 128, wv[1]);
        u32x4 xr[4][2];
#pragma unroll
        for (int m = 0; m < 4; ++m)
#pragma unroll
            for (int bj = 0; bj < 2; ++bj) xr[m][bj] = *(const u32x4*)(XB + (size_t)EPI_ROW(u, 0, wr, m, fr) * D_MODEL + col0 + bj * 128);
        float rs[8];
        {
            stat_t v[8]; unsigned sp = 0;
            for (;;) {
                bool ok = true;
#pragma unroll
                for (int q = 0; q < 8; ++q) { v[q] = __hip_atomic_load(ssT + EPI_ROW(u, q >> 2, wr, q & 3, fr), __ATOMIC_RELAXED, __HIP_MEMORY_SCOPE_AGENT); ok = ok && ((unsigned)v[q] & 255u) == 16u; }
                if (__all(ok)) break;
                __builtin_amdgcn_s_sleep(1);
                if (++sp > (1u << 22)) { if (ln_ == 0) __hip_atomic_store(tmo, 1u, __ATOMIC_RELAXED, __HIP_MEMORY_SCOPE_AGENT); break; }
            }
#pragma unroll
            for (int q = 0; q < 8; ++q) rs[q] = ss_dec(v[q] >> 8);
        }
        float so[8];
#pragma unroll
        for (int ai = 0; ai < 2; ++ai) {
            if (ai == 1) {
#pragma unroll
                for (int m = 0; m < 4; ++m)
#pragma unroll
                    for (int bj = 0; bj < 2; ++bj) xr[m][bj] = *(const u32x4*)(XB + (size_t)EPI_ROW(u, 1, wr, m, fr) * D_MODEL + col0 + bj * 128);
            }
#pragma unroll
            for (int m = 0; m < 4; ++m) {
                const float rstd = fast_rsq(rs[ai * 4 + m] * (1.0f / D_MODEL) + EPS);
                float sq = 0.f;
#pragma unroll
                for (int bj = 0; bj < 2; ++bj) {
                    float t[8], xv[8]; unpack8s(acc[ai][bj][m][0], acc[ai][bj][m][1], rstd, t); unpack_bf8(xr[m][bj], xv);
#pragma unroll
                    for (int j = 0; j < 8; ++j) { xv[j] += t[j] * wv[bj][j]; sq += xv[j] * xv[j]; }
                    *(u32x4*)(XB + (size_t)EPI_ROW(u, ai, wr, m, fr) * D_MODEL + col0 + bj * 128) = pack8(xv);
                }
                so[ai * 4 + m] = sq;
            }
        }
        if (ss_out) {
#pragma unroll
            for (int q = 0; q < 8; ++q) so[q] += shx(so[q], 16, ln_);
#pragma unroll
            for (int q = 0; q < 8; ++q) so[q] += shx(so[q], 32, ln_);
            if (fq == 0) {
#pragma unroll
                for (int q = 0; q < 8; ++q) atomicAdd(ss_out + EPI_ROW(u, q >> 2, wr, q & 3, fr), ss_enc(so[q]));
            }
        }
    }
};
struct EpiStat {
    static constexpr bool PERM = true, AFTER_DRAIN = false, PREF = false;
    bf16_t* O; stat_t* ss;
    __device__ __forceinline__ void operator()(const f32x4 (&acc)[2][2][4][2], const Unit& u, int wr, int wc, int fr, int fq) const {
        const int ln_ = fresh_lane(); fr = ln_ & 15; fq = ln_ >> 4;
        float s[8];
#pragma unroll
        for (int q = 0; q < 8; ++q) {
            const int ai = q >> 2, m = q & 3, row = EPI_ROW(u, ai, wr, m, fr);
            float sq = 0.f;
#pragma unroll
            for (int bj = 0; bj < 2; ++bj) {
                float v[8]; unpack8s(acc[ai][bj][m][0], acc[ai][bj][m][1], 1.0f, v);
#pragma unroll
                for (int j = 0; j < 8; ++j) sq += v[j] * v[j];
                *(u32x4*)(O + (size_t)row * D_MODEL + u.pn * 256 + bj * 128 + wc * 32 + 8 * fq) = pack8(v);
            }
            s[q] = sq;
        }
#pragma unroll
        for (int q = 0; q < 8; ++q) s[q] += shx(s[q], 16, ln_);
#pragma unroll
        for (int q = 0; q < 8; ++q) s[q] += shx(s[q], 32, ln_);
        if (fq == 0) {
#pragma unroll
            for (int q = 0; q < 8; ++q) atomicAdd(ss + EPI_ROW(u, q >> 2, wr, q & 3, fr), ss_enc(s[q]));
        }
    }
};
struct EpiPle {
    static constexpr bool PERM = true, AFTER_DRAIN = false, PREF = false;
    const bf16_t* XBc; const bf16_t* PP; const stat_t* ss_pp; const float* wple; bf16_t* XBn; stat_t* ss_next; float* xout;
    __device__ __forceinline__ void operator()(const f32x4 (&acc)[2][2][4][2], const Unit& u, int wr, int wc, int fr, int fq) const {
        typedef float f32x2 __attribute__((ext_vector_type(2)));
        const int ln_ = fresh_lane(); fr = ln_ & 15; fq = ln_ >> 4;
        const int col0 = u.pn * 256 + wc * 32 + 8 * fq;
        float rs[8];
        u32x4 wpk[2];
        { float w0[8], w1[8]; ld8f(wple + col0, w0); ld8f(wple + col0 + 128, w1); wpk[0] = pack8(w0); wpk[1] = pack8(w1); }
#pragma unroll
        for (int q = 0; q < 4; ++q) rs[q] = ss_dec(ss_pp[EPI_ROW(u, 0, wr, q, fr)]);
        u32x4 xr[3][2], pr[3][2];
#define PLE_LOAD(b_, set_) do { _Pragma("unroll") for (int mm = 0; mm < 2; ++mm) { const unsigned off_ = ((unsigned)EPI_ROW(u, (b_) >> 2, wr, 2 * (((b_) >> 1) & 1) + mm, fr) * D_MODEL + col0 + ((b_) & 1) * 128) * 2u; \
            xr[set_][mm] = *(const u32x4*)((const char*)XBc + off_); pr[set_][mm] = *(const u32x4*)((const char*)PP + off_); } } while (0)
        PLE_LOAD(0, 0); PLE_LOAD(1, 1);
        stat_t rawB[4];
#pragma unroll
        for (int q = 0; q < 4; ++q) rawB[q] = ss_pp[EPI_ROW(u, 1, wr, q, fr)];
        float rpp2[2] = {0.f, 0.f}, sacc[2] = {0.f, 0.f};
#pragma unroll
        for (int b = 0; b < 8; ++b) {
            const int ai = b >> 2, mp = (b >> 1) & 1, bj = b & 1, set = b % 3;
            if (b + 2 < 8) PLE_LOAD(b + 2, (b + 2) % 3);
            if (b == 2) {
#pragma unroll
                for (int q = 0; q < 4; ++q) rs[4 + q] = ss_dec(rawB[q]);
            }
            const unsigned wq[4] = {wpk[bj].x, wpk[bj].y, wpk[bj].z, wpk[bj].w};
#pragma unroll
            for (int mm = 0; mm < 2; ++mm) {
                const int m = 2 * mp + mm, q = ai * 4 + m;
                if (bj == 0) { rpp2[mm] = fast_rsq(rs[q] * (1.0f / D_MODEL) + EPS); sacc[mm] = 0.f; }
                const float rpp = rpp2[mm];
                const unsigned off = (unsigned)EPI_ROW(u, ai, wr, m, fr) * D_MODEL + col0 + bj * 128;
                const unsigned xw[4] = {xr[set][mm].x, xr[set][mm].y, xr[set][mm].z, xr[set][mm].w}, pw[4] = {pr[set][mm].x, pr[set][mm].y, pr[set][mm].z, pr[set][mm].w};
                f32x2 sq2 = {0.f, 0.f}; f32x2 xo[4];
#pragma unroll
                for (int k = 0; k < 4; ++k) {
                    const f32x2 g = {acc[ai][bj][m][k >> 1][2 * (k & 1)], acc[ai][bj][m][k >> 1][2 * (k & 1) + 1]};
                    f32x2 xv = {__uint_as_float(xw[k] << 16), __uint_as_float(xw[k] & 0xffff0000u)}; const f32x2 pv = {__uint_as_float(pw[k] << 16), __uint_as_float(pw[k] & 0xffff0000u)};
                    const f32x2 wk = {__uint_as_float(wq[k] << 16), __uint_as_float(wq[k] & 0xffff0000u)};
                    f32x2 e = g * (-LOG2E_); e.x = __builtin_amdgcn_exp2f(e.x); e.y = __builtin_amdgcn_exp2f(e.y);
                    f32x2 d = e + 1.0f; d.x = __builtin_amdgcn_rcpf(d.x); d.y = __builtin_amdgcn_rcpf(d.y);
                    xv = xv + d * ((pv * wk) * rpp); sq2 = sq2 + xv * xv; xo[k] = xv;
                }
                if (XBn) { u32x4 o; o.x = cvt_pk_bf16(xo[0].x, xo[0].y); o.y = cvt_pk_bf16(xo[1].x, xo[1].y); o.z = cvt_pk_bf16(xo[2].x, xo[2].y); o.w = cvt_pk_bf16(xo[3].x, xo[3].y); *(u32x4*)((char*)XBn + off * 2u) = o; }
                if (xout) { *(f32x4*)((char*)xout + off * 4u) = (f32x4){xo[0].x, xo[0].y, xo[1].x, xo[1].y}; *(f32x4*)((char*)xout + off * 4u + 16) = (f32x4){xo[2].x, xo[2].y, xo[3].x, xo[3].y}; }
                sacc[mm] += sq2.x + sq2.y;
                if (bj == 1) rs[q] = sacc[mm];
            }
        }
#undef PLE_LOAD
        if (ss_next) {
#pragma unroll
            for (int q = 0; q < 8; ++q) rs[q] += shx(rs[q], 16, ln_);
#pragma unroll
            for (int q = 0; q < 8; ++q) rs[q] += shx(rs[q], 32, ln_);
            if (fq == 0) {
#pragma unroll
                for (int q = 0; q < 8; ++q) atomicAdd(ss_next + EPI_ROW(u, q >> 2, wr, q & 3, fr), ss_enc(rs[q]));
            }
        }
    }
};

__device__ __forceinline__ void ew_rows(bf16_t* XB, const bf16_t* T, const float* w, stat_t* ss_out, int gw, int NGW, int lane) {
    const int hl = lane & 31, hr = lane >> 5;
    float wv[4][8];
#pragma unroll
    for (int j = 0; j < 4; ++j) ld8f(w + 8 * hl + 256 * j, wv[j]);
#pragma unroll 2
    for (int r2 = gw; r2 < M / 2; r2 += NGW) {
        const int row = 2 * r2 + hr; const size_t base = (size_t)row * D_MODEL + 8 * hl;
        u32x4 xr[4], tr[4];
#pragma unroll
        for (int j = 0; j < 4; ++j) { xr[j] = *(const u32x4*)(XB + base + 256 * j); tr[j] = *(const u32x4*)(T + base + 256 * j); }
        float tv[4][8]; float st = 0.f;
#pragma unroll
        for (int j = 0; j < 4; ++j) { unpack_bf8(tr[j], tv[j]);
#pragma unroll
            for (int k = 0; k < 8; ++k) st += tv[j][k] * tv[j][k]; }
#pragma unroll
        for (int o = 1; o < 32; o <<= 1) st += shx(st, o, lane);
        const float rT = fast_rsq(st * (1.0f / D_MODEL) + EPS);
        float s = 0.f;
#pragma unroll
        for (int j = 0; j < 4; ++j) {
            float xv[8]; unpack_bf8(xr[j], xv);
#pragma unroll
            for (int k = 0; k < 8; ++k) { xv[k] += tv[j][k] * rT * wv[j][k]; s += xv[k] * xv[k]; }
            *(u32x4*)(XB + base + 256 * j) = pack8(xv);
        }
        if (ss_out) {
#pragma unroll
            for (int o = 1; o < 32; o <<= 1) s += shx(s, o, lane);
            if (hl == 0) ss_out[row] = ss_enc(s);
        }
    }
}
__device__ __forceinline__ void xprep_rows(const float* x, bf16_t* XB, stat_t* ss_out, int gw, int NGW, int lane) {
    const int hl = lane & 31, hr = lane >> 5;
#pragma unroll 2
    for (int r2 = gw; r2 < M / 2; r2 += NGW) {
        const int row = 2 * r2 + hr; const size_t base = (size_t)row * D_MODEL + 8 * hl;
        float xv[4][8];
#pragma unroll
        for (int j = 0; j < 4; ++j) ld8f(x + base + 256 * j, xv[j]);
        float s = 0.f;
#pragma unroll
        for (int j = 0; j < 4; ++j) {
#pragma unroll
            for (int k = 0; k < 8; ++k) s += xv[j][k] * xv[j][k];
            *(u32x4*)(XB + base + 256 * j) = pack8(xv[j]);
        }
#pragma unroll
        for (int o = 1; o < 32; o <<= 1) s += shx(s, o, lane);
        if (hl == 0) ss_out[row] = ss_enc(s);
    }
}

struct TrDesc { const float* W; const float* gain; bf16_t* WT; int ldw, K, sc, rho0, k0; };
struct TrRegs { f32x4 v[8]; float g[8]; };
__device__ __forceinline__ void tr_load(const TrDesc& d, TrRegs& R, int lane) {
    const int q = lane & 7, r = lane >> 3;
#pragma unroll
    for (int i = 0; i < 8; ++i) {
        const int kk = d.k0 + 8 * i + r;
        R.v[i] = d.sc >= 0 ? *(const f32x4*)(d.W + (size_t)kk * d.ldw + d.sc + 4 * q) : (f32x4){0.f, 0.f, 0.f, 0.f};
        R.g[i] = d.gain ? d.gain[kk] : 1.0f;
    }
}
__device__ __forceinline__ void tr_store(const TrDesc& d, const TrRegs& R, LAS float* scr, int lane) {
    const int q = lane & 7, r = lane >> 3;
#pragma unroll
    for (int i = 0; i < 8; ++i) {
        LAS float* s = scr + (8 * i + r) * 33 + 4 * q;
        s[0] = R.v[i].x * R.g[i]; s[1] = R.v[i].y * R.g[i]; s[2] = R.v[i].z * R.g[i]; s[3] = R.v[i].w * R.g[i];
    }
    asm volatile("s_waitcnt lgkmcnt(0)" ::: "memory");
    const int c = lane & 7;
#pragma unroll
    for (int j = 0; j < 4; ++j) {
        const int n = (lane >> 3) + 8 * j; const LAS float* s = scr + (8 * c) * 33 + n;
        u32x4 o; o.x = cvt_pk_bf16(s[0 * 33], s[1 * 33]); o.y = cvt_pk_bf16(s[2 * 33], s[3 * 33]); o.z = cvt_pk_bf16(s[4 * 33], s[5 * 33]); o.w = cvt_pk_bf16(s[6 * 33], s[7 * 33]);
        *(u32x4*)(d.WT + (size_t)(d.rho0 + n) * d.K + d.k0 + 8 * c) = o;
    }
    asm volatile("s_waitcnt lgkmcnt(0)" ::: "memory");
}

struct Args { const float* in[19]; float* out; unsigned char* ws; int ph_lo, ph_hi, li, pad; };

typedef const __attribute__((address_space(4))) Args* KArgs;
__device__ __forceinline__ KArgs kargs() { KArgs p = (KArgs)__builtin_amdgcn_kernarg_segment_ptr(); asm volatile("" : "+s"(p)); return p; }


__device__ __forceinline__ void prologue(KArgs ap, LAS unsigned char* lds, int gw, int NGW, int wave, int lane) {
    unsigned char* ws = ap->ws;
    LAS float* scr = (LAS float*)(lds + wave * 16384);
    {
        constexpr int I0 = 16 * 88, I1 = 16 * 32, I2 = 16 * 176, I3 = 44 * 32, I4 = 16 * 32, I5 = 4 * 32, IT = I0 + I1 + I2 + I3 + I4 + I5;
        auto desc = [&](int it) -> TrDesc {
            const int L = it >= IT ? 1 : 0; int r = it - L * IT;
            unsigned char* wl = ws + WS_W + (size_t)L * W_LAYER;
            if (r < I0) { const int nb = r % 88, kb = r / 88, pn = nb >> 3, bj = (nb >> 2) & 1, wc = nb & 3, hs = 4 * pn + wc;
                return TrDesc{ap->in[3] + (size_t)L * D_MODEL * IN_W, ap->in[2] + L * D_MODEL, (bf16_t*)(wl + W_IN), IN_W, 1024, hs < NHEADS ? hs * 64 + 32 * bj : -1, nb * 32, kb * 64}; } r -= I0;
            if (r < I1) { const int nb = r % 32, kb = r / 32;
                return TrDesc{ap->in[10] + (size_t)L * D_MODEL * D_MODEL, nullptr, (bf16_t*)(wl + W_OUT), D_MODEL, 1024, nb * 32, nb * 32, kb * 64}; } r -= I1;
            if (r < I2) { const int nb = r % 176, kb = r / 176, pn = nb >> 3, bj = (nb >> 2) & 1, q = nb & 3;
                return TrDesc{ap->in[13] + (size_t)L * D_MODEL * 2 * D_FF, ap->in[12] + L * D_MODEL, (bf16_t*)(wl + W_FFI), 2 * D_FF, 1024, bj * D_FF + 128 * pn + 32 * q, nb * 32, kb * 64}; } r -= I2;
            if (r < I3) { const int nb = r % 32, kb = r / 32;
                return TrDesc{ap->in[14] + (size_t)L * D_FF * D_MODEL, nullptr, (bf16_t*)(wl + W_FFO), D_MODEL, D_FF, nb * 32, nb * 32, kb * 64}; } r -= I3;
            if (r < I4) { const int nb = r % 32, kb = r / 32;
                return TrDesc{ap->in[16] + (size_t)L * D_MODEL * D_MODEL, nullptr, (bf16_t*)(wl + W_G), D_MODEL, 1024, nb * 32, nb * 32, kb * 64}; } r -= I4;
            { const int nb = r % 32, kb = r / 32;
                return TrDesc{ap->in[17] + (size_t)L * PLE_DIM * D_MODEL, nullptr, (bf16_t*)(wl + W_P), D_MODEL, PLE_DIM, nb * 32, nb * 32, kb * 64}; }
        };
        int it = gw;
        if (it < DEPTH * IT) {
            TrDesc d = desc(it); TrRegs R; tr_load(d, R, lane);
            for (;;) {
                const int nx = it + NGW; const bool hn = nx < DEPTH * IT;
                TrDesc dn = d; TrRegs Rn = R;
                if (hn) { dn = desc(nx); tr_load(dn, Rn, lane); }
                tr_store(d, R, scr, lane);
                if (!hn) break;
                d = dn; R = Rn; it = nx;
            }
        }
    }
    {
        float* tab = (float*)(ws + WS_TAB);
        for (int i = gw * 64 + lane; i < 2048 * 32; i += NGW * 64) {
            { const int pos = i >> 5, j = i & 31; const double rev = (double)pos * c_inv_ret[j] * 0.15915494309189535; const float fr = (float)(rev - floor(rev));
              tab[TAB_RC + i] = __builtin_amdgcn_cosf(fr); tab[TAB_RS + i] = __builtin_amdgcn_sinf(fr); }
            if (i < 2048 * 8) { const int pos = i >> 3, j = i & 7; const double rev = (double)pos * c_inv_swa[j] * 0.15915494309189535; const float fr = (float)(rev - floor(rev));
              tab[TAB_SC + i] = __builtin_amdgcn_cosf(fr); tab[TAB_SS + i] = __builtin_amdgcn_sinf(fr); }
        }
    }
    {
        const float* p = ap->in[1]; bf16_t* PB = (bf16_t*)(ws + WS_PB);
        const size_t n8 = (size_t)DEPTH * M * PLE_DIM / 8;
        for (size_t i = (size_t)gw * 64 + lane; i < n8; i += (size_t)NGW * 64) {
            float v[8]; ld8f(p + i * 8, v); *(u32x4*)(PB + i * 8) = pack8(v);
        }
    }
    {
        const float* wsrc = ap->in[6]; bf16_t* Wm = (bf16_t*)(ws + WS_WM);
        for (int i = gw * 64 + lane; i < DEPTH * 4 * CHUNK * CHUNK; i += NGW * 64) { const int s_ = i & 127, t_ = (i >> 7) & 127; Wm[i] = f2bf(s_ <= t_ ? wsrc[i] : 0.f); }
    }
    xprep_rows(ap->in[0], (bf16_t*)(ws + WS_XB0), stat_ptr(ws, 0, ST_X1), gw, NGW, lane);
}

typedef float f32x16 __attribute__((ext_vector_type(16)));
typedef short s16x4 __attribute__((ext_vector_type(4)));
using pg8::bf16x8;
constexpr int TS = 144;
constexpr float LOG2E = 1.4426950408889634f;
__device__ __forceinline__ int crow(int r, int hi) { return (r & 3) + 8 * (r >> 2) + 4 * hi; }
__device__ __forceinline__ s16x4 tr16(LAS const unsigned char* p) { return __builtin_bit_cast(s16x4, __builtin_amdgcn_ds_read_tr16_b64_v4i16((LAS s16x4*)p)); }
__device__ __forceinline__ bf16x8 rd_row(LAS const unsigned char* tile, int row0, int k0, int lane) {
    return *(LAS const bf16x8*)(tile + (row0 + (lane & 31)) * TS + (k0 + 8 * (lane >> 5)) * 2);
}
template <bool PERMK> __device__ __forceinline__ bf16x8 rd_tr(LAS const unsigned char* tile, int k0, int n0, int lane) {
    const int h = lane >> 5, g1 = (lane >> 4) & 1, q = (lane & 15) >> 2, p = lane & 3;
    const int rA = k0 + (PERMK ? 4 * h : 8 * h) + q, rB = rA + (PERMK ? 8 : 4);
    const int cb = (n0 + 16 * g1 + 4 * p) * 2;
    const s16x4 lo = tr16(tile + rA * TS + cb), hi = tr16(tile + rB * TS + cb);
    return (bf16x8){lo[0], lo[1], lo[2], lo[3], hi[0], hi[1], hi[2], hi[3]};
}
__device__ __forceinline__ bf16x8 pack_frag(const f32x16& v, int s) {
    u32x4 w; w.x = cvt_pk_bf16(v[8 * s + 0], v[8 * s + 1]); w.y = cvt_pk_bf16(v[8 * s + 2], v[8 * s + 3]); w.z = cvt_pk_bf16(v[8 * s + 4], v[8 * s + 5]); w.w = cvt_pk_bf16(v[8 * s + 6], v[8 * s + 7]);
    return __builtin_bit_cast(bf16x8, w);
}
#define MFMA32(a, b, c) __builtin_amdgcn_mfma_f32_32x32x16_bf16((a), (b), (c), 0, 0, 0)
template <bool SCALE> __device__ __forceinline__ void load_tile(LAS unsigned char* tile, const bf16_t* g, int rows, int zero_below, float sl, int tid) {
    for (int i = tid; i < rows * 8; i += NTHREADS) {
        const int r = i >> 3, c = i & 7;
        u32x4 v = (u32x4){0u, 0u, 0u, 0u};
        if (r >= zero_below) v = *(const u32x4*)(g + (ptrdiff_t)r * IN_W + c * 8);
        if (SCALE) { float f[8]; unpack_bf8(v, f); const float s = exp2f((float)r * sl);
#pragma unroll
            for (int j = 0; j < 8; ++j) f[j] *= s;
            v = pack8(f); }
        *(LAS u32x4*)(tile + r * TS + c * 16) = v;
    }
}

constexpr int GM_BUF = 2 * CHUNK * TS;
struct GmRegs { u32x4 r[4]; };
__device__ __forceinline__ void gm_load(GmRegs& R, const bf16_t* P, int item, int tid) {
    const int h = item & 3, bc = item >> 2; const size_t row0 = (size_t)bc * CHUNK;
    const int r = tid >> 3, c = tid & 7;
#pragma unroll
    for (int i = 0; i < 2; ++i) {
        R.r[i] = *(const u32x4*)(P + (row0 + r + 64 * i) * IN_W + (H_AU + h) * 64 + c * 8);
        R.r[2 + i] = *(const u32x4*)(P + (row0 + r + 64 * i) * IN_W + (H_AV + h) * 64 + c * 8);
    }
}
__device__ __forceinline__ void gm_write(const GmRegs& R, LAS unsigned char* buf, int tid) {
    const int r = tid >> 3, c = tid & 7;
#pragma unroll
    for (int i = 0; i < 2; ++i) { *(LAS u32x4*)(buf + (r + 64 * i) * TS + c * 16) = R.r[i]; *(LAS u32x4*)(buf + CHUNK * TS + (r + 64 * i) * TS + c * 16) = R.r[2 + i]; }
}
__device__ __forceinline__ void gm_compute(LAS unsigned char* buf, const bf16_t* Wm, const float* bs, bf16_t* Y, int item, int tid, int wave, int lane, volatile LAS unsigned* slotp, unsigned fut) {
    const int h = item & 3, bc = item >> 2; const size_t row0 = (size_t)bc * CHUNK;
    LAS unsigned char* AUs = buf; LAS unsigned char* AVs = buf + CHUNK * TS;
    const int tb = wave >> 1, db = wave & 1, hh = lane >> 5;
    f32x16 acc = {};
    const bf16_t* wrow = Wm + (size_t)(h * CHUNK + 32 * tb + (lane & 31)) * CHUNK + 8 * hh;
    for (int ks = 0; ks < 2 * (tb + 1); ++ks) {
        const bf16x8 a = *(const bf16x8*)(wrow + 16 * ks);
        const bf16x8 b = rd_tr<false>(AVs, 16 * ks, 32 * db, lane);
        acc = MFMA32(a, b, acc);
    }
    const int d = 32 * db + (lane & 31);
#pragma unroll
    for (int r = 0; r < 16; ++r) {
        const int t = 32 * tb + crow(r, hh);
        LAS bf16_t* pu = (LAS bf16_t*)(AUs + t * TS) + d;
        *pu = f2bf(bf2f(*pu) * (acc[r] + bs[h * CHUNK + t]));
    }
    if (tid == 0) *slotp = fut;
    __syncthreads();
    for (int i = tid; i < CHUNK * 8; i += NTHREADS) { const int r = i >> 3, c = i & 7; *(u32x4*)(Y + (row0 + r) * D_MODEL + h * 64 + c * 8) = *(LAS const u32x4*)(AUs + r * TS + c * 16); }
}

constexpr int SWA_K = 0, SWA_V = 384 * TS, SWA_WSF = 2 * 384 * TS, SWA_OST = SWA_WSF + NWAVES * 128, SWA_END = SWA_OST + NWAVES * 4096;
struct SwaRegs { u32x4 k[6], v[6]; };
__device__ __forceinline__ void swa_load(SwaRegs& R, const bf16_t* P, int item, int tid) {
    const int hk = item & 1, cp = (item >> 1) & 7, b = item >> 4;
    const ptrdiff_t rowk0 = (ptrdiff_t)b * SEQ + 256 * cp - 128;
    const int r0 = tid >> 3, c = tid & 7;
#pragma unroll
    for (int i = 0; i < 6; ++i) {
        const int r = r0 + 64 * i;
        if (cp == 0 && r < 128) { R.k[i] = (u32x4){0u, 0u, 0u, 0u}; R.v[i] = (u32x4){0u, 0u, 0u, 0u}; }
        else { R.k[i] = *(const u32x4*)(P + (rowk0 + r) * IN_W + (H_CK + hk) * 64 + c * 8); R.v[i] = *(const u32x4*)(P + (rowk0 + r) * IN_W + (H_CV + hk) * 64 + c * 8); }
    }
}
__device__ __forceinline__ void swa_write(const SwaRegs& R, LAS unsigned char* lds, int tid) {
    const int r0 = tid >> 3, c = tid & 7;
#pragma unroll
    for (int i = 0; i < 6; ++i) { *(LAS u32x4*)(lds + SWA_K + (r0 + 64 * i) * TS + c * 16) = R.k[i]; *(LAS u32x4*)(lds + SWA_V + (r0 + 64 * i) * TS + c * 16) = R.v[i]; }
}
__device__ __forceinline__ void swa_compute(LAS unsigned char* lds, const bf16_t* P, const float* sinks, bf16_t* Y, int item, int wave, int lane) {
    const int hk = item & 1, cp = (item >> 1) & 7, b = item >> 4;
    const size_t rowq0 = (size_t)b * SEQ + 256 * cp;
    LAS unsigned char* Ks = lds + SWA_K; LAS unsigned char* Vs = lds + SWA_V;
    const int qi = lane & 31, hh = lane >> 5;
    LAS float* wsf = (LAS float*)(lds + SWA_WSF + wave * 128);
    LAS unsigned char* ost = lds + SWA_OST + wave * 4096;
    constexpr float SC = 0.125f * LOG2E;
    for (int g = 0; g < 3; ++g) {
        const int qh = 3 * hk + g;
        const bf16_t* qrow = P + (rowq0 + 32 * wave + qi) * IN_W + (H_CQ + qh) * 64 + 8 * hh;
        bf16x8 bq[4];
#pragma unroll
        for (int kd = 0; kd < 4; ++kd) bq[kd] = *(const bf16x8*)(qrow + 16 * kd);
        f32x16 S[5];
#pragma unroll
        for (int kb = 0; kb < 5; ++kb) {
            S[kb] = (f32x16){};
#pragma unroll
            for (int kd = 0; kd < 4; ++kd) S[kb] = MFMA32(rd_row(Ks, 32 * (wave + kb), 16 * kd, lane), bq[kd], S[kb]);
        }
        const float sk = sinks[qh] * LOG2E;
        float m = sk;
#pragma unroll
        for (int kb = 0; kb < 5; ++kb) {
            const bool blk_ok = cp > 0 || wave + kb >= 4;
#pragma unroll
            for (int r = 0; r < 16; ++r) {
                const int cr = crow(r, hh);
                bool ok = blk_ok;
                if (kb == 0) ok = ok && cr > qi;
                if (kb == 4) ok = ok && cr <= qi;
                const float s = ok ? S[kb][r] * SC : -1e30f;
                S[kb][r] = s; m = fmaxf(m, s);
            }
        }
        m = fmaxf(m, shx(m, 32, lane));
        float l = 0.f;
#pragma unroll
        for (int kb = 0; kb < 5; ++kb)
#pragma unroll
            for (int r = 0; r < 16; ++r) { const float p = __builtin_amdgcn_exp2f(S[kb][r] - m); S[kb][r] = p; l += p; }
        l += shx(l, 32, lane);
        l += __builtin_amdgcn_exp2f(sk - m);
        f32x16 O[2]; O[0] = (f32x16){}; O[1] = (f32x16){};
#pragma unroll
        for (int kb = 0; kb < 5; ++kb)
#pragma unroll
            for (int s2 = 0; s2 < 2; ++s2) {
                const bf16x8 a = pack_frag(S[kb], s2);
#pragma unroll
                for (int db = 0; db < 2; ++db) O[db] = MFMA32(a, rd_tr<true>(Vs, 32 * (wave + kb) + 16 * s2, 32 * db, lane), O[db]);
            }
        if (hh == 0) wsf[qi] = __builtin_amdgcn_rcpf(l);
        asm volatile("s_waitcnt lgkmcnt(0)" ::: "memory");
#pragma unroll
        for (int r = 0; r < 16; ++r) {
            const int q = crow(r, hh); const float rl = wsf[q];
#pragma unroll
            for (int db = 0; db < 2; ++db) *((LAS bf16_t*)(ost + q * 128) + 32 * db + qi) = f2bf(O[db][r] * rl);
        }
        asm volatile("s_waitcnt lgkmcnt(0)" ::: "memory");
#pragma unroll
        for (int i = 0; i < 4; ++i) { const int row = i * 8 + (lane >> 3), ch = lane & 7;
            *(u32x4*)(Y + (rowq0 + 32 * wave + row) * D_MODEL + 640 + qh * 64 + ch * 8) = *(LAS const u32x4*)(ost + row * 128 + ch * 16); }
        asm volatile("s_waitcnt lgkmcnt(0)" ::: "memory");
    }
}

constexpr int RT_Q = 0, RT_K = CHUNK * TS, RT_V = 2 * CHUNK * TS, RT_S = 3 * CHUNK * TS, RT_O = RT_S + 64 * TS, RT_X = RT_O + CHUNK * 68 * 4, RT_END = RT_X + 16384;
struct RetRegs { u32x4 q[2], k[2], v[2], g[2]; };
__device__ __forceinline__ void ret_load(RetRegs& R, const bf16_t* P, size_t row0, int h, int tid) {
    const int r0 = tid >> 3, c = tid & 7;
#pragma unroll
    for (int i = 0; i < 2; ++i) {
        const bf16_t* pr = P + (row0 + r0 + 64 * i) * IN_W + c * 8;
        R.q[i] = *(const u32x4*)(pr + (H_BQ + h) * 64); R.k[i] = *(const u32x4*)(pr + (H_BK + h) * 64); R.v[i] = *(const u32x4*)(pr + (H_BV + h) * 64);
    }
    const int row = tid >> 2, part = tid & 3;
    const bf16_t* gp = P + (row0 + row) * IN_W + (H_BG + h) * 64 + 16 * part;
    R.g[0] = *(const u32x4*)gp; R.g[1] = *(const u32x4*)(gp + 8);
}
typedef float f32x2m __attribute__((ext_vector_type(2)));
__device__ __forceinline__ u32x4 scale_bf8(const u32x4& r, float sc) {
    const unsigned w[4] = {r.x, r.y, r.z, r.w}; unsigned o[4];
#pragma unroll
    for (int k = 0; k < 4; ++k) { f32x2m v = {__uint_as_float(w[k] << 16), __uint_as_float(w[k] & 0xffff0000u)}; v = v * sc; o[k] = cvt_pk_bf16(v.x, v.y); }
    return (u32x4){o[0], o[1], o[2], o[3]};
}
__device__ __forceinline__ void ret_write(const RetRegs& R, LAS unsigned char* lds, int tid) {
    const int r0 = tid >> 3, c = tid & 7;
#pragma unroll
    for (int i = 0; i < 2; ++i) {
        const int r = r0 + 64 * i;
        *(LAS u32x4*)(lds + RT_Q + r * TS + c * 16) = R.q[i];
        *(LAS u32x4*)(lds + RT_K + r * TS + c * 16) = R.k[i];
        *(LAS u32x4*)(lds + RT_V + r * TS + c * 16) = R.v[i];
    }
}
__device__ __forceinline__ void ret_item(LAS unsigned char* lds, const bf16_t* P, const float* gn_w, bf16_t* Y, int item, int tid, int wave, int lane, volatile LAS unsigned* slotp, unsigned fut) {
    const int h = item % 6, b = item / 6;
    const float lg = c_log2g[h];
    const float g1 = exp2f(lg), g127 = exp2f(127.f * lg), g128 = exp2f(128.f * lg);
    LAS unsigned char* Qs = lds + RT_Q; LAS unsigned char* Ks = lds + RT_K; LAS unsigned char* Vs = lds + RT_V; LAS unsigned char* Sb = lds + RT_S;
    LAS float* Os = (LAS float*)(lds + RT_O); LAS float* Xs = (LAS float*)(lds + RT_X);
    const int tb = wave >> 1, eb = wave & 1, qi = lane & 31, hh = lane >> 5;
    const int db = (wave >> 1) & 1, kh = wave >> 2;
    const int erow = tid >> 2, part = tid & 3;
    float gw0[8], gw1[8]; ld8f(gn_w + h * 64 + 16 * part, gw0); ld8f(gn_w + h * 64 + 16 * part + 8, gw1);
    f32x16 st = {};
    RetRegs R; ret_load(R, P, (size_t)b * SEQ, h, tid);
    for (int c = 0; c < 16; ++c) {
        const size_t row0 = (size_t)b * SEQ + (size_t)c * CHUNK;
        ret_write(R, lds, tid);
        const u32x4 gq0 = R.g[0], gq1 = R.g[1];
        __syncthreads();
        if (c + 1 < 16) ret_load(R, P, row0 + CHUNK, h, tid);
        f32x16 O = {};
        for (int sb = 0; sb <= tb; ++sb) {
            f32x16 S = {};
#pragma unroll
            for (int kd = 0; kd < 4; ++kd) S = MFMA32(rd_row(Ks, 32 * sb, 16 * kd, lane), rd_row(Qs, 32 * tb, 16 * kd, lane), S);
            if (sb == tb) {
#pragma unroll
                for (int r = 0; r < 16; ++r) S[r] = crow(r, hh) <= qi ? S[r] : 0.f;
            }
#pragma unroll
            for (int s2 = 0; s2 < 2; ++s2) O = MFMA32(pack_frag(S, s2), rd_tr<true>(Vs, 32 * sb + 16 * s2, 32 * eb, lane), O);
        }
        if (c > 0) {
#pragma unroll
            for (int kd = 0; kd < 4; ++kd) O = MFMA32(rd_row(Qs, 32 * tb, 16 * kd, lane), rd_row(Sb, 32 * eb, 16 * kd, lane), O);
        }
#pragma unroll
        for (int r = 0; r < 16; ++r) Os[(32 * tb + crow(r, hh)) * 68 + 32 * eb + qi] = O[r];
        if (c + 1 < 16) {
            f32x16 acc = {};
#pragma unroll
            for (int ks = 0; ks < 4; ++ks) acc = MFMA32(rd_tr<false>(Vs, 64 * kh + 16 * ks, 32 * eb, lane), rd_tr<false>(Ks, 64 * kh + 16 * ks, 32 * db, lane), acc);
#pragma unroll
            for (int r = 0; r < 16; ++r) st[r] = st[r] * g128 + g127 * acc[r];
            if (kh == 1) {
#pragma unroll
                for (int r = 0; r < 16; ++r) Xs[((eb * 2 + db) * 16 + r) * 64 + lane] = st[r];
            }
        }
        __syncthreads();
        if (c + 1 < 16 && kh == 0) {
#pragma unroll
            for (int r = 0; r < 16; ++r) { const int e = 32 * eb + crow(r, hh), d = 32 * db + qi; const float sv = (st[r] + Xs[((eb * 2 + db) * 16 + r) * 64 + lane]) * g1; *((LAS bf16_t*)(Sb + e * TS) + d) = (bf16_t)cvt_pk_bf16(sv, sv); }
        }
        {
            float v[16]; float s = 0.f;
#pragma unroll
            for (int j = 0; j < 16; ++j) { v[j] = Os[erow * 68 + 16 * part + j]; s += v[j]; }
            s += shx(s, 1, lane); s += shx(s, 2, lane);
            const float mu = s * (1.0f / 64.0f); float q = 0.f;
#pragma unroll
            for (int j = 0; j < 16; ++j) { v[j] -= mu; q += v[j] * v[j]; }
            q += shx(q, 1, lane); q += shx(q, 2, lane);
            const float rs = fast_rsq(q * (1.0f / 64.0f) + EPS);
            float ga[8], gb[8], o0[8], o1[8];
            unpack_bf8(gq0, ga); unpack_bf8(gq1, gb);
#pragma unroll
            for (int j = 0; j < 8; ++j) { o0[j] = (ga[j] * gw0[j]) * (v[j] * rs); o1[j] = (gb[j] * gw1[j]) * (v[8 + j] * rs); }
            bf16_t* yp = Y + (row0 + erow) * D_MODEL + 256 + h * 64 + 16 * part;
            *(u32x4*)yp = pack8(o0); *(u32x4*)(yp + 8) = pack8(o1);
        }
    }
    if (tid == 0) *slotp = fut;
    __syncthreads();
}

constexpr int CW_TMO = 1024;
constexpr int CW_QUEUE = 2048;
constexpr int MQ_RET = 192, MQ_SWA = MQ_RET + 512, MQ_ALL = MQ_SWA + 2048;
__device__ __forceinline__ void mixers(KArgs ap, int L, LAS unsigned char* lds, int tid, int wave, int lane, int grp) {
    unsigned char* ws = ap->ws;
    const bf16_t* P = (const bf16_t*)(ws + WS_BIG); bf16_t* Y = (bf16_t*)(ws + WS_Y);
    const bf16_t* Wm = (const bf16_t*)(ws + WS_WM) + (size_t)L * 4 * CHUNK * CHUNK;
    const float* gbs = ap->in[7] + L * 4 * CHUNK; const float* gn_w = ap->in[8] + L * 384; const float* sinks = ap->in[9] + L * 6;
    const bool gq = grp >= 0;
    const unsigned q_ret = gq ? MQ_RET / 8 : MQ_RET, q_swa = gq ? MQ_SWA / 8 : MQ_SWA, q_all = gq ? MQ_ALL / 8 : MQ_ALL;
    const int o_ret = gq ? grp * (MQ_RET / 8) : 0, o_swa = gq ? grp * ((MQ_SWA - MQ_RET) / 8) : 0, o_gm = gq ? grp * ((MQ_ALL - MQ_SWA) / 8) : 0;
    unsigned* head = (unsigned*)ws + CW_QUEUE + 64 * (gq ? 2 + 8 * L + grp : L);
    volatile LAS unsigned* slot = (volatile LAS unsigned*)(lds + MISC_OFF + 64);
    if (tid == 0) slot[0] = atomicAdd(head, 1u);
    __syncthreads();
    unsigned cur = (unsigned)__builtin_amdgcn_readfirstlane((int)slot[0]);
    __syncthreads();
    if (tid == 0) slot[1] = atomicAdd(head, 1u);
    __syncthreads();
    unsigned nxt = (unsigned)__builtin_amdgcn_readfirstlane((int)slot[1]);
    int k = 0;
#define MQ_FETCH() unsigned fut = 0u; if (tid == 0) fut = atomicAdd(head, 1u)
#define MQ_ADVANCE() do { cur = nxt; nxt = (unsigned)__builtin_amdgcn_readfirstlane((int)slot[k]); k ^= 1; } while (0)
    while (cur < q_all) {
        if (cur < q_ret) {
            MQ_FETCH();
            ret_item(lds, P, gn_w, Y, (int)cur + o_ret, tid, wave, lane, slot + k, fut);
            MQ_ADVANCE();
        } else if (cur < q_swa) {
            MQ_FETCH();
            { SwaRegs R; swa_load(R, P, (int)(cur - q_ret) + o_swa, tid); swa_write(R, lds, tid); }
            __syncthreads();
            swa_compute(lds, P, sinks, Y, (int)(cur - q_ret) + o_swa, wave, lane);
            if (tid == 0) slot[k] = fut;
            __syncthreads();
            MQ_ADVANCE();
        } else {
            GmRegs R; gm_load(R, P, (int)(cur - q_swa) + o_gm, tid);
            int bsel = 0;
            for (;;) {
                MQ_FETCH();
                LAS unsigned char* buf = lds + bsel * GM_BUF;
                gm_write(R, buf, tid);
                __syncthreads();
                const bool more = nxt < q_all;
                if (more) gm_load(R, P, (int)(nxt - q_swa) + o_gm, tid);
                gm_compute(buf, Wm, gbs, Y, (int)(cur - q_swa) + o_gm, tid, wave, lane, slot + k, fut);
                MQ_ADVANCE(); bsel ^= 1;
                if (!more) break;
            }
            __syncthreads();
        }
    }
#undef MQ_FETCH
#undef MQ_ADVANCE
    __syncthreads();
}

#ifndef PG8_SP2
#define PG8_SP2 true
#endif
#ifndef PG8_ALIGN
#define PG8_ALIGN true
#endif
constexpr int N_PHASES = 1 + 8 * DEPTH;
#ifndef PHMASK
#define PHMASK 0x1ff
#endif
#ifndef DUP_MASK
#define DUP_MASK 0
#endif
#define NREP(bit) ((DUP_MASK & (bit)) ? 2 : 1)
#ifndef KREP3
#define KREP3 1
#endif
__global__ void __launch_bounds__(NTHREADS, 2) mega(Args a_) {
    extern __shared__ __attribute__((aligned(16))) unsigned char lds_raw[];
    LAS unsigned char* lds = (LAS unsigned char*)lds_raw;
    const int G = gridDim.x, bid = blockIdx.x;
    const int vcu = (G % 8 == 0) ? (bid % 8) * (G / 8) + bid / 8 : bid;
    const int NGW = G * NWAVES;
    const int wave0 = __builtin_amdgcn_readfirstlane((int)threadIdx.x >> 6);
#define opq_tid() pg8::pg8_tid(wave0)
    { const int tid = opq_tid(); for (int u = tid; u < (LDS_BYTES - RING_BYTES) / 4; u += NTHREADS) ((LAS unsigned*)(lds + RING_BYTES))[u] = 0u; }
    __syncthreads();
    XcdBarrier bar = xcd_barrier_post((unsigned*)kargs()->ws + CW_BAR + kargs()->li * XCD_BAR_WORDS, (volatile LAS unsigned*)(lds + MISC_OFF));
    const int lo = kargs()->ph_lo, hi = kargs()->ph_hi;
#define IN(k) (lo <= (k) && (k) < hi)
#define SEAM(k) do { if (IN(k) && IN((k) + 1)) xcd_barrier(bar, opq_tid(), (k) > 0); } while (0)
#define VBID() ({ volatile LAS unsigned* st_ = (volatile LAS unsigned*)(lds + MISC_OFF); (int)__builtin_amdgcn_readfirstlane(st_[3] ? (int)(st_[2] * 8u + bar.x) : bid); })
#define VGRP() ({ volatile LAS unsigned* st_ = (volatile LAS unsigned*)(lds + MISC_OFF); (int)__builtin_amdgcn_readfirstlane(st_[3] ? (int)bar.x : -1); })
#define LANE_VARS const int tid_ = opq_tid(), lane = tid_ & 63, wave = __builtin_amdgcn_readfirstlane(tid_ >> 6), gw = vcu * NWAVES + wave
    if (IN(0) && (PHMASK & 1)) for (int rep = 0; rep < NREP(1); ++rep) { LANE_VARS; prologue(kargs(), lds, gw, NGW, wave, lane); }
    SEAM(0);
#define OPQ(p) ({ auto _p = (p); asm volatile("" : "+s"(_p)); _p; })
    for (int L = 0; L < DEPTH; ++L) {
        const int p0 = 1 + 8 * L;
        if (IN(p0 + 0) && (PHMASK & 2)) for (int rep = 0; rep < NREP(2); ++rep) {
            KArgs ap = kargs(); unsigned char* wsp = ap->ws; const int Lp = OPQ(L);
            pg8::Gemm g{(const bf16_t*)(wsp + ((Lp & 1) ? WS_XB1 : WS_XB0)), (const bf16_t*)(wsp + WS_W + (size_t)Lp * W_LAYER + W_IN), M, 2816, 1024}; pg8::StaticOrder S; S.init(M, 2816, G, VBID());
            EpiProj E{(bf16_t*)(wsp + WS_BIG), stat_ptr(wsp, Lp, ST_X1), ap->in[4] + Lp * 256, ap->in[5] + Lp * 256, (const float*)(wsp + WS_TAB)};
            pg8::gemm_phase<EpiProj, pg8::StaticOrder, PG8_ALIGN, PG8_SP2>(lds, g, S, E, wave0);
        }
        SEAM(p0 + 0);
        if (IN(p0 + 1) && (PHMASK & 4)) {
            LANE_VARS; (void)gw; mixers(kargs(), OPQ(L), lds, tid_, wave, lane, VGRP());
        }
        SEAM(p0 + 1);
        if (IN(p0 + 2) && (PHMASK & 8)) {
            KArgs ap = kargs(); unsigned char* wsp = ap->ws; const int Lp = OPQ(L);
            pg8::Gemm g{(const bf16_t*)(wsp + WS_Y), (const bf16_t*)(wsp + WS_W + (size_t)Lp * W_LAYER + W_OUT), M, 1024, 1024}; pg8::StaticOrder S; S.init(M, 1024, G, VBID());
            EpiNormRes E{(bf16_t*)(wsp + ((Lp & 1) ? WS_XB1 : WS_XB0)), ap->in[11] + Lp * D_MODEL, stat_ptr(wsp, Lp, ST_MIX), stat_ptr(wsp, Lp, ST_X2), (unsigned*)wsp + CW_TMO};
            pg8::gemm_phase<EpiNormRes, pg8::StaticOrder, PG8_ALIGN, PG8_SP2>(lds, g, S, E, wave0);
        }
        SEAM(p0 + 2);
        if (IN(p0 + 4) && (PHMASK & 32)) for (int rep = 0; rep < NREP(32); ++rep) {
            KArgs ap = kargs(); unsigned char* wsp = ap->ws; const int Lp = OPQ(L);
            pg8::Gemm g{(const bf16_t*)(wsp + ((Lp & 1) ? WS_XB1 : WS_XB0)), (const bf16_t*)(wsp + WS_W + (size_t)Lp * W_LAYER + W_FFI), M, 5632, 1024}; pg8::StaticOrder S; S.init(M, 5632, G, VBID());
            EpiSwiglu E{(bf16_t*)(wsp + WS_BIG), stat_ptr(wsp, Lp, ST_X2), 1.0f / KREP3};
            pg8::gemm_phase<EpiSwiglu, pg8::StaticOrder, PG8_ALIGN, PG8_SP2, KREP3>(lds, g, S, E, wave0);
        }
        SEAM(p0 + 4);
        if (IN(p0 + 5) && (PHMASK & 64)) {
            { KArgs ap = kargs(); unsigned char* wsp = ap->ws; const int Lp = OPQ(L);
              pg8::Gemm g{(const bf16_t*)(wsp + WS_BIG), (const bf16_t*)(wsp + WS_W + (size_t)Lp * W_LAYER + W_FFO), M, 1024, D_FF}; pg8::StaticOrder S; S.init(M, 1024, G, VBID());
              EpiNormRes E{(bf16_t*)(wsp + ((Lp & 1) ? WS_XB1 : WS_XB0)), ap->in[15] + Lp * D_MODEL, stat_ptr(wsp, Lp, ST_F), nullptr, (unsigned*)wsp + CW_TMO};
              pg8::gemm_phase<EpiNormRes, pg8::StaticOrder, PG8_ALIGN, PG8_SP2>(lds, g, S, E, wave0); }
            { KArgs ap = kargs(); unsigned char* wsp = ap->ws; const int Lp = OPQ(L);
              pg8::Gemm g{(const bf16_t*)(wsp + WS_PB) + (size_t)Lp * M * PLE_DIM, (const bf16_t*)(wsp + WS_W + (size_t)Lp * W_LAYER + W_P), M, 1024, PLE_DIM}; pg8::StaticOrder S; S.init(M, 1024, G, VBID());
              EpiStat E{(bf16_t*)(wsp + WS_MIX), stat_ptr(wsp, Lp, ST_PP)};
              pg8::gemm_phase<EpiStat, pg8::StaticOrder, PG8_ALIGN, PG8_SP2>(lds, g, S, E, wave0); }
        }
        SEAM(p0 + 5);
        if (IN(p0 + 7) && (PHMASK & 256)) {
            KArgs ap = kargs(); unsigned char* wsp = ap->ws; const int Lp = OPQ(L);
            const bf16_t* XBc = (const bf16_t*)(wsp + ((Lp & 1) ? WS_XB1 : WS_XB0));
            pg8::Gemm g{XBc, (const bf16_t*)(wsp + WS_W + (size_t)Lp * W_LAYER + W_G), M, 1024, 1024}; pg8::StaticOrder S; S.init(M, 1024, G, VBID());
            const bool last = (Lp == DEPTH - 1);
            EpiPle E{XBc, (const bf16_t*)(wsp + WS_MIX), stat_ptr(wsp, Lp, ST_PP), ap->in[18] + Lp * D_MODEL, last ? nullptr : (bf16_t*)(wsp + ((Lp & 1) ? WS_XB0 : WS_XB1)), last ? nullptr : stat_ptr(wsp, Lp + 1, ST_X1), last ? ap->out : nullptr};
            if (last && VGRP() >= 0) {
                volatile LAS unsigned* st_ = (volatile LAS unsigned*)(lds + MISC_OFF);
                StealOrder SS; SS.init((int)bar.x, (int)__builtin_amdgcn_readfirstlane((int)st_[2]), (unsigned*)wsp + CW_CLAIM, bar.bar, 6u * (unsigned)DEPTH, (unsigned*)wsp + CW_TMO);
                pg8::gemm_phase<EpiPle, StealOrder, PG8_ALIGN, PG8_SP2>(lds, g, SS, E, wave0);
            } else
            pg8::gemm_phase<EpiPle, pg8::StaticOrder, PG8_ALIGN, PG8_SP2>(lds, g, S, E, wave0);
        }
        SEAM(p0 + 7);
    }
#undef IN
#undef SEAM
#undef VBID
#undef VGRP
#undef LANE_VARS
#undef opq_tid
}

extern "C" void kernel_launch(void* const* d_in, const int* in_sizes, int n_in, void* d_out, int out_size, void* d_ws, size_t ws_size, hipStream_t stream) {
    static int grid = 0;
    if (grid == 0) {
        if (n_in != 19 || out_size != M * D_MODEL || ws_size < WS_END) { fprintf(stderr, "kernel_launch: unexpected shapes (n_in %d out %d ws %zu)\n", n_in, out_size, ws_size); grid = -1; return; }
        int dev = 0, cus = 0, per_cu = 0;
        if (hipGetDevice(&dev) != hipSuccess || hipDeviceGetAttribute(&cus, hipDeviceAttributeMultiprocessorCount, dev) != hipSuccess) { grid = -1; return; }
        if (hipFuncSetAttribute((const void*)mega, hipFuncAttributeMaxDynamicSharedMemorySize, LDS_BYTES) != hipSuccess) { fprintf(stderr, "kernel_launch: hipFuncSetAttribute failed\n"); grid = -1; return; }
        if (hipOccupancyMaxActiveBlocksPerMultiprocessor(&per_cu, (const void*)mega, NTHREADS, LDS_BYTES) != hipSuccess || per_cu < 1) { fprintf(stderr, "kernel_launch: occupancy query says %d\n", per_cu); }
        (void)hipGetLastError();
        grid = cus >= 256 ? 256 : cus;
    }
    if (grid < 0) return;
    unsigned char* ws = (unsigned char*)d_ws;
    (void)hipMemsetAsync(ws + WS_CTL, 0, CTL_ZERO_BYTES, stream);
    Args a{};
    for (int i = 0; i < 19; ++i) a.in[i] = (const float*)d_in[i];
    a.out = (float*)d_out; a.ws = ws; a.li = 0; a.pad = 0;
    a.ph_lo = 0; a.ph_hi = N_PHASES;
    hipLaunchKernelGGL(mega, dim3(grid), dim3(NTHREADS), LDS_BYTES, stream, a);
}
```

```cpp
#include <hip/hip_runtime.h>
#include <stdint.h>
#include <stdio.h>

constexpr int D_MODEL = 1024, BATCH = 32, SEQ = 2048, DEPTH = 2, PLE_DIM = 256, HD = 64, CHUNK = 128;
constexpr int M = BATCH * SEQ;
constexpr int IN_W = 2688, D_FF = 2816, NHEADS = 42;
constexpr int H_AU = 0, H_AV = 4, H_BQ = 8, H_BK = 14, H_BV = 20, H_BG = 26, H_CQ = 32, H_CK = 38, H_CV = 40;
constexpr float EPS = 1e-6f;
typedef unsigned short bf16_t;

__device__ __forceinline__ float bf2f(bf16_t v) { return __uint_as_float(((unsigned)v) << 16); }
__device__ __forceinline__ bf16_t f2bf(float f) { unsigned u = __float_as_uint(f); return (bf16_t)((u + 0x7fffu + ((u >> 16) & 1u)) >> 16); }
__device__ __forceinline__ float shx(float v, int mask, int lane) { return __int_as_float(__builtin_amdgcn_ds_bpermute((lane ^ mask) << 2, __float_as_int(v))); }
__device__ __forceinline__ float wave_sum(float v) {
#pragma unroll
    for (int o = 1; o < 64; o <<= 1) v += __shfl_xor(v, o);
    return v;
}
constexpr float LOG2E_ = 1.4426950408889634f;

__constant__ double c_inv_ret[32] = {1.0, 0.7498942093324559, 0.5623413251903491, 0.4216965034285822, 0.31622776601683794, 0.23713737056616552, 0.1778279410038923, 0.1333521432163324, 0.1, 0.07498942093324558, 0.05623413251903491, 0.042169650342858224, 0.03162277660168379, 0.023713737056616554, 0.01778279410038923, 0.01333521432163324, 0.01, 0.007498942093324558, 0.005623413251903491, 0.004216965034285823, 0.0031622776601683794, 0.0023713737056616554, 0.0017782794100389228, 0.001333521432163324, 0.001, 0.0007498942093324559, 0.0005623413251903491, 0.00042169650342858224, 0.00031622776601683794, 0.00023713737056616554, 0.00017782794100389227, 0.0001333521432163324};
__constant__ double c_inv_swa[8] = {1.0, 0.19392274474868576, 0.03760603093086393, 0.007292664737217109, 0.001414213562373095, 0.0002742481756762073, 5.318295896944988e-05, 1.031338537721246e-05};
__constant__ float c_log2g[6] = {-0.04580368961312479f, -0.02272007650008353f, -0.011315313227834146f, -0.005646563141142063f, -0.0028205190623786626f, -0.0014095702546713536f};

constexpr size_t MiB = 1u << 20;
constexpr size_t WS_CTL = 0, CTL_ZERO_BYTES = 7 * MiB;
constexpr size_t WS_STAT = 1 * MiB;
constexpr size_t WS_TAB = 7 * MiB;
constexpr size_t WS_WM = 7 * MiB + 768 * 1024;
constexpr size_t WS_W = 8 * MiB;
constexpr size_t WS_XB0 = 64 * MiB;
constexpr size_t WS_BIG = 192 * MiB;
constexpr size_t WS_Y = 544 * MiB;
constexpr size_t WS_MIX = 672 * MiB;
constexpr size_t WS_XB1 = 800 * MiB;
constexpr size_t WS_PB = 928 * MiB;
constexpr size_t WS_END = 992 * MiB;
constexpr int TAB_RC = 0, TAB_RS = 2048 * 32, TAB_SC = 2 * 2048 * 32, TAB_SS = 2 * 2048 * 32 + 2048 * 8;


namespace pg8 {
#define PG8_LAS __attribute__((address_space(3)))
typedef unsigned short bf16_t;
typedef short bf16x8 __attribute__((ext_vector_type(8)));
typedef float f32x4 __attribute__((ext_vector_type(4)));
typedef unsigned u32x4 __attribute__((ext_vector_type(4)));
constexpr int BM = 256, BK = 64, HALF = 128, HTB = HALF * BK * 2  , STAGE_BYTES = 8 * HTB, NXCD = 8, WGM = 8;

__host__ __device__ __forceinline__ int lds_byte(int r, int c) { const int st = (r >> 4) * 2 + (c >> 5), rr = r & 15, cc = c & 31, ob = rr * 64 + cc * 2; return st * 1024 + (ob ^ (((ob >> 9) & 1) << 5)); }
__host__ __device__ __forceinline__ void stage_rc(int b, int& R, int& C) { const int st = b / 1024, sb = b % 1024, swz = sb ^ (((sb >> 9) & 1) << 5); R = (st >> 1) * 16 + swz / 64; C = (st & 1) * 32 + (swz % 64) / 2; }
__host__ __device__ __forceinline__ int perm32(int rho) { const int n = rho >> 4, i = rho & 15; return 8 * (i >> 2) + 4 * n + (i & 3); }

constexpr int PREF_OFF = 147456 + 4096;
struct Unit { int pm, pn; };
struct Gemm { const bf16_t* A; const bf16_t* Bt; int M, N, K; };

struct StaticOrder {
    int nM, nN, nwg, G, c, wgm, flip;
    __host__ __device__ void init(int M, int N, int G_, int c_) { nM = M / BM; nN = N / BM; nwg = nM * nN; G = G_; c = c_; wgm = nN >= 8 ? 4 : WGM; flip = 0; }
    __host__ __device__ bool next(int i, Unit& u) const {
        const long L = (long)i * G + c; if (L >= nwg) return false;
        int wgid = (int)L; { const int q = nwg / NXCD, r = nwg % NXCD, xcd = wgid % NXCD, off = wgid / NXCD; wgid = (xcd < r ? xcd * (q + 1) : r * (q + 1) + (xcd - r) * q) + off; }
        const int nig = wgm * nN, gid = wgid / nig, fm = gid * wgm, gsz = (nM - fm) < wgm ? (nM - fm) : wgm;
        u.pm = fm + ((wgid % nig) % gsz); u.pn = (wgid % nig) / gsz;
        if (nN >= 8 && (gid & 1)) u.pn = nN - 1 - u.pn;
        if (flip && nM % NXCD == 0) { const int per = nM / NXCD, xb = (u.pm / per) * per; u.pm = xb + per - 1 - (u.pm - xb); }
        return true;
    }
    __device__ __forceinline__ void a_ready(const Unit&) const {}
    __device__ __forceinline__ void done(const Unit&) const {}
};

typedef float f32x2_cv __attribute__((ext_vector_type(2))); typedef __bf16 bf16x2_cv __attribute__((ext_vector_type(2)));
__device__ __forceinline__ unsigned cvt_pk_bf16(float lo, float hi) { const f32x2_cv v = {lo, hi}; const bf16x2_cv b = __builtin_convertvector(v, bf16x2_cv); return __builtin_bit_cast(unsigned, b); }
__device__ __forceinline__ int pg8_tid(int wave0) {
    unsigned ones = ~0u; asm volatile("" : "+s"(ones));
    return wave0 * 64 + (int)__builtin_amdgcn_mbcnt_hi(ones, __builtin_amdgcn_mbcnt_lo(ones, 0u));
}
template <class Epi, class Sched, bool ALIGN_EPI = false, bool SP2 = false, int KREP = 1>
__device__ __forceinline__ void gemm_phase(PG8_LAS unsigned char* lds, const Gemm g, const Sched& S, const Epi& E, int wave0) {
    const int tid = pg8_tid(wave0);
    const int wid = __builtin_amdgcn_readfirstlane(tid >> 6), lane = tid & 63, wr = wid >> 2, wc = wid & 3, fr = lane & 15, fq = lane >> 4;
    const int K = g.K, nt = K / BK;
    unsigned voffA[2], voffB[2];
#pragma unroll
    for (int i = 0; i < 2; ++i) { int R, C; stage_rc(tid * 16 + i * 8192, R, C); const int Rb = Epi::PERM ? ((R & ~31) + perm32(R & 31)) : R;
        voffA[i] = (unsigned)(R * K + C) * 2u; voffB[i] = (unsigned)(Rb * K + C) * 2u; }
    const size_t kstep = (size_t)(BK * 2);
    const size_t hstep = (size_t)HALF * K * 2;
    const size_t tstep = 2 * hstep;
    const unsigned ldsw = (unsigned)wid * 1024u;
    const int aoff = lds_byte(wr * 64 + fr, fq * 8), boff = lds_byte(wc * 32 + fr, fq * 8);
#define PG8_SA(b, h) (((b) * 2 + (h)) * HTB)
#define PG8_SB(b, h) ((4 + (b) * 2 + (h)) * HTB)
#define PG8_STAGE(bufoff, gbase, voff) do { _Pragma("unroll") for (int _i = 0; _i < 2; ++_i) \
        __builtin_amdgcn_global_load_lds((const unsigned*)((const char*)(gbase) + (voff)[_i]), (PG8_LAS unsigned*)(lds + (bufoff) + ldsw + _i * 8192), 16, 0, 0); } while (0)
#define PG8_LDA(dst, b, h) do { _Pragma("unroll") for (int m = 0; m < 4; ++m) _Pragma("unroll") for (int k = 0; k < 2; ++k) dst[m][k] = *(const PG8_LAS bf16x8*)(lds + PG8_SA(b, h) + aoff + m * 2048 + k * 1024); } while (0)
#define PG8_LDB(dst, b, h) do { _Pragma("unroll") for (int n = 0; n < 2; ++n) _Pragma("unroll") for (int k = 0; k < 2; ++k) dst[n][k] = *(const PG8_LAS bf16x8*)(lds + PG8_SB(b, h) + boff + n * 2048 + k * 1024); } while (0)
#define PG8_MMA(ai, bj, At, Bt) do { __builtin_amdgcn_s_setprio(1); _Pragma("unroll") for (int m = 0; m < 4; ++m) _Pragma("unroll") for (int n = 0; n < 2; ++n) _Pragma("unroll") for (int k = 0; k < 2; ++k) \
        acc[ai][bj][m][n] = __builtin_amdgcn_mfma_f32_16x16x32_bf16(Bt[n][k], At[m][k], acc[ai][bj][m][n], 0, 0, 0); __builtin_amdgcn_s_setprio(0); } while (0)
#define PG8_WAIT_V(n) asm volatile("s_waitcnt vmcnt(" #n ")" ::: "memory")
#define PG8_WAIT_L(n) asm volatile("s_waitcnt lgkmcnt(" #n ")" ::: "memory")
#define PG8_BAR __builtin_amdgcn_s_barrier()
#define PG8_SCHED __builtin_amdgcn_sched_barrier(0)
    Unit cur, nxt; int ui = 0;
    if (!S.next(0, cur)) return;
    f32x4 acc[2][2][4][2];
#pragma unroll
    for (int a = 0; a < 2; ++a)
#pragma unroll
        for (int b = 0; b < 2; ++b)
#pragma unroll
            for (int m = 0; m < 4; ++m)
#pragma unroll
                for (int n = 0; n < 2; ++n) acc[a][b][m][n] = (f32x4){0.f, 0.f, 0.f, 0.f};
    bf16x8 At[4][2], B0[2][2], B1[2][2];
    const char* cA = (const char*)g.A + (size_t)cur.pm * tstep; const char* cB = (const char*)g.Bt + (size_t)cur.pn * tstep;
    S.a_ready(cur);
    if constexpr (SP2) {
        PG8_STAGE(PG8_SB(0, 0), cB, voffB); PG8_STAGE(PG8_SB(0, 1), cB + hstep, voffB); PG8_STAGE(PG8_SA(0, 0), cA, voffA); PG8_STAGE(PG8_SA(0, 1), cA + hstep, voffA);
        if (wr == 1) PG8_BAR;
        PG8_WAIT_V(2); PG8_BAR;
        PG8_STAGE(PG8_SB(1, 0), cB + kstep, voffB); PG8_STAGE(PG8_SA(1, 0), cA + kstep, voffA); PG8_STAGE(PG8_SB(1, 1), cB + hstep + kstep, voffB);
        PG8_WAIT_V(6); PG8_BAR;
    } else {
        PG8_STAGE(PG8_SB(0, 0), cB, voffB); PG8_STAGE(PG8_SA(0, 0), cA, voffA); PG8_STAGE(PG8_SB(0, 1), cB + hstep, voffB); PG8_STAGE(PG8_SA(0, 1), cA + hstep, voffA);
        if (wr == 1) PG8_BAR;
        PG8_WAIT_V(4); PG8_BAR;
        PG8_STAGE(PG8_SB(1, 0), cB + kstep, voffB); PG8_STAGE(PG8_SA(1, 0), cA + kstep, voffA); PG8_STAGE(PG8_SB(1, 1), cB + hstep + kstep, voffB);
        PG8_WAIT_V(6); PG8_BAR;
    }
    for (;;) {
        const bool has_next = S.next(ui + 1, nxt);
        const char* nA = has_next ? (const char*)g.A + (size_t)nxt.pm * tstep : cA; const char* nB = has_next ? (const char*)g.Bt + (size_t)nxt.pn * tstep : cB;
        for (int t = 0; t < nt * KREP; t += 2) {
            const bool last = (t == nt * KREP - 2);
            const int t1 = KREP > 1 ? (t + 1) % nt : t + 1, t2 = KREP > 1 ? (t + 2) % nt : t + 2;
            const char* a1 = cA + (size_t)t1 * kstep;
            const char* a2 = last ? nA : cA + (size_t)t2 * kstep; const char* b2 = last ? nB : cB + (size_t)t2 * kstep;
            const char* a3 = a2 + kstep; const char* b3 = b2 + kstep;
            if (last && has_next) S.a_ready(nxt);
            if constexpr (Epi::PREF) { if (last) E.prefetch(lds, cur, wid, lane); }
            if constexpr (SP2) {
            PG8_LDB(B0, 0, 0); PG8_LDB(B1, 0, 1); PG8_SCHED; PG8_LDA(At, 0, 0); PG8_STAGE(PG8_SA(1, 1), a1 + hstep, voffA);
            PG8_WAIT_V(8); PG8_WAIT_L(0); PG8_BAR; PG8_MMA(0, 0, At, B0); PG8_MMA(0, 1, At, B1); PG8_BAR; PG8_SCHED;
            PG8_LDA(At, 0, 1); PG8_STAGE(PG8_SB(0, 0), b2, voffB); PG8_STAGE(PG8_SB(0, 1), b2 + hstep, voffB); PG8_STAGE(PG8_SA(0, 0), a2, voffA);
            PG8_WAIT_V(8); PG8_WAIT_L(0); PG8_BAR; PG8_MMA(1, 0, At, B0); PG8_MMA(1, 1, At, B1); PG8_BAR; PG8_SCHED;
            PG8_LDB(B0, 1, 0); PG8_LDB(B1, 1, 1); PG8_SCHED; PG8_LDA(At, 1, 0); PG8_STAGE(PG8_SA(0, 1), a2 + hstep, voffA);
            PG8_WAIT_V(8); PG8_WAIT_L(0); PG8_BAR; PG8_MMA(0, 0, At, B0); PG8_MMA(0, 1, At, B1); PG8_BAR; PG8_SCHED;
            PG8_LDA(At, 1, 1); PG8_STAGE(PG8_SB(1, 0), b3, voffB); PG8_STAGE(PG8_SB(1, 1), b3 + hstep, voffB); PG8_STAGE(PG8_SA(1, 0), a3, voffA);
            PG8_WAIT_V(8); PG8_WAIT_L(0); PG8_BAR; PG8_MMA(1, 0, At, B0); PG8_MMA(1, 1, At, B1); PG8_BAR; PG8_SCHED;
            } else {
            PG8_LDB(B0, 0, 0); PG8_SCHED; PG8_LDA(At, 0, 0); PG8_STAGE(PG8_SA(1, 1), a1 + hstep, voffA);
            PG8_WAIT_L(8); PG8_BAR; PG8_WAIT_L(0); PG8_MMA(0, 0, At, B0); PG8_BAR; PG8_SCHED;
            PG8_LDB(B1, 0, 1); PG8_STAGE(PG8_SB(0, 0), b2, voffB);
            PG8_BAR; PG8_WAIT_L(0); PG8_MMA(0, 1, At, B1); PG8_BAR;
            PG8_LDA(At, 0, 1); PG8_STAGE(PG8_SA(0, 0), a2, voffA);
            PG8_BAR; PG8_WAIT_L(0); PG8_MMA(1, 0, At, B0); PG8_BAR; PG8_SCHED;
            PG8_STAGE(PG8_SB(0, 1), b2 + hstep, voffB);
            PG8_WAIT_V(6); PG8_BAR; PG8_MMA(1, 1, At, B1); PG8_BAR;
            PG8_LDB(B0, 1, 0); PG8_SCHED; PG8_LDA(At, 1, 0); PG8_STAGE(PG8_SA(0, 1), a2 + hstep, voffA);
            PG8_WAIT_L(8); PG8_BAR; PG8_WAIT_L(0); PG8_MMA(0, 0, At, B0); PG8_BAR; PG8_SCHED;
            PG8_LDB(B1, 1, 1); PG8_STAGE(PG8_SB(1, 0), b3, voffB);
            PG8_BAR; PG8_WAIT_L(0); PG8_MMA(0, 1, At, B1); PG8_BAR;
            PG8_LDA(At, 1, 1); PG8_STAGE(PG8_SA(1, 0), a3, voffA);
            PG8_BAR; PG8_WAIT_L(0); PG8_MMA(1, 0, At, B0); PG8_BAR; PG8_SCHED;
            PG8_STAGE(PG8_SB(1, 1), b3 + hstep, voffB);
            PG8_WAIT_V(6); PG8_BAR; PG8_MMA(1, 1, At, B1); PG8_BAR;
            }
        }
        if constexpr (ALIGN_EPI) { if (wr == 0) PG8_BAR; }
        if constexpr (!Epi::AFTER_DRAIN) { E(acc, cur, wr, wc, fr, fq); S.done(cur); }
        if (!has_next) break;
#pragma unroll
        for (int a = 0; a < 2; ++a)
#pragma unroll
            for (int b = 0; b < 2; ++b)
#pragma unroll
                for (int m = 0; m < 4; ++m)
#pragma unroll
                    for (int n = 0; n < 2; ++n) acc[a][b][m][n] = (f32x4){0.f, 0.f, 0.f, 0.f};
        cur = nxt; cA = nA; cB = nB; ++ui;
        if constexpr (ALIGN_EPI) { if (wr == 1) PG8_BAR; }
    }
    PG8_WAIT_V(0);
    if constexpr (!ALIGN_EPI) { if (wr == 0) PG8_BAR; }
    PG8_BAR;
    if constexpr (Epi::AFTER_DRAIN) { E.fused(acc, cur, wr, wc, fr, fq, lds, wid, lane); S.done(cur); }
#undef PG8_SA
#undef PG8_SB
#undef PG8_STAGE
#undef PG8_LDA
#undef PG8_LDB
#undef PG8_MMA
#undef PG8_WAIT_V
#undef PG8_WAIT_L
#undef PG8_BAR
#undef PG8_SCHED
}
}

#define LAS __attribute__((address_space(3)))
#define GAS __attribute__((address_space(1)))
using pg8::f32x4; using pg8::u32x4; using pg8::Unit; using pg8::cvt_pk_bf16;
typedef unsigned u32x2 __attribute__((ext_vector_type(2)));
typedef GAS unsigned gu32;
#define RLX_AGENT __ATOMIC_RELAXED, __HIP_MEMORY_SCOPE_AGENT

constexpr int NWAVES = 8, NTHREADS = 512;
constexpr int LDS_BYTES = 163840;
constexpr int RING_BYTES = 147456, MISC_OFF = RING_BYTES + 320;
constexpr size_t W_IN = 0, W_OUT = W_IN + (size_t)2816 * 1024 * 2, W_FFI = W_OUT + (size_t)1024 * 1024 * 2, W_FFO = W_FFI + (size_t)5632 * 1024 * 2,
                 W_G = W_FFO + (size_t)1024 * 2816 * 2, W_P = W_G + (size_t)1024 * 1024 * 2, W_LAYER = W_P + (size_t)1024 * 256 * 2;
static_assert(WS_W + 2 * W_LAYER <= WS_XB0, "weights fit");
enum { ST_X1 = 0, ST_MIX = 1, ST_X2 = 2, ST_F = 3, ST_PP = 4, ST_N = 5 };
typedef unsigned long long stat_t;
__host__ __device__ __forceinline__ stat_t* stat_ptr(unsigned char* ws, int L, int idx) { return (stat_t*)(ws + WS_STAT) + (size_t)(L * ST_N + idx) * M; }
static_assert(WS_STAT + (size_t)2 * ST_N * M * 8 <= CTL_ZERO_BYTES && CTL_ZERO_BYTES <= WS_TAB, "stats inside the zeroed region");
__device__ __forceinline__ stat_t ss_enc(float s) { return (stat_t)(s * 16777216.0f); }
__device__ __forceinline__ float ss_dec(stat_t v) { return (float)v * (1.0f / 16777216.0f); }
constexpr int CW_BAR = 4096;

#define XB_TMO      128
#define XB_XCNT(j)  (256  + 64 * (j))
#define XB_XSUB(j)  (1280 + 64 * (j))
#define XB_XGEN(j)  (2304 + 64 * (j))
#define XB_TOP      3328
#define XB_TOPGEN   3392
#define XCD_BAR_WORDS 3456
#define XB_SPIN_CAP (1u << 22)
__device__ __forceinline__ unsigned xb_ld(unsigned* p)              { return __hip_atomic_load(p, __ATOMIC_RELAXED, __HIP_MEMORY_SCOPE_AGENT); }
__device__ __forceinline__ unsigned xb_add(unsigned* p, unsigned v) { return __hip_atomic_fetch_add(p, v, __ATOMIC_RELAXED, __HIP_MEMORY_SCOPE_AGENT); }
__device__ __forceinline__ unsigned xb_xcc_id() { return (unsigned)__builtin_amdgcn_s_getreg((3 << 11) | 20) & 0xFu; }
#define XB_SPIN(cond, bar) do { unsigned _sp = 0; while (cond) { __builtin_amdgcn_s_sleep(1); \
    if ((++_sp & 255u) == 0u) { if (xb_ld(&(bar)[XB_TMO])) break; if (_sp > XB_SPIN_CAP) { atomicAdd(&(bar)[XB_TMO], 1u); break; } } } } while (0)
struct XcdBarrier { unsigned* bar; unsigned x; volatile LAS unsigned* st; };
__device__ __forceinline__ XcdBarrier xcd_barrier_post(unsigned* bar, volatile LAS unsigned* st) {
    XcdBarrier b; b.bar = bar; b.x = xb_xcc_id(); b.st = st;
    if (threadIdx.x == 0) st[2] = xb_add(&bar[XB_XCNT(b.x)], 1u);
    return b;
}
__device__ __forceinline__ void xcd_barrier_complete(unsigned* bar, unsigned x, unsigned& nloc, unsigned& nx, unsigned& uni) {
    const unsigned G = gridDim.x * gridDim.y * gridDim.z;
    unsigned sum, cnt, mine, odd, sp = 0u;
    for (;;) {
        sum = 0u; cnt = 0u; mine = 0u; odd = 0u;
#pragma unroll
        for (unsigned j = 0; j < 16; ++j) { const unsigned c = xb_ld(&bar[XB_XCNT(j)]); sum += c; cnt += (c > 0u) ? 1u : 0u; mine = (j == x) ? c : mine; odd |= (c != 0u && c != 32u) ? 1u : 0u; odd |= (c != 0u && j >= 8u) ? 1u : 0u; }
        if (sum == G) break;
        __builtin_amdgcn_s_sleep(1);
        if ((++sp & 255u) == 0u) { if (xb_ld(&bar[XB_TMO])) break; if (sp > XB_SPIN_CAP) { atomicAdd(&bar[XB_TMO], 1u); break; } }
    }
    nloc = mine > 0u ? mine : 1u; nx = cnt > 0u ? cnt : 1u;
    uni = (sum == G && G == 256u && cnt == 8u && odd == 0u) ? 1u : 0u;
}
__device__ __forceinline__ void xcd_barrier(const XcdBarrier& b, int tid, bool may_local = false, bool publish = true) {
    asm volatile("s_waitcnt vmcnt(0)" ::: "memory");
    __syncthreads();
    if (tid == 0) {
        unsigned* bar = b.bar;
        __builtin_amdgcn_s_waitcnt(0);
        unsigned nloc = b.st[0], nx = b.st[1];
        if (nloc == 0u) { unsigned uni; xcd_barrier_complete(bar, b.x, nloc, nx, uni); b.st[0] = nloc; b.st[1] = nx; b.st[3] = uni; }
        const bool local = may_local && b.st[3] != 0u;
        const unsigned old = xb_add(&bar[XB_XSUB(b.x)], 1u);
        const unsigned gen = old / nloc;
        if (old + 1u == (gen + 1u) * nloc) {
            if (!local || publish) __builtin_amdgcn_fence(__ATOMIC_RELEASE, "agent");
            asm volatile("s_waitcnt vmcnt(0)" ::: "memory");
            if (!local) {
                const unsigned og = xb_add(&bar[XB_TOP], 1u);
                const unsigned tg = og / nx;
                if (og + 1u == (tg + 1u) * nx) xb_add(&bar[XB_TOPGEN], 1u);
                else XB_SPIN(xb_ld(&bar[XB_TOPGEN]) == tg, bar);
            }
            if (local) { xb_add(&bar[XB_XGEN(b.x)], 1u); __builtin_amdgcn_fence(__ATOMIC_ACQUIRE, "agent"); }
            else { __builtin_amdgcn_fence(__ATOMIC_ACQUIRE, "agent"); xb_add(&bar[XB_XGEN(b.x)], 1u); }
            asm volatile("s_waitcnt vmcnt(0)" ::: "memory");
        } else if (local) {
            __builtin_amdgcn_fence(__ATOMIC_ACQUIRE, "agent");
            XB_SPIN(xb_ld(&bar[XB_XGEN(b.x)]) == gen, bar);
            asm volatile("s_waitcnt vmcnt(0)" ::: "memory");
        } else {
            XB_SPIN(xb_ld(&bar[XB_XGEN(b.x)]) == gen, bar);
            __builtin_amdgcn_fence(__ATOMIC_ACQUIRE, "agent");
            asm volatile("s_waitcnt vmcnt(0)" ::: "memory");
        }
    }
    __syncthreads();
}

constexpr int CW_CLAIM = 8192;
struct StealOrder {
    int x, j; unsigned* claim; unsigned* bar; unsigned need; unsigned* tmo;
    mutable int own_i, vy, vr;
    __device__ __forceinline__ void init(int x_, int j_, unsigned* claim_, unsigned* bar_, unsigned need_, unsigned* tmo_) { x = x_; j = j_; claim = claim_; bar = bar_; need = need_; tmo = tmo_; own_i = 0; vy = 1; vr = 3; }
    __device__ __forceinline__ bool mine(int wgid) const {
        const unsigned me = (unsigned)(x * 32 + j) + 1u;
        unsigned* w_ = claim + wgid;
        typedef unsigned u32x2_t __attribute__((ext_vector_type(2)));
        const u32x2_t dc = {me, 0u};
        unsigned old_; unsigned long long sv_;
        asm volatile("s_mov_b64 %1, exec\n\ts_mov_b64 exec, 1\n\tglobal_atomic_cmpswap %0, %2, %3, off sc0\n\ts_waitcnt vmcnt(0)\n\ts_mov_b64 exec, %1"
                     : "=&v"(old_), "=&s"(sv_) : "v"(w_), "v"(dc) : "memory");
        const unsigned r = (unsigned)__builtin_amdgcn_readfirstlane((int)old_);
        return r == 0u || r == me;
    }
    static __device__ __forceinline__ void tile(int wgid, pg8::Unit& u) { const int gid = wgid >> 5, s = wgid & 31; u.pm = gid * 8 + (s & 7); u.pn = s >> 3; }
    __device__ __forceinline__ bool next(int, pg8::Unit& u) const {
        while (own_i < 4) { const int wgid = x * 128 + own_i * 32 + j; ++own_i; if (mine(wgid)) { tile(wgid, u); return true; } }
        while (vy < 8) {
            const int y = (x + vy) & 7;
            while (vr >= 1) { const int wgid = y * 128 + vr * 32 + j; --vr; if (mine(wgid)) { tile(wgid, u); return true; } }
            vr = 3; ++vy;
        }
        return false;
    }
    __device__ __forceinline__ void a_ready(const pg8::Unit& u) const {
        const int y = u.pm >> 5;
        if (y == x) return;
        unsigned sp = 0;
        while (xb_ld(&bar[XB_XGEN(y)]) < need + (y >= 4 ? 1u : 0u)) { __builtin_amdgcn_s_sleep(2); if (++sp > XB_SPIN_CAP) { __hip_atomic_store(tmo, 1u, __ATOMIC_RELAXED, __HIP_MEMORY_SCOPE_AGENT); break; } }
        __builtin_amdgcn_fence(__ATOMIC_ACQUIRE, "agent");
    }
    __device__ __forceinline__ void done(const pg8::Unit&) const {}
};

__device__ __forceinline__ float fast_rsq(float x) { return __builtin_amdgcn_rsqf(x); }
__device__ __forceinline__ float sigm(float x) { return __builtin_amdgcn_rcpf(1.0f + __builtin_amdgcn_exp2f(-LOG2E_ * x)); }
__device__ __forceinline__ float gelu_t(float x) { return x * sigm(1.5957691216057308f * (x + 0.044715f * x * x * x)); }
__device__ __forceinline__ void unpack8s(const f32x4& v0, const f32x4& v1, float s, float (&o)[8]) {
    o[0] = v0[0] * s; o[1] = v0[1] * s; o[2] = v0[2] * s; o[3] = v0[3] * s; o[4] = v1[0] * s; o[5] = v1[1] * s; o[6] = v1[2] * s; o[7] = v1[3] * s;
}
__device__ __forceinline__ u32x4 pack8(const float (&o)[8]) {
    u32x4 w; w.x = cvt_pk_bf16(o[0], o[1]); w.y = cvt_pk_bf16(o[2], o[3]); w.z = cvt_pk_bf16(o[4], o[5]); w.w = cvt_pk_bf16(o[6], o[7]); return w;
}
__device__ __forceinline__ void ld8f(const float* p, float (&o)[8]) {
    const f32x4 a = *(const f32x4*)p, b = *(const f32x4*)(p + 4);
    o[0] = a[0]; o[1] = a[1]; o[2] = a[2]; o[3] = a[3]; o[4] = b[0]; o[5] = b[1]; o[6] = b[2]; o[7] = b[3];
}
__device__ __forceinline__ void ld8f_nt(const float* p, float (&o)[8]) {
    const f32x4 a = __builtin_nontemporal_load((const f32x4*)p), b = __builtin_nontemporal_load((const f32x4*)(p + 4));
    o[0] = a[0]; o[1] = a[1]; o[2] = a[2]; o[3] = a[3]; o[4] = b[0]; o[5] = b[1]; o[6] = b[2]; o[7] = b[3];
}

__device__ __forceinline__ void unpack_bf8(const u32x4& r, float (&o)[8]) {
    o[0] = __uint_as_float(r.x << 16); o[1] = __uint_as_float(r.x & 0xffff0000u); o[2] = __uint_as_float(r.y << 16); o[3] = __uint_as_float(r.y & 0xffff0000u);
    o[4] = __uint_as_float(r.z << 16); o[5] = __uint_as_float(r.z & 0xffff0000u); o[6] = __uint_as_float(r.w << 16); o[7] = __uint_as_float(r.w & 0xffff0000u);
}
__device__ __forceinline__ int fresh_lane() { unsigned ones = ~0u; asm volatile("" : "+s"(ones)); return (int)__builtin_amdgcn_mbcnt_hi(ones, __builtin_amdgcn_mbcnt_lo(ones, 0u)); }
#define EPI_ROW(u, ai, wr, m, fr) ((u).pm * 256 + (ai) * 128 + (wr) * 64 + (m) * 16 + (fr))

enum { T_AU, T_AV, T_BQ, T_BK, T_BV, T_BG, T_CQ, T_CK, T_CV };
struct EpiProj {
    static constexpr bool PERM = true, AFTER_DRAIN = false, PREF = true;
    bf16_t* P; const stat_t* ss; const float* ln_w; const float* ln_b; const float* tab;
    __device__ __forceinline__ void prefetch(LAS unsigned char* lds, const Unit& u, int wid, int lane) const {
        const stat_t* src = ss + u.pm * 256 + (lane >> 5) * 128 + (wid >> 2) * 64 + 2 * (lane & 31);
        __builtin_amdgcn_global_load_lds((const unsigned*)src, (LAS unsigned*)(lds + pg8::PREF_OFF + wid * 1024), 16, 0, 0);
    }
    template <int TYPE> __device__ __forceinline__ void rows(const f32x4 (&acc)[2][2][4][2], const Unit& u, int wr, int hs, int hrel, int fr, int fq) const {
        const int d0 = 8 * fq, ln_ = fr + 16 * fq;
        float rs[8];
#pragma unroll
        for (int q = 0; q < 8; ++q) rs[q] = ss_dec(*(const LAS stat_t*)((LAS unsigned char*)(pg8::PREF_OFF + (wr * 4 + (hs & 3)) * 1024) + (q >> 2) * 512 + ((q & 3) * 16 + fr) * 8));
        float wa[8], wb[8], ba[8], bb[8];
        if constexpr (TYPE == T_AV) { ld8f(ln_w + hrel * 64 + d0, wa); ld8f(ln_w + hrel * 64 + 32 + d0, wb); ld8f(ln_b + hrel * 64 + d0, ba); ld8f(ln_b + hrel * 64 + 32 + d0, bb); }
#pragma unroll
        for (int hp = 0; hp < 4; ++hp) {
            const int ai = hp >> 1;
            float tc[2][8], tsn[2][8];
            if constexpr (TYPE == T_BQ || TYPE == T_BK) {
#pragma unroll
                for (int mm = 0; mm < 2; ++mm) { const int pos = EPI_ROW(u, ai, wr, 2 * (hp & 1) + mm, fr) & (SEQ - 1); ld8f(tab + TAB_RC + pos * 32 + d0, tc[mm]); ld8f(tab + TAB_RS + pos * 32 + d0, tsn[mm]); }
            }
            if constexpr (TYPE == T_CQ || TYPE == T_CK) {
#pragma unroll
                for (int mm = 0; mm < 2; ++mm) { const int pos = EPI_ROW(u, ai, wr, 2 * (hp & 1) + mm, fr) & (SEQ - 1); ld8f(tab + TAB_SC + pos * 8, tc[mm]); ld8f(tab + TAB_SS + pos * 8, tsn[mm]); }
            }
#pragma unroll
            for (int mm = 0; mm < 2; ++mm) {
                const int m = 2 * (hp & 1) + mm;
                const int row = EPI_ROW(u, ai, wr, m, fr);
                const float rstd = fast_rsq(rs[ai * 4 + m] * (1.0f / D_MODEL) + EPS);
                float a[8], b[8];
                unpack8s(acc[ai][0][m][0], acc[ai][0][m][1], rstd, a); unpack8s(acc[ai][1][m][0], acc[ai][1][m][1], rstd, b);
                if constexpr (TYPE == T_AU) {
#pragma unroll
                    for (int j = 0; j < 8; ++j) { a[j] = gelu_t(a[j]); b[j] = gelu_t(b[j]); }
                } else if constexpr (TYPE == T_AV) {
                    float sm = 0.f;
#pragma unroll
                    for (int j = 0; j < 8; ++j) { a[j] = gelu_t(a[j]); b[j] = gelu_t(b[j]); sm += a[j] + b[j]; }
                    sm += shx(sm, 16, ln_); sm += shx(sm, 32, ln_);
                    const float mu = sm * (1.0f / 64.0f); float q = 0.f;
#pragma unroll
                    for (int j = 0; j < 8; ++j) { a[j] -= mu; b[j] -= mu; q += a[j] * a[j] + b[j] * b[j]; }
                    q += shx(q, 16, ln_); q += shx(q, 32, ln_);
                    const float rsd = fast_rsq(q * (1.0f / 64.0f) + EPS);
#pragma unroll
                    for (int j = 0; j < 8; ++j) { a[j] = a[j] * rsd * wa[j] + ba[j]; b[j] = b[j] * rsd * wb[j] + bb[j]; }
                } else if constexpr (TYPE == T_BQ || TYPE == T_BK) {
                    const float tch = (float)(row & (CHUNK - 1)) * c_log2g[hrel];
                    const float sc = __builtin_amdgcn_exp2f(TYPE == T_BK ? -tch - 3.0f : tch);
#pragma unroll
                    for (int j = 0; j < 8; ++j) { const float x1 = a[j], x2 = b[j]; a[j] = (x1 * tc[mm][j] - x2 * tsn[mm][j]) * sc; b[j] = (x2 * tc[mm][j] + x1 * tsn[mm][j]) * sc; }
                } else if constexpr (TYPE == T_BG) {
#pragma unroll
                    for (int j = 0; j < 8; ++j) { a[j] = a[j] * sigm(a[j]); b[j] = b[j] * sigm(b[j]); }
                } else if constexpr (TYPE == T_CQ || TYPE == T_CK) {
                    float o[8];
#pragma unroll
                    for (int j = 0; j < 8; ++j) o[j] = shx(a[j], 16, ln_);
                    if (fq < 2) {
                        const float sg = fq == 0 ? -1.0f : 1.0f;
#pragma unroll
                        for (int j = 0; j < 8; ++j) a[j] = a[j] * tc[mm][j] + sg * o[j] * tsn[mm][j];
                    }
                }
                bf16_t* dst = P + (size_t)row * IN_W + hs * 64 + d0;
                *(u32x4*)dst = pack8(a); *(u32x4*)(dst + 32) = pack8(b);
            }
        }
    }
    __device__ __forceinline__ void operator()(const f32x4 (&acc)[2][2][4][2], const Unit& u, int wr, int wc, int fr, int fq) const {
        const int ln_ = fresh_lane(); fr = ln_ & 15; fq = ln_ >> 4;
        const int hs = u.pn * 4 + wc;
        if (hs >= NHEADS) return;
        if (hs < H_AV) rows<T_AU>(acc, u, wr, hs, hs - H_AU, fr, fq);
        else if (hs < H_BQ) rows<T_AV>(acc, u, wr, hs, hs - H_AV, fr, fq);
        else if (hs < H_BK) rows<T_BQ>(acc, u, wr, hs, hs - H_BQ, fr, fq);
        else if (hs < H_BV) rows<T_BK>(acc, u, wr, hs, hs - H_BK, fr, fq);
        else if (hs < H_BG) rows<T_BV>(acc, u, wr, hs, hs - H_BV, fr, fq);
        else if (hs < H_CQ) rows<T_BG>(acc, u, wr, hs, hs - H_BG, fr, fq);
        else if (hs < H_CK) rows<T_CQ>(acc, u, wr, hs, hs - H_CQ, fr, fq);
        else if (hs < H_CV) rows<T_CK>(acc, u, wr, hs, hs - H_CK, fr, fq);
        else rows<T_CV>(acc, u, wr, hs, hs - H_CV, fr, fq);
    }
};
struct EpiSwiglu {
    static constexpr bool PERM = true, AFTER_DRAIN = false, PREF = true;
    bf16_t* H; const stat_t* ss; float kscale;
    __device__ __forceinline__ void prefetch(LAS unsigned char* lds, const Unit& u, int wid, int lane) const {
        const stat_t* src = ss + u.pm * 256 + (lane >> 5) * 128 + (wid >> 2) * 64 + 2 * (lane & 31);
        __builtin_amdgcn_global_load_lds((const unsigned*)src, (LAS unsigned*)(lds + pg8::PREF_OFF + wid * 1024), 16, 0, 0);
    }
    __device__ __forceinline__ void operator()(const f32x4 (&acc)[2][2][4][2], const Unit& u, int wr, int wc, int fr, int fq) const {
        const int ln_ = fresh_lane(); fr = ln_ & 15; fq = ln_ >> 4;
        float rs[8];
#pragma unroll
        for (int q = 0; q < 8; ++q) rs[q] = ss_dec(*(const LAS stat_t*)((LAS unsigned char*)(pg8::PREF_OFF + (wr * 4 + wc) * 1024) + (q >> 2) * 512 + ((q & 3) * 16 + fr) * 8));
#pragma unroll
        for (int ai = 0; ai < 2; ++ai)
#pragma unroll
            for (int m = 0; m < 4; ++m) {
                const int row = EPI_ROW(u, ai, wr, m, fr);
                const float ms = rs[ai * 4 + m] * (1.0f / D_MODEL) + EPS;
                const float rstd = fast_rsq(ms) * kscale;
                typedef float f32x2 __attribute__((ext_vector_type(2)));
                const float cexp = -LOG2E_ * rstd, ir2 = ms / (kscale * kscale);
                unsigned wv4[4];
#pragma unroll
                for (int n = 0; n < 2; ++n)
#pragma unroll
                    for (int hf = 0; hf < 2; ++hf) {
                        const f32x2 ag = {acc[ai][0][m][n][2 * hf], acc[ai][0][m][n][2 * hf + 1]}, au = {acc[ai][1][m][n][2 * hf], acc[ai][1][m][n][2 * hf + 1]};
                        f32x2 e = ag * cexp; e.x = __builtin_amdgcn_exp2f(e.x); e.y = __builtin_amdgcn_exp2f(e.y);
                        f32x2 d = e * ir2 + ir2; d.x = __builtin_amdgcn_rcpf(d.x); d.y = __builtin_amdgcn_rcpf(d.y);
                        const f32x2 hh = (ag * au) * d;
                        wv4[2 * n + hf] = cvt_pk_bf16(hh.x, hh.y);
                    }
                const u32x4 g = {wv4[0], wv4[1], wv4[2], wv4[3]};
                *(u32x4*)(H + (size_t)row * D_FF + u.pn * 128 + wc * 32 + 8 * fq) = g;
            }
    }
};
struct EpiStore {
    static constexpr bool PERM = true, AFTER_DRAIN = false, PREF = false;
    bf16_t* O;
    __device__ __forceinline__ void operator()(const f32x4 (&acc)[2][2][4][2], const Unit& u, int wr, int wc, int fr, int fq) const {
        const int ln_ = fresh_lane(); fr = ln_ & 15; fq = ln_ >> 4;
#pragma unroll
        for (int q = 0; q < 8; ++q) {
            const int ai = q >> 2, m = q & 3, row = EPI_ROW(u, ai, wr, m, fr);
#pragma unroll
            for (int bj = 0; bj < 2; ++bj) {
                float v[8]; unpack8s(acc[ai][bj][m][0], acc[ai][bj][m][1], 1.0f, v);
                *(u32x4*)(O + (size_t)row * D_MODEL + u.pn * 256 + bj * 128 + wc * 32 + 8 * fq) = pack8(v);
            }
        }
    }
};
struct EpiNormRes {
    static constexpr bool PERM = true, AFTER_DRAIN = false, PREF = false;
    bf16_t* XB; const float* w; stat_t* ssT; stat_t* ss_out; unsigned* tmo;
    __device__ __forceinline__ void operator()(const f32x4 (&acc)[2][2][4][2], const Unit& u, int wr, int wc, int fr, int fq) const {
        const int ln_ = fresh_lane(); fr = ln_ & 15; fq = ln_ >> 4;
        const int col0 = u.pn * 256 + wc * 32 + 8 * fq;
        float s[8];
#pragma unroll
        for (int q = 0; q < 8; ++q) {
            const int ai = q >> 2, m = q & 3; float sq = 0.f;
#pragma unroll
            for (int bj = 0; bj < 2; ++bj)
#pragma unroll
                for (int n = 0; n < 2; ++n) { const f32x4 v = acc[ai][bj][m][n]; sq += (v[0] * v[0] + v[1] * v[1]) + (v[2] * v[2] + v[3] * v[3]); }
            s[q] = sq;
        }
#pragma unroll
        for (int q = 0; q < 8; ++q) s[q] += shx(s[q], 16, ln_);
#pragma unroll
        for (int q = 0; q < 8; ++q) s[q] += shx(s[q], 32, ln_);
        if (fq == 0) {
#pragma unroll
            for (int q = 0; q < 8; ++q) atomicAdd(ssT + EPI_ROW(u, q >> 2, wr, q & 3, fr), (ss_enc(s[q]) << 8) | 1ull);
        }
        float wv[2][8]; ld8f(w + col0, wv[0]); ld8f(w + col0 + 128, wv[1]);
        u32x4 xr[4][2];
#pragma unroll
        for (int m = 0; m < 4; ++m)
#pragma unroll
            for (int bj = 0; bj < 2; ++bj) xr[m][bj] = *(const u32x4*)(XB + (size_t)EPI_ROW(u, 0, wr, m, fr) * D_MODEL + col0 + bj * 128);
        float rs[8];
        {
            stat_t v[8]; unsigned sp = 0;
            for (;;) {
                bool ok = true;
#pragma unroll
                for (int q = 0; q < 8; ++q) { v[q] = __hip_atomic_load(ssT + EPI_ROW(u, q >> 2, wr, q & 3, fr), __ATOMIC_RELAXED, __HIP_MEMORY_SCOPE_AGENT); ok = ok && ((unsigned)v[q] & 255u) == 16u; }
                if (__all(ok)) break;
                __builtin_amdgcn_s_sleep(1);
                if (++sp > (1u << 22)) { if (ln_ == 0) __hip_atomic_store(tmo, 1u, __ATOMIC_RELAXED, __HIP_MEMORY_SCOPE_AGENT); break; }
            }
#pragma unroll
            for (int q = 0; q < 8; ++q) rs[q] = ss_dec(v[q] >> 8);
        }
        float so[8];
#pragma unroll
        for (int ai = 0; ai < 2; ++ai) {
            if (ai == 1) {
#pragma unroll
                for (int m = 0; m < 4; ++m)
#pragma unroll
                    for (int bj = 0; bj < 2; ++bj) xr[m][bj] = *(const u32x4*)(XB + (size_t)EPI_ROW(u, 1, wr, m, fr) * D_MODEL + col0 + bj * 128);
            }
#pragma unroll
            for (int m = 0; m < 4; ++m) {
                const float rstd = fast_rsq(rs[ai * 4 + m] * (1.0f / D_MODEL) + EPS);
                float sq = 0.f;
#pragma unroll
                for (int bj = 0; bj < 2; ++bj) {
                    float t[8], xv[8]; unpack8s(acc[ai][bj][m][0], acc[ai][bj][m][1], rstd, t); unpack_bf8(xr[m][bj], xv);
#pragma unroll
                    for (int j = 0; j < 8; ++j) { xv[j] += t[j] * wv[bj][j]; sq += xv[j] * xv[j]; }
                    *(u32x4*)(XB + (size_t)EPI_ROW(u, ai, wr, m, fr) * D_MODEL + col0 + bj * 128) = pack8(xv);
                }
                so[ai * 4 + m] = sq;
            }
        }
        if (ss_out) {
#pragma unroll
            for (int q = 0; q < 8; ++q) so[q] += shx(so[q], 16, ln_);
#pragma unroll
            for (int q = 0; q < 8; ++q) so[q] += shx(so[q], 32, ln_);
            if (fq == 0) {
#pragma unroll
                for (int q = 0; q < 8; ++q) atomicAdd(ss_out + EPI_ROW(u, q >> 2, wr, q & 3, fr), ss_enc(so[q]));
            }
        }
    }
};
struct EpiStat {
    static constexpr bool PERM = true, AFTER_DRAIN = false, PREF = false;
    bf16_t* O; stat_t* ss;
    __device__ __forceinline__ void operator()(const f32x4 (&acc)[2][2][4][2], const Unit& u, int wr, int wc, int fr, int fq) const {
        const int ln_ = fresh_lane(); fr = ln_ & 15; fq = ln_ >> 4;
        float s[8];
#pragma unroll
        for (int q = 0; q < 8; ++q) {
            const int ai = q >> 2, m = q & 3, row = EPI_ROW(u, ai, wr, m, fr);
            float sq = 0.f;
#pragma unroll
            for (int bj = 0; bj < 2; ++bj) {
                float v[8]; unpack8s(acc[ai][bj][m][0], acc[ai][bj][m][1], 1.0f, v);
#pragma unroll
                for (int j = 0; j < 8; ++j) sq += v[j] * v[j];
                *(u32x4*)(O + (size_t)row * D_MODEL + u.pn * 256 + bj * 128 + wc * 32 + 8 * fq) = pack8(v);
            }
            s[q] = sq;
        }
#pragma unroll
        for (int q = 0; q < 8; ++q) s[q] += shx(s[q], 16, ln_);
#pragma unroll
        for (int q = 0; q < 8; ++q) s[q] += shx(s[q], 32, ln_);
        if (fq == 0) {
#pragma unroll
            for (int q = 0; q < 8; ++q) atomicAdd(ss + EPI_ROW(u, q >> 2, wr, q & 3, fr), ss_enc(s[q]));
        }
    }
};
struct EpiPle {
    static constexpr bool PERM = true, AFTER_DRAIN = false, PREF = false;
    const bf16_t* XBc; const bf16_t* PP; const stat_t* ss_pp; const float* wple; bf16_t* XBn; stat_t* ss_next; float* xout;
    __device__ __forceinline__ void operator()(const f32x4 (&acc)[2][2][4][2], const Unit& u, int wr, int wc, int fr, int fq) const {
        typedef float f32x2 __attribute__((ext_vector_type(2)));
        const int ln_ = fresh_lane(); fr = ln_ & 15; fq = ln_ >> 4;
        const int col0 = u.pn * 256 + wc * 32 + 8 * fq;
        float rs[8];
        u32x4 wpk[2];
        { float w0[8], w1[8]; ld8f(wple + col0, w0); ld8f(wple + col0 + 128, w1); wpk[0] = pack8(w0); wpk[1] = pack8(w1); }
#pragma unroll
        for (int q = 0; q < 4; ++q) rs[q] = ss_dec(ss_pp[EPI_ROW(u, 0, wr, q, fr)]);
        u32x4 xr[3][2], pr[3][2];
#define PLE_LOAD(b_, set_) do { _Pragma("unroll") for (int mm = 0; mm < 2; ++mm) { const unsigned off_ = ((unsigned)EPI_ROW(u, (b_) >> 2, wr, 2 * (((b_) >> 1) & 1) + mm, fr) * D_MODEL + col0 + ((b_) & 1) * 128) * 2u; \
            xr[set_][mm] = *(const u32x4*)((const char*)XBc + off_); pr[set_][mm] = *(const u32x4*)((const char*)PP + off_); } } while (0)
        PLE_LOAD(0, 0); PLE_LOAD(1, 1);
        stat_t rawB[4];
#pragma unroll
        for (int q = 0; q < 4; ++q) rawB[q] = ss_pp[EPI_ROW(u, 1, wr, q, fr)];
        float rpp2[2] = {0.f, 0.f}, sacc[2] = {0.f, 0.f};
#pragma unroll
        for (int b = 0; b < 8; ++b) {
            const int ai = b >> 2, mp = (b >> 1) & 1, bj = b & 1, set = b % 3;
            if (b + 2 < 8) PLE_LOAD(b + 2, (b + 2) % 3);
            if (b == 2) {
#pragma unroll
                for (int q = 0; q < 4; ++q) rs[4 + q] = ss_dec(rawB[q]);
            }
            const unsigned wq[4] = {wpk[bj].x, wpk[bj].y, wpk[bj].z, wpk[bj].w};
#pragma unroll
            for (int mm = 0; mm < 2; ++mm) {
                const int m = 2 * mp + mm, q = ai * 4 + m;
                if (bj == 0) { rpp2[mm] = fast_rsq(rs[q] * (1.0f / D_MODEL) + EPS); sacc[mm] = 0.f; }
                const float rpp = rpp2[mm];
                const unsigned off = (unsigned)EPI_ROW(u, ai, wr, m, fr) * D_MODEL + col0 + bj * 128;
                const unsigned xw[4] = {xr[set][mm].x, xr[set][mm].y, xr[set][mm].z, xr[set][mm].w}, pw[4] = {pr[set][mm].x, pr[set][mm].y, pr[set][mm].z, pr[set][mm].w};
                f32x2 sq2 = {0.f, 0.f}; f32x2 xo[4];
#pragma unroll
                for (int k = 0; k < 4; ++k) {
                    const f32x2 g = {acc[ai][bj][m][k >> 1][2 * (k & 1)], acc[ai][bj][m][k >> 1][2 * (k & 1) + 1]};
                    f32x2 xv = {__uint_as_float(xw[k] << 16), __uint_as_float(xw[k] & 0xffff0000u)}; const f32x2 pv = {__uint_as_float(pw[k] << 16), __uint_as_float(pw[k] & 0xffff0000u)};
                    const f32x2 wk = {__uint_as_float(wq[k] << 16), __uint_as_float(wq[k] & 0xffff0000u)};
                    f32x2 e = g * (-LOG2E_); e.x = __builtin_amdgcn_exp2f(e.x); e.y = __builtin_amdgcn_exp2f(e.y);
                    f32x2 d = e + 1.0f; d.x = __builtin_amdgcn_rcpf(d.x); d.y = __builtin_amdgcn_rcpf(d.y);
                    xv = xv + d * ((pv * wk) * rpp); sq2 = sq2 + xv * xv; xo[k] = xv;
                }
                if (XBn) { u32x4 o; o.x = cvt_pk_bf16(xo[0].x, xo[0].y); o.y = cvt_pk_bf16(xo[1].x, xo[1].y); o.z = cvt_pk_bf16(xo[2].x, xo[2].y); o.w = cvt_pk_bf16(xo[3].x, xo[3].y); *(u32x4*)((char*)XBn + off * 2u) = o; }
                if (xout) { *(f32x4*)((char*)xout + off * 4u) = (f32x4){xo[0].x, xo[0].y, xo[1].x, xo[1].y}; *(f32x4*)((char*)xout + off * 4u + 16) = (f32x4){xo[2].x, xo[2].y, xo[3].x, xo[3].y}; }
                sacc[mm] += sq2.x + sq2.y;
                if (bj == 1) rs[q] = sacc[mm];
            }
        }
#undef PLE_LOAD
        if (ss_next) {
#pragma unroll
            for (int q = 0; q < 8; ++q) rs[q] += shx(rs[q], 16, ln_);
#pragma unroll
            for (int q = 0; q < 8; ++q) rs[q] += shx(rs[q], 32, ln_);
            if (fq == 0) {
#pragma unroll
                for (int q = 0; q < 8; ++q) atomicAdd(ss_next + EPI_ROW(u, q >> 2, wr, q & 3, fr), ss_enc(rs[q]));
            }
        }
    }
};

__device__ __forceinline__ void ew_rows(bf16_t* XB, const bf16_t* T, const float* w, stat_t* ss_out, int gw, int NGW, int lane) {
    const int hl = lane & 31, hr = lane >> 5;
    float wv[4][8];
#pragma unroll
    for (int j = 0; j < 4; ++j) ld8f(w + 8 * hl + 256 * j, wv[j]);
#pragma unroll 2
    for (int r2 = gw; r2 < M / 2; r2 += NGW) {
        const int row = 2 * r2 + hr; const size_t base = (size_t)row * D_MODEL + 8 * hl;
        u32x4 xr[4], tr[4];
#pragma unroll
        for (int j = 0; j < 4; ++j) { xr[j] = *(const u32x4*)(XB + base + 256 * j); tr[j] = *(const u32x4*)(T + base + 256 * j); }
        float tv[4][8]; float st = 0.f;
#pragma unroll
        for (int j = 0; j < 4; ++j) { unpack_bf8(tr[j], tv[j]);
#pragma unroll
            for (int k = 0; k < 8; ++k) st += tv[j][k] * tv[j][k]; }
#pragma unroll
        for (int o = 1; o < 32; o <<= 1) st += shx(st, o, lane);
        const float rT = fast_rsq(st * (1.0f / D_MODEL) + EPS);
        float s = 0.f;
#pragma unroll
        for (int j = 0; j < 4; ++j) {
            float xv[8]; unpack_bf8(xr[j], xv);
#pragma unroll
            for (int k = 0; k < 8; ++k) { xv[k] += tv[j][k] * rT * wv[j][k]; s += xv[k] * xv[k]; }
            *(u32x4*)(XB + base + 256 * j) = pack8(xv);
        }
        if (ss_out) {
#pragma unroll
            for (int o = 1; o < 32; o <<= 1) s += shx(s, o, lane);
            if (hl == 0) ss_out[row] = ss_enc(s);
        }
    }
}
__device__ __forceinline__ void xprep_rows(const float* x, bf16_t* XB, stat_t* ss_out, int r2_begin, int r2_end, int gw, int NGW, int lane) {
    const int hl = lane & 31, hr = lane >> 5;
#pragma unroll 2
    for (int r2 = r2_begin + gw; r2 < r2_end; r2 += NGW) {
        const int row = 2 * r2 + hr; const size_t base = (size_t)row * D_MODEL + 8 * hl;
        float xv[4][8];
#pragma unroll
        for (int j = 0; j < 4; ++j) ld8f_nt(x + base + 256 * j, xv[j]);
        float s = 0.f;
#pragma unroll
        for (int j = 0; j < 4; ++j) {
#pragma unroll
            for (int k = 0; k < 8; ++k) s += xv[j][k] * xv[j][k];
            *(u32x4*)(XB + base + 256 * j) = pack8(xv[j]);
        }
#pragma unroll
        for (int o = 1; o < 32; o <<= 1) s += shx(s, o, lane);
        if (hl == 0) ss_out[row] = ss_enc(s);
    }
}

struct TrDesc { const float* W; const float* gain; bf16_t* WT; int ldw, K, sc, rho0, k0; };
struct TrRegs { f32x4 v[8]; float g[8]; };
__device__ __forceinline__ void tr_load(const TrDesc& d, TrRegs& R, int lane) {
    const int q = lane & 7, r = lane >> 3;
#pragma unroll
    for (int i = 0; i < 8; ++i) {
        const int kk = d.k0 + 8 * i + r;
        R.v[i] = d.sc >= 0 ? __builtin_nontemporal_load((const f32x4*)(d.W + (size_t)kk * d.ldw + d.sc + 4 * q)) : (f32x4){0.f, 0.f, 0.f, 0.f};
        R.g[i] = d.gain ? d.gain[kk] : 1.0f;
    }
}
__device__ __forceinline__ void tr_store(const TrDesc& d, const TrRegs& R, LAS float* scr, int lane) {
    const int q = lane & 7, r = lane >> 3;
#pragma unroll
    for (int i = 0; i < 8; ++i) {
        LAS float* s = scr + (8 * i + r) * 33 + 4 * q;
        s[0] = R.v[i].x * R.g[i]; s[1] = R.v[i].y * R.g[i]; s[2] = R.v[i].z * R.g[i]; s[3] = R.v[i].w * R.g[i];
    }
    asm volatile("s_waitcnt lgkmcnt(0)" ::: "memory");
    const int c = lane & 7;
#pragma unroll
    for (int j = 0; j < 4; ++j) {
        const int n = (lane >> 3) + 8 * j; const LAS float* s = scr + (8 * c) * 33 + n;
        u32x4 o; o.x = cvt_pk_bf16(s[0 * 33], s[1 * 33]); o.y = cvt_pk_bf16(s[2 * 33], s[3 * 33]); o.z = cvt_pk_bf16(s[4 * 33], s[5 * 33]); o.w = cvt_pk_bf16(s[6 * 33], s[7 * 33]);
        *(u32x4*)(d.WT + (size_t)(d.rho0 + n) * d.K + d.k0 + 8 * c) = o;
    }
    asm volatile("s_waitcnt lgkmcnt(0)" ::: "memory");
}

struct Args { const float* in[19]; float* out; unsigned char* ws; int ph_lo, ph_hi, li, pad; };

typedef const __attribute__((address_space(4))) Args* KArgs;
__device__ __forceinline__ KArgs kargs() { KArgs p = (KArgs)__builtin_amdgcn_kernarg_segment_ptr(); asm volatile("" : "+s"(p)); return p; }


__device__ __forceinline__ void prologue(KArgs ap, LAS unsigned char* lds, int gw, int NGW, int wave, int lane) {
    unsigned char* ws = ap->ws;
    LAS float* scr = (LAS float*)(lds + wave * 16384);
    {
        constexpr int I0 = 16 * 88, I1 = 16 * 32, I2 = 16 * 176, I3 = 44 * 32, I4 = 16 * 32, I5 = 4 * 32, IT = I0 + I1 + I2 + I3 + I4 + I5;
        auto desc = [&](int it) -> TrDesc {
            const int L = it >= IT ? 1 : 0; int r = it - L * IT;
            unsigned char* wl = ws + WS_W + (size_t)L * W_LAYER;
            if (r < I0) { const int nb = r % 88, kb = r / 88, pn = nb >> 3, bj = (nb >> 2) & 1, wc = nb & 3, hs = 4 * pn + wc;
                return TrDesc{ap->in[3] + (size_t)L * D_MODEL * IN_W, ap->in[2] + L * D_MODEL, (bf16_t*)(wl + W_IN), IN_W, 1024, hs < NHEADS ? hs * 64 + 32 * bj : -1, nb * 32, kb * 64}; } r -= I0;
            if (r < I1) { const int nb = r % 32, kb = r / 32;
                return TrDesc{ap->in[10] + (size_t)L * D_MODEL * D_MODEL, nullptr, (bf16_t*)(wl + W_OUT), D_MODEL, 1024, nb * 32, nb * 32, kb * 64}; } r -= I1;
            if (r < I2) { const int nb = r % 176, kb = r / 176, pn = nb >> 3, bj = (nb >> 2) & 1, q = nb & 3;
                return TrDesc{ap->in[13] + (size_t)L * D_MODEL * 2 * D_FF, ap->in[12] + L * D_MODEL, (bf16_t*)(wl + W_FFI), 2 * D_FF, 1024, bj * D_FF + 128 * pn + 32 * q, nb * 32, kb * 64}; } r -= I2;
            if (r < I3) { const int nb = r % 32, kb = r / 32;
                return TrDesc{ap->in[14] + (size_t)L * D_FF * D_MODEL, nullptr, (bf16_t*)(wl + W_FFO), D_MODEL, D_FF, nb * 32, nb * 32, kb * 64}; } r -= I3;
            if (r < I4) { const int nb = r % 32, kb = r / 32;
                return TrDesc{ap->in[16] + (size_t)L * D_MODEL * D_MODEL, nullptr, (bf16_t*)(wl + W_G), D_MODEL, 1024, nb * 32, nb * 32, kb * 64}; } r -= I4;
            { const int nb = r % 32, kb = r / 32;
                return TrDesc{ap->in[17] + (size_t)L * PLE_DIM * D_MODEL, nullptr, (bf16_t*)(wl + W_P), D_MODEL, PLE_DIM, nb * 32, nb * 32, kb * 64}; }
        };
        int it = gw;
        if (it < DEPTH * IT) {
            TrDesc d = desc(it); TrRegs R; tr_load(d, R, lane);
            for (;;) {
                const int nx = it + NGW; const bool hn = nx < DEPTH * IT;
                TrDesc dn = d; TrRegs Rn = R;
                if (hn) { dn = desc(nx); tr_load(dn, Rn, lane); }
                tr_store(d, R, scr, lane);
                if (!hn) break;
                d = dn; R = Rn; it = nx;
            }
        }
    }
    {
        float* tab = (float*)(ws + WS_TAB);
        for (int i = gw * 64 + lane; i < 2048 * 32; i += NGW * 64) {
            { const int pos = i >> 5, j = i & 31; const double rev = (double)pos * c_inv_ret[j] * 0.15915494309189535; const float fr = (float)(rev - floor(rev));
              tab[TAB_RC + i] = __builtin_amdgcn_cosf(fr); tab[TAB_RS + i] = __builtin_amdgcn_sinf(fr); }
            if (i < 2048 * 8) { const int pos = i >> 3, j = i & 7; const double rev = (double)pos * c_inv_swa[j] * 0.15915494309189535; const float fr = (float)(rev - floor(rev));
              tab[TAB_SC + i] = __builtin_amdgcn_cosf(fr); tab[TAB_SS + i] = __builtin_amdgcn_sinf(fr); }
        }
    }
    {
        const float* wsrc = ap->in[6]; bf16_t* Wm = (bf16_t*)(ws + WS_WM);
        for (int i = gw * 64 + lane; i < DEPTH * 4 * CHUNK * CHUNK; i += NGW * 64) { const int s_ = i & 127, t_ = (i >> 7) & 127; Wm[i] = f2bf(s_ <= t_ ? wsrc[i] : 0.f); }
    }
}
__device__ __forceinline__ void pprep_rows(KArgs ap, int row0, int nrows, int gw, int NGW, int lane, int Lbeg = 0, int Lend = DEPTH) {
    const float* p = ap->in[1]; bf16_t* PB = (bf16_t*)(ap->ws + WS_PB);
    const size_t n8 = (size_t)nrows * PLE_DIM / 8;
    for (int L = Lbeg; L < Lend; ++L) {
        const size_t o8 = ((size_t)L * M + row0) * PLE_DIM / 8;
#pragma unroll 2
        for (size_t i = (size_t)gw * 64 + lane; i < n8; i += (size_t)NGW * 64) {
            float v[8]; ld8f_nt(p + (o8 + i) * 8, v); *(u32x4*)(PB + (o8 + i) * 8) = pack8(v);
        }
    }
}

typedef float f32x16 __attribute__((ext_vector_type(16)));
typedef short s16x4 __attribute__((ext_vector_type(4)));
using pg8::bf16x8;
constexpr int TS = 144;
constexpr float LOG2E = 1.4426950408889634f;
__device__ __forceinline__ int crow(int r, int hi) { return (r & 3) + 8 * (r >> 2) + 4 * hi; }
__device__ __forceinline__ s16x4 tr16(LAS const unsigned char* p) { return __builtin_bit_cast(s16x4, __builtin_amdgcn_ds_read_tr16_b64_v4i16((LAS s16x4*)p)); }
__device__ __forceinline__ bf16x8 rd_row(LAS const unsigned char* tile, int row0, int k0, int lane) {
    return *(LAS const bf16x8*)(tile + (row0 + (lane & 31)) * TS + (k0 + 8 * (lane >> 5)) * 2);
}
template <bool PERMK> __device__ __forceinline__ bf16x8 rd_tr(LAS const unsigned char* tile, int k0, int n0, int lane) {
    const int h = lane >> 5, g1 = (lane >> 4) & 1, q = (lane & 15) >> 2, p = lane & 3;
    const int rA = k0 + (PERMK ? 4 * h : 8 * h) + q, rB = rA + (PERMK ? 8 : 4);
    const int cb = (n0 + 16 * g1 + 4 * p) * 2;
    const s16x4 lo = tr16(tile + rA * TS + cb), hi = tr16(tile + rB * TS + cb);
    return (bf16x8){lo[0], lo[1], lo[2], lo[3], hi[0], hi[1], hi[2], hi[3]};
}
__device__ __forceinline__ bf16x8 pack_frag(const f32x16& v, int s) {
    u32x4 w; w.x = cvt_pk_bf16(v[8 * s + 0], v[8 * s + 1]); w.y = cvt_pk_bf16(v[8 * s + 2], v[8 * s + 3]); w.z = cvt_pk_bf16(v[8 * s + 4], v[8 * s + 5]); w.w = cvt_pk_bf16(v[8 * s + 6], v[8 * s + 7]);
    return __builtin_bit_cast(bf16x8, w);
}
#define MFMA32(a, b, c) __builtin_amdgcn_mfma_f32_32x32x16_bf16((a), (b), (c), 0, 0, 0)
template <bool SCALE> __device__ __forceinline__ void load_tile(LAS unsigned char* tile, const bf16_t* g, int rows, int zero_below, float sl, int tid) {
    for (int i = tid; i < rows * 8; i += NTHREADS) {
        const int r = i >> 3, c = i & 7;
        u32x4 v = (u32x4){0u, 0u, 0u, 0u};
        if (r >= zero_below) v = *(const u32x4*)(g + (ptrdiff_t)r * IN_W + c * 8);
        if (SCALE) { float f[8]; unpack_bf8(v, f); const float s = exp2f((float)r * sl);
#pragma unroll
            for (int j = 0; j < 8; ++j) f[j] *= s;
            v = pack8(f); }
        *(LAS u32x4*)(tile + r * TS + c * 16) = v;
    }
}

constexpr int GM_BUF = 2 * CHUNK * TS;
struct GmRegs { u32x4 r[4]; };
__device__ __forceinline__ void gm_load(GmRegs& R, const bf16_t* P, int item, int tid) {
    const int h = item & 3, bc = item >> 2; const size_t row0 = (size_t)bc * CHUNK;
    const int r = tid >> 3, c = tid & 7;
#pragma unroll
    for (int i = 0; i < 2; ++i) {
        R.r[i] = *(const u32x4*)(P + (row0 + r + 64 * i) * IN_W + (H_AU + h) * 64 + c * 8);
        R.r[2 + i] = *(const u32x4*)(P + (row0 + r + 64 * i) * IN_W + (H_AV + h) * 64 + c * 8);
    }
}
__device__ __forceinline__ void gm_write(const GmRegs& R, LAS unsigned char* buf, int tid) {
    const int r = tid >> 3, c = tid & 7;
#pragma unroll
    for (int i = 0; i < 2; ++i) { *(LAS u32x4*)(buf + (r + 64 * i) * TS + c * 16) = R.r[i]; *(LAS u32x4*)(buf + CHUNK * TS + (r + 64 * i) * TS + c * 16) = R.r[2 + i]; }
}
__device__ __forceinline__ void gm_compute(LAS unsigned char* buf, const bf16_t* Wm, const float* bs, bf16_t* Y, int item, int tid, int wave, int lane, volatile LAS unsigned* slotp, unsigned fut) {
    const int h = item & 3, bc = item >> 2; const size_t row0 = (size_t)bc * CHUNK;
    LAS unsigned char* AUs = buf; LAS unsigned char* AVs = buf + CHUNK * TS;
    const int tb = wave >> 1, db = wave & 1, hh = lane >> 5;
    f32x16 acc = {};
    const bf16_t* wrow = Wm + (size_t)(h * CHUNK + 32 * tb + (lane & 31)) * CHUNK + 8 * hh;
    for (int ks = 0; ks < 2 * (tb + 1); ++ks) {
        const bf16x8 a = *(const bf16x8*)(wrow + 16 * ks);
        const bf16x8 b = rd_tr<false>(AVs, 16 * ks, 32 * db, lane);
        acc = MFMA32(a, b, acc);
    }
    const int d = 32 * db + (lane & 31);
#pragma unroll
    for (int r = 0; r < 16; ++r) {
        const int t = 32 * tb + crow(r, hh);
        LAS bf16_t* pu = (LAS bf16_t*)(AUs + t * TS) + d;
        *pu = f2bf(bf2f(*pu) * (acc[r] + bs[h * CHUNK + t]));
    }
    if (tid == 0) *slotp = fut;
    __syncthreads();
    for (int i = tid; i < CHUNK * 8; i += NTHREADS) { const int r = i >> 3, c = i & 7; *(u32x4*)(Y + (row0 + r) * D_MODEL + h * 64 + c * 8) = *(LAS const u32x4*)(AUs + r * TS + c * 16); }
}

constexpr int SWA_K = 0, SWA_V = 384 * TS, SWA_WSF = 2 * 384 * TS, SWA_OST = SWA_WSF + NWAVES * 128, SWA_END = SWA_OST + NWAVES * 4096;
struct SwaRegs { u32x4 k[6], v[6]; };
__device__ __forceinline__ void swa_load(SwaRegs& R, const bf16_t* P, int item, int tid) {
    const int hk = item & 1, cp = (item >> 1) & 7, b = item >> 4;
    const ptrdiff_t rowk0 = (ptrdiff_t)b * SEQ + 256 * cp - 128;
    const int r0 = tid >> 3, c = tid & 7;
#pragma unroll
    for (int i = 0; i < 6; ++i) {
        const int r = r0 + 64 * i;
        if (cp == 0 && r < 128) { R.k[i] = (u32x4){0u, 0u, 0u, 0u}; R.v[i] = (u32x4){0u, 0u, 0u, 0u}; }
        else { R.k[i] = *(const u32x4*)(P + (rowk0 + r) * IN_W + (H_CK + hk) * 64 + c * 8); R.v[i] = *(const u32x4*)(P + (rowk0 + r) * IN_W + (H_CV + hk) * 64 + c * 8); }
    }
}
__device__ __forceinline__ void swa_write(const SwaRegs& R, LAS unsigned char* lds, int tid) {
    const int r0 = tid >> 3, c = tid & 7;
#pragma unroll
    for (int i = 0; i < 6; ++i) { *(LAS u32x4*)(lds + SWA_K + (r0 + 64 * i) * TS + c * 16) = R.k[i]; *(LAS u32x4*)(lds + SWA_V + (r0 + 64 * i) * TS + c * 16) = R.v[i]; }
}
__device__ __forceinline__ void swa_compute(LAS unsigned char* lds, const bf16_t* P, const float* sinks, bf16_t* Y, int item, int wave, int lane) {
    const int hk = item & 1, cp = (item >> 1) & 7, b = item >> 4;
    const size_t rowq0 = (size_t)b * SEQ + 256 * cp;
    LAS unsigned char* Ks = lds + SWA_K; LAS unsigned char* Vs = lds + SWA_V;
    const int qi = lane & 31, hh = lane >> 5;
    LAS float* wsf = (LAS float*)(lds + SWA_WSF + wave * 128);
    LAS unsigned char* ost = lds + SWA_OST + wave * 4096;
    constexpr float SC = 0.125f * LOG2E;
    for (int g = 0; g < 3; ++g) {
        const int qh = 3 * hk + g;
        const bf16_t* qrow = P + (rowq0 + 32 * wave + qi) * IN_W + (H_CQ + qh) * 64 + 8 * hh;
        bf16x8 bq[4];
#pragma unroll
        for (int kd = 0; kd < 4; ++kd) bq[kd] = *(const bf16x8*)(qrow + 16 * kd);
        f32x16 S[5];
#pragma unroll
        for (int kb = 0; kb < 5; ++kb) {
            S[kb] = (f32x16){};
#pragma unroll
            for (int kd = 0; kd < 4; ++kd) S[kb] = MFMA32(rd_row(Ks, 32 * (wave + kb), 16 * kd, lane), bq[kd], S[kb]);
        }
        const float sk = sinks[qh] * LOG2E;
        float m = sk;
#pragma unroll
        for (int kb = 0; kb < 5; ++kb) {
            const bool blk_ok = cp > 0 || wave + kb >= 4;
#pragma unroll
            for (int r = 0; r < 16; ++r) {
                const int cr = crow(r, hh);
                bool ok = blk_ok;
                if (kb == 0) ok = ok && cr > qi;
                if (kb == 4) ok = ok && cr <= qi;
                const float s = ok ? S[kb][r] * SC : -1e30f;
                S[kb][r] = s; m = fmaxf(m, s);
            }
        }
        m = fmaxf(m, shx(m, 32, lane));
        float l = 0.f;
#pragma unroll
        for (int kb = 0; kb < 5; ++kb)
#pragma unroll
            for (int r = 0; r < 16; ++r) { const float p = __builtin_amdgcn_exp2f(S[kb][r] - m); S[kb][r] = p; l += p; }
        l += shx(l, 32, lane);
        l += __builtin_amdgcn_exp2f(sk - m);
        f32x16 O[2]; O[0] = (f32x16){}; O[1] = (f32x16){};
#pragma unroll
        for (int kb = 0; kb < 5; ++kb)
#pragma unroll
            for (int s2 = 0; s2 < 2; ++s2) {
                const bf16x8 a = pack_frag(S[kb], s2);
#pragma unroll
                for (int db = 0; db < 2; ++db) O[db] = MFMA32(a, rd_tr<true>(Vs, 32 * (wave + kb) + 16 * s2, 32 * db, lane), O[db]);
            }
        if (hh == 0) wsf[qi] = __builtin_amdgcn_rcpf(l);
        asm volatile("s_waitcnt lgkmcnt(0)" ::: "memory");
#pragma unroll
        for (int r = 0; r < 16; ++r) {
            const int q = crow(r, hh); const float rl = wsf[q];
#pragma unroll
            for (int db = 0; db < 2; ++db) *((LAS bf16_t*)(ost + q * 128) + 32 * db + qi) = f2bf(O[db][r] * rl);
        }
        asm volatile("s_waitcnt lgkmcnt(0)" ::: "memory");
#pragma unroll
        for (int i = 0; i < 4; ++i) { const int row = i * 8 + (lane >> 3), ch = lane & 7;
            *(u32x4*)(Y + (rowq0 + 32 * wave + row) * D_MODEL + 640 + qh * 64 + ch * 8) = *(LAS const u32x4*)(ost + row * 128 + ch * 16); }
        asm volatile("s_waitcnt lgkmcnt(0)" ::: "memory");
    }
}

constexpr int RT_Q = 0, RT_K = CHUNK * TS, RT_V = 2 * CHUNK * TS, RT_S = 3 * CHUNK * TS, RT_O = RT_S + 64 * TS, RT_X = RT_O + CHUNK * 68 * 4, RT_END = RT_X + 16384;
struct RetRegs { u32x4 q[2], k[2], v[2], g[2]; };
__device__ __forceinline__ void ret_load(RetRegs& R, const bf16_t* P, size_t row0, int h, int tid) {
    const int r0 = tid >> 3, c = tid & 7;
#pragma unroll
    for (int i = 0; i < 2; ++i) {
        const bf16_t* pr = P + (row0 + r0 + 64 * i) * IN_W + c * 8;
        R.q[i] = *(const u32x4*)(pr + (H_BQ + h) * 64); R.k[i] = *(const u32x4*)(pr + (H_BK + h) * 64); R.v[i] = *(const u32x4*)(pr + (H_BV + h) * 64);
    }
    const int row = tid >> 2, part = tid & 3;
    const bf16_t* gp = P + (row0 + row) * IN_W + (H_BG + h) * 64 + 16 * part;
    R.g[0] = *(const u32x4*)gp; R.g[1] = *(const u32x4*)(gp + 8);
}
typedef float f32x2m __attribute__((ext_vector_type(2)));
__device__ __forceinline__ u32x4 scale_bf8(const u32x4& r, float sc) {
    const unsigned w[4] = {r.x, r.y, r.z, r.w}; unsigned o[4];
#pragma unroll
    for (int k = 0; k < 4; ++k) { f32x2m v = {__uint_as_float(w[k] << 16), __uint_as_float(w[k] & 0xffff0000u)}; v = v * sc; o[k] = cvt_pk_bf16(v.x, v.y); }
    return (u32x4){o[0], o[1], o[2], o[3]};
}
__device__ __forceinline__ void ret_write(const RetRegs& R, LAS unsigned char* lds, int tid) {
    const int r0 = tid >> 3, c = tid & 7;
#pragma unroll
    for (int i = 0; i < 2; ++i) {
        const int r = r0 + 64 * i;
        *(LAS u32x4*)(lds + RT_Q + r * TS + c * 16) = R.q[i];
        *(LAS u32x4*)(lds + RT_K + r * TS + c * 16) = R.k[i];
        *(LAS u32x4*)(lds + RT_V + r * TS + c * 16) = R.v[i];
    }
}
__device__ __forceinline__ void ret_item(LAS unsigned char* lds, const bf16_t* P, const float* gn_w, bf16_t* Y, int item, int tid, int wave, int lane, volatile LAS unsigned* slotp, unsigned fut) {
    const int h = item % 6, b = item / 6;
    const float lg = c_log2g[h];
    const float g1 = exp2f(lg), g127 = exp2f(127.f * lg), g128 = exp2f(128.f * lg);
    LAS unsigned char* Qs = lds + RT_Q; LAS unsigned char* Ks = lds + RT_K; LAS unsigned char* Vs = lds + RT_V; LAS unsigned char* Sb = lds + RT_S;
    LAS float* Os = (LAS float*)(lds + RT_O); LAS float* Xs = (LAS float*)(lds + RT_X);
    const int tb = wave >> 1, eb = wave & 1, qi = lane & 31, hh = lane >> 5;
    const int db = (wave >> 1) & 1, kh = wave >> 2;
    const int erow = tid >> 2, part = tid & 3;
    float gw0[8], gw1[8]; ld8f(gn_w + h * 64 + 16 * part, gw0); ld8f(gn_w + h * 64 + 16 * part + 8, gw1);
    f32x16 st = {};
    RetRegs R; ret_load(R, P, (size_t)b * SEQ, h, tid);
    for (int c = 0; c < 16; ++c) {
        const size_t row0 = (size_t)b * SEQ + (size_t)c * CHUNK;
        ret_write(R, lds, tid);
        const u32x4 gq0 = R.g[0], gq1 = R.g[1];
        __syncthreads();
        if (c + 1 < 16) ret_load(R, P, row0 + CHUNK, h, tid);
        f32x16 O = {};
        for (int sb = 0; sb <= tb; ++sb) {
            f32x16 S = {};
#pragma unroll
            for (int kd = 0; kd < 4; ++kd) S = MFMA32(rd_row(Ks, 32 * sb, 16 * kd, lane), rd_row(Qs, 32 * tb, 16 * kd, lane), S);
            if (sb == tb) {
#pragma unroll
                for (int r = 0; r < 16; ++r) S[r] = crow(r, hh) <= qi ? S[r] : 0.f;
            }
#pragma unroll
            for (int s2 = 0; s2 < 2; ++s2) O = MFMA32(pack_frag(S, s2), rd_tr<true>(Vs, 32 * sb + 16 * s2, 32 * eb, lane), O);
        }
        if (c > 0) {
#pragma unroll
            for (int kd = 0; kd < 4; ++kd) O = MFMA32(rd_row(Qs, 32 * tb, 16 * kd, lane), rd_row(Sb, 32 * eb, 16 * kd, lane), O);
        }
#pragma unroll
        for (int r = 0; r < 16; ++r) Os[(32 * tb + crow(r, hh)) * 68 + 32 * eb + qi] = O[r];
        if (c + 1 < 16) {
            f32x16 acc = {};
#pragma unroll
            for (int ks = 0; ks < 4; ++ks) acc = MFMA32(rd_tr<false>(Vs, 64 * kh + 16 * ks, 32 * eb, lane), rd_tr<false>(Ks, 64 * kh + 16 * ks, 32 * db, lane), acc);
#pragma unroll
            for (int r = 0; r < 16; ++r) st[r] = st[r] * g128 + g127 * acc[r];
            if (kh == 1) {
#pragma unroll
                for (int r = 0; r < 16; ++r) Xs[((eb * 2 + db) * 16 + r) * 64 + lane] = st[r];
            }
        }
        __syncthreads();
        if (c + 1 < 16 && kh == 0) {
#pragma unroll
            for (int r = 0; r < 16; ++r) { const int e = 32 * eb + crow(r, hh), d = 32 * db + qi; const float sv = (st[r] + Xs[((eb * 2 + db) * 16 + r) * 64 + lane]) * g1; *((LAS bf16_t*)(Sb + e * TS) + d) = (bf16_t)cvt_pk_bf16(sv, sv); }
        }
        {
            float v[16]; float s = 0.f;
#pragma unroll
            for (int j = 0; j < 16; ++j) { v[j] = Os[erow * 68 + 16 * part + j]; s += v[j]; }
            s += shx(s, 1, lane); s += shx(s, 2, lane);
            const float mu = s * (1.0f / 64.0f); float q = 0.f;
#pragma unroll
            for (int j = 0; j < 16; ++j) { v[j] -= mu; q += v[j] * v[j]; }
            q += shx(q, 1, lane); q += shx(q, 2, lane);
            const float rs = fast_rsq(q * (1.0f / 64.0f) + EPS);
            float ga[8], gb[8], o0[8], o1[8];
            unpack_bf8(gq0, ga); unpack_bf8(gq1, gb);
#pragma unroll
            for (int j = 0; j < 8; ++j) { o0[j] = (ga[j] * gw0[j]) * (v[j] * rs); o1[j] = (gb[j] * gw1[j]) * (v[8 + j] * rs); }
            bf16_t* yp = Y + (row0 + erow) * D_MODEL + 256 + h * 64 + 16 * part;
            *(u32x4*)yp = pack8(o0); *(u32x4*)(yp + 8) = pack8(o1);
        }
    }
    if (tid == 0) *slotp = fut;
    __syncthreads();
}

constexpr int CW_TMO = 1024;
constexpr int CW_QUEUE = 2048;
constexpr int MQ_RET = 192, MQ_SWA = MQ_RET + 512, MQ_ALL = MQ_SWA + 2048;
__device__ __forceinline__ void mixers(KArgs ap, int L, LAS unsigned char* lds, int tid, int wave, int lane, int grp, bool rev) {
    unsigned char* ws = ap->ws;
    const bf16_t* P = (const bf16_t*)(ws + WS_BIG); bf16_t* Y = (bf16_t*)(ws + WS_Y);
    const bf16_t* Wm = (const bf16_t*)(ws + WS_WM) + (size_t)L * 4 * CHUNK * CHUNK;
    const float* gbs = ap->in[7] + L * 4 * CHUNK; const float* gn_w = ap->in[8] + L * 384; const float* sinks = ap->in[9] + L * 6;
    const bool gq = grp >= 0;
    const unsigned q_ret = gq ? MQ_RET / 8 : MQ_RET, q_swa = gq ? MQ_SWA / 8 : MQ_SWA, q_all = gq ? MQ_ALL / 8 : MQ_ALL;
    const int o_ret = gq ? grp * (MQ_RET / 8) : 0, o_swa = gq ? grp * ((MQ_SWA - MQ_RET) / 8) : 0, o_gm = gq ? grp * ((MQ_ALL - MQ_SWA) / 8) : 0;
    unsigned* head = (unsigned*)ws + CW_QUEUE + 64 * (gq ? 2 + 8 * L + grp : L);
    volatile LAS unsigned* slot = (volatile LAS unsigned*)(lds + MISC_OFF + 64);
    if (tid == 0) slot[0] = atomicAdd(head, 1u);
    __syncthreads();
    unsigned cur = (unsigned)__builtin_amdgcn_readfirstlane((int)slot[0]);
    __syncthreads();
    if (tid == 0) slot[1] = atomicAdd(head, 1u);
    __syncthreads();
    unsigned nxt = (unsigned)__builtin_amdgcn_readfirstlane((int)slot[1]);
    int k = 0;
#define RV(i_, n_) (rev ? (n_) - 1 - (i_) : (i_))
#define MQ_FETCH() unsigned fut = 0u; if (tid == 0) fut = atomicAdd(head, 1u)
#define MQ_ADVANCE() do { cur = nxt; nxt = (unsigned)__builtin_amdgcn_readfirstlane((int)slot[k]); k ^= 1; } while (0)
    while (cur < q_all) {
        if (cur < q_ret) {
            MQ_FETCH();
            ret_item(lds, P, gn_w, Y, RV((int)cur, (int)q_ret) + o_ret, tid, wave, lane, slot + k, fut);
            MQ_ADVANCE();
        } else if (cur < q_swa) {
            MQ_FETCH();
            { SwaRegs R; swa_load(R, P, RV((int)(cur - q_ret), (int)(q_swa - q_ret)) + o_swa, tid); swa_write(R, lds, tid); }
            __syncthreads();
            swa_compute(lds, P, sinks, Y, RV((int)(cur - q_ret), (int)(q_swa - q_ret)) + o_swa, wave, lane);
            if (tid == 0) slot[k] = fut;
            __syncthreads();
            MQ_ADVANCE();
        } else {
            GmRegs R; gm_load(R, P, RV((int)(cur - q_swa), (int)(q_all - q_swa)) + o_gm, tid);
            int bsel = 0;
            for (;;) {
                MQ_FETCH();
                LAS unsigned char* buf = lds + bsel * GM_BUF;
                gm_write(R, buf, tid);
                __syncthreads();
                const bool more = nxt < q_all;
                if (more) gm_load(R, P, RV((int)(nxt - q_swa), (int)(q_all - q_swa)) + o_gm, tid);
                gm_compute(buf, Wm, gbs, Y, RV((int)(cur - q_swa), (int)(q_all - q_swa)) + o_gm, tid, wave, lane, slot + k, fut);
                MQ_ADVANCE(); bsel ^= 1;
                if (!more) break;
            }
            __syncthreads();
        }
    }
#undef MQ_FETCH
#undef RV
#undef MQ_ADVANCE
    __syncthreads();
}

#ifndef PG8_SP2
#define PG8_SP2 true
#endif
#ifndef PG8_ALIGN
#define PG8_ALIGN true
#endif
constexpr int N_PHASES = 1 + 8 * DEPTH;
#ifndef PHMASK
#define PHMASK 0x1ff
#endif
#ifndef DUP_MASK
#define DUP_MASK 0
#endif
#define NREP(bit) ((DUP_MASK & (bit)) ? 2 : 1)
#ifndef KREP3
#define KREP3 1
#endif
__global__ void __launch_bounds__(NTHREADS, 2) mega(Args a_) {
    extern __shared__ __attribute__((aligned(16))) unsigned char lds_raw[];
    LAS unsigned char* lds = (LAS unsigned char*)lds_raw;
    const int G = gridDim.x, bid = blockIdx.x;
    const int vcu = (G % 8 == 0) ? (bid % 8) * (G / 8) + bid / 8 : bid;
    const int NGW = G * NWAVES;
    const int wave0 = __builtin_amdgcn_readfirstlane((int)threadIdx.x >> 6);
#define opq_tid() pg8::pg8_tid(wave0)
    { const int tid = opq_tid(); for (int u = tid; u < (LDS_BYTES - RING_BYTES) / 4; u += NTHREADS) ((LAS unsigned*)(lds + RING_BYTES))[u] = 0u; }
    __syncthreads();
    XcdBarrier bar = xcd_barrier_post((unsigned*)kargs()->ws + CW_BAR + kargs()->li * XCD_BAR_WORDS, (volatile LAS unsigned*)(lds + MISC_OFF));
    const int lo = kargs()->ph_lo, hi = kargs()->ph_hi;
#define IN(k) (lo <= (k) && (k) < hi)
#define SEAM(k) do { if (IN(k) && IN((k) + 1)) xcd_barrier(bar, opq_tid(), (k) > 0, (k) == 8 * (DEPTH - 1) + 6); } while (0)
#define VBID() ({ volatile LAS unsigned* st_ = (volatile LAS unsigned*)(lds + MISC_OFF); (int)__builtin_amdgcn_readfirstlane(st_[3] ? (int)(st_[2] * 8u + bar.x) : bid); })
#define VGRP() ({ volatile LAS unsigned* st_ = (volatile LAS unsigned*)(lds + MISC_OFF); (int)__builtin_amdgcn_readfirstlane(st_[3] ? (int)bar.x : -1); })
#define LANE_VARS const int tid_ = opq_tid(), lane = tid_ & 63, wave = __builtin_amdgcn_readfirstlane(tid_ >> 6), gw = vcu * NWAVES + wave
    if (IN(0) && (PHMASK & 1)) for (int rep = 0; rep < NREP(1); ++rep) { LANE_VARS; prologue(kargs(), lds, gw, NGW, wave, lane); }
    SEAM(0);
#define OPQ(p) ({ auto _p = (p); asm volatile("" : "+s"(_p)); _p; })
#define FLIP(L_, ph) ((int)(((((DEPTH - 1 - (L_)) & 1) ? 43u : 20u) >> (ph)) & 1u))
#define GEMM5_PHASE(L_) do { KArgs ap = kargs(); unsigned char* wsp = ap->ws; const int Lp = OPQ(L_); \
        pg8::Gemm g{(const bf16_t*)(wsp + WS_PB) + (size_t)Lp * M * PLE_DIM, (const bf16_t*)(wsp + WS_W + (size_t)Lp * W_LAYER + W_P), M, 1024, PLE_DIM}; pg8::StaticOrder S; S.init(M, 1024, G, VBID()); S.flip = FLIP(Lp, 4); \
        EpiStat E{(bf16_t*)(wsp + WS_MIX), stat_ptr(wsp, Lp, ST_PP)}; \
        pg8::gemm_phase<EpiStat, pg8::StaticOrder, PG8_ALIGN, PG8_SP2>(lds, g, S, E, wave0); } while (0)
    if (IN(0) && (PHMASK & 1)) {
        const int grp = VGRP();
        if (grp < 0) {
            { LANE_VARS; pprep_rows(kargs(), 0, M, gw, NGW, lane); xprep_rows(kargs()->in[0], (bf16_t*)(kargs()->ws + WS_XB0), stat_ptr(kargs()->ws, 0, ST_X1), 0, M / 2, gw, NGW, lane); }
            xcd_barrier(bar, opq_tid(), false);
        } else {
            const int row0 = grp * (M / 8);
            if (grp >= 4) {
                { volatile LAS unsigned* st_ = (volatile LAS unsigned*)(lds + MISC_OFF); const int tid_ = opq_tid(), lane = tid_ & 63, lw = (int)st_[2] * NWAVES + (tid_ >> 6);
                  pprep_rows(kargs(), row0, M / 8, lw, 32 * NWAVES, lane, 0, 1); }
                xcd_barrier(bar, opq_tid(), true, false);
                GEMM5_PHASE(0);
            }
            { volatile LAS unsigned* st_ = (volatile LAS unsigned*)(lds + MISC_OFF); const int tid_ = opq_tid(), lane = tid_ & 63, lw = (int)st_[2] * NWAVES + (tid_ >> 6);
              xprep_rows(kargs()->in[0], (bf16_t*)(kargs()->ws + WS_XB0), stat_ptr(kargs()->ws, 0, ST_X1), row0 / 2, (row0 + M / 8) / 2, lw, 32 * NWAVES, lane); }
            xcd_barrier(bar, opq_tid(), true, false);
        }
    }
    for (int L = 0; L < DEPTH; ++L) {
        const int p0 = 1 + 8 * L;
        if (IN(p0 + 0) && (PHMASK & 2)) for (int rep = 0; rep < NREP(2); ++rep) {
            KArgs ap = kargs(); unsigned char* wsp = ap->ws; const int Lp = OPQ(L);
            pg8::Gemm g{(const bf16_t*)(wsp + ((Lp & 1) ? WS_XB1 : WS_XB0)), (const bf16_t*)(wsp + WS_W + (size_t)Lp * W_LAYER + W_IN), M, 2816, 1024}; pg8::StaticOrder S; S.init(M, 2816, G, VBID()); S.flip = FLIP(Lp, 0);
            EpiProj E{(bf16_t*)(wsp + WS_BIG), stat_ptr(wsp, Lp, ST_X1), ap->in[4] + Lp * 256, ap->in[5] + Lp * 256, (const float*)(wsp + WS_TAB)};
            pg8::gemm_phase<EpiProj, pg8::StaticOrder, PG8_ALIGN, PG8_SP2>(lds, g, S, E, wave0);
        }
        if (L > 0 && L == DEPTH - 1 && VGRP() >= 0 && VGRP() < 4) GEMM5_PHASE(L);
        SEAM(p0 + 0);
        if (IN(p0 + 1) && (PHMASK & 4)) {
            LANE_VARS; (void)gw; mixers(kargs(), OPQ(L), lds, tid_, wave, lane, VGRP(), FLIP(L, 1) != 0);
        }
        SEAM(p0 + 1);
        if (IN(p0 + 2) && (PHMASK & 8)) {
            KArgs ap = kargs(); unsigned char* wsp = ap->ws; const int Lp = OPQ(L);
            pg8::Gemm g{(const bf16_t*)(wsp + WS_Y), (const bf16_t*)(wsp + WS_W + (size_t)Lp * W_LAYER + W_OUT), M, 1024, 1024}; pg8::StaticOrder S; S.init(M, 1024, G, VBID()); S.flip = FLIP(Lp, 2);
            EpiNormRes E{(bf16_t*)(wsp + ((Lp & 1) ? WS_XB1 : WS_XB0)), ap->in[11] + Lp * D_MODEL, stat_ptr(wsp, Lp, ST_MIX), stat_ptr(wsp, Lp, ST_X2), (unsigned*)wsp + CW_TMO};
            pg8::gemm_phase<EpiNormRes, pg8::StaticOrder, PG8_ALIGN, PG8_SP2>(lds, g, S, E, wave0);
        }
        SEAM(p0 + 2);
        if (L == 0 && VGRP() >= 0) {
            volatile LAS unsigned* st_ = (volatile LAS unsigned*)(lds + MISC_OFF); const int tid_ = opq_tid(), lane = tid_ & 63, lw = (int)st_[2] * NWAVES + (tid_ >> 6);
            pprep_rows(kargs(), VGRP() * (M / 8), M / 8, lw, 32 * NWAVES, lane, VGRP() < 4 ? 0 : 1, DEPTH);
        }
        if (IN(p0 + 4) && (PHMASK & 32)) for (int rep = 0; rep < NREP(32); ++rep) {
            KArgs ap = kargs(); unsigned char* wsp = ap->ws; const int Lp = OPQ(L);
            pg8::Gemm g{(const bf16_t*)(wsp + ((Lp & 1) ? WS_XB1 : WS_XB0)), (const bf16_t*)(wsp + WS_W + (size_t)Lp * W_LAYER + W_FFI), M, 5632, 1024}; pg8::StaticOrder S; S.init(M, 5632, G, VBID()); S.flip = FLIP(Lp, 3);
            EpiSwiglu E{(bf16_t*)(wsp + WS_BIG), stat_ptr(wsp, Lp, ST_X2), 1.0f / KREP3};
            pg8::gemm_phase<EpiSwiglu, pg8::StaticOrder, PG8_ALIGN, PG8_SP2, KREP3>(lds, g, S, E, wave0);
        }
        SEAM(p0 + 4);
        if (IN(p0 + 5) && (PHMASK & 64)) {
            { KArgs ap = kargs(); unsigned char* wsp = ap->ws; const int Lp = OPQ(L);
              pg8::Gemm g{(const bf16_t*)(wsp + WS_BIG), (const bf16_t*)(wsp + WS_W + (size_t)Lp * W_LAYER + W_FFO), M, 1024, D_FF}; pg8::StaticOrder S; S.init(M, 1024, G, VBID()); S.flip = FLIP(Lp, 4);
              EpiNormRes E{(bf16_t*)(wsp + ((Lp & 1) ? WS_XB1 : WS_XB0)), ap->in[15] + Lp * D_MODEL, stat_ptr(wsp, Lp, ST_F), nullptr, (unsigned*)wsp + CW_TMO};
              pg8::gemm_phase<EpiNormRes, pg8::StaticOrder, PG8_ALIGN, PG8_SP2>(lds, g, S, E, wave0); }
            if (!(L == 0 && VGRP() >= 4) && !(L > 0 && L == DEPTH - 1 && VGRP() >= 0 && VGRP() < 4)) GEMM5_PHASE(L);
        }
        SEAM(p0 + 5);
        if (IN(p0 + 7) && (PHMASK & 256)) {
            KArgs ap = kargs(); unsigned char* wsp = ap->ws; const int Lp = OPQ(L);
            const bf16_t* XBc = (const bf16_t*)(wsp + ((Lp & 1) ? WS_XB1 : WS_XB0));
            pg8::Gemm g{XBc, (const bf16_t*)(wsp + WS_W + (size_t)Lp * W_LAYER + W_G), M, 1024, 1024}; pg8::StaticOrder S; S.init(M, 1024, G, VBID()); S.flip = FLIP(Lp, 5);
            const bool last = (Lp == DEPTH - 1);
            EpiPle E{XBc, (const bf16_t*)(wsp + WS_MIX), stat_ptr(wsp, Lp, ST_PP), ap->in[18] + Lp * D_MODEL, last ? nullptr : (bf16_t*)(wsp + ((Lp & 1) ? WS_XB0 : WS_XB1)), last ? nullptr : stat_ptr(wsp, Lp + 1, ST_X1), last ? ap->out : nullptr};
            if (last && VGRP() >= 0) {
                volatile LAS unsigned* st_ = (volatile LAS unsigned*)(lds + MISC_OFF);
                StealOrder SS; SS.init((int)bar.x, (int)__builtin_amdgcn_readfirstlane((int)st_[2]), (unsigned*)wsp + CW_CLAIM, bar.bar, 6u * (unsigned)DEPTH + 1u, (unsigned*)wsp + CW_TMO);
                pg8::gemm_phase<EpiPle, StealOrder, PG8_ALIGN, PG8_SP2>(lds, g, SS, E, wave0);
            } else
            pg8::gemm_phase<EpiPle, pg8::StaticOrder, PG8_ALIGN, PG8_SP2>(lds, g, S, E, wave0);
        }
        SEAM(p0 + 7);
    }
#undef IN
#undef SEAM
#undef VBID
#undef VGRP
#undef GEMM5_PHASE
#undef FLIP
#undef LANE_VARS
#undef opq_tid
}

extern "C" void kernel_launch(void* const* d_in, const int* in_sizes, int n_in, void* d_out, int out_size, void* d_ws, size_t ws_size, hipStream_t stream) {
    static int grid = 0;
    if (grid == 0) {
        if (n_in != 19 || out_size != M * D_MODEL || ws_size < WS_END) { fprintf(stderr, "kernel_launch: unexpected shapes (n_in %d out %d ws %zu)\n", n_in, out_size, ws_size); grid = -1; return; }
        int dev = 0, cus = 0, per_cu = 0;
        if (hipGetDevice(&dev) != hipSuccess || hipDeviceGetAttribute(&cus, hipDeviceAttributeMultiprocessorCount, dev) != hipSuccess) { grid = -1; return; }
        if (hipFuncSetAttribute((const void*)mega, hipFuncAttributeMaxDynamicSharedMemorySize, LDS_BYTES) != hipSuccess) { fprintf(stderr, "kernel_launch: hipFuncSetAttribute failed\n"); grid = -1; return; }
        if (hipOccupancyMaxActiveBlocksPerMultiprocessor(&per_cu, (const void*)mega, NTHREADS, LDS_BYTES) != hipSuccess || per_cu < 1) { fprintf(stderr, "kernel_launch: occupancy query says %d\n", per_cu); }
        (void)hipGetLastError();
        grid = cus >= 256 ? 256 : cus;
    }
    if (grid < 0) return;
    unsigned char* ws = (unsigned char*)d_ws;
    (void)hipMemsetAsync(ws + WS_CTL, 0, CTL_ZERO_BYTES, stream);
    Args a{};
    for (int i = 0; i < 19; ++i) a.in[i] = (const float*)d_in[i];
    a.out = (float*)d_out; a.ws = ws; a.li = 0; a.pad = 0;
    a.ph_lo = 0; a.ph_hi = N_PHASES;
    hipLaunchKernelGGL(mega, dim3(grid), dim3(NTHREADS), LDS_BYTES, stream, a);
}
```
